# Optimizing an MI355X kernel written in HIP

```python
import jax, jax.numpy as jnp
from jax import lax
import numpy as np

D_MODEL = 2048
BATCH = 4
SEQ = 2048
DEPTH = 2

CHUNK = 64
N_META = 16
FRONT_PAD = CHUNK - N_META
Q_BLOCK = 128
EPS = 1e-6

RET_WIDTH = D_MODEL // 2
RET_DV = 128
RET_HEADS = RET_WIDTH // RET_DV
RET_DK = 128
RET_QK = RET_HEADS * RET_DK

DIFF_WIDTH = D_MODEL // 2
DIFF_DH = 64
DIFF_DV = 2 * DIFF_DH
DIFF_HEADS = DIFF_WIDTH // DIFF_DV
DIFF_QK = DIFF_HEADS * 2 * DIFF_DH

MIX_WIDTH = RET_WIDTH + DIFF_WIDTH
IN_SIZES = [RET_QK, RET_QK, RET_WIDTH, RET_WIDTH, DIFF_QK, DIFF_QK, DIFF_WIDTH, DIFF_WIDTH]
IN_WIDTH = sum(IN_SIZES)

kernel_name = 'hymba_retention_diffattn_chunk_causal'


def rms_norm(x, g):
    xf = x.astype(jnp.float32)
    y = xf * lax.rsqrt(jnp.mean(xf * xf, axis=-1, keepdims=True) + EPS)
    return (y * g).astype(x.dtype)


def head_layer_norm(o, g):
    B, L, H, E = o.shape
    of = o.astype(jnp.float32)
    mu = jnp.mean(of, axis=-1, keepdims=True)
    var = jnp.mean((of - mu) ** 2, axis=-1, keepdims=True)
    y = ((of - mu) * lax.rsqrt(var + EPS)).reshape(B, L, H * E)
    return (y * g).astype(o.dtype)


def head_rms_norm(o, g):
    B, L, H, E = o.shape
    of = o.astype(jnp.float32)
    y = (of * lax.rsqrt(jnp.mean(of * of, axis=-1, keepdims=True) + EPS)).reshape(B, L, H * E)
    return (y * g).astype(o.dtype)


def retention(q, k, v, valid):
    B, L, H, DK = q.shape
    DV = v.shape[-1]
    N = L // CHUNK
    log_g = jnp.log(1.0 - 2.0 ** (-5.0 - jnp.arange(H, dtype=jnp.float32)))
    k = k * (valid[None, :, None, None].astype(k.dtype) * (DK ** -0.5))
    qc = q.reshape(B, N, CHUNK, H, DK)
    kc = k.reshape(B, N, CHUNK, H, DK)
    vc = v.reshape(B, N, CHUNK, H, DV)
    idx = jnp.arange(CHUNK, dtype=jnp.float32)
    dist = jnp.abs(idx[:, None] - idx[None, :])
    dmat = jnp.exp(log_g[:, None, None] * dist).astype(v.dtype)
    s = jnp.einsum('bnthd,bnshd->bnhts', qc, kc) * dmat
    intra = jnp.einsum('bnhts,bnshe->bnthe', s, vc)
    zeta = jnp.exp(log_g[:, None] * (CHUNK - 1 - idx)[None, :]).astype(v.dtype)
    kv = jnp.einsum('bnshd,hs,bnshe->bnhde', kc, zeta, vc)
    chunk_decay = jnp.exp(log_g * CHUNK).astype(v.dtype)[None, :, None, None]

    def step(state, kv_n):
        return chunk_decay * state + kv_n, state

    init = jnp.zeros((B, H, DK, DV), kv.dtype)
    _, prev = lax.scan(step, init, jnp.moveaxis(kv, 1, 0))
    prev = jnp.moveaxis(prev, 0, 1)
    xi = jnp.exp(log_g[:, None] * (idx + 1.0)[None, :]).astype(v.dtype)
    cross = jnp.einsum('bnthd,bnhde,ht->bnthe', qc, prev, xi)
    return (intra + cross).reshape(B, L, H, DV)


def diff_attention(q, k, v, valid, lam):
    B, L, H, _, DH = q.shape
    nb = L // Q_BLOCK
    slopes = 2.0 ** (-8.0 * jnp.arange(1, H + 1, dtype=jnp.float32) / H)
    kpos = jnp.arange(L)
    kchunk = kpos // CHUNK
    qb_all = jnp.moveaxis(q.reshape(B, nb, Q_BLOCK, H, 2, DH), 1, 0)
    starts = jnp.arange(nb, dtype=jnp.int32) * Q_BLOCK
    scale = DH ** -0.5

    def block(args):
        qb, start = args
        qpos = start + jnp.arange(Q_BLOCK, dtype=jnp.int32)
        dist = jnp.abs(qpos[:, None] - kpos[None, :]).astype(jnp.float32)
        bias = -slopes[:, None, None] * dist
        allowed = (kchunk[None, :] <= (qpos // CHUNK)[:, None]) & valid[None, :]
        s = jnp.einsum('bqhcd,bkhcd->bhcqk', qb, k).astype(jnp.float32) * scale
        s = jnp.where(allowed[None, None, None], s + bias[None, :, None], -jnp.inf)
        p = jax.nn.softmax(s, axis=-1)
        a = p[:, :, 0] - lam * p[:, :, 1]
        return jnp.einsum('bhqk,bkhe->bqhe', a.astype(v.dtype), v)

    o = lax.map(block, (qb_all, starts))
    return jnp.moveaxis(o, 0, 1).reshape(B, L, H, v.shape[-1])


def hybrid_layer(h, valid, g_norm, w_in, w_out, g_ret, g_diff, lq1, lk1, lq2, lk2, lam_init):
    B, L, _ = h.shape
    u = rms_norm(h, g_norm)
    proj = u @ w_in
    offs = np.cumsum(IN_SIZES)[:-1].tolist()
    rq, rk, rv, rgate, dq, dk, dv, dgate = jnp.split(proj, offs, axis=-1)
    r = retention(rq.reshape(B, L, RET_HEADS, RET_DK), rk.reshape(B, L, RET_HEADS, RET_DK),
                  rv.reshape(B, L, RET_HEADS, RET_DV), valid)
    r = head_layer_norm(r, g_ret) * jax.nn.silu(rgate)
    lam = (jnp.exp(jnp.sum(lq1.astype(jnp.float32) * lk1.astype(jnp.float32)))
           - jnp.exp(jnp.sum(lq2.astype(jnp.float32) * lk2.astype(jnp.float32))) + lam_init)
    d = diff_attention(dq.reshape(B, L, DIFF_HEADS, 2, DIFF_DH), dk.reshape(B, L, DIFF_HEADS, 2, DIFF_DH),
                       dv.reshape(B, L, DIFF_HEADS, DIFF_DV), valid, lam)
    d = head_rms_norm(d, g_diff) * (1.0 - lam_init) * jax.nn.silu(dgate)
    y = jnp.concatenate([r, d], axis=-1) @ w_out
    return h + y


def setup_inputs(seed: int = 0) -> dict:
    key = jax.random.key(seed)
    ks = jax.random.split(key, 13)
    f32 = jnp.float32
    return {
        'x': jax.random.normal(ks[0], (BATCH, SEQ, D_MODEL), f32),
        'meta_tokens': jax.random.normal(ks[1], (N_META, D_MODEL), f32),
        'norm_g': 1.0 + 0.01 * jax.random.normal(ks[2], (DEPTH, D_MODEL), f32),
        'w_in': jax.random.normal(ks[3], (DEPTH, D_MODEL, IN_WIDTH), f32) * D_MODEL ** -0.5,
        'w_out': jax.random.normal(ks[4], (DEPTH, MIX_WIDTH, D_MODEL), f32) * MIX_WIDTH ** -0.5,
        'ret_norm_g': 1.0 + 0.01 * jax.random.normal(ks[5], (DEPTH, RET_WIDTH), f32),
        'diff_norm_g': 1.0 + 0.01 * jax.random.normal(ks[6], (DEPTH, DIFF_WIDTH), f32),
        'lambda_q1': 0.1 * jax.random.normal(ks[7], (DEPTH, DIFF_DH), f32),
        'lambda_k1': 0.1 * jax.random.normal(ks[8], (DEPTH, DIFF_DH), f32),
        'lambda_q2': 0.1 * jax.random.normal(ks[9], (DEPTH, DIFF_DH), f32),
        'lambda_k2': 0.1 * jax.random.normal(ks[10], (DEPTH, DIFF_DH), f32),
        'final_norm_g': 1.0 + 0.01 * jax.random.normal(ks[11], (D_MODEL,), f32),
    }


def reference(x, meta_tokens, norm_g, w_in, w_out, ret_norm_g, diff_norm_g,
              lambda_q1, lambda_k1, lambda_q2, lambda_k2, final_norm_g):
    B, S, D = x.shape
    total = CHUNK + S
    Lp = -(-total // Q_BLOCK) * Q_BLOCK
    meta = jnp.broadcast_to(meta_tokens[None].astype(x.dtype), (B, N_META, D))
    h = jnp.concatenate([jnp.zeros((B, FRONT_PAD, D), x.dtype), meta, x,
                         jnp.zeros((B, Lp - total, D), x.dtype)], axis=1)
    pos = jnp.arange(Lp)
    valid = (pos >= FRONT_PAD) & (pos < total)
    for i in range(DEPTH):
        lam_init = 0.8 - 0.6 * float(np.exp(-0.3 * i))
        h = hybrid_layer(h, valid, norm_g[i], w_in[i], w_out[i], ret_norm_g[i], diff_norm_g[i],
                         lambda_q1[i], lambda_k1[i], lambda_q2[i], lambda_k2[i], lam_init)
    h = rms_norm(h, final_norm_g)
    return h[:, CHUNK:CHUNK + S]
```

```cpp
#include <hip/hip_runtime.h>
#include <hip/hip_cooperative_groups.h>
#include <cstdio>
namespace cg = cooperative_groups;

typedef unsigned short bf16_t;
typedef short bf16x8 __attribute__((ext_vector_type(8)));
typedef short s16x4 __attribute__((ext_vector_type(4)));
typedef float f32x4 __attribute__((ext_vector_type(4)));
typedef float f32x2 __attribute__((ext_vector_type(2)));
typedef unsigned u32x4 __attribute__((ext_vector_type(4)));
typedef unsigned u32x2 __attribute__((ext_vector_type(2)));
typedef __bf16 bf16x2_t __attribute__((ext_vector_type(2)));
#define DI __device__ __forceinline__
#define LAS __attribute__((address_space(3)))
#define MFMA16(a, b, c) __builtin_amdgcn_mfma_f32_16x16x32_bf16((a), (b), (c), 0, 0, 0)

constexpr int LROW = 2112;
constexpr int MROWS = 4 * LROW;
constexpr int DM = 2048;
constexpr int NIN = 8192;
constexpr int NCH = 33;
constexpr float LOG2E = 1.4426950408889634f;
constexpr int SMEM_BYTES = 147456 + 64;

struct Params {
  const float *x, *meta, *norm_g, *w_in, *w_out, *ret_g, *diff_g, *lq1, *lk1, *lq2, *lk2, *fin_g;
  float* out;
  bf16_t *WinT, *WoutT, *hb, *proj, *T, *mix, *ST;
  float *h, *ss, *lam, *P2;
  unsigned* ctr;
  unsigned* bar;
};

DI Params load_params() {
  const Params __attribute__((address_space(4)))* q = (const Params __attribute__((address_space(4)))*)__builtin_amdgcn_kernarg_segment_ptr();
  asm volatile("" : "+s"(q));
  Params r; __builtin_memcpy(&r, (const void*)q, sizeof(Params)); return r;
}
DI unsigned pk2(float a, float b) { f32x2 v = {a, b}; bf16x2_t r = __builtin_convertvector(v, bf16x2_t); return __builtin_bit_cast(unsigned, r); }
DI float bf2f(unsigned v16) { return __uint_as_float(v16 << 16); }
DI float bflo(unsigned u) { return __uint_as_float(u << 16); }
DI float bfhi(unsigned u) { return __uint_as_float(u & 0xffff0000u); }
DI int opaque_tid() { int t = threadIdx.x; asm volatile("" : "+v"(t)); return t; }
#define EXP2(x) __builtin_amdgcn_exp2f(x)
DI float xmax16(float x) { const u32x2 r = __builtin_amdgcn_permlane16_swap(__float_as_uint(x), __float_as_uint(x), false, false); return fmaxf(__uint_as_float(r[0]), __uint_as_float(r[1])); }
DI float xmax32(float x) { const u32x2 r = __builtin_amdgcn_permlane32_swap(__float_as_uint(x), __float_as_uint(x), false, false); return fmaxf(__uint_as_float(r[0]), __uint_as_float(r[1])); }
DI float silu(float v) { return v * __builtin_amdgcn_rcpf(1.f + __expf(-v)); }

DI int lds_byte(int r, int c) { int st = (r >> 4) * 2 + (c >> 5), rr = r & 15, cc = c & 31, ob = rr * 64 + cc * 2; return st * 1024 + (ob ^ (((ob >> 9) & 1) << 5)); }
DI int perm32(int rho) { const int n = rho >> 4, i = rho & 15; return 8 * (i >> 2) + 4 * n + (i & 3); }
DI void stage_rc(int b, int& R, int& C) { int st = b / 1024, sb = b % 1024, swz = sb ^ (((sb >> 9) & 1) << 5); R = (st >> 1) * 16 + swz / 64; C = (st & 1) * 32 + (swz % 64) / 2; }

DI void prep_weights(const Params& p, LAS unsigned char* lds, int ubeg, int uend, int wgi, int wgn, bool do_lam) {
  const int tid = opaque_tid();
  const int NTOT = uend;
  const int lrow = tid >> 6, c4 = (tid & 63) * 4;
  f32x4 r[8];
#define PREP_DECODE(u) const float* src; bf16_t* dst; int N; const float* g; int kt, ntile; \
    { const int _l = (u) >= 1280 ? 1 : 0, _v = (u) - _l * 1280; \
      if (_v < 1024) { kt = _v >> 5; ntile = _v & 31; src = p.w_in + (size_t)_l * DM * NIN; dst = p.WinT + (size_t)_l * NIN * DM; N = NIN; g = p.norm_g + _l * DM; } \
      else { const int q = _v - 1024; kt = q >> 3; ntile = q & 7; src = p.w_out + (size_t)_l * DM * DM; dst = p.WoutT + (size_t)_l * DM * DM; N = DM; g = nullptr; } } \
    const int k0 = kt * 64, n0 = ntile * 256;
#define PREP_LOAD(u) do { PREP_DECODE(u) (void)dst; _Pragma("unroll") for (int i = 0; i < 8; ++i) { const int kk = lrow + 8 * i; \
    const f32x4 v = *(const f32x4*)(src + (size_t)(k0 + kk) * N + n0 + c4); const float gg = g ? g[k0 + kk] : 1.f; r[i] = v * gg; } } while (0)
  int u = ubeg + wgi;
  if (u < NTOT) PREP_LOAD(u);
  for (; u < NTOT; u += wgn) {
#pragma unroll
    for (int i = 0; i < 8; ++i) *(LAS f32x4*)(lds + ((lrow + 8 * i) * 260 + c4) * 4) = r[i];
    __syncthreads();
    const int un = u + wgn;
    if (un < NTOT) PREP_LOAD(un);
    {
      PREP_DECODE(u) (void)src; (void)N; (void)g;
      const int n = tid >> 1, kh = (tid & 1) * 32;
      bf16_t* op = dst + (size_t)(n0 + n) * DM + k0 + kh;
#pragma unroll
      for (int q = 0; q < 4; ++q) {
        float f[8];
#pragma unroll
        for (int j = 0; j < 8; ++j) f[j] = *(const LAS float*)(lds + ((kh + q * 8 + j) * 260 + n) * 4);
        const u32x4 o = {pk2(f[0], f[1]), pk2(f[2], f[3]), pk2(f[4], f[5]), pk2(f[6], f[7])};
        *(u32x4*)(op + q * 8) = o;
      }
    }
    __syncthreads();
  }
#undef PREP_DECODE
#undef PREP_LOAD
  if (do_lam && blockIdx.x == 0 && tid < 64) {
    for (int l = 0; l < 2; ++l) {
      float a = p.lq1[l * 64 + tid] * p.lk1[l * 64 + tid], b = p.lq2[l * 64 + tid] * p.lk2[l * 64 + tid];
#pragma unroll
      for (int off = 32; off >= 1; off >>= 1) { a += __shfl_xor(a, off); b += __shfl_xor(b, off); }
      float li = 0.8f - 0.6f * expf(-0.3f * (float)l);
      if (tid == 0) p.lam[l] = expf(a) - expf(b) + li;
    }
  }
}

template <int MODE> DI void rownorm(const Params& p) {
  const int tid = opaque_tid(); const int wave = tid >> 6, lane = tid & 63;
  const int nw = gridDim.x * 8;
  for (int row = (MODE == 1 ? 8192 : 0) + blockIdx.x * 8 + wave; row < MROWS; row += nw) {
    const int b = row / LROW, pos = row - b * LROW;
    if (MODE == 2 && pos < 64) continue;
    const float* src;
    if (MODE <= 1) src = pos < 48 ? nullptr : (pos < 64 ? p.meta + (size_t)(pos - 48) * DM : p.x + ((size_t)b * 2048 + (pos - 64)) * DM);
    else src = p.h + (size_t)row * DM;
    float4 v[8]; float ss = 0.f;
#pragma unroll
    for (int i = 0; i < 8; ++i) {
      v[i] = src ? *(const float4*)(src + i * 256 + lane * 4) : make_float4(0.f, 0.f, 0.f, 0.f);
      if (MODE != 0 && row >= 8192) {
#pragma unroll
        for (int s = 0; s < 8; ++s) { const float4 q = *(const float4*)(p.P2 + ((size_t)s * 256 + (row - 8192)) * DM + i * 256 + lane * 4); v[i].x += q.x; v[i].y += q.y; v[i].z += q.z; v[i].w += q.w; }
      }
      ss += v[i].x * v[i].x + v[i].y * v[i].y + v[i].z * v[i].z + v[i].w * v[i].w;
    }
#pragma unroll
    for (int off = 32; off >= 1; off >>= 1) ss += __shfl_xor(ss, off);
    const float rs = rsqrtf(ss * (1.f / 2048.f) + 1e-6f);
    if (MODE < 2) {
#pragma unroll
      for (int i = 0; i < 8; ++i) {
        if (MODE == 1) *(float4*)(p.h + (size_t)row * DM + i * 256 + lane * 4) = v[i];
        uint2 o; o.x = pk2(v[i].x, v[i].y); o.y = pk2(v[i].z, v[i].w);
        *(uint2*)(p.hb + (size_t)row * DM + i * 256 + lane * 4) = o;
      }
      if (lane == 0) p.ss[(MODE == 0 ? 0 : 1) * MROWS + row] = ss;
    } else {
      float* dst = p.out + ((size_t)b * 2048 + (pos - 64)) * DM;
#pragma unroll
      for (int i = 0; i < 8; ++i) {
        float4 g = *(const float4*)(p.fin_g + i * 256 + lane * 4);
        float4 o; o.x = v[i].x * rs * g.x; o.y = v[i].y * rs * g.y; o.z = v[i].z * rs * g.z; o.w = v[i].w * rs * g.w;
        *(float4*)(dst + i * 256 + lane * 4) = o;
      }
    }
  }
}

constexpr int GK = 2048, GBK = 64, GHALF = 128, GHTB = GHALF * GBK * 2;
constexpr size_t TSTEP = (size_t)256 * GK * 2;
struct Unit { int mt, nt, tr, k0, nkt; };

template <class Epi, class Sched>
DI void gemm_phase(LAS unsigned char* lds, const Sched& S, const Epi& E) {
  const int tid = opaque_tid(), wid = __builtin_amdgcn_readfirstlane(tid >> 6), lane = tid & 63, wr = wid >> 2, wc = wid & 3, fr = lane & 15, fq = lane >> 4;
  constexpr int K = GK;
  unsigned voffA[2], voffB[2];
#pragma unroll
  for (int i = 0; i < 2; ++i) { int R, C; stage_rc(tid * 16 + i * 8192, R, C); const int Rb = (R & ~31) + perm32(R & 31);
    voffA[i] = (unsigned)(R * K + C) * 2u; voffB[i] = (unsigned)(Rb * K + C) * 2u; }
  const size_t kstep = (size_t)(GBK * 2);
  const size_t hstep = (size_t)GHALF * K * 2;
  const unsigned ldsw = (unsigned)wid * 1024u;
  const int aoff = lds_byte(wr * 64 + fr, fq * 8), boff = lds_byte(wc * 32 + fr, fq * 8);
#define G_SA(b, h) (((b) * 2 + (h)) * GHTB)
#define G_SB(b, h) ((4 + (b) * 2 + (h)) * GHTB)
#define G_STAGE(bufoff, gbase, voff) do { _Pragma("unroll") for (int _i = 0; _i < 2; ++_i) \
    __builtin_amdgcn_global_load_lds((const unsigned*)((const char*)(gbase) + voff[_i]), (LAS unsigned*)(lds + (bufoff) + ldsw + _i * 8192), 16, 0, 0); } while (0)
#define G_LDA(dst, b, h) do { _Pragma("unroll") for (int m = 0; m < 4; ++m) _Pragma("unroll") for (int k = 0; k < 2; ++k) dst[m][k] = *(const LAS bf16x8*)(lds + G_SA(b, h) + aoff + m * 2048 + k * 1024); } while (0)
#define G_LDB(dst, b, h) do { _Pragma("unroll") for (int n = 0; n < 2; ++n) _Pragma("unroll") for (int k = 0; k < 2; ++k) dst[n][k] = *(const LAS bf16x8*)(lds + G_SB(b, h) + boff + n * 2048 + k * 1024); } while (0)
#define G_MMA(ai, bj, At, Bx) do { __builtin_amdgcn_s_setprio(1); _Pragma("unroll") for (int m = 0; m < 4; ++m) _Pragma("unroll") for (int n = 0; n < 2; ++n) _Pragma("unroll") for (int k = 0; k < 2; ++k) \
    acc[ai][bj][m][n] = MFMA16(Bx[n][k], At[m][k], acc[ai][bj][m][n]); __builtin_amdgcn_s_setprio(0); } while (0)
#define G_WAIT_V(n) asm volatile("s_waitcnt vmcnt(" #n ")" ::: "memory")
#define G_WAIT_L(n) asm volatile("s_waitcnt lgkmcnt(" #n ")" ::: "memory")
#define G_BAR __builtin_amdgcn_s_barrier()
#define G_SCHED __builtin_amdgcn_sched_barrier(0)
  Unit cur, nxt; int ui = 0;
  if (!S.next(0, cur)) return;
  f32x4 acc[2][2][4][2];
  E.init(acc, cur, wr, wc, fr, fq);
  bf16x8 At[4][2], B0[2][2], B1[2][2];
  const char* cA = S.pa(cur); const char* cB = S.pb(cur);
  G_STAGE(G_SB(0, 0), cB, voffB); G_STAGE(G_SA(0, 0), cA, voffA); G_STAGE(G_SB(0, 1), cB + hstep, voffB); G_STAGE(G_SA(0, 1), cA + hstep, voffA);
  if (wr == 1) G_BAR;
  G_WAIT_V(4); G_BAR;
  G_STAGE(G_SB(1, 0), cB + kstep, voffB); G_STAGE(G_SA(1, 0), cA + kstep, voffA); G_STAGE(G_SB(1, 1), cB + hstep + kstep, voffB);
  G_WAIT_V(6); G_BAR;
  for (;;) {
    const bool has_next = S.next(ui + 1, nxt);
    const char* nA = has_next ? S.pa(nxt) : cA; const char* nB = has_next ? S.pb(nxt) : cB;
    const int nt = cur.nkt;
    for (int t = 0; t < nt; t += 2) {
      const bool last = (t == nt - 2);
      const char* a1 = cA + (size_t)(t + 1) * kstep;
      const char* a2 = last ? nA : cA + (size_t)(t + 2) * kstep; const char* b2 = last ? nB : cB + (size_t)(t + 2) * kstep;
      const char* a3 = a2 + kstep; const char* b3 = b2 + kstep;
      G_LDB(B0, 0, 0); G_SCHED; G_LDA(At, 0, 0); G_STAGE(G_SA(1, 1), a1 + hstep, voffA);
      G_WAIT_L(8); G_BAR; G_WAIT_L(0); G_MMA(0, 0, At, B0); G_BAR; G_SCHED;
      G_LDB(B1, 0, 1); G_STAGE(G_SB(0, 0), b2, voffB);
      G_BAR; G_WAIT_L(0); G_MMA(0, 1, At, B1); G_BAR;
      G_LDA(At, 0, 1); G_STAGE(G_SA(0, 0), a2, voffA);
      G_BAR; G_WAIT_L(0); G_MMA(1, 0, At, B0); G_BAR; G_SCHED;
      G_STAGE(G_SB(0, 1), b2 + hstep, voffB);
      G_WAIT_V(6); G_BAR; G_MMA(1, 1, At, B1); G_BAR;
      G_LDB(B0, 1, 0); G_SCHED; G_LDA(At, 1, 0); G_STAGE(G_SA(0, 1), a2 + hstep, voffA);
      G_WAIT_L(8); G_BAR; G_WAIT_L(0); G_MMA(0, 0, At, B0); G_BAR; G_SCHED;
      G_LDB(B1, 1, 1); G_STAGE(G_SB(1, 0), b3, voffB);
      G_BAR; G_WAIT_L(0); G_MMA(0, 1, At, B1); G_BAR;
      G_LDA(At, 1, 1); G_STAGE(G_SA(1, 0), a3, voffA);
      G_BAR; G_WAIT_L(0); G_MMA(1, 0, At, B0); G_BAR; G_SCHED;
      G_STAGE(G_SB(1, 1), b3 + hstep, voffB);
      G_WAIT_V(6); G_BAR; G_MMA(1, 1, At, B1); G_BAR;
    }
    E(acc, cur, wr, wc, fr, fq);
    if (!has_next) break;
    cur = nxt; cA = nA; cB = nB; ++ui;
    E.init(acc, cur, wr, wc, fr, fq);
  }
  G_WAIT_V(0);
  if (wr == 0) G_BAR;
  G_BAR;
}

#define XB_TMO      128
#define XB_XCNT(j)  (256  + 64 * (j))
#define XB_XSUB(j)  (1280 + 64 * (j))
#define XB_XGEN(j)  (2304 + 64 * (j))
#define XB_TOP      3328
#define XB_TOPGEN   3392
#define XCD_BAR_WORDS 3456
#define XB_SPIN_CAP (1u << 18)
DI unsigned xb_ld(unsigned* p) { return __hip_atomic_load(p, __ATOMIC_RELAXED, __HIP_MEMORY_SCOPE_AGENT); }
DI unsigned xb_add(unsigned* p, unsigned v) { return __hip_atomic_fetch_add(p, v, __ATOMIC_RELAXED, __HIP_MEMORY_SCOPE_AGENT); }
DI unsigned xb_xcc_id() { return (unsigned)__builtin_amdgcn_s_getreg((3 << 11) | 20) & 0xFu; }
#define XB_SPIN(cond, bar) do { unsigned _sp = 0; while (cond) { __builtin_amdgcn_s_sleep(1); \
    if ((++_sp & 255u) == 0u) { if (xb_ld(&(bar)[XB_TMO])) break; if (_sp > XB_SPIN_CAP) { atomicAdd(&(bar)[XB_TMO], 1u); break; } } } } while (0)
struct XcdBarrier { unsigned* bar; unsigned x; volatile LAS unsigned* st; };
DI XcdBarrier xcd_barrier_post(unsigned* bar, volatile LAS unsigned* st) {
  XcdBarrier b; b.bar = bar; b.x = xb_xcc_id(); b.st = st;
  if (threadIdx.x == 0) (void)xb_add(&bar[XB_XCNT(b.x)], 1u);
  return b;
}
DI void xcd_barrier_complete(unsigned* bar, unsigned x, unsigned& nloc, unsigned& nx) {
  const unsigned G = gridDim.x * gridDim.y * gridDim.z;
  unsigned sum, cnt, mine, sp = 0u;
  for (;;) {
    sum = 0u; cnt = 0u; mine = 0u;
#pragma unroll
    for (unsigned j = 0; j < 16; ++j) { const unsigned c = xb_ld(&bar[XB_XCNT(j)]); sum += c; cnt += (c > 0u) ? 1u : 0u; mine = (j == x) ? c : mine; }
    if (sum == G) break;
    __builtin_amdgcn_s_sleep(1);
    if ((++sp & 255u) == 0u) { if (xb_ld(&bar[XB_TMO])) break; if (sp > XB_SPIN_CAP) { atomicAdd(&bar[XB_TMO], 1u); break; } }
  }
  nloc = mine > 0u ? mine : 1u; nx = cnt > 0u ? cnt : 1u;
}
DI void xcd_barrier(const XcdBarrier& b) {
  asm volatile("s_waitcnt vmcnt(0)" ::: "memory");
  __syncthreads();
  if (threadIdx.x == 0) {
    unsigned* bar = b.bar;
    __builtin_amdgcn_s_waitcnt(0);
    unsigned nloc = b.st[0], nx = b.st[1];
    if (nloc == 0u) { xcd_barrier_complete(bar, b.x, nloc, nx); b.st[0] = nloc; b.st[1] = nx; }
    const unsigned old = xb_add(&bar[XB_XSUB(b.x)], 1u);
    const unsigned gen = old / nloc;
    if (old + 1u == (gen + 1u) * nloc) {
      __builtin_amdgcn_fence(__ATOMIC_RELEASE, "agent");
      asm volatile("s_waitcnt vmcnt(0)" ::: "memory");
      const unsigned og = xb_add(&bar[XB_TOP], 1u);
      const unsigned tg = og / nx;
      if (og + 1u == (tg + 1u) * nx) xb_add(&bar[XB_TOPGEN], 1u);
      else XB_SPIN(xb_ld(&bar[XB_TOPGEN]) == tg, bar);
      __builtin_amdgcn_fence(__ATOMIC_ACQUIRE, "agent");
      xb_add(&bar[XB_XGEN(b.x)], 1u);
      asm volatile("s_waitcnt vmcnt(0)" ::: "memory");
    } else {
      XB_SPIN(xb_ld(&bar[XB_XGEN(b.x)]) == gen, bar);
      __builtin_amdgcn_fence(__ATOMIC_ACQUIRE, "agent");
      asm volatile("s_waitcnt vmcnt(0)" ::: "memory");
    }
  }
  __syncthreads();
}

DI void tile_map(int wgid, int nM, int nN, int& pm, int& pn) {
  const int nwg = nM * nN;
  { int q = nwg / 8, r = nwg % 8, xcd = wgid % 8, off = wgid / 8; wgid = (xcd < r ? xcd * (q + 1) : r * (q + 1) + (xcd - r) * q) + off; }
  const int nig = 8 * nN, gid = wgid / nig, fm = gid * 8, gsz = min(nM - fm, 8);
  pm = fm + ((wgid % nig) % gsz); pn = (wgid % nig) / gsz;
}

struct Sched1 {
  const bf16_t* hb; const bf16_t* W; int ubeg, uend;
  DI bool next(int i, Unit& u) const {
    const int U = ubeg + i * (int)gridDim.x + (int)blockIdx.x; if (U >= uend) return false;
    int pm, pn;
    if (U < 928) tile_map(U, 29, 32, pm, pn);
    else if (U < 1024) { const int q = U - 928, c = q % 24; pm = 29 + q / 24; pn = c < 12 ? c : c + 4; }
    else { const int q = U - 1024, g = q & 7; pm = 29 + (q >> 3); pn = g < 4 ? 12 + g : 24 + g; }
    u.mt = pm; u.nt = pn; u.k0 = 0; u.nkt = 32; const int g = pn >> 2; u.tr = (g == 1 || g == 2 || g == 6) ? 1 : 0; return true;
  }
  DI const char* pa(const Unit& u) const { return u.tr ? (const char*)W + (size_t)u.nt * TSTEP : (const char*)hb + (size_t)u.mt * TSTEP; }
  DI const char* pb(const Unit& u) const { return u.tr ? (const char*)hb + (size_t)u.mt * TSTEP : (const char*)W + (size_t)u.nt * TSTEP; }
};
struct Sched2 {
  const bf16_t* mix; const bf16_t* W;
  DI bool next(int i, Unit& u) const {
    const int U = i * (int)gridDim.x + (int)blockIdx.x; if (U >= 256 + 64) return false;
    if (U < 256) { int pm, pn; tile_map(U, 32, 8, pm, pn); u.mt = pm; u.nt = pn; u.tr = 0; u.k0 = 0; u.nkt = 32; }
    else { const int j = U - 256; u.mt = 32; u.nt = j >> 3; u.tr = 1 + (j & 7); u.k0 = (j & 7) * 256; u.nkt = 4; }
    return true;
  }
  DI const char* pa(const Unit& u) const { return (const char*)mix + (size_t)u.mt * TSTEP + (size_t)u.k0 * 2; }
  DI const char* pb(const Unit& u) const { return (const char*)W + (size_t)u.nt * TSTEP + (size_t)u.k0 * 2; }
};

DI void acc_zero(f32x4 (&acc)[2][2][4][2]) {
#pragma unroll
  for (int a = 0; a < 2; ++a)
#pragma unroll
    for (int b = 0; b < 2; ++b)
#pragma unroll
      for (int m = 0; m < 4; ++m)
#pragma unroll
        for (int n = 0; n < 2; ++n) acc[a][b][m][n] = (f32x4){0.f, 0.f, 0.f, 0.f};
}
struct Epi1 {
  bf16_t* proj; bf16_t* T; const float* ss;
  DI void init(f32x4 (&acc)[2][2][4][2], const Unit&, int, int, int, int) const { acc_zero(acc); }
  DI void operator()(const f32x4 (&acc)[2][2][4][2], const Unit& u, int wr, int wc, int fr, int fq) const {
    const int g = u.nt >> 2;
    if (!u.tr) {
      const float sc = (g == 4) ? 0.125f * LOG2E : 1.f;
      const int n0 = u.nt * 256 + wc * 32 + fq * 8;
#pragma unroll
      for (int ai = 0; ai < 2; ++ai)
#pragma unroll
        for (int mi = 0; mi < 4; ++mi) {
          const int m = u.mt * 256 + ai * 128 + wr * 64 + mi * 16 + fr;
          const float rs = rsqrtf(ss[m] * (1.f / 2048.f) + 1e-6f) * sc;
          bf16_t* rowp = proj + (size_t)m * NIN + n0;
#pragma unroll
          for (int bj = 0; bj < 2; ++bj) {
            const f32x4 a = acc[ai][bj][mi][0], c = acc[ai][bj][mi][1];
            const u32x4 o = {pk2(a[0] * rs, a[1] * rs), pk2(a[2] * rs, a[3] * rs), pk2(c[0] * rs, c[1] * rs), pk2(c[2] * rs, c[3] * rs)};
            *(u32x4*)(rowp + bj * 128) = o;
          }
        }
    } else {
      const int tbase = (g == 1 ? 0 : (g == 2 ? 1024 : 2048)) - g * 1024;
#pragma unroll
      for (int bj = 0; bj < 2; ++bj) {
        const int m8 = u.mt * 256 + bj * 128 + wc * 32 + fq * 8;
        const int b = m8 / LROW, pos = m8 - b * LROW;
        const f32x4 q0 = *(const f32x4*)(ss + m8), q1 = *(const f32x4*)(ss + m8 + 4);
        float rs[8];
#pragma unroll
        for (int j = 0; j < 4; ++j) { rs[j] = rsqrtf(q0[j] * (1.f / 2048.f) + 1e-6f); rs[4 + j] = rsqrtf(q1[j] * (1.f / 2048.f) + 1e-6f); }
        if (g == 1) {
#pragma unroll
          for (int j = 0; j < 8; ++j) rs[j] = (pos + j >= 48) ? rs[j] * 0.08838834764831845f : 0.f;
        }
#pragma unroll
        for (int ai = 0; ai < 2; ++ai)
#pragma unroll
          for (int mi = 0; mi < 4; ++mi) {
            const int col = u.nt * 256 + ai * 128 + wr * 64 + mi * 16 + fr;
            const f32x4 a = acc[ai][bj][mi][0], c = acc[ai][bj][mi][1];
            float v[8] = {a[0] * rs[0], a[1] * rs[1], a[2] * rs[2], a[3] * rs[3], c[0] * rs[4], c[1] * rs[5], c[2] * rs[6], c[3] * rs[7]};
            if (g == 1) {
              const int hh = (col - 1024) >> 7;
              const float l2g = log2f(1.f - exp2f(-5.f - (float)hh));
              const int pz = 63 - (pos & 63);
#pragma unroll
              for (int j = 0; j < 8; ++j) v[j] *= exp2f(l2g * (float)(pz - j));
            }
            const u32x4 o = {pk2(v[0], v[1]), pk2(v[2], v[3]), pk2(v[4], v[5]), pk2(v[6], v[7])};
            *(u32x4*)(T + ((size_t)(b * 3072 + tbase + col)) * LROW + pos) = o;
          }
      }
    }
  }
};
struct Epi2 {
  float* h; float* P2; bf16_t* hb; float* ssn; const float* x; const float* meta;
  DI void init(f32x4 (&acc)[2][2][4][2], const Unit& u, int wr, int wc, int fr, int fq) const {
    if (u.tr) { acc_zero(acc); return; }
    const int n0 = u.nt * 256 + wc * 32 + fq * 8;
#pragma unroll
    for (int ai = 0; ai < 2; ++ai)
#pragma unroll
      for (int mi = 0; mi < 4; ++mi) {
        const int m = u.mt * 256 + ai * 128 + wr * 64 + mi * 16 + fr;
        const float* rowp = h + (size_t)m * DM + n0;
        if (x) { const int b = m / LROW, pos = m - b * LROW; rowp = pos < 48 ? nullptr : (pos < 64 ? meta + (size_t)(pos - 48) * DM : x + ((size_t)b * 2048 + (pos - 64)) * DM) + n0; }
#pragma unroll
        for (int bj = 0; bj < 2; ++bj)
#pragma unroll
          for (int ni = 0; ni < 2; ++ni) acc[ai][bj][mi][ni] = rowp ? *(const f32x4*)(rowp + bj * 128 + ni * 4) : (f32x4){0.f, 0.f, 0.f, 0.f};
      }
  }
  DI void operator()(const f32x4 (&acc)[2][2][4][2], const Unit& u, int wr, int wc, int fr, int fq) const {
    const int n0 = u.nt * 256 + wc * 32 + fq * 8;
#pragma unroll
    for (int ai = 0; ai < 2; ++ai)
#pragma unroll
      for (int mi = 0; mi < 4; ++mi) {
        const int m = u.mt * 256 + ai * 128 + wr * 64 + mi * 16 + fr;
        float* rowp = (u.tr ? P2 + ((size_t)(u.tr - 1) * 256 + (m - 8192)) * DM : h + (size_t)m * DM) + n0;
        float sq = 0.f;
#pragma unroll
        for (int bj = 0; bj < 2; ++bj) {
          const f32x4 a = acc[ai][bj][mi][0], c = acc[ai][bj][mi][1];
          *(f32x4*)(rowp + bj * 128) = a; *(f32x4*)(rowp + bj * 128 + 4) = c;
          if (ssn && !u.tr) {
            sq += a[0] * a[0] + a[1] * a[1] + a[2] * a[2] + a[3] * a[3] + c[0] * c[0] + c[1] * c[1] + c[2] * c[2] + c[3] * c[3];
            const u32x4 o = {pk2(a[0], a[1]), pk2(a[2], a[3]), pk2(c[0], c[1]), pk2(c[2], c[3])};
            *(u32x4*)(hb + (size_t)m * DM + n0 + bj * 128) = o;
          }
        }
        if (ssn && !u.tr) {
          sq += __shfl_xor(sq, 16); sq += __shfl_xor(sq, 32);
          if (fq == 0) unsafeAtomicAdd(ssn + m, sq);
        }
      }
  }
};

DI void gemm1_phase(const Params& p, int l, LAS unsigned char* lds, int ubeg, int uend) {
  Sched1 S{p.hb, p.WinT + (size_t)l * NIN * DM, ubeg, uend}; Epi1 E{p.proj, p.T, p.ss + (size_t)l * MROWS};
  gemm_phase(lds, S, E);
}
DI void gemm2_phase(const Params& p, int l, LAS unsigned char* lds) {
  Sched2 S{p.mix, p.WoutT + (size_t)l * DM * DM}; Epi2 E{p.h, p.P2, p.hb, l == 0 ? p.ss + MROWS : nullptr, l == 0 ? p.x : nullptr, p.meta};
  gemm_phase(lds, S, E);
}

DI void ret_scan_chain(const Params& p, int b, int h, LAS unsigned char* lds, unsigned* done_ctr) {
  constexpr int D = 6;
  const int tid = opaque_tid(), w = __builtin_amdgcn_readfirstlane(tid >> 6), lane = tid & 63, fr = lane & 15, fq = lane >> 4;
  const float l2g = log2f(1.f - exp2f(-5.f - (float)h));
  const float dec64 = exp2f(l2g * 64.f);
  const int sub16 = lds_byte(fr, fq * 8);
  const int fillT = lds_byte(tid >> 3, (tid & 7) * 8);
  const bf16_t* gk = p.T + (size_t)b * 3072 * LROW + (size_t)(h * 128 + (tid >> 3)) * LROW + (tid & 7) * 8;
  u32x4* so = (u32x4*)p.ST + ((size_t)((b * 8 + h) * NCH) * 8 + w) * 256 + lane;
  f32x4 st[8];
#pragma unroll
  for (int i = 0; i < 8; ++i) st[i] = (f32x4){0.f, 0.f, 0.f, 0.f};
  u32x4 ring[D][4];
#define SCAN_LOAD(slot, n) do { const bf16_t* _t = gk + (n) * 64; ring[slot][0] = *(const u32x4*)_t; ring[slot][1] = *(const u32x4*)(_t + (size_t)64 * LROW); \
    ring[slot][2] = *(const u32x4*)(_t + (size_t)1024 * LROW); ring[slot][3] = *(const u32x4*)(_t + (size_t)1088 * LROW); } while (0)
#define SCAN_STORE(n) do { _Pragma("unroll") for (int kd = 0; kd < 4; ++kd) { const f32x4 sa = st[2 * kd], sc = st[2 * kd + 1]; \
    const u32x4 bsu = {pk2(sa[0], sa[1]), pk2(sa[2], sa[3]), pk2(sc[0], sc[1]), pk2(sc[2], sc[3])}; so[(size_t)(n) * 2048 + kd * 64] = bsu; } } while (0)
#pragma unroll
  for (int i = 0; i < D; ++i) SCAN_LOAD(i, i);
#pragma unroll
  for (int n = 0; n < NCH - 1; ++n) {
    const int slot = n % D, bo = (n & 1) * 32768;
    *(LAS u32x4*)(lds + bo + fillT) = ring[slot][0]; *(LAS u32x4*)(lds + bo + fillT + 8192) = ring[slot][1];
    *(LAS u32x4*)(lds + bo + 16384 + fillT) = ring[slot][2]; *(LAS u32x4*)(lds + bo + 16384 + fillT + 8192) = ring[slot][3];
    if (n + D < NCH - 1) SCAN_LOAD(slot, n + D);
    __syncthreads();
    SCAN_STORE(n);
    const bf16x8 vf0 = *(const LAS bf16x8*)(lds + bo + 16384 + w * 2048 + sub16), vf1 = *(const LAS bf16x8*)(lds + bo + 16384 + w * 2048 + 1024 + sub16);
#pragma unroll
    for (int db = 0; db < 8; ++db) {
      st[db] *= dec64;
      const bf16x8 a0 = *(const LAS bf16x8*)(lds + bo + sub16 + db * 2048);
      const bf16x8 a1 = *(const LAS bf16x8*)(lds + bo + sub16 + db * 2048 + 1024);
      st[db] = MFMA16(a0, vf0, st[db]); st[db] = MFMA16(a1, vf1, st[db]);
    }
  }
  SCAN_STORE(NCH - 1);
  asm volatile("s_waitcnt vmcnt(0)" ::: "memory");
  __syncthreads();
  if (threadIdx.x == 0) { __builtin_amdgcn_fence(__ATOMIC_RELEASE, "agent"); asm volatile("s_waitcnt vmcnt(0)" ::: "memory"); xb_add(done_ctr, 1u); }
#undef SCAN_LOAD
#undef SCAN_STORE
}

DI void retention_items(const Params& p, int l, LAS unsigned char* lds, int first, int stride, int count) {
  constexpr int QS = 0, KS = 16384, VTS = 49152, PS = 65536, OS = 73728;
  const int tid = opaque_tid(), w = __builtin_amdgcn_readfirstlane(tid >> 6), lane = tid & 63, fr = lane & 15, fq = lane >> 4;
  const int sub16 = lds_byte(fr, fq * 8), sub8a = lds_byte(fr, fq * 4), sub8b = lds_byte(fr, fq * 4 + 16);
  const int dq = (tid & 15) * 8;
  const int fillQ = (dq >> 6) * 8192 + lds_byte(tid >> 4, dq & 63);
  const int fillT = lds_byte(tid >> 3, (tid & 7) * 8);
  const int sb = w & 3, tb0 = (w >> 2) * 2;
  const int kbase = KS + sb * 2048 + sub16, qbase = QS + tb0 * 2048 + sub16;
  const int pbase = PS + tb0 * 2048 + (sb >> 1) * 1024 + ((sb & 1) ? sub8b : sub8a);
  const int vbase = VTS + w * 2048 + sub16;
  const int obase = OS + ((fq * 4) * 132 + w * 16 + fr) * 4;
  const int nbase = OS + ((tid >> 3) * 132 + (tid & 7) * 16) * 4;
  u32x4 pq0, pq1, pk0, pk1, pv0, pv1, ns0, ns1, ns2, ns3, ng0, ng1;
#define RET_GLOAD(it) do { const int _bh = (it) / NCH, _n = (it) - _bh * NCH, _b = _bh >> 3, _h = _bh & 7; \
    const bf16_t* _q = p.proj + ((size_t)_b * LROW + _n * 64 + (tid >> 4)) * NIN + _h * 128 + dq; \
    const bf16_t* _t = p.T + ((size_t)_b * 3072 + 1024 + _h * 128 + (tid >> 3)) * LROW + _n * 64 + (tid & 7) * 8; \
    pq0 = *(const u32x4*)_q; pq1 = *(const u32x4*)(_q + (size_t)32 * NIN); pk0 = *(const u32x4*)(_t - (size_t)1024 * LROW); pk1 = *(const u32x4*)(_t - (size_t)960 * LROW); \
    pv0 = *(const u32x4*)_t; pv1 = *(const u32x4*)(_t + (size_t)64 * LROW); \
    const u32x4* _sp = (const u32x4*)p.ST + ((size_t)(it) * 8 + w) * 256 + lane; ns0 = _sp[0]; ns1 = _sp[64]; ns2 = _sp[128]; ns3 = _sp[192]; \
    const bf16_t* _gp = p.proj + ((size_t)_b * LROW + _n * 64 + (tid >> 3)) * NIN + 3072 + _h * 128 + (tid & 7) * 16; \
    ng0 = *(const u32x4*)_gp; ng1 = *(const u32x4*)(_gp + 8); } while (0)
  int it = first;
  const int iend = first + stride * count;
  if (it < iend) RET_GLOAD(it);
  for (; it < iend; it += stride) {
    const int bh = it / NCH, n = it - bh * NCH, b = bh >> 3, h = bh & 7;
    const float l2g = log2f(1.f - exp2f(-5.f - (float)h));
    *(LAS u32x4*)(lds + QS + fillQ) = pq0; *(LAS u32x4*)(lds + QS + fillQ + 4096) = pq1;
    {
      const int d0 = tid >> 3, s0 = (tid & 7) * 8;
#pragma unroll
      for (int i = 0; i < 2; ++i) {
        const u32x4 kv = i ? pk1 : pk0;
        const int d = d0 + 64 * i, ko = KS + (d >> 6) * 8192;
#pragma unroll
        for (int j = 0; j < 8; ++j) {
          const unsigned wv = kv[j >> 1];
          *(LAS bf16_t*)(lds + ko + lds_byte(s0 + j, d & 63)) = (bf16_t)((j & 1) ? (wv >> 16) : (wv & 0xffffu));
        }
      }
    }
    *(LAS u32x4*)(lds + VTS + fillT) = pv0; *(LAS u32x4*)(lds + VTS + fillT + 8192) = pv1;
    const u32x4 sf0 = ns0, sf1 = ns1, sf2 = ns2, sf3 = ns3, g0 = ng0, g1 = ng1;
    __syncthreads();
    if (it + stride < iend) RET_GLOAD(it + stride);
    const size_t row = (size_t)b * LROW + n * 64 + (tid >> 3);
    {
      f32x4 s0 = {0.f, 0.f, 0.f, 0.f}, s1 = {0.f, 0.f, 0.f, 0.f};
#pragma unroll
      for (int ks = 0; ks < 4; ++ks) {
        const int off = (ks >> 1) * 8192 + (ks & 1) * 1024;
        const bf16x8 a = *(const LAS bf16x8*)(lds + kbase + off);
        const bf16x8 b0 = *(const LAS bf16x8*)(lds + qbase + off);
        const bf16x8 b1 = *(const LAS bf16x8*)(lds + qbase + off + 2048);
        s0 = MFMA16(a, b0, s0); s1 = MFMA16(a, b1, s1);
      }
      const int srow = sb * 16 + fq * 4;
#pragma unroll
      for (int i = 0; i < 2; ++i) {
        const f32x4 sv = i ? s1 : s0;
        const int t = (tb0 + i) * 16 + fr;
        const float v0 = sv[0] * EXP2(l2g * (fabsf((float)(t - srow)) - (float)(63 - srow))), v1 = sv[1] * EXP2(l2g * (fabsf((float)(t - srow - 1)) - (float)(62 - srow)));
        const float v2 = sv[2] * EXP2(l2g * (fabsf((float)(t - srow - 2)) - (float)(61 - srow))), v3 = sv[3] * EXP2(l2g * (fabsf((float)(t - srow - 3)) - (float)(60 - srow)));
        const u32x2 o = {pk2(v0, v1), pk2(v2, v3)};
        *(LAS u32x2*)(lds + pbase + i * 2048) = o;
      }
    }
    __syncthreads();
    {
      const bf16x8 vf0 = *(const LAS bf16x8*)(lds + vbase), vf1 = *(const LAS bf16x8*)(lds + vbase + 1024);
      f32x4 o[4], cr[4];
#pragma unroll
      for (int tb = 0; tb < 4; ++tb) {
        o[tb] = (f32x4){0.f, 0.f, 0.f, 0.f}; cr[tb] = (f32x4){0.f, 0.f, 0.f, 0.f};
        const bf16x8 a0 = *(const LAS bf16x8*)(lds + PS + sub16 + tb * 2048);
        const bf16x8 a1 = *(const LAS bf16x8*)(lds + PS + sub16 + tb * 2048 + 1024);
        o[tb] = MFMA16(a0, vf0, o[tb]); o[tb] = MFMA16(a1, vf1, o[tb]);
      }
#pragma unroll
      for (int kd = 0; kd < 4; ++kd) {
        const bf16x8 bsv = __builtin_bit_cast(bf16x8, kd == 0 ? sf0 : (kd == 1 ? sf1 : (kd == 2 ? sf2 : sf3)));
#pragma unroll
        for (int tb = 0; tb < 4; ++tb) {
          const int off = QS + (kd >> 1) * 8192 + (tb * 2 + (kd & 1)) * 1024;
          const s16x4 lo = *(const LAS s16x4*)(lds + off + sub8a);
          const s16x4 hi = *(const LAS s16x4*)(lds + off + sub8b);
          const bf16x8 a = __builtin_shufflevector(lo, hi, 0, 1, 2, 3, 4, 5, 6, 7);
          cr[tb] = MFMA16(a, bsv, cr[tb]);
        }
      }
#pragma unroll
      for (int tb = 0; tb < 4; ++tb)
#pragma unroll
        for (int j = 0; j < 4; ++j) o[tb][j] += EXP2(l2g * (float)(tb * 16 + fq * 4 + j + 1)) * cr[tb][j];
#pragma unroll
      for (int tb = 0; tb < 4; ++tb)
#pragma unroll
        for (int j = 0; j < 4; ++j) *(LAS float*)(lds + obase + (tb * 16 + j) * 528) = o[tb][j];
    }
    __syncthreads();
    {
      const int seg = tid & 7;
      const f32x4 x0 = *(const LAS f32x4*)(lds + nbase), x1 = *(const LAS f32x4*)(lds + nbase + 16), x2 = *(const LAS f32x4*)(lds + nbase + 32), x3 = *(const LAS f32x4*)(lds + nbase + 48);
      f32x4 xs = x0 + x1 + x2 + x3;
      float sum = xs[0] + xs[1] + xs[2] + xs[3];
      sum += __shfl_xor(sum, 1); sum += __shfl_xor(sum, 2); sum += __shfl_xor(sum, 4);
      const float mu = sum * (1.f / 128.f);
      const f32x4 d0 = x0 - mu, d1 = x1 - mu, d2 = x2 - mu, d3 = x3 - mu;
      const f32x4 q = d0 * d0 + d1 * d1 + d2 * d2 + d3 * d3;
      float vs = q[0] + q[1] + q[2] + q[3];
      vs += __shfl_xor(vs, 1); vs += __shfl_xor(vs, 2); vs += __shfl_xor(vs, 4);
      const float rn = rsqrtf(vs * (1.f / 128.f) + 1e-6f);
      const float* gr = p.ret_g + l * 1024 + h * 128 + seg * 16;
      const f32x4 w0 = *(const f32x4*)gr, w1 = *(const f32x4*)(gr + 4), w2 = *(const f32x4*)(gr + 8), w3 = *(const f32x4*)(gr + 12);
      uint4 oa, ob;
      oa.x = pk2(d0[0] * rn * w0[0] * silu(bflo(g0[0])), d0[1] * rn * w0[1] * silu(bfhi(g0[0])));
      oa.y = pk2(d0[2] * rn * w0[2] * silu(bflo(g0[1])), d0[3] * rn * w0[3] * silu(bfhi(g0[1])));
      oa.z = pk2(d1[0] * rn * w1[0] * silu(bflo(g0[2])), d1[1] * rn * w1[1] * silu(bfhi(g0[2])));
      oa.w = pk2(d1[2] * rn * w1[2] * silu(bflo(g0[3])), d1[3] * rn * w1[3] * silu(bfhi(g0[3])));
      ob.x = pk2(d2[0] * rn * w2[0] * silu(bflo(g1[0])), d2[1] * rn * w2[1] * silu(bfhi(g1[0])));
      ob.y = pk2(d2[2] * rn * w2[2] * silu(bflo(g1[1])), d2[3] * rn * w2[3] * silu(bfhi(g1[1])));
      ob.z = pk2(d3[0] * rn * w3[0] * silu(bflo(g1[2])), d3[1] * rn * w3[1] * silu(bfhi(g1[2])));
      ob.w = pk2(d3[2] * rn * w3[2] * silu(bflo(g1[3])), d3[3] * rn * w3[3] * silu(bfhi(g1[3])));
      bf16_t* mp = p.mix + row * DM + h * 128 + seg * 16;
      *(uint4*)mp = oa; *(uint4*)(mp + 8) = ob;
    }
  }
#undef RET_GLOAD
}

DI void diff_pv(LAS unsigned char* lds, int vgb, const bf16x8 (&pfr)[2][2], f32x4 (&o)[2][8], int sub8a, int sub8b) {
  __builtin_amdgcn_s_setprio(1);
#pragma unroll
  for (int eb = 0; eb < 8; ++eb)
#pragma unroll
    for (int kp = 0; kp < 2; ++kp) {
      const s16x4 lo = *(const LAS s16x4*)(lds + vgb + (eb * 2 + kp) * 1024 + sub8a);
      const s16x4 hi = *(const LAS s16x4*)(lds + vgb + (eb * 2 + kp) * 1024 + sub8b);
      const bf16x8 a = __builtin_shufflevector(lo, hi, 0, 1, 2, 3, 4, 5, 6, 7);
      o[0][eb] = MFMA16(a, pfr[0][kp], o[0][eb]);
      o[1][eb] = MFMA16(a, pfr[1][kp], o[1][eb]);
    }
  __builtin_amdgcn_s_setprio(0);
}
DI void diff_tile(bool general, LAS unsigned char* lds, int kfb, const bf16x8 (&qf)[2][2], f32x4 (&o)[2][8], bf16x8 (&pfr)[2][2], float& m0, float& m1, float& l0, float& l1,
                  const f32x4 (&cj)[4], float slope2, int kt, int qrow, int fq) {
  f32x4 s[2][4];
#pragma unroll
  for (int kb = 0; kb < 4; ++kb) {
    const f32x4 init = cj[kb];
    const bf16x8 a0 = *(const LAS bf16x8*)(lds + kfb + (kb * 2) * 1024);
    const bf16x8 a1 = *(const LAS bf16x8*)(lds + kfb + (kb * 2 + 1) * 1024);
    s[0][kb] = MFMA16(a0, qf[0][0], init); s[1][kb] = MFMA16(a0, qf[1][0], init);
    s[0][kb] = MFMA16(a1, qf[0][1], s[0][kb]); s[1][kb] = MFMA16(a1, qf[1][1], s[1][kb]);
  }
  const float tconst = slope2 * (float)(kt * 64);
#pragma unroll
  for (int rb = 0; rb < 2; ++rb) {
    if (general) {
      const int qrel = qrow + rb * 16 - kt * 64;
      const float ms2 = -2.f * slope2;
#pragma unroll
      for (int kb = 0; kb < 4; ++kb)
#pragma unroll
        for (int j = 0; j < 4; ++j) {
          const int kl = kb * 16 + fq * 4 + j;
          float v = s[rb][kb][j] + ms2 * (float)max(kl - qrel, 0);
          if (kt == 0 && kl < 48) v = -INFINITY;
          s[rb][kb][j] = v;
        }
    }
    float mx = fmaxf(fmaxf(s[rb][0][0], s[rb][0][1]), fmaxf(s[rb][0][2], s[rb][0][3]));
#pragma unroll
    for (int kb = 1; kb < 4; ++kb) mx = fmaxf(fmaxf(mx, fmaxf(s[rb][kb][0], s[rb][kb][1])), fmaxf(s[rb][kb][2], s[rb][kb][3]));
    mx = xmax32(xmax16(mx));
    const float mloc = (rb ? m1 : m0) - tconst;
    const float mnew = fmaxf(mloc, mx);
    const float alpha = EXP2(mloc - mnew);
    float rsum = 0.f;
#pragma unroll
    for (int kb = 0; kb < 4; ++kb)
#pragma unroll
      for (int j = 0; j < 4; ++j) { const float pv = EXP2(s[rb][kb][j] - mnew); s[rb][kb][j] = pv; rsum += pv; }
    if (rb) { l1 = l1 * alpha + rsum; m1 = mnew + tconst; } else { l0 = l0 * alpha + rsum; m0 = mnew + tconst; }
    if (__any(alpha != 1.f)) {
#pragma unroll
      for (int eb = 0; eb < 8; ++eb) o[rb][eb] *= alpha;
    }
#pragma unroll
    for (int kp = 0; kp < 2; ++kp) {
      const f32x4 sa = s[rb][2 * kp], sc = s[rb][2 * kp + 1];
      const u32x4 pbu = {pk2(sa[0], sa[1]), pk2(sa[2], sa[3]), pk2(sc[0], sc[1]), pk2(sc[2], sc[3])};
      pfr[rb][kp] = __builtin_bit_cast(bf16x8, pbu);
    }
  }
}

DI void diff_item(const Params& p, int l, int b, int h, int pi, float lam, float lam_init, LAS unsigned char* lds) {
  const int tid = opaque_tid(), w = __builtin_amdgcn_readfirstlane(tid >> 6), lane = tid & 63, fr = lane & 15, fq = lane >> 4;
  const int c = w & 1, rgq = w >> 1, qc = 2 * pi + (rgq >> 1);
  const bool active = qc <= 32;
  const int ktmax = min(2 * pi + 1, 32);
  const int sub16 = lds_byte(fr, fq * 8), sub8a = lds_byte(fr, fq * 4), sub8b = lds_byte(fr, fq * 4 + 16);
  const bf16_t* projb = p.proj + (size_t)b * LROW * NIN;
  const int qrow = qc * 64 + (rgq & 1) * 32 + fr;
  bf16x8 qf[2][2];
#pragma unroll
  for (int rb = 0; rb < 2; ++rb)
#pragma unroll
    for (int ks = 0; ks < 2; ++ks)
      qf[rb][ks] = active ? *(const bf16x8*)(projb + (size_t)(qrow + rb * 16) * NIN + 4096 + h * 128 + c * 64 + ks * 32 + fq * 8) : (bf16x8){0, 0, 0, 0, 0, 0, 0, 0};
  float m0 = -INFINITY, m1 = -INFINITY, l0 = 0.f, l1 = 0.f;
  f32x4 o[2][8];
#pragma unroll
  for (int rb = 0; rb < 2; ++rb)
#pragma unroll
    for (int eb = 0; eb < 8; ++eb) o[rb][eb] = (f32x4){0.f, 0.f, 0.f, 0.f};
  const float slope2 = exp2f(-(float)(h + 1)) * LOG2E;
  f32x4 cj[4];
#pragma unroll
  for (int kb = 0; kb < 4; ++kb)
#pragma unroll
    for (int j = 0; j < 4; ++j) cj[kb][j] = slope2 * (float)(kb * 16 + fq * 4 + j);
  const int cd = (tid & 15) * 8;
  const int fillK = (cd >> 6) * 8192 + lds_byte(tid >> 4, cd & 63);
  const int fillV = 32768 + lds_byte(tid >> 3, (tid & 7) * 8);
  const bf16_t* gk = projb + (size_t)(tid >> 4) * NIN + 5120 + h * 128 + cd;
  const bf16_t* gv = p.T + (size_t)b * 3072 * LROW + (size_t)(2048 + h * 128 + (tid >> 3)) * LROW + (tid & 7) * 8;
  u32x4 pk0, pk1, pv0, pv1;
#define DIFF_GLOAD(kt) do { const bf16_t* _k = gk + (size_t)(kt) * 64 * NIN; const bf16_t* _v = gv + (kt) * 64; \
    pk0 = *(const u32x4*)_k; pk1 = *(const u32x4*)(_k + (size_t)32 * NIN); pv0 = *(const u32x4*)_v; pv1 = *(const u32x4*)(_v + (size_t)64 * LROW); } while (0)
#define DIFF_FILL(kb_, vs_) do { *(LAS u32x4*)(lds + (kb_) + fillK) = pk0; *(LAS u32x4*)(lds + (kb_) + fillK + 4096) = pk1; \
    *(LAS u32x4*)(lds + (vs_) + fillV) = pv0; *(LAS u32x4*)(lds + (vs_) + fillV + 8192) = pv1; } while (0)
  DIFF_GLOAD(0);
  DIFF_FILL(0, 0);
  __syncthreads();
  if (ktmax >= 1) DIFF_GLOAD(1);
  const int kfb0 = c * 8192 + sub16;
  const bool stag = (w >> 2) != 0;
  bf16x8 pfr[2][2];
  int vs = 0;
  for (int kt = 0; kt <= ktmax; ++kt) {
    const int kb = (kt & 1) * 16384;
    const int vsn = vs == 32768 ? 0 : vs + 16384;
    if (kt + 1 <= ktmax) { DIFF_FILL(16384 - kb, vsn); if (kt + 2 <= ktmax) DIFF_GLOAD(kt + 2); }
    if (active && kt <= qc) {
      if (stag && kt > 0) diff_pv(lds, 32768 + (vs == 0 ? 32768 : vs - 16384), pfr, o, sub8a, sub8b);
      diff_tile(kt == 0 || kt == qc, lds, kfb0 + kb, qf, o, pfr, m0, m1, l0, l1, cj, slope2, kt, qrow, fq);
      if (!stag) diff_pv(lds, 32768 + vs, pfr, o, sub8a, sub8b);
    }
    vs = vsn;
    __syncthreads();
  }
  if (active && stag) { const int lastslot = (qc % 3) * 16384; diff_pv(lds, 32768 + lastslot, pfr, o, sub8a, sub8b); }
#undef DIFF_GLOAD
#undef DIFF_FILL
  l0 += __shfl_xor(l0, 16); l0 += __shfl_xor(l0, 32);
  l1 += __shfl_xor(l1, 16); l1 += __shfl_xor(l1, 32);
  const int xb = 81920 + rgq * 16384 + lane * 4;
  if (c == 1 && active) {
#pragma unroll
    for (int rb = 0; rb < 2; ++rb) {
      const float inv = lam / (rb ? l1 : l0);
#pragma unroll
      for (int eb = 0; eb < 8; ++eb)
#pragma unroll
        for (int j = 0; j < 4; ++j) *(LAS float*)(lds + xb + ((rb * 8 + eb) * 4 + j) * 256) = o[rb][eb][j] * inv;
    }
  }
  if (tid == 0) { unsigned sp = 0; while (xb_ld(p.ctr + 32 + l) < 32u && ++sp < (1u << 22)) __builtin_amdgcn_s_sleep(2); }
  __syncthreads();
  __builtin_amdgcn_fence(__ATOMIC_ACQUIRE, "agent");
  if (c == 0 && active) {
#pragma unroll
    for (int rb = 0; rb < 2; ++rb) {
      const float inv = 1.f / (rb ? l1 : l0);
      float ss = 0.f;
#pragma unroll
      for (int eb = 0; eb < 8; ++eb)
#pragma unroll
        for (int j = 0; j < 4; ++j) { const float d = o[rb][eb][j] * inv - *(const LAS float*)(lds + xb + ((rb * 8 + eb) * 4 + j) * 256); o[rb][eb][j] = d; ss += d * d; }
      ss += __shfl_xor(ss, 16); ss += __shfl_xor(ss, 32);
      const float rn = rsqrtf(ss * (1.f / 128.f) + 1e-6f) * (1.f - lam_init);
      const size_t row = (size_t)b * LROW + qrow + rb * 16;
#pragma unroll
      for (int eb = 0; eb < 8; ++eb) {
        const int e0 = h * 128 + eb * 16 + fq * 4;
        const uint2 gu = *(const uint2*)(p.proj + row * NIN + 7168 + e0);
        const float4 gg = *(const float4*)(p.diff_g + l * 1024 + e0);
        const float y0 = o[rb][eb][0] * rn * gg.x * silu(bflo(gu.x)), y1 = o[rb][eb][1] * rn * gg.y * silu(bfhi(gu.x));
        const float y2 = o[rb][eb][2] * rn * gg.z * silu(bflo(gu.y)), y3 = o[rb][eb][3] * rn * gg.w * silu(bfhi(gu.y));
        uint2 ov; ov.x = pk2(y0, y1); ov.y = pk2(y2, y3);
        *(uint2*)(p.mix + row * DM + 1024 + e0) = ov;
      }
    }
  }
}

DI void mixer_phase(const Params& p, int l, LAS unsigned char* lds) {
  volatile LAS int* s_item = (volatile LAS int*)(lds + 147456);
  const float lam = p.lam[l];
  const float lam_init = 0.8f - 0.6f * expf(-0.3f * (float)l);
  for (int c = (int)blockIdx.x - 32; c >= 0 && c < 32; c += (int)gridDim.x) ret_scan_chain(p, c >> 3, c & 7, lds, p.ctr + 34 + l);
  const int xcd = blockIdx.x & 7;
  for (;;) {
    if (threadIdx.x == 0) *s_item = (int)atomicAdd(p.ctr + l * 8 + xcd, 1u);
    __syncthreads();
    const int it = *s_item;
    __syncthreads();
    if (it >= 68 + 22) break;
    if (it < 48 || it >= 70) {
      const int ai = it < 48 ? it : it - 22;
      const int bh = 4 * xcd + (ai & 3);
      diff_item(p, l, bh >> 3, bh & 7, 16 - (ai >> 2), lam, lam_init, lds);
    } else {
      if (threadIdx.x == 0) { unsigned sp = 0; while ((xb_ld(p.ctr + 34 + l) < 32u || xb_ld(p.ctr + 32 + l) < 32u) && ++sp < (1u << 22)) __builtin_amdgcn_s_sleep(2); }
      __syncthreads();
      __builtin_amdgcn_fence(__ATOMIC_ACQUIRE, "agent");
      retention_items(p, l, lds, xcd + 48 * (it - 48), 8, 6);
      __syncthreads();
    }
  }
}

__global__ void __launch_bounds__(512) hymba_megakernel(Params p_unused) {
  cg::grid_group grid = cg::this_grid();
  extern __shared__ __attribute__((aligned(16))) char smem[];
  LAS unsigned char* lds = (LAS unsigned char*)smem;
  volatile LAS unsigned* xst = (volatile LAS unsigned*)(lds + 147456 + 16);
  if (threadIdx.x == 0) { xst[0] = 0u; xst[1] = 0u; }
  __syncthreads();
  XcdBarrier xb;
  { const Params p = load_params(); xb = xcd_barrier_post(p.bar, xst); }
  { const Params p = load_params(); prep_weights(p, lds, 0, 1792, blockIdx.x, gridDim.x, true); }
  { const Params p = load_params(); rownorm<0>(p); }
  grid.sync();
  for (int l = 0; l < 2; ++l) {
    { const Params p = load_params(); gemm1_phase(p, l, lds, 0, 1024); }
    xcd_barrier(xb);
    if (blockIdx.x < 32) {
      const Params p = load_params();
      gemm1_phase(p, l, lds, 1024, 1056);
      if (threadIdx.x == 0) {
        int nl = 0; for (int U = 1024 + (int)blockIdx.x; U < 1056; U += (int)gridDim.x) ++nl;
        __builtin_amdgcn_fence(__ATOMIC_RELEASE, "agent");
        asm volatile("s_waitcnt vmcnt(0)" ::: "memory");
        xb_add(p.ctr + 32 + l, (unsigned)nl);
      }
    }
    { const Params p = load_params(); mixer_phase(p, l, lds); }
    xcd_barrier(xb);
    { const Params p = load_params(); gemm2_phase(p, l, lds); }
    if (l == 0) { const Params p = load_params(); if (gridDim.x > 64) { if (blockIdx.x >= 64) prep_weights(p, lds, 1792, 2560, blockIdx.x - 64, gridDim.x - 64, false); } else prep_weights(p, lds, 1792, 2560, blockIdx.x, gridDim.x, false); }
    xcd_barrier(xb);
    if (l == 0) { { const Params p = load_params(); rownorm<1>(p); } xcd_barrier(xb); }
    else { const Params p = load_params(); rownorm<2>(p); }
  }
}

extern "C" void kernel_launch(void* const* d_in, const int* in_sizes, int n_in, void* d_out, int out_size, void* d_ws, size_t ws_size, hipStream_t stream) {
  static int grid_blocks = 0;
  if (!grid_blocks) {
    int dev = 0, cus = 0, per_cu = 0;
    hipGetDevice(&dev);
    hipDeviceGetAttribute(&cus, hipDeviceAttributeMultiprocessorCount, dev);
    hipFuncSetAttribute((const void*)hymba_megakernel, hipFuncAttributeMaxDynamicSharedMemorySize, SMEM_BYTES);
    hipOccupancyMaxActiveBlocksPerMultiprocessor(&per_cu, hymba_megakernel, 512, SMEM_BYTES);
    if (per_cu < 1) per_cu = 1;
    if (per_cu > 1) per_cu = 1;
    grid_blocks = cus * per_cu;
  }
  Params p{};
  p.x = (const float*)d_in[0]; p.meta = (const float*)d_in[1]; p.norm_g = (const float*)d_in[2]; p.w_in = (const float*)d_in[3];
  p.w_out = (const float*)d_in[4]; p.ret_g = (const float*)d_in[5]; p.diff_g = (const float*)d_in[6];
  p.lq1 = (const float*)d_in[7]; p.lk1 = (const float*)d_in[8]; p.lq2 = (const float*)d_in[9]; p.lk2 = (const float*)d_in[10];
  p.fin_g = (const float*)d_in[11];
  p.out = (float*)d_out;
  char* ws = (char*)d_ws; size_t off = 0;
  auto take = [&](size_t bytes) { char* r = ws + off; off += (bytes + 255) & ~(size_t)255; return r; };
  p.ctr = (unsigned*)take(256);
  p.bar = (unsigned*)take((size_t)XCD_BAR_WORDS * 4);
  p.ss = (float*)take((size_t)2 * MROWS * 4);
  p.lam = (float*)take(256);
  p.WinT = (bf16_t*)take((size_t)2 * NIN * DM * 2);
  p.WoutT = (bf16_t*)take((size_t)2 * DM * DM * 2);
  p.h = (float*)take((size_t)MROWS * DM * 4);
  p.hb = (bf16_t*)take((size_t)MROWS * DM * 2);
  p.proj = (bf16_t*)take((size_t)MROWS * NIN * 2);
  p.T = (bf16_t*)take((size_t)4 * 3072 * LROW * 2);
  p.mix = (bf16_t*)take((size_t)MROWS * DM * 2);
  p.ST = (bf16_t*)take((size_t)32 * NCH * 32768);
  p.P2 = (float*)take((size_t)8 * 256 * DM * 4);
  hipMemsetAsync(p.ctr, 0, 256 + (size_t)XCD_BAR_WORDS * 4 + (size_t)2 * MROWS * 4, stream);
  void* args[] = {&p};
  hipError_t e = hipLaunchCooperativeKernel((void*)hymba_megakernel, dim3(grid_blocks), dim3(512), args, SMEM_BYTES, stream);
  if (e != hipSuccess) fprintf(stderr, "cooperative launch failed: %s (grid %d)\n", hipGetErrorString(e), grid_blocks);
}
```

```cpp
#include <hip/hip_runtime.h>
#include <hip/hip_cooperative_groups.h>
#include <cstdio>
namespace cg = cooperative_groups;

typedef unsigned short bf16_t;
typedef short bf16x8 __attribute__((ext_vector_type(8)));
typedef short s16x4 __attribute__((ext_vector_type(4)));
typedef float f32x4 __attribute__((ext_vector_type(4)));
typedef float f32x2 __attribute__((ext_vector_type(2)));
typedef unsigned u32x4 __attribute__((ext_vector_type(4)));
typedef unsigned u32x2 __attribute__((ext_vector_type(2)));
typedef __bf16 bf16x2_t __attribute__((ext_vector_type(2)));
#define DI __device__ __forceinline__
#define LAS __attribute__((address_space(3)))
#define MFMA16(a, b, c) __builtin_amdgcn_mfma_f32_16x16x32_bf16((a), (b), (c), 0, 0, 0)

constexpr int LROW = 2112;
constexpr int MROWS = 4 * LROW;
constexpr int DM = 2048;
constexpr int NIN = 8192;
constexpr int NCH = 33;
constexpr float LOG2E = 1.4426950408889634f;
constexpr int SMEM_BYTES = 147456 + 64;

struct Params {
  const float *x, *meta, *norm_g, *w_in, *w_out, *ret_g, *diff_g, *lq1, *lk1, *lq2, *lk2, *fin_g;
  float* out;
  bf16_t *WinT, *WoutT, *hb, *proj, *T, *mix, *ST;
  float *h, *ss, *lam, *P2;
  unsigned* ctr;
  unsigned* bar;
};

DI Params load_params() {
  const Params __attribute__((address_space(4)))* q = (const Params __attribute__((address_space(4)))*)__builtin_amdgcn_kernarg_segment_ptr();
  asm volatile("" : "+s"(q));
  Params r; __builtin_memcpy(&r, (const void*)q, sizeof(Params)); return r;
}
DI unsigned pk2(float a, float b) { f32x2 v = {a, b}; bf16x2_t r = __builtin_convertvector(v, bf16x2_t); return __builtin_bit_cast(unsigned, r); }
DI float bf2f(unsigned v16) { return __uint_as_float(v16 << 16); }
DI float bflo(unsigned u) { return __uint_as_float(u << 16); }
DI float bfhi(unsigned u) { return __uint_as_float(u & 0xffff0000u); }
DI int opaque_tid() { int t = threadIdx.x; asm volatile("" : "+v"(t)); return t; }
#define EXP2(x) __builtin_amdgcn_exp2f(x)
DI float xmax16(float x) { const u32x2 r = __builtin_amdgcn_permlane16_swap(__float_as_uint(x), __float_as_uint(x), false, false); return fmaxf(__uint_as_float(r[0]), __uint_as_float(r[1])); }
DI float xmax32(float x) { const u32x2 r = __builtin_amdgcn_permlane32_swap(__float_as_uint(x), __float_as_uint(x), false, false); return fmaxf(__uint_as_float(r[0]), __uint_as_float(r[1])); }
DI float silu(float v) { return v * __builtin_amdgcn_rcpf(1.f + __expf(-v)); }

DI int lds_byte(int r, int c) { int st = (r >> 4) * 2 + (c >> 5), rr = r & 15, cc = c & 31, ob = rr * 64 + cc * 2; return st * 1024 + (ob ^ (((ob >> 9) & 1) << 5)); }
DI int perm32(int rho) { const int n = rho >> 4, i = rho & 15; return 8 * (i >> 2) + 4 * n + (i & 3); }
DI void stage_rc(int b, int& R, int& C) { int st = b / 1024, sb = b % 1024, swz = sb ^ (((sb >> 9) & 1) << 5); R = (st >> 1) * 16 + swz / 64; C = (st & 1) * 32 + (swz % 64) / 2; }

DI void prep_weights(const Params& p, LAS unsigned char* lds, int ubeg, int uend, int wgi, int wgn, bool do_lam) {
  const int tid = opaque_tid();
  const int NTOT = uend;
  const int lrow = tid >> 6, c4 = (tid & 63) * 4;
  f32x4 r[8];
#define PREP_DECODE(u) const float* src; bf16_t* dst; int N; const float* g; int kt, ntile; \
    { const int _l = (u) >= 1280 ? 1 : 0, _v = (u) - _l * 1280; \
      if (_v < 1024) { kt = _v >> 5; ntile = _v & 31; src = p.w_in + (size_t)_l * DM * NIN; dst = p.WinT + (size_t)_l * NIN * DM; N = NIN; g = p.norm_g + _l * DM; } \
      else { const int q = _v - 1024; kt = q >> 3; ntile = q & 7; src = p.w_out + (size_t)_l * DM * DM; dst = p.WoutT + (size_t)_l * DM * DM; N = DM; g = nullptr; } } \
    const int k0 = kt * 64, n0 = ntile * 256;
#define PREP_LOAD(u) do { PREP_DECODE(u) (void)dst; _Pragma("unroll") for (int i = 0; i < 8; ++i) { const int kk = lrow + 8 * i; \
    const f32x4 v = *(const f32x4*)(src + (size_t)(k0 + kk) * N + n0 + c4); const float gg = g ? g[k0 + kk] : 1.f; r[i] = v * gg; } } while (0)
  int u = ubeg + wgi;
  if (u < NTOT) PREP_LOAD(u);
  for (; u < NTOT; u += wgn) {
#pragma unroll
    for (int i = 0; i < 8; ++i) *(LAS f32x4*)(lds + ((lrow + 8 * i) * 260 + c4) * 4) = r[i];
    __syncthreads();
    const int un = u + wgn;
    if (un < NTOT) PREP_LOAD(un);
    {
      PREP_DECODE(u) (void)src; (void)N; (void)g;
      const int n = tid >> 1, kh = (tid & 1) * 32;
      bf16_t* op = dst + (size_t)(n0 + n) * DM + k0 + kh;
#pragma unroll
      for (int q = 0; q < 4; ++q) {
        float f[8];
#pragma unroll
        for (int j = 0; j < 8; ++j) f[j] = *(const LAS float*)(lds + ((kh + q * 8 + j) * 260 + n) * 4);
        const u32x4 o = {pk2(f[0], f[1]), pk2(f[2], f[3]), pk2(f[4], f[5]), pk2(f[6], f[7])};
        *(u32x4*)(op + q * 8) = o;
      }
    }
    __syncthreads();
  }
#undef PREP_DECODE
#undef PREP_LOAD
  if (do_lam && blockIdx.x == 0 && tid < 64) {
    for (int l = 0; l < 2; ++l) {
      float a = p.lq1[l * 64 + tid] * p.lk1[l * 64 + tid], b = p.lq2[l * 64 + tid] * p.lk2[l * 64 + tid];
#pragma unroll
      for (int off = 32; off >= 1; off >>= 1) { a += __shfl_xor(a, off); b += __shfl_xor(b, off); }
      float li = 0.8f - 0.6f * expf(-0.3f * (float)l);
      if (tid == 0) p.lam[l] = expf(a) - expf(b) + li;
    }
  }
}

template <int MODE> DI void rownorm(const Params& p) {
  const int tid = opaque_tid(); const int wave = tid >> 6, lane = tid & 63;
  const int nw = gridDim.x * 8;
  for (int row = (MODE == 1 ? 8192 : 0) + blockIdx.x * 8 + wave; row < MROWS; row += nw) {
    const int b = row / LROW, pos = row - b * LROW;
    if (MODE == 2 && pos < 64) continue;
    const float* src;
    if (MODE <= 1) src = pos < 48 ? nullptr : (pos < 64 ? p.meta + (size_t)(pos - 48) * DM : p.x + ((size_t)b * 2048 + (pos - 64)) * DM);
    else src = p.h + (size_t)row * DM;
    float4 v[8]; float ss = 0.f;
#pragma unroll
    for (int i = 0; i < 8; ++i) {
      v[i] = src ? *(const float4*)(src + i * 256 + lane * 4) : make_float4(0.f, 0.f, 0.f, 0.f);
      if (MODE != 0 && row >= 8192) {
#pragma unroll
        for (int s = 0; s < 8; ++s) { const float4 q = *(const float4*)(p.P2 + ((size_t)s * 256 + (row - 8192)) * DM + i * 256 + lane * 4); v[i].x += q.x; v[i].y += q.y; v[i].z += q.z; v[i].w += q.w; }
      }
      ss += v[i].x * v[i].x + v[i].y * v[i].y + v[i].z * v[i].z + v[i].w * v[i].w;
    }
#pragma unroll
    for (int off = 32; off >= 1; off >>= 1) ss += __shfl_xor(ss, off);
    const float rs = rsqrtf(ss * (1.f / 2048.f) + 1e-6f);
    if (MODE < 2) {
#pragma unroll
      for (int i = 0; i < 8; ++i) {
        if (MODE == 1) *(float4*)(p.h + (size_t)row * DM + i * 256 + lane * 4) = v[i];
        uint2 o; o.x = pk2(v[i].x, v[i].y); o.y = pk2(v[i].z, v[i].w);
        *(uint2*)(p.hb + (size_t)row * DM + i * 256 + lane * 4) = o;
      }
      if (lane == 0) p.ss[(MODE == 0 ? 0 : 1) * MROWS + row] = ss;
    } else {
      float* dst = p.out + ((size_t)b * 2048 + (pos - 64)) * DM;
#pragma unroll
      for (int i = 0; i < 8; ++i) {
        float4 g = *(const float4*)(p.fin_g + i * 256 + lane * 4);
        float4 o; o.x = v[i].x * rs * g.x; o.y = v[i].y * rs * g.y; o.z = v[i].z * rs * g.z; o.w = v[i].w * rs * g.w;
        *(float4*)(dst + i * 256 + lane * 4) = o;
      }
    }
  }
}

constexpr int GK = 2048, GBK = 64, GHALF = 128, GHTB = GHALF * GBK * 2;
constexpr size_t TSTEP = (size_t)256 * GK * 2;
struct Unit { int mt, nt, tr, k0, nkt; };

template <class Epi, class Sched>
DI void gemm_phase(LAS unsigned char* lds, const Sched& S, const Epi& E) {
  const int tid = opaque_tid(), wid = __builtin_amdgcn_readfirstlane(tid >> 6), lane = tid & 63, wr = wid >> 2, wc = wid & 3, fr = lane & 15, fq = lane >> 4;
  constexpr int K = GK;
  unsigned voffA[2], voffB[2];
#pragma unroll
  for (int i = 0; i < 2; ++i) { int R, C; stage_rc(tid * 16 + i * 8192, R, C); const int Rb = (R & ~31) + perm32(R & 31);
    voffA[i] = (unsigned)(R * K + C) * 2u; voffB[i] = (unsigned)(Rb * K + C) * 2u; }
  const size_t kstep = (size_t)(GBK * 2);
  const size_t hstep = (size_t)GHALF * K * 2;
  const unsigned ldsw = (unsigned)wid * 1024u;
  const int aoff = lds_byte(wr * 64 + fr, fq * 8), boff = lds_byte(wc * 32 + fr, fq * 8);
#define G_SA(b, h) (((b) * 2 + (h)) * GHTB)
#define G_SB(b, h) ((4 + (b) * 2 + (h)) * GHTB)
#define G_STAGE(bufoff, gbase, voff) do { _Pragma("unroll") for (int _i = 0; _i < 2; ++_i) \
    __builtin_amdgcn_global_load_lds((const unsigned*)((const char*)(gbase) + voff[_i]), (LAS unsigned*)(lds + (bufoff) + ldsw + _i * 8192), 16, 0, 0); } while (0)
#define G_LDA(dst, b, h) do { _Pragma("unroll") for (int m = 0; m < 4; ++m) _Pragma("unroll") for (int k = 0; k < 2; ++k) dst[m][k] = *(const LAS bf16x8*)(lds + G_SA(b, h) + aoff + m * 2048 + k * 1024); } while (0)
#define G_LDB(dst, b, h) do { _Pragma("unroll") for (int n = 0; n < 2; ++n) _Pragma("unroll") for (int k = 0; k < 2; ++k) dst[n][k] = *(const LAS bf16x8*)(lds + G_SB(b, h) + boff + n * 2048 + k * 1024); } while (0)
#define G_MMA(ai, bj, At, Bx) do { __builtin_amdgcn_s_setprio(1); _Pragma("unroll") for (int m = 0; m < 4; ++m) _Pragma("unroll") for (int n = 0; n < 2; ++n) _Pragma("unroll") for (int k = 0; k < 2; ++k) \
    acc[ai][bj][m][n] = MFMA16(Bx[n][k], At[m][k], acc[ai][bj][m][n]); __builtin_amdgcn_s_setprio(0); } while (0)
#define G_WAIT_V(n) asm volatile("s_waitcnt vmcnt(" #n ")" ::: "memory")
#define G_WAIT_L(n) asm volatile("s_waitcnt lgkmcnt(" #n ")" ::: "memory")
#define G_BAR __builtin_amdgcn_s_barrier()
#define G_SCHED __builtin_amdgcn_sched_barrier(0)
  Unit cur, nxt; int ui = 0;
  if (!S.next(0, cur)) return;
  f32x4 acc[2][2][4][2];
  E.init(acc, cur, wr, wc, fr, fq);
  bf16x8 At[4][2], B0[2][2], B1[2][2];
  const char* cA = S.pa(cur); const char* cB = S.pb(cur);
  G_STAGE(G_SB(0, 0), cB, voffB); G_STAGE(G_SA(0, 0), cA, voffA); G_STAGE(G_SB(0, 1), cB + hstep, voffB); G_STAGE(G_SA(0, 1), cA + hstep, voffA);
  if (wr == 1) G_BAR;
  G_WAIT_V(4); G_BAR;
  G_STAGE(G_SB(1, 0), cB + kstep, voffB); G_STAGE(G_SA(1, 0), cA + kstep, voffA); G_STAGE(G_SB(1, 1), cB + hstep + kstep, voffB);
  G_WAIT_V(6); G_BAR;
  for (;;) {
    const bool has_next = S.next(ui + 1, nxt);
    const char* nA = has_next ? S.pa(nxt) : cA; const char* nB = has_next ? S.pb(nxt) : cB;
    const int nt = cur.nkt;
    for (int t = 0; t < nt; t += 2) {
      const bool last = (t == nt - 2);
      const char* a1 = cA + (size_t)(t + 1) * kstep;
      const char* a2 = last ? nA : cA + (size_t)(t + 2) * kstep; const char* b2 = last ? nB : cB + (size_t)(t + 2) * kstep;
      const char* a3 = a2 + kstep; const char* b3 = b2 + kstep;
      G_LDB(B0, 0, 0); G_SCHED; G_LDA(At, 0, 0); G_STAGE(G_SA(1, 1), a1 + hstep, voffA);
      G_WAIT_L(8); G_BAR; G_WAIT_L(0); G_MMA(0, 0, At, B0); G_BAR; G_SCHED;
      G_LDB(B1, 0, 1); G_STAGE(G_SB(0, 0), b2, voffB);
      G_BAR; G_WAIT_L(0); G_MMA(0, 1, At, B1); G_BAR;
      G_LDA(At, 0, 1); G_STAGE(G_SA(0, 0), a2, voffA);
      G_BAR; G_WAIT_L(0); G_MMA(1, 0, At, B0); G_BAR; G_SCHED;
      G_STAGE(G_SB(0, 1), b2 + hstep, voffB);
      G_WAIT_V(6); G_BAR; G_MMA(1, 1, At, B1); G_BAR;
      G_LDB(B0, 1, 0); G_SCHED; G_LDA(At, 1, 0); G_STAGE(G_SA(0, 1), a2 + hstep, voffA);
      G_WAIT_L(8); G_BAR; G_WAIT_L(0); G_MMA(0, 0, At, B0); G_BAR; G_SCHED;
      G_LDB(B1, 1, 1); G_STAGE(G_SB(1, 0), b3, voffB);
      G_BAR; G_WAIT_L(0); G_MMA(0, 1, At, B1); G_BAR;
      G_LDA(At, 1, 1); G_STAGE(G_SA(1, 0), a3, voffA);
      G_BAR; G_WAIT_L(0); G_MMA(1, 0, At, B0); G_BAR; G_SCHED;
      G_STAGE(G_SB(1, 1), b3 + hstep, voffB);
      G_WAIT_V(6); G_BAR; G_MMA(1, 1, At, B1); G_BAR;
    }
    E(acc, cur, wr, wc, fr, fq);
    if (!has_next) break;
    cur = nxt; cA = nA; cB = nB; ++ui;
    E.init(acc, cur, wr, wc, fr, fq);
  }
  G_WAIT_V(0);
  if (wr == 0) G_BAR;
  G_BAR;
}

#define XB_TMO      128
#define XB_XCNT(j)  (256  + 64 * (j))
#define XB_XSUB(j)  (1280 + 64 * (j))
#define XB_XGEN(j)  (2304 + 64 * (j))
#define XB_TOP      3328
#define XB_TOPGEN   3392
#define XCD_BAR_WORDS 3456
#define XB_SPIN_CAP (1u << 18)
DI unsigned xb_ld(unsigned* p) { return __hip_atomic_load(p, __ATOMIC_RELAXED, __HIP_MEMORY_SCOPE_AGENT); }
DI unsigned xb_add(unsigned* p, unsigned v) { return __hip_atomic_fetch_add(p, v, __ATOMIC_RELAXED, __HIP_MEMORY_SCOPE_AGENT); }
DI unsigned xb_xcc_id() { return (unsigned)__builtin_amdgcn_s_getreg((3 << 11) | 20) & 0xFu; }
#define XB_SPIN(cond, bar) do { unsigned _sp = 0; while (cond) { __builtin_amdgcn_s_sleep(1); \
    if ((++_sp & 255u) == 0u) { if (xb_ld(&(bar)[XB_TMO])) break; if (_sp > XB_SPIN_CAP) { atomicAdd(&(bar)[XB_TMO], 1u); break; } } } } while (0)
struct XcdBarrier { unsigned* bar; unsigned x; volatile LAS unsigned* st; };
DI XcdBarrier xcd_barrier_post(unsigned* bar, volatile LAS unsigned* st) {
  XcdBarrier b; b.bar = bar; b.x = xb_xcc_id(); b.st = st;
  if (threadIdx.x == 0) (void)xb_add(&bar[XB_XCNT(b.x)], 1u);
  return b;
}
DI void xcd_barrier_complete(unsigned* bar, unsigned x, unsigned& nloc, unsigned& nx) {
  const unsigned G = gridDim.x * gridDim.y * gridDim.z;
  unsigned sum, cnt, mine, sp = 0u;
  for (;;) {
    sum = 0u; cnt = 0u; mine = 0u;
#pragma unroll
    for (unsigned j = 0; j < 16; ++j) { const unsigned c = xb_ld(&bar[XB_XCNT(j)]); sum += c; cnt += (c > 0u) ? 1u : 0u; mine = (j == x) ? c : mine; }
    if (sum == G) break;
    __builtin_amdgcn_s_sleep(1);
    if ((++sp & 255u) == 0u) { if (xb_ld(&bar[XB_TMO])) break; if (sp > XB_SPIN_CAP) { atomicAdd(&bar[XB_TMO], 1u); break; } }
  }
  nloc = mine > 0u ? mine : 1u; nx = cnt > 0u ? cnt : 1u;
}
DI void xcd_barrier(const XcdBarrier& b) {
  asm volatile("s_waitcnt vmcnt(0)" ::: "memory");
  __syncthreads();
  if (threadIdx.x == 0) {
    unsigned* bar = b.bar;
    __builtin_amdgcn_s_waitcnt(0);
    unsigned nloc = b.st[0], nx = b.st[1];
    if (nloc == 0u) { xcd_barrier_complete(bar, b.x, nloc, nx); b.st[0] = nloc; b.st[1] = nx; }
    const unsigned old = xb_add(&bar[XB_XSUB(b.x)], 1u);
    const unsigned gen = old / nloc;
    if (old + 1u == (gen + 1u) * nloc) {
      __builtin_amdgcn_fence(__ATOMIC_RELEASE, "agent");
      asm volatile("s_waitcnt vmcnt(0)" ::: "memory");
      const unsigned og = xb_add(&bar[XB_TOP], 1u);
      const unsigned tg = og / nx;
      if (og + 1u == (tg + 1u) * nx) xb_add(&bar[XB_TOPGEN], 1u);
      else XB_SPIN(xb_ld(&bar[XB_TOPGEN]) == tg, bar);
      __builtin_amdgcn_fence(__ATOMIC_ACQUIRE, "agent");
      xb_add(&bar[XB_XGEN(b.x)], 1u);
      asm volatile("s_waitcnt vmcnt(0)" ::: "memory");
    } else {
      XB_SPIN(xb_ld(&bar[XB_XGEN(b.x)]) == gen, bar);
      __builtin_amdgcn_fence(__ATOMIC_ACQUIRE, "agent");
      asm volatile("s_waitcnt vmcnt(0)" ::: "memory");
    }
  }
  __syncthreads();
}

DI void tile_map(int wgid, int nM, int nN, int& pm, int& pn) {
  const int nwg = nM * nN;
  { int q = nwg / 8, r = nwg % 8, xcd = wgid % 8, off = wgid / 8; wgid = (xcd < r ? xcd * (q + 1) : r * (q + 1) + (xcd - r) * q) + off; }
  const int nig = 8 * nN, gid = wgid / nig, fm = gid * 8, gsz = min(nM - fm, 8);
  pm = fm + ((wgid % nig) % gsz); pn = (wgid % nig) / gsz;
}

struct Sched1 {
  const bf16_t* hb; const bf16_t* W; int ubeg, uend;
  DI bool next(int i, Unit& u) const {
    const int U = ubeg + i * (int)gridDim.x + (int)blockIdx.x; if (U >= uend) return false;
    int pm, pn;
    if (U < 928) tile_map(U, 29, 32, pm, pn);
    else if (U < 1024) { const int q = U - 928, c = q % 24; pm = 29 + q / 24; pn = c < 12 ? c : c + 4; }
    else { const int q = U - 1024, g = q & 7; pm = 29 + (q >> 3); pn = g < 4 ? 12 + g : 24 + g; }
    u.mt = pm; u.nt = pn; u.k0 = 0; u.nkt = 32; const int g = pn >> 2; u.tr = (g == 1 || g == 2 || g == 6) ? 1 : 0; return true;
  }
  DI const char* pa(const Unit& u) const { return u.tr ? (const char*)W + (size_t)u.nt * TSTEP : (const char*)hb + (size_t)u.mt * TSTEP; }
  DI const char* pb(const Unit& u) const { return u.tr ? (const char*)hb + (size_t)u.mt * TSTEP : (const char*)W + (size_t)u.nt * TSTEP; }
};
struct Sched2 {
  const bf16_t* mix; const bf16_t* W;
  DI bool next(int i, Unit& u) const {
    const int U = i * (int)gridDim.x + (int)blockIdx.x; if (U >= 256 + 64) return false;
    if (U < 256) { int pm, pn; tile_map(U, 32, 8, pm, pn); u.mt = pm; u.nt = pn; u.tr = 0; u.k0 = 0; u.nkt = 32; }
    else { const int j = U - 256; u.mt = 32; u.nt = j >> 3; u.tr = 1 + (j & 7); u.k0 = (j & 7) * 256; u.nkt = 4; }
    return true;
  }
  DI const char* pa(const Unit& u) const { return (const char*)mix + (size_t)u.mt * TSTEP + (size_t)u.k0 * 2; }
  DI const char* pb(const Unit& u) const { return (const char*)W + (size_t)u.nt * TSTEP + (size_t)u.k0 * 2; }
};

DI void acc_zero(f32x4 (&acc)[2][2][4][2]) {
#pragma unroll
  for (int a = 0; a < 2; ++a)
#pragma unroll
    for (int b = 0; b < 2; ++b)
#pragma unroll
      for (int m = 0; m < 4; ++m)
#pragma unroll
        for (int n = 0; n < 2; ++n) acc[a][b][m][n] = (f32x4){0.f, 0.f, 0.f, 0.f};
}
struct Epi1 {
  bf16_t* proj; bf16_t* T; const float* ss;
  DI void init(f32x4 (&acc)[2][2][4][2], const Unit&, int, int, int, int) const { acc_zero(acc); }
  DI void operator()(const f32x4 (&acc)[2][2][4][2], const Unit& u, int wr, int wc, int fr, int fq) const {
    const int g = u.nt >> 2;
    if (!u.tr) {
      const float sc = (g == 4) ? 0.125f * LOG2E : 1.f;
      const int n0 = u.nt * 256 + wc * 32 + fq * 8;
#pragma unroll
      for (int ai = 0; ai < 2; ++ai)
#pragma unroll
        for (int mi = 0; mi < 4; ++mi) {
          const int m = u.mt * 256 + ai * 128 + wr * 64 + mi * 16 + fr;
          const float rs = rsqrtf(ss[m] * (1.f / 2048.f) + 1e-6f) * sc;
          bf16_t* rowp = proj + (size_t)m * NIN + n0;
#pragma unroll
          for (int bj = 0; bj < 2; ++bj) {
            const f32x4 a = acc[ai][bj][mi][0], c = acc[ai][bj][mi][1];
            const u32x4 o = {pk2(a[0] * rs, a[1] * rs), pk2(a[2] * rs, a[3] * rs), pk2(c[0] * rs, c[1] * rs), pk2(c[2] * rs, c[3] * rs)};
            *(u32x4*)(rowp + bj * 128) = o;
          }
        }
    } else {
      const int tbase = (g == 1 ? 0 : (g == 2 ? 1024 : 2048)) - g * 1024;
#pragma unroll
      for (int bj = 0; bj < 2; ++bj) {
        const int m8 = u.mt * 256 + bj * 128 + wc * 32 + fq * 8;
        const int b = m8 / LROW, pos = m8 - b * LROW;
        const f32x4 q0 = *(const f32x4*)(ss + m8), q1 = *(const f32x4*)(ss + m8 + 4);
        float rs[8];
#pragma unroll
        for (int j = 0; j < 4; ++j) { rs[j] = rsqrtf(q0[j] * (1.f / 2048.f) + 1e-6f); rs[4 + j] = rsqrtf(q1[j] * (1.f / 2048.f) + 1e-6f); }
        if (g == 1) {
#pragma unroll
          for (int j = 0; j < 8; ++j) rs[j] = (pos + j >= 48) ? rs[j] * 0.08838834764831845f : 0.f;
        }
#pragma unroll
        for (int ai = 0; ai < 2; ++ai)
#pragma unroll
          for (int mi = 0; mi < 4; ++mi) {
            const int col = u.nt * 256 + ai * 128 + wr * 64 + mi * 16 + fr;
            const f32x4 a = acc[ai][bj][mi][0], c = acc[ai][bj][mi][1];
            float v[8] = {a[0] * rs[0], a[1] * rs[1], a[2] * rs[2], a[3] * rs[3], c[0] * rs[4], c[1] * rs[5], c[2] * rs[6], c[3] * rs[7]};
            if (g == 1) {
              const int hh = (col - 1024) >> 7;
              const float l2g = log2f(1.f - exp2f(-5.f - (float)hh));
              const int pz = 63 - (pos & 63);
#pragma unroll
              for (int j = 0; j < 8; ++j) v[j] *= exp2f(l2g * (float)(pz - j));
            }
            bf16_t* tp = T + ((size_t)(b * 3072 + tbase + col)) * LROW + (pos & ~31) + 16 * ((pos >> 3) & 1) + 4 * ((pos >> 4) & 1);
            const u32x2 o0 = {pk2(v[0], v[1]), pk2(v[2], v[3])}, o1 = {pk2(v[4], v[5]), pk2(v[6], v[7])};
            *(u32x2*)tp = o0; *(u32x2*)(tp + 8) = o1;
          }
      }
    }
  }
};
struct Epi2 {
  float* h; float* P2; bf16_t* hb; float* ssn; const float* x; const float* meta;
  DI void init(f32x4 (&acc)[2][2][4][2], const Unit& u, int wr, int wc, int fr, int fq) const {
    if (u.tr) { acc_zero(acc); return; }
    const int n0 = u.nt * 256 + wc * 32 + fq * 8;
#pragma unroll
    for (int ai = 0; ai < 2; ++ai)
#pragma unroll
      for (int mi = 0; mi < 4; ++mi) {
        const int m = u.mt * 256 + ai * 128 + wr * 64 + mi * 16 + fr;
        const float* rowp = h + (size_t)m * DM + n0;
        if (x) { const int b = m / LROW, pos = m - b * LROW; rowp = pos < 48 ? nullptr : (pos < 64 ? meta + (size_t)(pos - 48) * DM : x + ((size_t)b * 2048 + (pos - 64)) * DM) + n0; }
#pragma unroll
        for (int bj = 0; bj < 2; ++bj)
#pragma unroll
          for (int ni = 0; ni < 2; ++ni) acc[ai][bj][mi][ni] = rowp ? *(const f32x4*)(rowp + bj * 128 + ni * 4) : (f32x4){0.f, 0.f, 0.f, 0.f};
      }
  }
  DI void operator()(const f32x4 (&acc)[2][2][4][2], const Unit& u, int wr, int wc, int fr, int fq) const {
    const int n0 = u.nt * 256 + wc * 32 + fq * 8;
#pragma unroll
    for (int ai = 0; ai < 2; ++ai)
#pragma unroll
      for (int mi = 0; mi < 4; ++mi) {
        const int m = u.mt * 256 + ai * 128 + wr * 64 + mi * 16 + fr;
        float* rowp = (u.tr ? P2 + ((size_t)(u.tr - 1) * 256 + (m - 8192)) * DM : h + (size_t)m * DM) + n0;
        float sq = 0.f;
#pragma unroll
        for (int bj = 0; bj < 2; ++bj) {
          const f32x4 a = acc[ai][bj][mi][0], c = acc[ai][bj][mi][1];
          *(f32x4*)(rowp + bj * 128) = a; *(f32x4*)(rowp + bj * 128 + 4) = c;
          if (ssn && !u.tr) {
            sq += a[0] * a[0] + a[1] * a[1] + a[2] * a[2] + a[3] * a[3] + c[0] * c[0] + c[1] * c[1] + c[2] * c[2] + c[3] * c[3];
            const u32x4 o = {pk2(a[0], a[1]), pk2(a[2], a[3]), pk2(c[0], c[1]), pk2(c[2], c[3])};
            *(u32x4*)(hb + (size_t)m * DM + n0 + bj * 128) = o;
          }
        }
        if (ssn && !u.tr) {
          sq += __shfl_xor(sq, 16); sq += __shfl_xor(sq, 32);
          if (fq == 0) unsafeAtomicAdd(ssn + m, sq);
        }
      }
  }
};

DI void gemm1_phase(const Params& p, int l, LAS unsigned char* lds, int ubeg, int uend) {
  Sched1 S{p.hb, p.WinT + (size_t)l * NIN * DM, ubeg, uend}; Epi1 E{p.proj, p.T, p.ss + (size_t)l * MROWS};
  gemm_phase(lds, S, E);
}
DI void gemm2_phase(const Params& p, int l, LAS unsigned char* lds) {
  Sched2 S{p.mix, p.WoutT + (size_t)l * DM * DM}; Epi2 E{p.h, p.P2, p.hb, l == 0 ? p.ss + MROWS : nullptr, l == 0 ? p.x : nullptr, p.meta};
  gemm_phase(lds, S, E);
}

DI void ret_scan_chain(const Params& p, int b, int h, LAS unsigned char* lds, unsigned* done_ctr) {
  constexpr int D = 6;
  const int tid = opaque_tid(), w = __builtin_amdgcn_readfirstlane(tid >> 6), lane = tid & 63, fr = lane & 15, fq = lane >> 4;
  const float l2g = log2f(1.f - exp2f(-5.f - (float)h));
  const float dec64 = exp2f(l2g * 64.f);
  const int sub16 = lds_byte(fr, fq * 8);
  const int fillT = lds_byte(tid >> 3, (tid & 7) * 8);
  const bf16_t* gk = p.T + (size_t)b * 3072 * LROW + (size_t)(h * 128 + (tid >> 3)) * LROW + (tid & 7) * 8;
  u32x4* so = (u32x4*)p.ST + ((size_t)((b * 8 + h) * NCH) * 8 + w) * 256 + lane;
  f32x4 st[8];
#pragma unroll
  for (int i = 0; i < 8; ++i) st[i] = (f32x4){0.f, 0.f, 0.f, 0.f};
  u32x4 ring[D][4];
#define SCAN_LOAD(slot, n) do { const bf16_t* _t = gk + (n) * 64; ring[slot][0] = *(const u32x4*)_t; ring[slot][1] = *(const u32x4*)(_t + (size_t)64 * LROW); \
    ring[slot][2] = *(const u32x4*)(_t + (size_t)1024 * LROW); ring[slot][3] = *(const u32x4*)(_t + (size_t)1088 * LROW); } while (0)
#define SCAN_STORE(n) do { _Pragma("unroll") for (int kd = 0; kd < 4; ++kd) { const f32x4 sa = st[2 * kd], sc = st[2 * kd + 1]; \
    const u32x4 bsu = {pk2(sa[0], sa[1]), pk2(sa[2], sa[3]), pk2(sc[0], sc[1]), pk2(sc[2], sc[3])}; so[(size_t)(n) * 2048 + kd * 64] = bsu; } } while (0)
#pragma unroll
  for (int i = 0; i < D; ++i) SCAN_LOAD(i, i);
#pragma unroll
  for (int n = 0; n < NCH - 1; ++n) {
    const int slot = n % D, bo = (n & 1) * 32768;
    *(LAS u32x4*)(lds + bo + fillT) = ring[slot][0]; *(LAS u32x4*)(lds + bo + fillT + 8192) = ring[slot][1];
    *(LAS u32x4*)(lds + bo + 16384 + fillT) = ring[slot][2]; *(LAS u32x4*)(lds + bo + 16384 + fillT + 8192) = ring[slot][3];
    if (n + D < NCH - 1) SCAN_LOAD(slot, n + D);
    __syncthreads();
    SCAN_STORE(n);
    const bf16x8 vf0 = *(const LAS bf16x8*)(lds + bo + 16384 + w * 2048 + sub16), vf1 = *(const LAS bf16x8*)(lds + bo + 16384 + w * 2048 + 1024 + sub16);
#pragma unroll
    for (int db = 0; db < 8; ++db) {
      st[db] *= dec64;
      const bf16x8 a0 = *(const LAS bf16x8*)(lds + bo + sub16 + db * 2048);
      const bf16x8 a1 = *(const LAS bf16x8*)(lds + bo + sub16 + db * 2048 + 1024);
      st[db] = MFMA16(a0, vf0, st[db]); st[db] = MFMA16(a1, vf1, st[db]);
    }
  }
  SCAN_STORE(NCH - 1);
  asm volatile("s_waitcnt vmcnt(0)" ::: "memory");
  __syncthreads();
  if (threadIdx.x == 0) { __builtin_amdgcn_fence(__ATOMIC_RELEASE, "agent"); asm volatile("s_waitcnt vmcnt(0)" ::: "memory"); xb_add(done_ctr, 1u); }
#undef SCAN_LOAD
#undef SCAN_STORE
}

DI void retention_items(const Params& p, int l, LAS unsigned char* lds, int first, int stride, int count) {
  constexpr int QS = 0, KS = 16384, VTS = 49152, PS = 65536, OS = 73728;
  const int tid = opaque_tid(), w = __builtin_amdgcn_readfirstlane(tid >> 6), lane = tid & 63, fr = lane & 15, fq = lane >> 4;
  const int sub16 = lds_byte(fr, fq * 8), sub8a = lds_byte(fr, fq * 4), sub8b = lds_byte(fr, fq * 4 + 16);
  const int dq = (tid & 15) * 8;
  const int fillQ = (dq >> 6) * 8192 + lds_byte(tid >> 4, dq & 63);
  const int fillT = lds_byte(tid >> 3, (tid & 7) * 8);
  const int sb = w & 3, tb0 = (w >> 2) * 2;
  const int kbase = KS + sb * 2048 + sub16, qbase = QS + tb0 * 2048 + sub16;
  const int pbase = PS + tb0 * 2048 + (sb >> 1) * 1024 + lds_byte(fr, fq * 8 + 4 * (sb & 1));
  const int vbase = VTS + w * 2048 + sub16;
  const int obase = OS + ((fq * 4) * 132 + w * 16 + fr) * 4;
  const int nbase = OS + ((tid >> 3) * 132 + (tid & 7) * 16) * 4;
  u32x4 pq0, pq1, pk0, pk1, pv0, pv1, ns0, ns1, ns2, ns3, ng0, ng1;
#define RET_GLOAD(it) do { const int _bh = (it) / NCH, _n = (it) - _bh * NCH, _b = _bh >> 3, _h = _bh & 7; \
    const bf16_t* _q = p.proj + ((size_t)_b * LROW + _n * 64 + (tid >> 4)) * NIN + _h * 128 + dq; \
    const bf16_t* _t = p.T + ((size_t)_b * 3072 + 1024 + _h * 128 + (tid >> 3)) * LROW + _n * 64 + (tid & 7) * 8; \
    pq0 = *(const u32x4*)_q; pq1 = *(const u32x4*)(_q + (size_t)32 * NIN); pk0 = *(const u32x4*)(_t - (size_t)1024 * LROW); pk1 = *(const u32x4*)(_t - (size_t)960 * LROW); \
    pv0 = *(const u32x4*)_t; pv1 = *(const u32x4*)(_t + (size_t)64 * LROW); \
    const u32x4* _sp = (const u32x4*)p.ST + ((size_t)(it) * 8 + w) * 256 + lane; ns0 = _sp[0]; ns1 = _sp[64]; ns2 = _sp[128]; ns3 = _sp[192]; \
    const bf16_t* _gp = p.proj + ((size_t)_b * LROW + _n * 64 + (tid >> 3)) * NIN + 3072 + _h * 128 + (tid & 7) * 16; \
    ng0 = *(const u32x4*)_gp; ng1 = *(const u32x4*)(_gp + 8); } while (0)
  int it = first;
  const int iend = first + stride * count;
  if (it < iend) RET_GLOAD(it);
  for (; it < iend; it += stride) {
    const int bh = it / NCH, n = it - bh * NCH, b = bh >> 3, h = bh & 7;
    const float l2g = log2f(1.f - exp2f(-5.f - (float)h));
    *(LAS u32x4*)(lds + QS + fillQ) = pq0; *(LAS u32x4*)(lds + QS + fillQ + 4096) = pq1;
    {
      const int d0 = tid >> 3, s0 = (tid & 7) * 8;
#pragma unroll
      for (int i = 0; i < 2; ++i) {
        const u32x4 kv = i ? pk1 : pk0;
        const int d = d0 + 64 * i, ko = KS + (d >> 6) * 8192;
#pragma unroll
        for (int j = 0; j < 8; ++j) {
          const unsigned wv = kv[j >> 1];
          const int st = (s0 & 32) + 16 * (j >> 2) + 4 * ((s0 >> 3) & 3) + (j & 3);
          *(LAS bf16_t*)(lds + ko + lds_byte(st, d & 63)) = (bf16_t)((j & 1) ? (wv >> 16) : (wv & 0xffffu));
        }
      }
    }
    *(LAS u32x4*)(lds + VTS + fillT) = pv0; *(LAS u32x4*)(lds + VTS + fillT + 8192) = pv1;
    const u32x4 sf0 = ns0, sf1 = ns1, sf2 = ns2, sf3 = ns3, g0 = ng0, g1 = ng1;
    __syncthreads();
    if (it + stride < iend) RET_GLOAD(it + stride);
    const size_t row = (size_t)b * LROW + n * 64 + (tid >> 3);
    {
      f32x4 s0 = {0.f, 0.f, 0.f, 0.f}, s1 = {0.f, 0.f, 0.f, 0.f};
#pragma unroll
      for (int ks = 0; ks < 4; ++ks) {
        const int off = (ks >> 1) * 8192 + (ks & 1) * 1024;
        const bf16x8 a = *(const LAS bf16x8*)(lds + kbase + off);
        const bf16x8 b0 = *(const LAS bf16x8*)(lds + qbase + off);
        const bf16x8 b1 = *(const LAS bf16x8*)(lds + qbase + off + 2048);
        s0 = MFMA16(a, b0, s0); s1 = MFMA16(a, b1, s1);
      }
      const int srow = sb * 16 + fq * 4;
#pragma unroll
      for (int i = 0; i < 2; ++i) {
        const f32x4 sv = i ? s1 : s0;
        const int t = (tb0 + i) * 16 + fr;
        const float v0 = sv[0] * EXP2(l2g * (fabsf((float)(t - srow)) - (float)(63 - srow))), v1 = sv[1] * EXP2(l2g * (fabsf((float)(t - srow - 1)) - (float)(62 - srow)));
        const float v2 = sv[2] * EXP2(l2g * (fabsf((float)(t - srow - 2)) - (float)(61 - srow))), v3 = sv[3] * EXP2(l2g * (fabsf((float)(t - srow - 3)) - (float)(60 - srow)));
        const u32x2 o = {pk2(v0, v1), pk2(v2, v3)};
        *(LAS u32x2*)(lds + pbase + i * 2048) = o;
      }
    }
    __syncthreads();
    {
      const bf16x8 vf0 = *(const LAS bf16x8*)(lds + vbase), vf1 = *(const LAS bf16x8*)(lds + vbase + 1024);
      f32x4 o[4], cr[4];
#pragma unroll
      for (int tb = 0; tb < 4; ++tb) {
        o[tb] = (f32x4){0.f, 0.f, 0.f, 0.f}; cr[tb] = (f32x4){0.f, 0.f, 0.f, 0.f};
        const bf16x8 a0 = *(const LAS bf16x8*)(lds + PS + sub16 + tb * 2048);
        const bf16x8 a1 = *(const LAS bf16x8*)(lds + PS + sub16 + tb * 2048 + 1024);
        o[tb] = MFMA16(a0, vf0, o[tb]); o[tb] = MFMA16(a1, vf1, o[tb]);
      }
#pragma unroll
      for (int kd = 0; kd < 4; ++kd) {
        const bf16x8 bsv = __builtin_bit_cast(bf16x8, kd == 0 ? sf0 : (kd == 1 ? sf1 : (kd == 2 ? sf2 : sf3)));
#pragma unroll
        for (int tb = 0; tb < 4; ++tb) {
          const int off = QS + (kd >> 1) * 8192 + (tb * 2 + (kd & 1)) * 1024;
          const s16x4 lo = *(const LAS s16x4*)(lds + off + sub8a);
          const s16x4 hi = *(const LAS s16x4*)(lds + off + sub8b);
          const bf16x8 a = __builtin_shufflevector(lo, hi, 0, 1, 2, 3, 4, 5, 6, 7);
          cr[tb] = MFMA16(a, bsv, cr[tb]);
        }
      }
#pragma unroll
      for (int tb = 0; tb < 4; ++tb)
#pragma unroll
        for (int j = 0; j < 4; ++j) o[tb][j] += EXP2(l2g * (float)(tb * 16 + fq * 4 + j + 1)) * cr[tb][j];
#pragma unroll
      for (int tb = 0; tb < 4; ++tb)
#pragma unroll
        for (int j = 0; j < 4; ++j) *(LAS float*)(lds + obase + (tb * 16 + j) * 528) = o[tb][j];
    }
    __syncthreads();
    {
      const int seg = tid & 7;
      const f32x4 x0 = *(const LAS f32x4*)(lds + nbase), x1 = *(const LAS f32x4*)(lds + nbase + 16), x2 = *(const LAS f32x4*)(lds + nbase + 32), x3 = *(const LAS f32x4*)(lds + nbase + 48);
      f32x4 xs = x0 + x1 + x2 + x3;
      float sum = xs[0] + xs[1] + xs[2] + xs[3];
      sum += __shfl_xor(sum, 1); sum += __shfl_xor(sum, 2); sum += __shfl_xor(sum, 4);
      const float mu = sum * (1.f / 128.f);
      const f32x4 d0 = x0 - mu, d1 = x1 - mu, d2 = x2 - mu, d3 = x3 - mu;
      const f32x4 q = d0 * d0 + d1 * d1 + d2 * d2 + d3 * d3;
      float vs = q[0] + q[1] + q[2] + q[3];
      vs += __shfl_xor(vs, 1); vs += __shfl_xor(vs, 2); vs += __shfl_xor(vs, 4);
      const float rn = rsqrtf(vs * (1.f / 128.f) + 1e-6f);
      const float* gr = p.ret_g + l * 1024 + h * 128 + seg * 16;
      const f32x4 w0 = *(const f32x4*)gr, w1 = *(const f32x4*)(gr + 4), w2 = *(const f32x4*)(gr + 8), w3 = *(const f32x4*)(gr + 12);
      uint4 oa, ob;
      oa.x = pk2(d0[0] * rn * w0[0] * silu(bflo(g0[0])), d0[1] * rn * w0[1] * silu(bfhi(g0[0])));
      oa.y = pk2(d0[2] * rn * w0[2] * silu(bflo(g0[1])), d0[3] * rn * w0[3] * silu(bfhi(g0[1])));
      oa.z = pk2(d1[0] * rn * w1[0] * silu(bflo(g0[2])), d1[1] * rn * w1[1] * silu(bfhi(g0[2])));
      oa.w = pk2(d1[2] * rn * w1[2] * silu(bflo(g0[3])), d1[3] * rn * w1[3] * silu(bfhi(g0[3])));
      ob.x = pk2(d2[0] * rn * w2[0] * silu(bflo(g1[0])), d2[1] * rn * w2[1] * silu(bfhi(g1[0])));
      ob.y = pk2(d2[2] * rn * w2[2] * silu(bflo(g1[1])), d2[3] * rn * w2[3] * silu(bfhi(g1[1])));
      ob.z = pk2(d3[0] * rn * w3[0] * silu(bflo(g1[2])), d3[1] * rn * w3[1] * silu(bfhi(g1[2])));
      ob.w = pk2(d3[2] * rn * w3[2] * silu(bflo(g1[3])), d3[3] * rn * w3[3] * silu(bfhi(g1[3])));
      bf16_t* mp = p.mix + row * DM + h * 128 + seg * 16;
      *(uint4*)mp = oa; *(uint4*)(mp + 8) = ob;
    }
  }
#undef RET_GLOAD
}

DI void diff_pv(LAS unsigned char* lds, int vgb, const bf16x8 (&pfr)[2][2], f32x4 (&o)[2][8], int sub16) {
  __builtin_amdgcn_s_setprio(1);
#pragma unroll
  for (int eb = 0; eb < 8; ++eb)
#pragma unroll
    for (int kp = 0; kp < 2; ++kp) {
      const bf16x8 a = *(const LAS bf16x8*)(lds + vgb + (eb * 2 + kp) * 1024 + sub16);
      o[0][eb] = MFMA16(a, pfr[0][kp], o[0][eb]);
      o[1][eb] = MFMA16(a, pfr[1][kp], o[1][eb]);
    }
  __builtin_amdgcn_s_setprio(0);
}
DI void diff_tile(bool general, LAS unsigned char* lds, int kfb, const bf16x8 (&qf)[2][2], f32x4 (&o)[2][8], bf16x8 (&pfr)[2][2], float& m0, float& m1, float& l0, float& l1,
                  const f32x4 (&cj)[4], float slope2, int kt, int qrow, int fq) {
  f32x4 s[2][4];
#pragma unroll
  for (int kb = 0; kb < 4; ++kb) {
    const f32x4 init = cj[kb];
    const bf16x8 a0 = *(const LAS bf16x8*)(lds + kfb + (kb * 2) * 1024);
    const bf16x8 a1 = *(const LAS bf16x8*)(lds + kfb + (kb * 2 + 1) * 1024);
    s[0][kb] = MFMA16(a0, qf[0][0], init); s[1][kb] = MFMA16(a0, qf[1][0], init);
    s[0][kb] = MFMA16(a1, qf[0][1], s[0][kb]); s[1][kb] = MFMA16(a1, qf[1][1], s[1][kb]);
  }
  const float tconst = slope2 * (float)(kt * 64);
#pragma unroll
  for (int rb = 0; rb < 2; ++rb) {
    if (general) {
      const int qrel = qrow + rb * 16 - kt * 64;
      const float ms2 = -2.f * slope2;
#pragma unroll
      for (int kb = 0; kb < 4; ++kb)
#pragma unroll
        for (int j = 0; j < 4; ++j) {
          const int kl = kb * 16 + fq * 4 + j;
          float v = s[rb][kb][j] + ms2 * (float)max(kl - qrel, 0);
          if (kt == 0 && kl < 48) v = -INFINITY;
          s[rb][kb][j] = v;
        }
    }
    float mx = fmaxf(fmaxf(s[rb][0][0], s[rb][0][1]), fmaxf(s[rb][0][2], s[rb][0][3]));
#pragma unroll
    for (int kb = 1; kb < 4; ++kb) mx = fmaxf(fmaxf(mx, fmaxf(s[rb][kb][0], s[rb][kb][1])), fmaxf(s[rb][kb][2], s[rb][kb][3]));
    mx = xmax32(xmax16(mx));
    const float mloc = (rb ? m1 : m0) - tconst;
    const float mnew = fmaxf(mloc, mx);
    const float alpha = EXP2(mloc - mnew);
    float rsum = 0.f;
#pragma unroll
    for (int kb = 0; kb < 4; ++kb)
#pragma unroll
      for (int j = 0; j < 4; ++j) { const float pv = EXP2(s[rb][kb][j] - mnew); s[rb][kb][j] = pv; rsum += pv; }
    if (rb) { l1 = l1 * alpha + rsum; m1 = mnew + tconst; } else { l0 = l0 * alpha + rsum; m0 = mnew + tconst; }
    if (__any(alpha != 1.f)) {
#pragma unroll
      for (int eb = 0; eb < 8; ++eb) o[rb][eb] *= alpha;
    }
#pragma unroll
    for (int kp = 0; kp < 2; ++kp) {
      const f32x4 sa = s[rb][2 * kp], sc = s[rb][2 * kp + 1];
      const u32x4 pbu = {pk2(sa[0], sa[1]), pk2(sa[2], sa[3]), pk2(sc[0], sc[1]), pk2(sc[2], sc[3])};
      pfr[rb][kp] = __builtin_bit_cast(bf16x8, pbu);
    }
  }
}

DI void diff_item(const Params& p, int l, int b, int h, int pi, float lam, float lam_init, LAS unsigned char* lds) {
  const int tid = opaque_tid(), w = __builtin_amdgcn_readfirstlane(tid >> 6), lane = tid & 63, fr = lane & 15, fq = lane >> 4;
  const int c = w & 1, rgq = w >> 1, qc = 2 * pi + (rgq >> 1);
  const bool active = qc <= 32;
  const int ktmax = min(2 * pi + 1, 32);
  const int sub16 = lds_byte(fr, fq * 8), sub8a = lds_byte(fr, fq * 4), sub8b = lds_byte(fr, fq * 4 + 16);
  const bf16_t* projb = p.proj + (size_t)b * LROW * NIN;
  const int qrow = qc * 64 + (rgq & 1) * 32 + fr;
  bf16x8 qf[2][2];
#pragma unroll
  for (int rb = 0; rb < 2; ++rb)
#pragma unroll
    for (int ks = 0; ks < 2; ++ks)
      qf[rb][ks] = active ? *(const bf16x8*)(projb + (size_t)(qrow + rb * 16) * NIN + 4096 + h * 128 + c * 64 + ks * 32 + fq * 8) : (bf16x8){0, 0, 0, 0, 0, 0, 0, 0};
  float m0 = -INFINITY, m1 = -INFINITY, l0 = 0.f, l1 = 0.f;
  f32x4 o[2][8];
#pragma unroll
  for (int rb = 0; rb < 2; ++rb)
#pragma unroll
    for (int eb = 0; eb < 8; ++eb) o[rb][eb] = (f32x4){0.f, 0.f, 0.f, 0.f};
  const float slope2 = exp2f(-(float)(h + 1)) * LOG2E;
  f32x4 cj[4];
#pragma unroll
  for (int kb = 0; kb < 4; ++kb)
#pragma unroll
    for (int j = 0; j < 4; ++j) cj[kb][j] = slope2 * (float)(kb * 16 + fq * 4 + j);
  const int kkey = ((tid >> 5) & 15) * 2 + ((tid >> 2) & 1), cd = ((tid >> 4) & 1) * 64 + ((tid >> 3) & 1) * 32 + (tid & 3) * 8;
  const int ve = ((tid >> 4) & 31) * 2 + ((tid >> 2) & 1), vk0 = ((tid >> 3) & 1) * 32 + (tid & 3) * 8;
  const int fillK = (cd >> 6) * 8192 + lds_byte(kkey, cd & 63);
  const int fillV = 32768 + lds_byte(ve, vk0);
  const bf16_t* gk = projb + (size_t)kkey * NIN + 5120 + h * 128 + cd;
  const bf16_t* gv = p.T + (size_t)b * 3072 * LROW + (size_t)(2048 + h * 128 + ve) * LROW + vk0;
  u32x4 pk0, pk1, pv0, pv1;
#define DIFF_GLOAD(kt) do { const bf16_t* _k = gk + (size_t)(kt) * 64 * NIN; const bf16_t* _v = gv + (kt) * 64; \
    pk0 = *(const u32x4*)_k; pk1 = *(const u32x4*)(_k + (size_t)32 * NIN); pv0 = *(const u32x4*)_v; pv1 = *(const u32x4*)(_v + (size_t)64 * LROW); } while (0)
#define DIFF_FILL(kb_, vs_) do { *(LAS u32x4*)(lds + (kb_) + fillK) = pk0; *(LAS u32x4*)(lds + (kb_) + fillK + 4096) = pk1; \
    *(LAS u32x4*)(lds + (vs_) + fillV) = pv0; *(LAS u32x4*)(lds + (vs_) + fillV + 8192) = pv1; } while (0)
  DIFF_GLOAD(0);
  DIFF_FILL(0, 0);
  __syncthreads();
  if (ktmax >= 1) DIFF_GLOAD(1);
  const int kfb0 = c * 8192 + sub16;
  const bool stag = (w >> 2) != 0;
  bf16x8 pfr[2][2];
  int vs = 0;
  for (int kt = 0; kt <= ktmax; ++kt) {
    const int kb = (kt & 1) * 16384;
    const int vsn = vs == 32768 ? 0 : vs + 16384;
    if (kt + 1 <= ktmax) { DIFF_FILL(16384 - kb, vsn); if (kt + 2 <= ktmax) DIFF_GLOAD(kt + 2); }
    if (active && kt <= qc) {
      if (stag && kt > 0) diff_pv(lds, 32768 + (vs == 0 ? 32768 : vs - 16384), pfr, o, sub16);
      diff_tile(kt == 0 || kt == qc, lds, kfb0 + kb, qf, o, pfr, m0, m1, l0, l1, cj, slope2, kt, qrow, fq);
      if (!stag) diff_pv(lds, 32768 + vs, pfr, o, sub16);
    }
    vs = vsn;
    __syncthreads();
  }
  if (active && stag) { const int lastslot = (qc % 3) * 16384; diff_pv(lds, 32768 + lastslot, pfr, o, sub16); }
#undef DIFF_GLOAD
#undef DIFF_FILL
  l0 += __shfl_xor(l0, 16); l0 += __shfl_xor(l0, 32);
  l1 += __shfl_xor(l1, 16); l1 += __shfl_xor(l1, 32);
  const int xb = 81920 + rgq * 16384 + lane * 4;
  if (c == 1 && active) {
#pragma unroll
    for (int rb = 0; rb < 2; ++rb) {
      const float inv = lam / (rb ? l1 : l0);
#pragma unroll
      for (int eb = 0; eb < 8; ++eb)
#pragma unroll
        for (int j = 0; j < 4; ++j) *(LAS float*)(lds + xb + ((rb * 8 + eb) * 4 + j) * 256) = o[rb][eb][j] * inv;
    }
  }
  if (tid == 0) { unsigned sp = 0; while (xb_ld(p.ctr + 32 + l) < 32u && ++sp < (1u << 22)) __builtin_amdgcn_s_sleep(2); }
  __syncthreads();
  __builtin_amdgcn_fence(__ATOMIC_ACQUIRE, "agent");
  if (c == 0 && active) {
#pragma unroll
    for (int rb = 0; rb < 2; ++rb) {
      const float inv = 1.f / (rb ? l1 : l0);
      float ss = 0.f;
#pragma unroll
      for (int eb = 0; eb < 8; ++eb)
#pragma unroll
        for (int j = 0; j < 4; ++j) { const float d = o[rb][eb][j] * inv - *(const LAS float*)(lds + xb + ((rb * 8 + eb) * 4 + j) * 256); o[rb][eb][j] = d; ss += d * d; }
      ss += __shfl_xor(ss, 16); ss += __shfl_xor(ss, 32);
      const float rn = rsqrtf(ss * (1.f / 128.f) + 1e-6f) * (1.f - lam_init);
      const size_t row = (size_t)b * LROW + qrow + rb * 16;
#pragma unroll
      for (int eb = 0; eb < 8; ++eb) {
        const int e0 = h * 128 + eb * 16 + fq * 4;
        const uint2 gu = *(const uint2*)(p.proj + row * NIN + 7168 + e0);
        const float4 gg = *(const float4*)(p.diff_g + l * 1024 + e0);
        const float y0 = o[rb][eb][0] * rn * gg.x * silu(bflo(gu.x)), y1 = o[rb][eb][1] * rn * gg.y * silu(bfhi(gu.x));
        const float y2 = o[rb][eb][2] * rn * gg.z * silu(bflo(gu.y)), y3 = o[rb][eb][3] * rn * gg.w * silu(bfhi(gu.y));
        uint2 ov; ov.x = pk2(y0, y1); ov.y = pk2(y2, y3);
        *(uint2*)(p.mix + row * DM + 1024 + e0) = ov;
      }
    }
  }
}

DI void mixer_phase(const Params& p, int l, LAS unsigned char* lds) {
  volatile LAS int* s_item = (volatile LAS int*)(lds + 147456);
  const float lam = p.lam[l];
  const float lam_init = 0.8f - 0.6f * expf(-0.3f * (float)l);
  for (int c = (int)blockIdx.x - 32; c >= 0 && c < 32; c += (int)gridDim.x) ret_scan_chain(p, c >> 3, c & 7, lds, p.ctr + 34 + l);
  const int xcd = blockIdx.x & 7;
  for (;;) {
    if (threadIdx.x == 0) *s_item = (int)atomicAdd(p.ctr + l * 8 + xcd, 1u);
    __syncthreads();
    const int it = *s_item;
    __syncthreads();
    if (it >= 68 + 22) break;
    if (it < 48 || it >= 70) {
      const int ai = it < 48 ? it : it - 22;
      const int bh = 4 * xcd + (ai & 3);
      diff_item(p, l, bh >> 3, bh & 7, 16 - (ai >> 2), lam, lam_init, lds);
    } else {
      if (threadIdx.x == 0) { unsigned sp = 0; while ((xb_ld(p.ctr + 34 + l) < 32u || xb_ld(p.ctr + 32 + l) < 32u) && ++sp < (1u << 22)) __builtin_amdgcn_s_sleep(2); }
      __syncthreads();
      __builtin_amdgcn_fence(__ATOMIC_ACQUIRE, "agent");
      retention_items(p, l, lds, xcd + 48 * (it - 48), 8, 6);
      __syncthreads();
    }
  }
}

__global__ void __launch_bounds__(512) hymba_megakernel(Params p_unused) {
  cg::grid_group grid = cg::this_grid();
  extern __shared__ __attribute__((aligned(16))) char smem[];
  LAS unsigned char* lds = (LAS unsigned char*)smem;
  volatile LAS unsigned* xst = (volatile LAS unsigned*)(lds + 147456 + 16);
  if (threadIdx.x == 0) { xst[0] = 0u; xst[1] = 0u; }
  __syncthreads();
  XcdBarrier xb;
  { const Params p = load_params(); xb = xcd_barrier_post(p.bar, xst); }
  { const Params p = load_params(); prep_weights(p, lds, 0, 1792, blockIdx.x, gridDim.x, true); }
  { const Params p = load_params(); rownorm<0>(p); }
  grid.sync();
  for (int l = 0; l < 2; ++l) {
    { const Params p = load_params(); gemm1_phase(p, l, lds, 0, 1024); }
    xcd_barrier(xb);
    if (blockIdx.x < 32) {
      const Params p = load_params();
      gemm1_phase(p, l, lds, 1024, 1056);
      if (threadIdx.x == 0) {
        int nl = 0; for (int U = 1024 + (int)blockIdx.x; U < 1056; U += (int)gridDim.x) ++nl;
        __builtin_amdgcn_fence(__ATOMIC_RELEASE, "agent");
        asm volatile("s_waitcnt vmcnt(0)" ::: "memory");
        xb_add(p.ctr + 32 + l, (unsigned)nl);
      }
    }
    { const Params p = load_params(); mixer_phase(p, l, lds); }
    xcd_barrier(xb);
    { const Params p = load_params(); gemm2_phase(p, l, lds); }
    if (l == 0) { const Params p = load_params(); if (gridDim.x > 64) { if (blockIdx.x >= 64) prep_weights(p, lds, 1792, 2560, blockIdx.x - 64, gridDim.x - 64, false); } else prep_weights(p, lds, 1792, 2560, blockIdx.x, gridDim.x, false); }
    xcd_barrier(xb);
    if (l == 0) { { const Params p = load_params(); rownorm<1>(p); } xcd_barrier(xb); }
    else { const Params p = load_params(); rownorm<2>(p); }
  }
}

extern "C" void kernel_launch(void* const* d_in, const int* in_sizes, int n_in, void* d_out, int out_size, void* d_ws, size_t ws_size, hipStream_t stream) {
  static int grid_blocks = 0;
  if (!grid_blocks) {
    int dev = 0, cus = 0, per_cu = 0;
    hipGetDevice(&dev);
    hipDeviceGetAttribute(&cus, hipDeviceAttributeMultiprocessorCount, dev);
    hipFuncSetAttribute((const void*)hymba_megakernel, hipFuncAttributeMaxDynamicSharedMemorySize, SMEM_BYTES);
    hipOccupancyMaxActiveBlocksPerMultiprocessor(&per_cu, hymba_megakernel, 512, SMEM_BYTES);
    if (per_cu < 1) per_cu = 1;
    if (per_cu > 1) per_cu = 1;
    grid_blocks = cus * per_cu;
  }
  Params p{};
  p.x = (const float*)d_in[0]; p.meta = (const float*)d_in[1]; p.norm_g = (const float*)d_in[2]; p.w_in = (const float*)d_in[3];
  p.w_out = (const float*)d_in[4]; p.ret_g = (const float*)d_in[5]; p.diff_g = (const float*)d_in[6];
  p.lq1 = (const float*)d_in[7]; p.lk1 = (const float*)d_in[8]; p.lq2 = (const float*)d_in[9]; p.lk2 = (const float*)d_in[10];
  p.fin_g = (const float*)d_in[11];
  p.out = (float*)d_out;
  char* ws = (char*)d_ws; size_t off = 0;
  auto take = [&](size_t bytes) { char* r = ws + off; off += (bytes + 255) & ~(size_t)255; return r; };
  p.ctr = (unsigned*)take(256);
  p.bar = (unsigned*)take((size_t)XCD_BAR_WORDS * 4);
  p.ss = (float*)take((size_t)2 * MROWS * 4);
  p.lam = (float*)take(256);
  p.WinT = (bf16_t*)take((size_t)2 * NIN * DM * 2);
  p.WoutT = (bf16_t*)take((size_t)2 * DM * DM * 2);
  p.h = (float*)take((size_t)MROWS * DM * 4);
  p.hb = (bf16_t*)take((size_t)MROWS * DM * 2);
  p.proj = (bf16_t*)take((size_t)MROWS * NIN * 2);
  p.T = (bf16_t*)take((size_t)4 * 3072 * LROW * 2);
  p.mix = (bf16_t*)take((size_t)MROWS * DM * 2);
  p.ST = (bf16_t*)take((size_t)32 * NCH * 32768);
  p.P2 = (float*)take((size_t)8 * 256 * DM * 4);
  hipMemsetAsync(p.ctr, 0, 256 + (size_t)XCD_BAR_WORDS * 4 + (size_t)2 * MROWS * 4, stream);
  void* args[] = {&p};
  hipError_t e = hipLaunchCooperativeKernel((void*)hymba_megakernel, dim3(grid_blocks), dim3(512), args, SMEM_BYTES, stream);
  if (e != hipSuccess) fprintf(stderr, "cooperative launch failed: %s (grid %d)\n", hipGetErrorString(e), grid_blocks);
}
```

```cpp
#include <hip/hip_runtime.h>
#include <hip/hip_cooperative_groups.h>
#include <cstdio>
namespace cg = cooperative_groups;

typedef unsigned short bf16_t;
typedef short bf16x8 __attribute__((ext_vector_type(8)));
typedef short s16x4 __attribute__((ext_vector_type(4)));
typedef float f32x4 __attribute__((ext_vector_type(4)));
typedef float f32x2 __attribute__((ext_vector_type(2)));
typedef unsigned u32x4 __attribute__((ext_vector_type(4)));
typedef unsigned u32x2 __attribute__((ext_vector_type(2)));
typedef __bf16 bf16x2_t __attribute__((ext_vector_type(2)));
#define DI __device__ __forceinline__
#define LAS __attribute__((address_space(3)))
#define MFMA16(a, b, c) __builtin_amdgcn_mfma_f32_16x16x32_bf16((a), (b), (c), 0, 0, 0)

constexpr int LROW = 2112;
constexpr int MROWS = 4 * LROW;
constexpr int DM = 2048;
constexpr int NIN = 8192;
constexpr int NCH = 33;
constexpr float LOG2E = 1.4426950408889634f;
constexpr int SMEM_BYTES = 147456 + 64;

struct Params {
  const float *x, *meta, *norm_g, *w_in, *w_out, *ret_g, *diff_g, *lq1, *lk1, *lq2, *lk2, *fin_g;
  float* out;
  bf16_t *WinT, *WoutT, *hb, *proj, *T, *mix, *ST;
  float *h, *ss, *lam, *P2;
  unsigned* ctr;
  unsigned* bar;
};

DI Params load_params() {
  const Params __attribute__((address_space(4)))* q = (const Params __attribute__((address_space(4)))*)__builtin_amdgcn_kernarg_segment_ptr();
  asm volatile("" : "+s"(q));
  Params r; __builtin_memcpy(&r, (const void*)q, sizeof(Params)); return r;
}
DI unsigned pk2(float a, float b) { f32x2 v = {a, b}; bf16x2_t r = __builtin_convertvector(v, bf16x2_t); return __builtin_bit_cast(unsigned, r); }
DI float bf2f(unsigned v16) { return __uint_as_float(v16 << 16); }
DI float bflo(unsigned u) { return __uint_as_float(u << 16); }
DI float bfhi(unsigned u) { return __uint_as_float(u & 0xffff0000u); }
DI int opaque_tid() { int t = threadIdx.x; asm volatile("" : "+v"(t)); return t; }
#define EXP2(x) __builtin_amdgcn_exp2f(x)
DI float xmax16(float x) { const u32x2 r = __builtin_amdgcn_permlane16_swap(__float_as_uint(x), __float_as_uint(x), false, false); return fmaxf(__uint_as_float(r[0]), __uint_as_float(r[1])); }
DI float xmax32(float x) { const u32x2 r = __builtin_amdgcn_permlane32_swap(__float_as_uint(x), __float_as_uint(x), false, false); return fmaxf(__uint_as_float(r[0]), __uint_as_float(r[1])); }
DI float silu(float v) { return v * __builtin_amdgcn_rcpf(1.f + __expf(-v)); }

DI int lds_byte(int r, int c) { int st = (r >> 4) * 2 + (c >> 5), rr = r & 15, cc = c & 31, ob = rr * 64 + cc * 2; return st * 1024 + (ob ^ (((ob >> 9) & 1) << 5)); }
DI int perm32(int rho) { const int n = rho >> 4, i = rho & 15; return 8 * (i >> 2) + 4 * n + (i & 3); }
DI void stage_rc(int b, int& R, int& C) { int st = b / 1024, sb = b % 1024, swz = sb ^ (((sb >> 9) & 1) << 5); R = (st >> 1) * 16 + swz / 64; C = (st & 1) * 32 + (swz % 64) / 2; }

DI void prep_weights(const Params& p, LAS unsigned char* lds, int ubeg, int uend, int wgi, int wgn, bool do_lam) {
  const int tid = opaque_tid();
  const int NTOT = uend;
  const int lrow = tid >> 6, c4 = (tid & 63) * 4;
  f32x4 r[8];
#define PREP_DECODE(u) const float* src; bf16_t* dst; int N; const float* g; int kt, ntile; \
    { const int _l = (u) >= 1280 ? 1 : 0, _v = (u) - _l * 1280; \
      if (_v < 1024) { kt = _v >> 5; ntile = _v & 31; src = p.w_in + (size_t)_l * DM * NIN; dst = p.WinT + (size_t)_l * NIN * DM; N = NIN; g = p.norm_g + _l * DM; } \
      else { const int q = _v - 1024; kt = q >> 3; ntile = q & 7; src = p.w_out + (size_t)_l * DM * DM; dst = p.WoutT + (size_t)_l * DM * DM; N = DM; g = nullptr; } } \
    const int k0 = kt * 64, n0 = ntile * 256;
#define PREP_LOAD(u) do { PREP_DECODE(u) (void)dst; _Pragma("unroll") for (int i = 0; i < 8; ++i) { const int kk = lrow + 8 * i; \
    const f32x4 v = *(const f32x4*)(src + (size_t)(k0 + kk) * N + n0 + c4); const float gg = g ? g[k0 + kk] : 1.f; r[i] = v * gg; } } while (0)
  int u = ubeg + wgi;
  if (u < NTOT) PREP_LOAD(u);
  for (; u < NTOT; u += wgn) {
#pragma unroll
    for (int i = 0; i < 8; ++i) *(LAS f32x4*)(lds + ((lrow + 8 * i) * 260 + c4) * 4) = r[i];
    __syncthreads();
    const int un = u + wgn;
    if (un < NTOT) PREP_LOAD(un);
    {
      PREP_DECODE(u) (void)src; (void)N; (void)g;
      const int n = tid >> 1, kh = (tid & 1) * 32;
      bf16_t* op = dst + (size_t)(n0 + n) * DM + k0 + kh;
#pragma unroll
      for (int q = 0; q < 4; ++q) {
        float f[8];
#pragma unroll
        for (int j = 0; j < 8; ++j) f[j] = *(const LAS float*)(lds + ((kh + q * 8 + j) * 260 + n) * 4);
        const u32x4 o = {pk2(f[0], f[1]), pk2(f[2], f[3]), pk2(f[4], f[5]), pk2(f[6], f[7])};
        *(u32x4*)(op + q * 8) = o;
      }
    }
    __syncthreads();
  }
#undef PREP_DECODE
#undef PREP_LOAD
  if (do_lam && blockIdx.x == 0 && tid < 64) {
    for (int l = 0; l < 2; ++l) {
      float a = p.lq1[l * 64 + tid] * p.lk1[l * 64 + tid], b = p.lq2[l * 64 + tid] * p.lk2[l * 64 + tid];
#pragma unroll
      for (int off = 32; off >= 1; off >>= 1) { a += __shfl_xor(a, off); b += __shfl_xor(b, off); }
      float li = 0.8f - 0.6f * expf(-0.3f * (float)l);
      if (tid == 0) p.lam[l] = expf(a) - expf(b) + li;
    }
  }
}

template <int MODE> DI void rownorm(const Params& p) {
  const int tid = opaque_tid(); const int wave = tid >> 6, lane = tid & 63;
  const int nw = gridDim.x * 8;
  for (int row = (MODE == 1 ? 8192 : 0) + blockIdx.x * 8 + wave; row < MROWS; row += nw) {
    const int b = row / LROW, pos = row - b * LROW;
    if (MODE == 2 && pos < 64) continue;
    const float* src;
    if (MODE <= 1) src = pos < 48 ? nullptr : (pos < 64 ? p.meta + (size_t)(pos - 48) * DM : p.x + ((size_t)b * 2048 + (pos - 64)) * DM);
    else src = p.h + (size_t)row * DM;
    float4 v[8]; float ss = 0.f;
#pragma unroll
    for (int i = 0; i < 8; ++i) {
      v[i] = src ? *(const float4*)(src + i * 256 + lane * 4) : make_float4(0.f, 0.f, 0.f, 0.f);
      if (MODE != 0 && row >= 8192) {
#pragma unroll
        for (int s = 0; s < 8; ++s) { const float4 q = *(const float4*)(p.P2 + ((size_t)s * 256 + (row - 8192)) * DM + i * 256 + lane * 4); v[i].x += q.x; v[i].y += q.y; v[i].z += q.z; v[i].w += q.w; }
      }
      ss += v[i].x * v[i].x + v[i].y * v[i].y + v[i].z * v[i].z + v[i].w * v[i].w;
    }
#pragma unroll
    for (int off = 32; off >= 1; off >>= 1) ss += __shfl_xor(ss, off);
    const float rs = rsqrtf(ss * (1.f / 2048.f) + 1e-6f);
    if (MODE < 2) {
#pragma unroll
      for (int i = 0; i < 8; ++i) {
        if (MODE == 1) *(float4*)(p.h + (size_t)row * DM + i * 256 + lane * 4) = v[i];
        uint2 o; o.x = pk2(v[i].x, v[i].y); o.y = pk2(v[i].z, v[i].w);
        *(uint2*)(p.hb + (size_t)row * DM + i * 256 + lane * 4) = o;
      }
      if (lane == 0) p.ss[(MODE == 0 ? 0 : 1) * MROWS + row] = ss;
    } else {
      float* dst = p.out + ((size_t)b * 2048 + (pos - 64)) * DM;
#pragma unroll
      for (int i = 0; i < 8; ++i) {
        float4 g = *(const float4*)(p.fin_g + i * 256 + lane * 4);
        float4 o; o.x = v[i].x * rs * g.x; o.y = v[i].y * rs * g.y; o.z = v[i].z * rs * g.z; o.w = v[i].w * rs * g.w;
        *(float4*)(dst + i * 256 + lane * 4) = o;
      }
    }
  }
}

constexpr int GK = 2048, GBK = 64, GHALF = 128, GHTB = GHALF * GBK * 2;
constexpr size_t TSTEP = (size_t)256 * GK * 2;
struct Unit { int mt, nt, tr, k0, nkt, nb; };

template <class Epi, class Sched>
DI void gemm_phase(LAS unsigned char* lds, const Sched& S, const Epi& E) {
  const int tid = opaque_tid(), wid = __builtin_amdgcn_readfirstlane(tid >> 6), lane = tid & 63, wr = wid >> 2, wc = wid & 3, fr = lane & 15, fq = lane >> 4;
  constexpr int K = GK;
  unsigned voffA[2], dperm;
#pragma unroll
  for (int i = 0; i < 2; ++i) { int R, C; stage_rc(tid * 16 + i * 8192, R, C); voffA[i] = (unsigned)(R * K + C) * 2u;
    if (i == 0) dperm = (unsigned)((perm32(R & 31) - (R & 31)) * K * 2); }
  const size_t kstep = (size_t)(GBK * 2);
  const size_t hstep = (size_t)GHALF * K * 2;
  const unsigned ldsw = (unsigned)wid * 1024u;
  const int aoff = lds_byte(wr * 64 + fr, fq * 8), boff = lds_byte(wc * 32 + fr, fq * 8);
#define G_SA(b, h) (((b) * 2 + (h)) * GHTB)
#define G_SB(b, h) ((4 + (b) * 2 + (h)) * GHTB)
#define G_STAGE(bufoff, gbase, voff) do { _Pragma("unroll") for (int _i = 0; _i < 2; ++_i) \
    __builtin_amdgcn_global_load_lds((const unsigned*)((const char*)(gbase) + voff[_i]), (LAS unsigned*)(lds + (bufoff) + ldsw + _i * 8192), 16, 0, 0); } while (0)
#define G_LDA(dst, b, h) do { _Pragma("unroll") for (int m = 0; m < 4; ++m) _Pragma("unroll") for (int k = 0; k < 2; ++k) dst[m][k] = *(const LAS bf16x8*)(lds + G_SA(b, h) + aoff + m * 2048 + k * 1024); } while (0)
#define G_LDB(dst, b, h) do { _Pragma("unroll") for (int n = 0; n < 2; ++n) _Pragma("unroll") for (int k = 0; k < 2; ++k) dst[n][k] = *(const LAS bf16x8*)(lds + G_SB(b, h) + boff + n * 2048 + k * 1024); } while (0)
#define G_MMA(ai, bj, At, Bx) do { __builtin_amdgcn_s_setprio(1); _Pragma("unroll") for (int m = 0; m < 4; ++m) _Pragma("unroll") for (int n = 0; n < 2; ++n) _Pragma("unroll") for (int k = 0; k < 2; ++k) \
    acc[ai][bj][m][n] = MFMA16(Bx[n][k], At[m][k], acc[ai][bj][m][n]); __builtin_amdgcn_s_setprio(0); } while (0)
#define G_WAIT_V(n) asm volatile("s_waitcnt vmcnt(" #n ")" ::: "memory")
#define G_WAIT_L(n) asm volatile("s_waitcnt lgkmcnt(" #n ")" ::: "memory")
#define G_BAR __builtin_amdgcn_s_barrier()
#define G_SCHED __builtin_amdgcn_sched_barrier(0)
  Unit cur, nxt; int ui = 0;
  if (!S.next(0, cur)) return;
  f32x4 acc[2][2][4][2];
  E.init(acc, cur, wr, wc, fr, fq);
  bf16x8 At[4][2], B0[2][2], B1[2][2];
  const char* cA = S.pa(cur); const char* cB = S.pb(cur);
  { const unsigned ds0 = cur.nb ? 0u : dperm; const unsigned vb[2] = {voffA[0] + ds0, voffA[1] + ds0};
  G_STAGE(G_SB(0, 0), cB, vb); G_STAGE(G_SA(0, 0), cA, voffA); G_STAGE(G_SB(0, 1), cB + hstep, vb); G_STAGE(G_SA(0, 1), cA + hstep, voffA);
  if (wr == 1) G_BAR;
  G_WAIT_V(4); G_BAR;
  G_STAGE(G_SB(1, 0), cB + kstep, vb); G_STAGE(G_SA(1, 0), cA + kstep, voffA); G_STAGE(G_SB(1, 1), cB + hstep + kstep, vb); }
  G_WAIT_V(6); G_BAR;
  for (;;) {
    const bool has_next = S.next(ui + 1, nxt);
    if (!has_next) nxt = cur;
    const char* nA = has_next ? S.pa(nxt) : cA; const char* nB = has_next ? S.pb(nxt) : cB;
    const int nt = cur.nkt;
    for (int t = 0; t < nt; t += 2) {
      const bool last = (t == nt - 2);
      const char* a1 = cA + (size_t)(t + 1) * kstep;
      const char* a2 = last ? nA : cA + (size_t)(t + 2) * kstep; const char* b2 = last ? nB : cB + (size_t)(t + 2) * kstep;
      const char* a3 = a2 + kstep; const char* b3 = b2 + kstep;
      const bool nbs = last ? (nxt.nb != 0) : (cur.nb != 0);
      const unsigned ds = nbs ? 0u : dperm; const unsigned vb[2] = {voffA[0] + ds, voffA[1] + ds};
      G_LDB(B0, 0, 0); G_SCHED; G_LDA(At, 0, 0); G_STAGE(G_SA(1, 1), a1 + hstep, voffA);
      G_WAIT_L(8); G_BAR; G_WAIT_L(0); G_MMA(0, 0, At, B0); G_BAR; G_SCHED;
      G_LDB(B1, 0, 1); G_STAGE(G_SB(0, 0), b2, vb);
      G_BAR; G_WAIT_L(0); G_MMA(0, 1, At, B1); G_BAR;
      G_LDA(At, 0, 1); G_STAGE(G_SA(0, 0), a2, voffA);
      G_BAR; G_WAIT_L(0); G_MMA(1, 0, At, B0); G_BAR; G_SCHED;
      G_STAGE(G_SB(0, 1), b2 + hstep, vb);
      G_WAIT_V(6); G_BAR; G_MMA(1, 1, At, B1); G_BAR;
      G_LDB(B0, 1, 0); G_SCHED; G_LDA(At, 1, 0); G_STAGE(G_SA(0, 1), a2 + hstep, voffA);
      G_WAIT_L(8); G_BAR; G_WAIT_L(0); G_MMA(0, 0, At, B0); G_BAR; G_SCHED;
      G_LDB(B1, 1, 1); G_STAGE(G_SB(1, 0), b3, vb);
      G_BAR; G_WAIT_L(0); G_MMA(0, 1, At, B1); G_BAR;
      G_LDA(At, 1, 1); G_STAGE(G_SA(1, 0), a3, voffA);
      G_BAR; G_WAIT_L(0); G_MMA(1, 0, At, B0); G_BAR; G_SCHED;
      G_STAGE(G_SB(1, 1), b3 + hstep, vb);
      G_WAIT_V(6); G_BAR; G_MMA(1, 1, At, B1); G_BAR;
    }
    { const int t2 = opaque_tid() & 63; E(acc, cur, wr, wc, t2 & 15, t2 >> 4); }
    if (!has_next) break;
    cur = nxt; cA = nA; cB = nB; ++ui;
    E.init(acc, cur, wr, wc, fr, fq);
  }
  G_WAIT_V(0);
  if (wr == 0) G_BAR;
  G_BAR;
}

#define XB_TMO      128
#define XB_XCNT(j)  (256  + 64 * (j))
#define XB_XSUB(j)  (1280 + 64 * (j))
#define XB_XGEN(j)  (2304 + 64 * (j))
#define XB_TOP      3328
#define XB_TOPGEN   3392
#define XCD_BAR_WORDS 3456
#define XB_SPIN_CAP (1u << 18)
DI unsigned xb_ld(unsigned* p) { return __hip_atomic_load(p, __ATOMIC_RELAXED, __HIP_MEMORY_SCOPE_AGENT); }
DI unsigned xb_add(unsigned* p, unsigned v) { return __hip_atomic_fetch_add(p, v, __ATOMIC_RELAXED, __HIP_MEMORY_SCOPE_AGENT); }
DI unsigned xb_xcc_id() { return (unsigned)__builtin_amdgcn_s_getreg((3 << 11) | 20) & 0xFu; }
#define XB_SPIN(cond, bar) do { unsigned _sp = 0; while (cond) { __builtin_amdgcn_s_sleep(1); \
    if ((++_sp & 255u) == 0u) { if (xb_ld(&(bar)[XB_TMO])) break; if (_sp > XB_SPIN_CAP) { atomicAdd(&(bar)[XB_TMO], 1u); break; } } } } while (0)
struct XcdBarrier { unsigned* bar; unsigned x; volatile LAS unsigned* st; };
DI XcdBarrier xcd_barrier_post(unsigned* bar, volatile LAS unsigned* st) {
  XcdBarrier b; b.bar = bar; b.x = xb_xcc_id(); b.st = st;
  if (threadIdx.x == 0) (void)xb_add(&bar[XB_XCNT(b.x)], 1u);
  return b;
}
DI void xcd_barrier_complete(unsigned* bar, unsigned x, unsigned& nloc, unsigned& nx) {
  const unsigned G = gridDim.x * gridDim.y * gridDim.z;
  unsigned sum, cnt, mine, sp = 0u;
  for (;;) {
    sum = 0u; cnt = 0u; mine = 0u;
#pragma unroll
    for (unsigned j = 0; j < 16; ++j) { const unsigned c = xb_ld(&bar[XB_XCNT(j)]); sum += c; cnt += (c > 0u) ? 1u : 0u; mine = (j == x) ? c : mine; }
    if (sum == G) break;
    __builtin_amdgcn_s_sleep(1);
    if ((++sp & 255u) == 0u) { if (xb_ld(&bar[XB_TMO])) break; if (sp > XB_SPIN_CAP) { atomicAdd(&bar[XB_TMO], 1u); break; } }
  }
  nloc = mine > 0u ? mine : 1u; nx = cnt > 0u ? cnt : 1u;
}
DI void xcd_barrier(const XcdBarrier& b) {
  asm volatile("s_waitcnt vmcnt(0)" ::: "memory");
  __syncthreads();
  if (threadIdx.x == 0) {
    unsigned* bar = b.bar;
    __builtin_amdgcn_s_waitcnt(0);
    unsigned nloc = b.st[0], nx = b.st[1];
    if (nloc == 0u) { xcd_barrier_complete(bar, b.x, nloc, nx); b.st[0] = nloc; b.st[1] = nx; }
    const unsigned old = xb_add(&bar[XB_XSUB(b.x)], 1u);
    const unsigned gen = old / nloc;
    if (old + 1u == (gen + 1u) * nloc) {
      __builtin_amdgcn_fence(__ATOMIC_RELEASE, "agent");
      asm volatile("s_waitcnt vmcnt(0)" ::: "memory");
      const unsigned og = xb_add(&bar[XB_TOP], 1u);
      const unsigned tg = og / nx;
      if (og + 1u == (tg + 1u) * nx) xb_add(&bar[XB_TOPGEN], 1u);
      else XB_SPIN(xb_ld(&bar[XB_TOPGEN]) == tg, bar);
      __builtin_amdgcn_fence(__ATOMIC_ACQUIRE, "agent");
      xb_add(&bar[XB_XGEN(b.x)], 1u);
      asm volatile("s_waitcnt vmcnt(0)" ::: "memory");
    } else {
      XB_SPIN(xb_ld(&bar[XB_XGEN(b.x)]) == gen, bar);
      __builtin_amdgcn_fence(__ATOMIC_ACQUIRE, "agent");
      asm volatile("s_waitcnt vmcnt(0)" ::: "memory");
    }
  }
  __syncthreads();
}

DI void tile_map(int wgid, int nM, int nN, int& pm, int& pn) {
  const int nwg = nM * nN;
  { int q = nwg / 8, r = nwg % 8, xcd = wgid % 8, off = wgid / 8; wgid = (xcd < r ? xcd * (q + 1) : r * (q + 1) + (xcd - r) * q) + off; }
  const int nig = 8 * nN, gid = wgid / nig, fm = gid * 8, gsz = min(nM - fm, 8);
  pm = fm + ((wgid % nig) % gsz); pn = (wgid % nig) / gsz;
}

struct Sched1 {
  const bf16_t* hb; const bf16_t* W; int ubeg, uend;
  DI bool next(int i, Unit& u) const {
    const int U = ubeg + i * (int)gridDim.x + (int)blockIdx.x; if (U >= uend) return false;
    int pm, pn;
    if (U < 928) tile_map(U, 29, 32, pm, pn);
    else if (U < 1024) { const int q = U - 928, c = q % 24; pm = 29 + q / 24; pn = c < 12 ? c : c + 4; }
    else { const int q = U - 1024, g = q & 7; pm = 29 + (q >> 3); pn = g < 4 ? 12 + g : 24 + g; }
    u.mt = pm; u.nt = pn; u.k0 = 0; u.nkt = 32; const int g = pn >> 2; u.tr = (g == 1 || g == 2 || g == 6) ? 1 : 0; u.nb = u.tr; return true;
  }
  DI const char* pa(const Unit& u) const { return u.tr ? (const char*)W + (size_t)u.nt * TSTEP : (const char*)hb + (size_t)u.mt * TSTEP; }
  DI const char* pb(const Unit& u) const { return u.tr ? (const char*)hb + (size_t)u.mt * TSTEP : (const char*)W + (size_t)u.nt * TSTEP; }
};
struct Sched2 {
  const bf16_t* mix; const bf16_t* W;
  DI bool next(int i, Unit& u) const {
    const int U = i * (int)gridDim.x + (int)blockIdx.x; if (U >= 256 + 64) return false;
    if (U < 256) { int pm, pn; tile_map(U, 32, 8, pm, pn); u.mt = pm; u.nt = pn; u.tr = 0; u.k0 = 0; u.nkt = 32; u.nb = 0; }
    else { const int j = U - 256; u.mt = 32; u.nt = j >> 3; u.tr = 1 + (j & 7); u.k0 = (j & 7) * 256; u.nkt = 4; u.nb = 0; }
    return true;
  }
  DI const char* pa(const Unit& u) const { return (const char*)mix + (size_t)u.mt * TSTEP + (size_t)u.k0 * 2; }
  DI const char* pb(const Unit& u) const { return (const char*)W + (size_t)u.nt * TSTEP + (size_t)u.k0 * 2; }
};

DI void acc_zero(f32x4 (&acc)[2][2][4][2]) {
#pragma unroll
  for (int a = 0; a < 2; ++a)
#pragma unroll
    for (int b = 0; b < 2; ++b)
#pragma unroll
      for (int m = 0; m < 4; ++m)
#pragma unroll
        for (int n = 0; n < 2; ++n) acc[a][b][m][n] = (f32x4){0.f, 0.f, 0.f, 0.f};
}
struct Epi1 {
  bf16_t* proj; bf16_t* T; const float* ss;
  DI void init(f32x4 (&acc)[2][2][4][2], const Unit&, int, int, int, int) const { acc_zero(acc); }
  DI void operator()(const f32x4 (&acc)[2][2][4][2], const Unit& u, int wr, int wc, int fr, int fq) const {
    const int g = u.nt >> 2;
    if (!u.tr) {
      const float sc = (g == 4) ? 0.125f * LOG2E : 1.f;
      const int n0 = u.nt * 256 + wc * 32 + fq * 8;
#pragma unroll
      for (int ai = 0; ai < 2; ++ai)
#pragma unroll
        for (int mi = 0; mi < 4; ++mi) {
          const int m = u.mt * 256 + ai * 128 + wr * 64 + mi * 16 + fr;
          const float rs = rsqrtf(ss[m] * (1.f / 2048.f) + 1e-6f) * sc;
          bf16_t* rowp = proj + (size_t)m * NIN + n0;
#pragma unroll
          for (int bj = 0; bj < 2; ++bj) {
            const f32x4 a = acc[ai][bj][mi][0], c = acc[ai][bj][mi][1];
            const u32x4 o = {pk2(a[0] * rs, a[1] * rs), pk2(a[2] * rs, a[3] * rs), pk2(c[0] * rs, c[1] * rs), pk2(c[2] * rs, c[3] * rs)};
            *(u32x4*)(rowp + bj * 128) = o;
          }
        }
    } else {
      const int tbase = (g == 1 ? 0 : (g == 2 ? 1024 : 2048)) - g * 1024;
#pragma unroll
      for (int bj = 0; bj < 2; ++bj) {
        const int mb = u.mt * 256 + bj * 128 + wc * 32;
        const int b = mb / LROW, posb = mb - b * LROW;
        const f32x4 q0 = *(const f32x4*)(ss + mb + 4 * fq), q1 = *(const f32x4*)(ss + mb + 16 + 4 * fq);
        float rs[8];
#pragma unroll
        for (int j = 0; j < 4; ++j) { rs[j] = rsqrtf(q0[j] * (1.f / 2048.f) + 1e-6f); rs[4 + j] = rsqrtf(q1[j] * (1.f / 2048.f) + 1e-6f); }
        const int p0 = posb + 4 * fq, p1 = p0 + 16;
        if (g == 1) {
#pragma unroll
          for (int j = 0; j < 4; ++j) { rs[j] = (p0 + j >= 48) ? rs[j] * 0.08838834764831845f : 0.f; rs[4 + j] = (p1 + j >= 48) ? rs[4 + j] * 0.08838834764831845f : 0.f; }
        }
#pragma unroll
        for (int ai = 0; ai < 2; ++ai)
#pragma unroll
          for (int mi = 0; mi < 4; ++mi) {
            const int col = u.nt * 256 + ai * 128 + wr * 64 + mi * 16 + fr;
            const f32x4 a = acc[ai][bj][mi][0], c = acc[ai][bj][mi][1];
            float v[8] = {a[0] * rs[0], a[1] * rs[1], a[2] * rs[2], a[3] * rs[3], c[0] * rs[4], c[1] * rs[5], c[2] * rs[6], c[3] * rs[7]};
            if (g == 1) {
              const int hh = (col - 1024) >> 7;
              const float l2g = log2f(1.f - exp2f(-5.f - (float)hh));
              const int z0 = 63 - (p0 & 63), z1 = 63 - (p1 & 63);
#pragma unroll
              for (int j = 0; j < 4; ++j) { v[j] *= exp2f(l2g * (float)(z0 - j)); v[4 + j] *= exp2f(l2g * (float)(z1 - j)); }
            }
            const u32x4 o = {pk2(v[0], v[1]), pk2(v[2], v[3]), pk2(v[4], v[5]), pk2(v[6], v[7])};
            *(u32x4*)(T + ((size_t)(b * 3072 + tbase + col)) * LROW + posb + 8 * fq) = o;
          }
      }
    }
  }
};
struct Epi2 {
  float* h; float* P2; bf16_t* hb; float* ssn; const float* x; const float* meta;
  DI void init(f32x4 (&acc)[2][2][4][2], const Unit& u, int wr, int wc, int fr, int fq) const {
    if (u.tr) { acc_zero(acc); return; }
    const int n0 = u.nt * 256 + wc * 32 + fq * 8;
#pragma unroll
    for (int ai = 0; ai < 2; ++ai)
#pragma unroll
      for (int mi = 0; mi < 4; ++mi) {
        const int m = u.mt * 256 + ai * 128 + wr * 64 + mi * 16 + fr;
        const float* rowp = h + (size_t)m * DM + n0;
        if (x) { const int b = m / LROW, pos = m - b * LROW; rowp = pos < 48 ? nullptr : (pos < 64 ? meta + (size_t)(pos - 48) * DM : x + ((size_t)b * 2048 + (pos - 64)) * DM) + n0; }
#pragma unroll
        for (int bj = 0; bj < 2; ++bj)
#pragma unroll
          for (int ni = 0; ni < 2; ++ni) acc[ai][bj][mi][ni] = rowp ? *(const f32x4*)(rowp + bj * 128 + ni * 4) : (f32x4){0.f, 0.f, 0.f, 0.f};
      }
  }
  DI void operator()(const f32x4 (&acc)[2][2][4][2], const Unit& u, int wr, int wc, int fr, int fq) const {
    const int n0 = u.nt * 256 + wc * 32 + fq * 8;
#pragma unroll
    for (int ai = 0; ai < 2; ++ai)
#pragma unroll
      for (int mi = 0; mi < 4; ++mi) {
        const int m = u.mt * 256 + ai * 128 + wr * 64 + mi * 16 + fr;
        float* rowp = (u.tr ? P2 + ((size_t)(u.tr - 1) * 256 + (m - 8192)) * DM : h + (size_t)m * DM) + n0;
        float sq = 0.f;
#pragma unroll
        for (int bj = 0; bj < 2; ++bj) {
          const f32x4 a = acc[ai][bj][mi][0], c = acc[ai][bj][mi][1];
          *(f32x4*)(rowp + bj * 128) = a; *(f32x4*)(rowp + bj * 128 + 4) = c;
          if (ssn && !u.tr) {
            sq += a[0] * a[0] + a[1] * a[1] + a[2] * a[2] + a[3] * a[3] + c[0] * c[0] + c[1] * c[1] + c[2] * c[2] + c[3] * c[3];
            const u32x4 o = {pk2(a[0], a[1]), pk2(a[2], a[3]), pk2(c[0], c[1]), pk2(c[2], c[3])};
            *(u32x4*)(hb + (size_t)m * DM + n0 + bj * 128) = o;
          }
        }
        if (ssn && !u.tr) {
          sq += __shfl_xor(sq, 16); sq += __shfl_xor(sq, 32);
          if (fq == 0) unsafeAtomicAdd(ssn + m, sq);
        }
      }
  }
};

DI void gemm1_phase(const Params& p, int l, LAS unsigned char* lds, int ubeg, int uend) {
  Sched1 S{p.hb, p.WinT + (size_t)l * NIN * DM, ubeg, uend}; Epi1 E{p.proj, p.T, p.ss + (size_t)l * MROWS};
  gemm_phase(lds, S, E);
}
DI void gemm2_phase(const Params& p, int l, LAS unsigned char* lds) {
  Sched2 S{p.mix, p.WoutT + (size_t)l * DM * DM}; Epi2 E{p.h, p.P2, p.hb, l == 0 ? p.ss + MROWS : nullptr, l == 0 ? p.x : nullptr, p.meta};
  gemm_phase(lds, S, E);
}

DI void ret_scan_chain(const Params& p, int b, int h, LAS unsigned char* lds, unsigned* done_ctr) {
  constexpr int D = 6;
  const int tid = opaque_tid(), w = __builtin_amdgcn_readfirstlane(tid >> 6), lane = tid & 63, fr = lane & 15, fq = lane >> 4;
  const float l2g = log2f(1.f - exp2f(-5.f - (float)h));
  const float dec64 = exp2f(l2g * 64.f);
  const int sub16 = lds_byte(fr, fq * 8);
  const int fillT = lds_byte(tid >> 3, (tid & 7) * 8);
  const bf16_t* gk = p.T + (size_t)b * 3072 * LROW + (size_t)(h * 128 + (tid >> 3)) * LROW + (tid & 7) * 8;
  u32x4* so = (u32x4*)p.ST + ((size_t)((b * 8 + h) * NCH) * 8 + w) * 256 + lane;
  f32x4 st[8];
#pragma unroll
  for (int i = 0; i < 8; ++i) st[i] = (f32x4){0.f, 0.f, 0.f, 0.f};
  u32x4 ring[D][4];
#define SCAN_LOAD(slot, n) do { const bf16_t* _t = gk + (n) * 64; ring[slot][0] = *(const u32x4*)_t; ring[slot][1] = *(const u32x4*)(_t + (size_t)64 * LROW); \
    ring[slot][2] = *(const u32x4*)(_t + (size_t)1024 * LROW); ring[slot][3] = *(const u32x4*)(_t + (size_t)1088 * LROW); } while (0)
#define SCAN_STORE(n) do { _Pragma("unroll") for (int kd = 0; kd < 4; ++kd) { const f32x4 sa = st[2 * kd], sc = st[2 * kd + 1]; \
    const u32x4 bsu = {pk2(sa[0], sa[1]), pk2(sa[2], sa[3]), pk2(sc[0], sc[1]), pk2(sc[2], sc[3])}; so[(size_t)(n) * 2048 + kd * 64] = bsu; } } while (0)
#pragma unroll
  for (int i = 0; i < D; ++i) SCAN_LOAD(i, i);
#pragma unroll
  for (int n = 0; n < NCH - 1; ++n) {
    const int slot = n % D, bo = (n & 1) * 32768;
    *(LAS u32x4*)(lds + bo + fillT) = ring[slot][0]; *(LAS u32x4*)(lds + bo + fillT + 8192) = ring[slot][1];
    *(LAS u32x4*)(lds + bo + 16384 + fillT) = ring[slot][2]; *(LAS u32x4*)(lds + bo + 16384 + fillT + 8192) = ring[slot][3];
    if (n + D < NCH - 1) SCAN_LOAD(slot, n + D);
    __syncthreads();
    SCAN_STORE(n);
    const bf16x8 vf0 = *(const LAS bf16x8*)(lds + bo + 16384 + w * 2048 + sub16), vf1 = *(const LAS bf16x8*)(lds + bo + 16384 + w * 2048 + 1024 + sub16);
#pragma unroll
    for (int db = 0; db < 8; ++db) {
      st[db] *= dec64;
      const bf16x8 a0 = *(const LAS bf16x8*)(lds + bo + sub16 + db * 2048);
      const bf16x8 a1 = *(const LAS bf16x8*)(lds + bo + sub16 + db * 2048 + 1024);
      st[db] = MFMA16(a0, vf0, st[db]); st[db] = MFMA16(a1, vf1, st[db]);
    }
  }
  SCAN_STORE(NCH - 1);
  asm volatile("s_waitcnt vmcnt(0)" ::: "memory");
  __syncthreads();
  if (threadIdx.x == 0) { __builtin_amdgcn_fence(__ATOMIC_RELEASE, "agent"); asm volatile("s_waitcnt vmcnt(0)" ::: "memory"); xb_add(done_ctr, 1u); }
#undef SCAN_LOAD
#undef SCAN_STORE
}

DI void retention_items(const Params& p, int l, LAS unsigned char* lds, int first, int stride, int count) {
  constexpr int QS = 0, KS = 16384, VTS = 49152, PS = 65536, OS = 73728;
  const int tid = opaque_tid(), w = __builtin_amdgcn_readfirstlane(tid >> 6), lane = tid & 63, fr = lane & 15, fq = lane >> 4;
  const int sub16 = lds_byte(fr, fq * 8), sub8a = lds_byte(fr, fq * 4), sub8b = lds_byte(fr, fq * 4 + 16);
  const int dq = (tid & 15) * 8;
  const int fillQ = (dq >> 6) * 8192 + lds_byte(tid >> 4, dq & 63);
  const int fillT = lds_byte(tid >> 3, (tid & 7) * 8);
  const int sb = w & 3, tb0 = (w >> 2) * 2;
  const int kbase = KS + sb * 2048 + sub16, qbase = QS + tb0 * 2048 + sub16;
  const int pbase = PS + tb0 * 2048 + (sb >> 1) * 1024 + lds_byte(fr, fq * 8 + 4 * (sb & 1));
  const int vbase = VTS + w * 2048 + sub16;
  const int obase = OS + ((fq * 4) * 132 + w * 16 + fr) * 4;
  const int nbase = OS + ((tid >> 3) * 132 + (tid & 7) * 16) * 4;
  u32x4 pq0, pq1, pk0, pk1, pv0, pv1, ns0, ns1, ns2, ns3, ng0, ng1;
#define RET_GLOAD(it) do { const int _bh = (it) / NCH, _n = (it) - _bh * NCH, _b = _bh >> 3, _h = _bh & 7; \
    const bf16_t* _q = p.proj + ((size_t)_b * LROW + _n * 64 + (tid >> 4)) * NIN + _h * 128 + dq; \
    const bf16_t* _t = p.T + ((size_t)_b * 3072 + 1024 + _h * 128 + (tid >> 3)) * LROW + _n * 64 + (tid & 7) * 8; \
    pq0 = *(const u32x4*)_q; pq1 = *(const u32x4*)(_q + (size_t)32 * NIN); pk0 = *(const u32x4*)(_t - (size_t)1024 * LROW); pk1 = *(const u32x4*)(_t - (size_t)960 * LROW); \
    pv0 = *(const u32x4*)_t; pv1 = *(const u32x4*)(_t + (size_t)64 * LROW); \
    const u32x4* _sp = (const u32x4*)p.ST + ((size_t)(it) * 8 + w) * 256 + lane; ns0 = _sp[0]; ns1 = _sp[64]; ns2 = _sp[128]; ns3 = _sp[192]; \
    const bf16_t* _gp = p.proj + ((size_t)_b * LROW + _n * 64 + (tid >> 3)) * NIN + 3072 + _h * 128 + (tid & 7) * 16; \
    ng0 = *(const u32x4*)_gp; ng1 = *(const u32x4*)(_gp + 8); } while (0)
  int it = first;
  const int iend = first + stride * count;
  if (it < iend) RET_GLOAD(it);
  for (; it < iend; it += stride) {
    const int bh = it / NCH, n = it - bh * NCH, b = bh >> 3, h = bh & 7;
    const float l2g = log2f(1.f - exp2f(-5.f - (float)h));
    *(LAS u32x4*)(lds + QS + fillQ) = pq0; *(LAS u32x4*)(lds + QS + fillQ + 4096) = pq1;
    {
      const int d0 = tid >> 3, s0 = (tid & 7) * 8;
#pragma unroll
      for (int i = 0; i < 2; ++i) {
        const u32x4 kv = i ? pk1 : pk0;
        const int d = d0 + 64 * i, ko = KS + (d >> 6) * 8192;
#pragma unroll
        for (int j = 0; j < 8; ++j) {
          const unsigned wv = kv[j >> 1];
          const int st = (s0 & 32) + 16 * (j >> 2) + 4 * ((s0 >> 3) & 3) + (j & 3);
          *(LAS bf16_t*)(lds + ko + lds_byte(st, d & 63)) = (bf16_t)((j & 1) ? (wv >> 16) : (wv & 0xffffu));
        }
      }
    }
    *(LAS u32x4*)(lds + VTS + fillT) = pv0; *(LAS u32x4*)(lds + VTS + fillT + 8192) = pv1;
    const u32x4 sf0 = ns0, sf1 = ns1, sf2 = ns2, sf3 = ns3, g0 = ng0, g1 = ng1;
    __syncthreads();
    if (it + stride < iend) RET_GLOAD(it + stride);
    const size_t row = (size_t)b * LROW + n * 64 + (tid >> 3);
    {
      f32x4 s0 = {0.f, 0.f, 0.f, 0.f}, s1 = {0.f, 0.f, 0.f, 0.f};
#pragma unroll
      for (int ks = 0; ks < 4; ++ks) {
        const int off = (ks >> 1) * 8192 + (ks & 1) * 1024;
        const bf16x8 a = *(const LAS bf16x8*)(lds + kbase + off);
        const bf16x8 b0 = *(const LAS bf16x8*)(lds + qbase + off);
        const bf16x8 b1 = *(const LAS bf16x8*)(lds + qbase + off + 2048);
        s0 = MFMA16(a, b0, s0); s1 = MFMA16(a, b1, s1);
      }
      const int srow = sb * 16 + fq * 4;
#pragma unroll
      for (int i = 0; i < 2; ++i) {
        const f32x4 sv = i ? s1 : s0;
        const int t = (tb0 + i) * 16 + fr;
        const float v0 = sv[0] * EXP2(l2g * (fabsf((float)(t - srow)) - (float)(63 - srow))), v1 = sv[1] * EXP2(l2g * (fabsf((float)(t - srow - 1)) - (float)(62 - srow)));
        const float v2 = sv[2] * EXP2(l2g * (fabsf((float)(t - srow - 2)) - (float)(61 - srow))), v3 = sv[3] * EXP2(l2g * (fabsf((float)(t - srow - 3)) - (float)(60 - srow)));
        const u32x2 o = {pk2(v0, v1), pk2(v2, v3)};
        *(LAS u32x2*)(lds + pbase + i * 2048) = o;
      }
    }
    __syncthreads();
    {
      const bf16x8 vf0 = *(const LAS bf16x8*)(lds + vbase), vf1 = *(const LAS bf16x8*)(lds + vbase + 1024);
      f32x4 o[4], cr[4];
#pragma unroll
      for (int tb = 0; tb < 4; ++tb) {
        o[tb] = (f32x4){0.f, 0.f, 0.f, 0.f}; cr[tb] = (f32x4){0.f, 0.f, 0.f, 0.f};
        const bf16x8 a0 = *(const LAS bf16x8*)(lds + PS + sub16 + tb * 2048);
        const bf16x8 a1 = *(const LAS bf16x8*)(lds + PS + sub16 + tb * 2048 + 1024);
        o[tb] = MFMA16(a0, vf0, o[tb]); o[tb] = MFMA16(a1, vf1, o[tb]);
      }
#pragma unroll
      for (int kd = 0; kd < 4; ++kd) {
        const bf16x8 bsv = __builtin_bit_cast(bf16x8, kd == 0 ? sf0 : (kd == 1 ? sf1 : (kd == 2 ? sf2 : sf3)));
#pragma unroll
        for (int tb = 0; tb < 4; ++tb) {
          const int off = QS + (kd >> 1) * 8192 + (tb * 2 + (kd & 1)) * 1024;
          const s16x4 lo = *(const LAS s16x4*)(lds + off + sub8a);
          const s16x4 hi = *(const LAS s16x4*)(lds + off + sub8b);
          const bf16x8 a = __builtin_shufflevector(lo, hi, 0, 1, 2, 3, 4, 5, 6, 7);
          cr[tb] = MFMA16(a, bsv, cr[tb]);
        }
      }
#pragma unroll
      for (int tb = 0; tb < 4; ++tb)
#pragma unroll
        for (int j = 0; j < 4; ++j) o[tb][j] += EXP2(l2g * (float)(tb * 16 + fq * 4 + j + 1)) * cr[tb][j];
#pragma unroll
      for (int tb = 0; tb < 4; ++tb)
#pragma unroll
        for (int j = 0; j < 4; ++j) *(LAS float*)(lds + obase + (tb * 16 + j) * 528) = o[tb][j];
    }
    __syncthreads();
    {
      const int seg = tid & 7;
      const f32x4 x0 = *(const LAS f32x4*)(lds + nbase), x1 = *(const LAS f32x4*)(lds + nbase + 16), x2 = *(const LAS f32x4*)(lds + nbase + 32), x3 = *(const LAS f32x4*)(lds + nbase + 48);
      f32x4 xs = x0 + x1 + x2 + x3;
      float sum = xs[0] + xs[1] + xs[2] + xs[3];
      sum += __shfl_xor(sum, 1); sum += __shfl_xor(sum, 2); sum += __shfl_xor(sum, 4);
      const float mu = sum * (1.f / 128.f);
      const f32x4 d0 = x0 - mu, d1 = x1 - mu, d2 = x2 - mu, d3 = x3 - mu;
      const f32x4 q = d0 * d0 + d1 * d1 + d2 * d2 + d3 * d3;
      float vs = q[0] + q[1] + q[2] + q[3];
      vs += __shfl_xor(vs, 1); vs += __shfl_xor(vs, 2); vs += __shfl_xor(vs, 4);
      const float rn = rsqrtf(vs * (1.f / 128.f) + 1e-6f);
      const float* gr = p.ret_g + l * 1024 + h * 128 + seg * 16;
      const f32x4 w0 = *(const f32x4*)gr, w1 = *(const f32x4*)(gr + 4), w2 = *(const f32x4*)(gr + 8), w3 = *(const f32x4*)(gr + 12);
      uint4 oa, ob;
      oa.x = pk2(d0[0] * rn * w0[0] * silu(bflo(g0[0])), d0[1] * rn * w0[1] * silu(bfhi(g0[0])));
      oa.y = pk2(d0[2] * rn * w0[2] * silu(bflo(g0[1])), d0[3] * rn * w0[3] * silu(bfhi(g0[1])));
      oa.z = pk2(d1[0] * rn * w1[0] * silu(bflo(g0[2])), d1[1] * rn * w1[1] * silu(bfhi(g0[2])));
      oa.w = pk2(d1[2] * rn * w1[2] * silu(bflo(g0[3])), d1[3] * rn * w1[3] * silu(bfhi(g0[3])));
      ob.x = pk2(d2[0] * rn * w2[0] * silu(bflo(g1[0])), d2[1] * rn * w2[1] * silu(bfhi(g1[0])));
      ob.y = pk2(d2[2] * rn * w2[2] * silu(bflo(g1[1])), d2[3] * rn * w2[3] * silu(bfhi(g1[1])));
      ob.z = pk2(d3[0] * rn * w3[0] * silu(bflo(g1[2])), d3[1] * rn * w3[1] * silu(bfhi(g1[2])));
      ob.w = pk2(d3[2] * rn * w3[2] * silu(bflo(g1[3])), d3[3] * rn * w3[3] * silu(bfhi(g1[3])));
      bf16_t* mp = p.mix + row * DM + h * 128 + seg * 16;
      *(uint4*)mp = oa; *(uint4*)(mp + 8) = ob;
    }
  }
#undef RET_GLOAD
}

DI void diff_pv(LAS unsigned char* lds, int vgb, const bf16x8 (&pfr)[2][2], f32x4 (&o)[2][8], int sub16) {
  __builtin_amdgcn_s_setprio(1);
#pragma unroll
  for (int eb = 0; eb < 8; ++eb)
#pragma unroll
    for (int kp = 0; kp < 2; ++kp) {
      const bf16x8 a = *(const LAS bf16x8*)(lds + vgb + (eb * 2 + kp) * 1024 + sub16);
      o[0][eb] = MFMA16(a, pfr[0][kp], o[0][eb]);
      o[1][eb] = MFMA16(a, pfr[1][kp], o[1][eb]);
    }
  __builtin_amdgcn_s_setprio(0);
}
DI void diff_tile(bool general, LAS unsigned char* lds, int kfb, const bf16x8 (&qf)[2][2], f32x4 (&o)[2][8], bf16x8 (&pfr)[2][2], float& m0, float& m1, float& l0, float& l1,
                  const f32x4 (&cj)[4], float slope2, int kt, int qrow, int fq) {
  f32x4 s[2][4];
#pragma unroll
  for (int kb = 0; kb < 4; ++kb) {
    const f32x4 init = cj[kb];
    const bf16x8 a0 = *(const LAS bf16x8*)(lds + kfb + (kb * 2) * 1024);
    const bf16x8 a1 = *(const LAS bf16x8*)(lds + kfb + (kb * 2 + 1) * 1024);
    s[0][kb] = MFMA16(a0, qf[0][0], init); s[1][kb] = MFMA16(a0, qf[1][0], init);
    s[0][kb] = MFMA16(a1, qf[0][1], s[0][kb]); s[1][kb] = MFMA16(a1, qf[1][1], s[1][kb]);
  }
  const float tconst = slope2 * (float)(kt * 64);
#pragma unroll
  for (int rb = 0; rb < 2; ++rb) {
    if (general) {
      const int qrel = qrow + rb * 16 - kt * 64;
      const float ms2 = -2.f * slope2;
#pragma unroll
      for (int kb = 0; kb < 4; ++kb)
#pragma unroll
        for (int j = 0; j < 4; ++j) {
          const int kl = kb * 16 + fq * 4 + j;
          float v = s[rb][kb][j] + ms2 * (float)max(kl - qrel, 0);
          if (kt == 0 && kl < 48) v = -INFINITY;
          s[rb][kb][j] = v;
        }
    }
    float mx = fmaxf(fmaxf(s[rb][0][0], s[rb][0][1]), fmaxf(s[rb][0][2], s[rb][0][3]));
#pragma unroll
    for (int kb = 1; kb < 4; ++kb) mx = fmaxf(fmaxf(mx, fmaxf(s[rb][kb][0], s[rb][kb][1])), fmaxf(s[rb][kb][2], s[rb][kb][3]));
    mx = xmax32(xmax16(mx));
    const float mloc = (rb ? m1 : m0) - tconst;
    const float mnew = fmaxf(mloc, mx);
    const float alpha = EXP2(mloc - mnew);
    float rsum = 0.f;
#pragma unroll
    for (int kb = 0; kb < 4; ++kb)
#pragma unroll
      for (int j = 0; j < 4; ++j) { const float pv = EXP2(s[rb][kb][j] - mnew); s[rb][kb][j] = pv; rsum += pv; }
    if (rb) { l1 = l1 * alpha + rsum; m1 = mnew + tconst; } else { l0 = l0 * alpha + rsum; m0 = mnew + tconst; }
    if (__any(alpha != 1.f)) {
#pragma unroll
      for (int eb = 0; eb < 8; ++eb) o[rb][eb] *= alpha;
    }
#pragma unroll
    for (int kp = 0; kp < 2; ++kp) {
      const f32x4 sa = s[rb][2 * kp], sc = s[rb][2 * kp + 1];
      const u32x4 pbu = {pk2(sa[0], sa[1]), pk2(sa[2], sa[3]), pk2(sc[0], sc[1]), pk2(sc[2], sc[3])};
      pfr[rb][kp] = __builtin_bit_cast(bf16x8, pbu);
    }
  }
}

DI void diff_item(const Params& p, int l, int b, int h, int pi, float lam, float lam_init, LAS unsigned char* lds) {
  const int tid = opaque_tid(), w = __builtin_amdgcn_readfirstlane(tid >> 6), lane = tid & 63, fr = lane & 15, fq = lane >> 4;
  const int c = w & 1, rgq = w >> 1, qc = 2 * pi + (rgq >> 1);
  const bool active = qc <= 32;
  const int ktmax = min(2 * pi + 1, 32);
  const int sub16 = lds_byte(fr, fq * 8), sub8a = lds_byte(fr, fq * 4), sub8b = lds_byte(fr, fq * 4 + 16);
  const bf16_t* projb = p.proj + (size_t)b * LROW * NIN;
  const int qrow = qc * 64 + (rgq & 1) * 32 + fr;
  bf16x8 qf[2][2];
#pragma unroll
  for (int rb = 0; rb < 2; ++rb)
#pragma unroll
    for (int ks = 0; ks < 2; ++ks)
      qf[rb][ks] = active ? *(const bf16x8*)(projb + (size_t)(qrow + rb * 16) * NIN + 4096 + h * 128 + c * 64 + ks * 32 + fq * 8) : (bf16x8){0, 0, 0, 0, 0, 0, 0, 0};
  float m0 = -INFINITY, m1 = -INFINITY, l0 = 0.f, l1 = 0.f;
  f32x4 o[2][8];
#pragma unroll
  for (int rb = 0; rb < 2; ++rb)
#pragma unroll
    for (int eb = 0; eb < 8; ++eb) o[rb][eb] = (f32x4){0.f, 0.f, 0.f, 0.f};
  const float slope2 = exp2f(-(float)(h + 1)) * LOG2E;
  f32x4 cj[4];
#pragma unroll
  for (int kb = 0; kb < 4; ++kb)
#pragma unroll
    for (int j = 0; j < 4; ++j) cj[kb][j] = slope2 * (float)(kb * 16 + fq * 4 + j);
  const int kkey = ((tid >> 5) & 15) * 2 + ((tid >> 2) & 1), cd = ((tid >> 4) & 1) * 64 + ((tid >> 3) & 1) * 32 + (tid & 3) * 8;
  const int ve = ((tid >> 4) & 31) * 2 + ((tid >> 2) & 1), vk0 = ((tid >> 3) & 1) * 32 + (tid & 3) * 8;
  const int fillK = (cd >> 6) * 8192 + lds_byte(kkey, cd & 63);
  const int fillV = 32768 + lds_byte(ve, vk0);
  const bf16_t* gk = projb + (size_t)kkey * NIN + 5120 + h * 128 + cd;
  const bf16_t* gv = p.T + (size_t)b * 3072 * LROW + (size_t)(2048 + h * 128 + ve) * LROW + vk0;
  u32x4 pk0, pk1, pv0, pv1;
#define DIFF_GLOAD(kt) do { const bf16_t* _k = gk + (size_t)(kt) * 64 * NIN; const bf16_t* _v = gv + (kt) * 64; \
    pk0 = *(const u32x4*)_k; pk1 = *(const u32x4*)(_k + (size_t)32 * NIN); pv0 = *(const u32x4*)_v; pv1 = *(const u32x4*)(_v + (size_t)64 * LROW); } while (0)
#define DIFF_FILL(kb_, vs_) do { *(LAS u32x4*)(lds + (kb_) + fillK) = pk0; *(LAS u32x4*)(lds + (kb_) + fillK + 4096) = pk1; \
    *(LAS u32x4*)(lds + (vs_) + fillV) = pv0; *(LAS u32x4*)(lds + (vs_) + fillV + 8192) = pv1; } while (0)
  DIFF_GLOAD(0);
  DIFF_FILL(0, 0);
  __syncthreads();
  if (ktmax >= 1) DIFF_GLOAD(1);
  const int kfb0 = c * 8192 + sub16;
  const bool stag = (w >> 2) != 0;
  bf16x8 pfr[2][2];
  int vs = 0;
  for (int kt = 0; kt <= ktmax; ++kt) {
    const int kb = (kt & 1) * 16384;
    const int vsn = vs == 32768 ? 0 : vs + 16384;
    if (kt + 1 <= ktmax) { DIFF_FILL(16384 - kb, vsn); if (kt + 2 <= ktmax) DIFF_GLOAD(kt + 2); }
    if (active && kt <= qc) {
      if (stag && kt > 0) diff_pv(lds, 32768 + (vs == 0 ? 32768 : vs - 16384), pfr, o, sub16);
      diff_tile(kt == 0 || kt == qc, lds, kfb0 + kb, qf, o, pfr, m0, m1, l0, l1, cj, slope2, kt, qrow, fq);
      if (!stag) diff_pv(lds, 32768 + vs, pfr, o, sub16);
    }
    vs = vsn;
    __syncthreads();
  }
  if (active && stag) { const int lastslot = (qc % 3) * 16384; diff_pv(lds, 32768 + lastslot, pfr, o, sub16); }
#undef DIFF_GLOAD
#undef DIFF_FILL
  l0 += __shfl_xor(l0, 16); l0 += __shfl_xor(l0, 32);
  l1 += __shfl_xor(l1, 16); l1 += __shfl_xor(l1, 32);
  const int xb = 81920 + rgq * 16384 + lane * 4;
  if (c == 1 && active) {
#pragma unroll
    for (int rb = 0; rb < 2; ++rb) {
      const float inv = lam / (rb ? l1 : l0);
#pragma unroll
      for (int eb = 0; eb < 8; ++eb)
#pragma unroll
        for (int j = 0; j < 4; ++j) *(LAS float*)(lds + xb + ((rb * 8 + eb) * 4 + j) * 256) = o[rb][eb][j] * inv;
    }
  }
  if (tid == 0) { unsigned sp = 0; while (xb_ld(p.ctr + 32 + l) < 32u && ++sp < (1u << 22)) __builtin_amdgcn_s_sleep(2); }
  __syncthreads();
  __builtin_amdgcn_fence(__ATOMIC_ACQUIRE, "agent");
  if (c == 0 && active) {
#pragma unroll
    for (int rb = 0; rb < 2; ++rb) {
      const float inv = 1.f / (rb ? l1 : l0);
      float ss = 0.f;
#pragma unroll
      for (int eb = 0; eb < 8; ++eb)
#pragma unroll
        for (int j = 0; j < 4; ++j) { const float d = o[rb][eb][j] * inv - *(const LAS float*)(lds + xb + ((rb * 8 + eb) * 4 + j) * 256); o[rb][eb][j] = d; ss += d * d; }
      ss += __shfl_xor(ss, 16); ss += __shfl_xor(ss, 32);
      const float rn = rsqrtf(ss * (1.f / 128.f) + 1e-6f) * (1.f - lam_init);
      const size_t row = (size_t)b * LROW + qrow + rb * 16;
#pragma unroll
      for (int eb = 0; eb < 8; ++eb) {
        const int e0 = h * 128 + eb * 16 + fq * 4;
        const uint2 gu = *(const uint2*)(p.proj + row * NIN + 7168 + e0);
        const float4 gg = *(const float4*)(p.diff_g + l * 1024 + e0);
        const float y0 = o[rb][eb][0] * rn * gg.x * silu(bflo(gu.x)), y1 = o[rb][eb][1] * rn * gg.y * silu(bfhi(gu.x));
        const float y2 = o[rb][eb][2] * rn * gg.z * silu(bflo(gu.y)), y3 = o[rb][eb][3] * rn * gg.w * silu(bfhi(gu.y));
        uint2 ov; ov.x = pk2(y0, y1); ov.y = pk2(y2, y3);
        *(uint2*)(p.mix + row * DM + 1024 + e0) = ov;
      }
    }
  }
}

DI void mixer_phase(const Params& p, int l, LAS unsigned char* lds) {
  volatile LAS int* s_item = (volatile LAS int*)(lds + 147456);
  const float lam = p.lam[l];
  const float lam_init = 0.8f - 0.6f * expf(-0.3f * (float)l);
  for (int c = (int)blockIdx.x - 32; c >= 0 && c < 32; c += (int)gridDim.x) ret_scan_chain(p, c >> 3, c & 7, lds, p.ctr + 34 + l);
  const int xcd = blockIdx.x & 7;
  for (;;) {
    if (threadIdx.x == 0) *s_item = (int)atomicAdd(p.ctr + l * 8 + xcd, 1u);
    __syncthreads();
    const int it = *s_item;
    __syncthreads();
    if (it >= 68 + 22) break;
    if (it < 48 || it >= 70) {
      const int ai = it < 48 ? it : it - 22;
      const int bh = 4 * xcd + (ai & 3);
      diff_item(p, l, bh >> 3, bh & 7, 16 - (ai >> 2), lam, lam_init, lds);
    } else {
      if (threadIdx.x == 0) { unsigned sp = 0; while ((xb_ld(p.ctr + 34 + l) < 32u || xb_ld(p.ctr + 32 + l) < 32u) && ++sp < (1u << 22)) __builtin_amdgcn_s_sleep(2); }
      __syncthreads();
      __builtin_amdgcn_fence(__ATOMIC_ACQUIRE, "agent");
      retention_items(p, l, lds, xcd + 48 * (it - 48), 8, 6);
      __syncthreads();
    }
  }
}

__global__ void __launch_bounds__(512) hymba_megakernel(Params p_unused) {
  cg::grid_group grid = cg::this_grid();
  extern __shared__ __attribute__((aligned(16))) char smem[];
  LAS unsigned char* lds = (LAS unsigned char*)smem;
  volatile LAS unsigned* xst = (volatile LAS unsigned*)(lds + 147456 + 16);
  if (threadIdx.x == 0) { xst[0] = 0u; xst[1] = 0u; }
  __syncthreads();
  XcdBarrier xb;
  { const Params p = load_params(); xb = xcd_barrier_post(p.bar, xst); }
  { const Params p = load_params(); prep_weights(p, lds, 0, 1792, blockIdx.x, gridDim.x, true); }
  { const Params p = load_params(); rownorm<0>(p); }
  grid.sync();
  for (int l = 0; l < 2; ++l) {
    { const Params p = load_params(); gemm1_phase(p, l, lds, 0, 1024); }
    xcd_barrier(xb);
    if (blockIdx.x < 32) {
      const Params p = load_params();
      gemm1_phase(p, l, lds, 1024, 1056);
      if (threadIdx.x == 0) {
        int nl = 0; for (int U = 1024 + (int)blockIdx.x; U < 1056; U += (int)gridDim.x) ++nl;
        __builtin_amdgcn_fence(__ATOMIC_RELEASE, "agent");
        asm volatile("s_waitcnt vmcnt(0)" ::: "memory");
        xb_add(p.ctr + 32 + l, (unsigned)nl);
      }
    }
    { const Params p = load_params(); mixer_phase(p, l, lds); }
    xcd_barrier(xb);
    { const Params p = load_params(); gemm2_phase(p, l, lds); }
    if (l == 0) { const Params p = load_params(); if (gridDim.x > 64) { if (blockIdx.x >= 64) prep_weights(p, lds, 1792, 2560, blockIdx.x - 64, gridDim.x - 64, false); } else prep_weights(p, lds, 1792, 2560, blockIdx.x, gridDim.x, false); }
    xcd_barrier(xb);
    if (l == 0) { { const Params p = load_params(); rownorm<1>(p); } xcd_barrier(xb); }
    else { const Params p = load_params(); rownorm<2>(p); }
  }
}

extern "C" void kernel_launch(void* const* d_in, const int* in_sizes, int n_in, void* d_out, int out_size, void* d_ws, size_t ws_size, hipStream_t stream) {
  static int grid_blocks = 0;
  if (!grid_blocks) {
    int dev = 0, cus = 0, per_cu = 0;
    hipGetDevice(&dev);
    hipDeviceGetAttribute(&cus, hipDeviceAttributeMultiprocessorCount, dev);
    hipFuncSetAttribute((const void*)hymba_megakernel, hipFuncAttributeMaxDynamicSharedMemorySize, SMEM_BYTES);
    hipOccupancyMaxActiveBlocksPerMultiprocessor(&per_cu, hymba_megakernel, 512, SMEM_BYTES);
    if (per_cu < 1) per_cu = 1;
    if (per_cu > 1) per_cu = 1;
    grid_blocks = cus * per_cu;
  }
  Params p{};
  p.x = (const float*)d_in[0]; p.meta = (const float*)d_in[1]; p.norm_g = (const float*)d_in[2]; p.w_in = (const float*)d_in[3];
  p.w_out = (const float*)d_in[4]; p.ret_g = (const float*)d_in[5]; p.diff_g = (const float*)d_in[6];
  p.lq1 = (const float*)d_in[7]; p.lk1 = (const float*)d_in[8]; p.lq2 = (const float*)d_in[9]; p.lk2 = (const float*)d_in[10];
  p.fin_g = (const float*)d_in[11];
  p.out = (float*)d_out;
  char* ws = (char*)d_ws; size_t off = 0;
  auto take = [&](size_t bytes) { char* r = ws + off; off += (bytes + 255) & ~(size_t)255; return r; };
  p.ctr = (unsigned*)take(256);
  p.bar = (unsigned*)take((size_t)XCD_BAR_WORDS * 4);
  p.ss = (float*)take((size_t)2 * MROWS * 4);
  p.lam = (float*)take(256);
  p.WinT = (bf16_t*)take((size_t)2 * NIN * DM * 2);
  p.WoutT = (bf16_t*)take((size_t)2 * DM * DM * 2);
  p.h = (float*)take((size_t)MROWS * DM * 4);
  p.hb = (bf16_t*)take((size_t)MROWS * DM * 2);
  p.proj = (bf16_t*)take((size_t)MROWS * NIN * 2);
  p.T = (bf16_t*)take((size_t)4 * 3072 * LROW * 2);
  p.mix = (bf16_t*)take((size_t)MROWS * DM * 2);
  p.ST = (bf16_t*)take((size_t)32 * NCH * 32768);
  p.P2 = (float*)take((size_t)8 * 256 * DM * 4);
  hipMemsetAsync(p.ctr, 0, 256 + (size_t)XCD_BAR_WORDS * 4 + (size_t)2 * MROWS * 4, stream);
  void* args[] = {&p};
  hipError_t e = hipLaunchCooperativeKernel((void*)hymba_megakernel, dim3(grid_blocks), dim3(512), args, SMEM_BYTES, stream);
  if (e != hipSuccess) fprintf(stderr, "cooperative launch failed: %s (grid %d)\n", hipGetErrorString(e), grid_blocks);
}
```

```cpp
#include <hip/hip_runtime.h>
#include <hip/hip_cooperative_groups.h>
#include <cstdio>
namespace cg = cooperative_groups;

typedef unsigned short bf16_t;
typedef short bf16x8 __attribute__((ext_vector_type(8)));
typedef short s16x4 __attribute__((ext_vector_type(4)));
typedef float f32x4 __attribute__((ext_vector_type(4)));
typedef float f32x2 __attribute__((ext_vector_type(2)));
typedef unsigned u32x4 __attribute__((ext_vector_type(4)));
typedef unsigned u32x2 __attribute__((ext_vector_type(2)));
typedef __bf16 bf16x2_t __attribute__((ext_vector_type(2)));
#define DI __device__ __forceinline__
#define LAS __attribute__((address_space(3)))
#define MFMA16(a, b, c) __builtin_amdgcn_mfma_f32_16x16x32_bf16((a), (b), (c), 0, 0, 0)

constexpr int LROW = 2112;
constexpr int MROWS = 4 * LROW;
constexpr int DM = 2048;
constexpr int NIN = 8192;
constexpr int NCH = 33;
constexpr float LOG2E = 1.4426950408889634f;
constexpr int SMEM_BYTES = 147456 + 64;

struct Params {
  const float *x, *meta, *norm_g, *w_in, *w_out, *ret_g, *diff_g, *lq1, *lk1, *lq2, *lk2, *fin_g;
  float* out;
  bf16_t *WinT, *WoutT, *hb, *proj, *T, *mix, *ST;
  float *h, *ss, *lam, *P2;
  unsigned* ctr;
  unsigned* bar;
};

DI Params load_params() {
  const Params __attribute__((address_space(4)))* q = (const Params __attribute__((address_space(4)))*)__builtin_amdgcn_kernarg_segment_ptr();
  asm volatile("" : "+s"(q));
  Params r; __builtin_memcpy(&r, (const void*)q, sizeof(Params)); return r;
}
DI unsigned pk2(float a, float b) { f32x2 v = {a, b}; bf16x2_t r = __builtin_convertvector(v, bf16x2_t); return __builtin_bit_cast(unsigned, r); }
DI float bf2f(unsigned v16) { return __uint_as_float(v16 << 16); }
DI float bflo(unsigned u) { return __uint_as_float(u << 16); }
DI float bfhi(unsigned u) { return __uint_as_float(u & 0xffff0000u); }
DI int opaque_tid() { int t = threadIdx.x; asm volatile("" : "+v"(t)); return t; }
#define EXP2(x) __builtin_amdgcn_exp2f(x)
DI float xmax16(float x) { const u32x2 r = __builtin_amdgcn_permlane16_swap(__float_as_uint(x), __float_as_uint(x), false, false); return fmaxf(__uint_as_float(r[0]), __uint_as_float(r[1])); }
DI float xmax32(float x) { const u32x2 r = __builtin_amdgcn_permlane32_swap(__float_as_uint(x), __float_as_uint(x), false, false); return fmaxf(__uint_as_float(r[0]), __uint_as_float(r[1])); }
DI float silu(float v) { return v * __builtin_amdgcn_rcpf(1.f + __expf(-v)); }

DI int lds_byte(int r, int c) { int st = (r >> 4) * 2 + (c >> 5), rr = r & 15, cc = c & 31, ob = rr * 64 + cc * 2; return st * 1024 + (ob ^ (((ob >> 9) & 1) << 5)); }
DI int perm32(int rho) { const int n = rho >> 4, i = rho & 15; return 8 * (i >> 2) + 4 * n + (i & 3); }
DI void stage_rc(int b, int& R, int& C) { int st = b / 1024, sb = b % 1024, swz = sb ^ (((sb >> 9) & 1) << 5); R = (st >> 1) * 16 + swz / 64; C = (st & 1) * 32 + (swz % 64) / 2; }

DI void prep_weights(const Params& p, LAS unsigned char* lds, int ubeg, int uend, int wgi, int wgn, bool do_lam) {
  const int tid = opaque_tid();
  const int NTOT = uend;
  const int lrow = tid >> 6, c4 = (tid & 63) * 4;
  f32x4 r[8];
#define PREP_DECODE(u) const float* src; bf16_t* dst; int N; const float* g; int kt, ntile; \
    { const int _l = (u) >= 1280 ? 1 : 0, _v = (u) - _l * 1280; \
      if (_v < 1024) { kt = _v >> 5; ntile = _v & 31; src = p.w_in + (size_t)_l * DM * NIN; dst = p.WinT + (size_t)_l * NIN * DM; N = NIN; g = p.norm_g + _l * DM; } \
      else { const int q = _v - 1024; kt = q >> 3; ntile = q & 7; src = p.w_out + (size_t)_l * DM * DM; dst = p.WoutT + (size_t)_l * DM * DM; N = DM; g = nullptr; } } \
    const int k0 = kt * 64, n0 = ntile * 256;
#define PREP_LOAD(u) do { PREP_DECODE(u) (void)dst; _Pragma("unroll") for (int i = 0; i < 8; ++i) { const int kk = lrow + 8 * i; \
    const f32x4 v = *(const f32x4*)(src + (size_t)(k0 + kk) * N + n0 + c4); const float gg = g ? g[k0 + kk] : 1.f; r[i] = v * gg; } } while (0)
  int u = ubeg + wgi;
  if (u < NTOT) PREP_LOAD(u);
  for (; u < NTOT; u += wgn) {
#pragma unroll
    for (int i = 0; i < 8; ++i) *(LAS f32x4*)(lds + ((lrow + 8 * i) * 260 + c4) * 4) = r[i];
    __syncthreads();
    const int un = u + wgn;
    if (un < NTOT) PREP_LOAD(un);
    {
      PREP_DECODE(u) (void)src; (void)N; (void)g;
      const int n = tid >> 1, kh = (tid & 1) * 32;
      bf16_t* op = dst + (size_t)(n0 + n) * DM + k0 + kh;
#pragma unroll
      for (int q = 0; q < 4; ++q) {
        float f[8];
#pragma unroll
        for (int j = 0; j < 8; ++j) f[j] = *(const LAS float*)(lds + ((kh + q * 8 + j) * 260 + n) * 4);
        const u32x4 o = {pk2(f[0], f[1]), pk2(f[2], f[3]), pk2(f[4], f[5]), pk2(f[6], f[7])};
        *(u32x4*)(op + q * 8) = o;
      }
    }
    __syncthreads();
  }
#undef PREP_DECODE
#undef PREP_LOAD
  if (do_lam && blockIdx.x == 0 && tid < 64) {
    for (int l = 0; l < 2; ++l) {
      float a = p.lq1[l * 64 + tid] * p.lk1[l * 64 + tid], b = p.lq2[l * 64 + tid] * p.lk2[l * 64 + tid];
#pragma unroll
      for (int off = 32; off >= 1; off >>= 1) { a += __shfl_xor(a, off); b += __shfl_xor(b, off); }
      float li = 0.8f - 0.6f * expf(-0.3f * (float)l);
      if (tid == 0) p.lam[l] = expf(a) - expf(b) + li;
    }
  }
}

template <int MODE> DI void rownorm(const Params& p) {
  const int tid = opaque_tid(); const int wave = tid >> 6, lane = tid & 63;
  const int nw = gridDim.x * 8;
  for (int row = (MODE == 1 ? 8192 : 0) + blockIdx.x * 8 + wave; row < MROWS; row += nw) {
    const int b = row / LROW, pos = row - b * LROW;
    if (MODE == 2 && pos < 64) continue;
    const float* src;
    if (MODE <= 1) src = pos < 48 ? nullptr : (pos < 64 ? p.meta + (size_t)(pos - 48) * DM : p.x + ((size_t)b * 2048 + (pos - 64)) * DM);
    else src = p.h + (size_t)row * DM;
    float4 v[8]; float ss = 0.f;
#pragma unroll
    for (int i = 0; i < 8; ++i) {
      v[i] = src ? *(const float4*)(src + i * 256 + lane * 4) : make_float4(0.f, 0.f, 0.f, 0.f);
      if (MODE != 0 && row >= 8192) {
#pragma unroll
        for (int s = 0; s < 8; ++s) { const float4 q = *(const float4*)(p.P2 + ((size_t)s * 256 + (row - 8192)) * DM + i * 256 + lane * 4); v[i].x += q.x; v[i].y += q.y; v[i].z += q.z; v[i].w += q.w; }
      }
      ss += v[i].x * v[i].x + v[i].y * v[i].y + v[i].z * v[i].z + v[i].w * v[i].w;
    }
#pragma unroll
    for (int off = 32; off >= 1; off >>= 1) ss += __shfl_xor(ss, off);
    const float rs = rsqrtf(ss * (1.f / 2048.f) + 1e-6f);
    if (MODE < 2) {
#pragma unroll
      for (int i = 0; i < 8; ++i) {
        if (MODE == 1) *(float4*)(p.h + (size_t)row * DM + i * 256 + lane * 4) = v[i];
        uint2 o; o.x = pk2(v[i].x, v[i].y); o.y = pk2(v[i].z, v[i].w);
        *(uint2*)(p.hb + (size_t)row * DM + i * 256 + lane * 4) = o;
      }
      if (lane == 0) p.ss[(MODE == 0 ? 0 : 1) * MROWS + row] = ss;
    } else {
      float* dst = p.out + ((size_t)b * 2048 + (pos - 64)) * DM;
#pragma unroll
      for (int i = 0; i < 8; ++i) {
        float4 g = *(const float4*)(p.fin_g + i * 256 + lane * 4);
        float4 o; o.x = v[i].x * rs * g.x; o.y = v[i].y * rs * g.y; o.z = v[i].z * rs * g.z; o.w = v[i].w * rs * g.w;
        *(float4*)(dst + i * 256 + lane * 4) = o;
      }
    }
  }
}

constexpr int GK = 2048, GBK = 64, GHALF = 128, GHTB = GHALF * GBK * 2;
constexpr size_t TSTEP = (size_t)256 * GK * 2;
struct Unit { int mt, nt, tr, k0, nkt, nb; };

template <class Epi, class Sched>
DI void gemm_phase(LAS unsigned char* lds, const Sched& S, const Epi& E) {
  const int tid = opaque_tid(), wid = __builtin_amdgcn_readfirstlane(tid >> 6), lane = tid & 63, wr = wid >> 2, wc = wid & 3, fr = lane & 15, fq = lane >> 4;
  constexpr int K = GK;
  unsigned voffA[2], dperm;
#pragma unroll
  for (int i = 0; i < 2; ++i) { int R, C; stage_rc(tid * 16 + i * 8192, R, C); voffA[i] = (unsigned)(R * K + C) * 2u;
    if (i == 0) dperm = (unsigned)((perm32(R & 31) - (R & 31)) * K * 2); }
  const size_t kstep = (size_t)(GBK * 2);
  const size_t hstep = (size_t)GHALF * K * 2;
  const unsigned ldsw = (unsigned)wid * 1024u;
  const int aoff = lds_byte(wr * 64 + fr, fq * 8), boff = lds_byte(wc * 32 + fr, fq * 8);
#define G_SA(b, h) (((b) * 2 + (h)) * GHTB)
#define G_SB(b, h) ((4 + (b) * 2 + (h)) * GHTB)
#define G_STAGE(bufoff, gbase, voff) do { _Pragma("unroll") for (int _i = 0; _i < 2; ++_i) \
    __builtin_amdgcn_global_load_lds((const unsigned*)((const char*)(gbase) + voff[_i]), (LAS unsigned*)(lds + (bufoff) + ldsw + _i * 8192), 16, 0, 0); } while (0)
#define G_LDA(dst, b, h) do { _Pragma("unroll") for (int m = 0; m < 4; ++m) _Pragma("unroll") for (int k = 0; k < 2; ++k) dst[m][k] = *(const LAS bf16x8*)(lds + G_SA(b, h) + aoff + m * 2048 + k * 1024); } while (0)
#define G_LDB(dst, b, h) do { _Pragma("unroll") for (int n = 0; n < 2; ++n) _Pragma("unroll") for (int k = 0; k < 2; ++k) dst[n][k] = *(const LAS bf16x8*)(lds + G_SB(b, h) + boff + n * 2048 + k * 1024); } while (0)
#define G_MMA(ai, bj, At, Bx) do { __builtin_amdgcn_s_setprio(1); _Pragma("unroll") for (int m = 0; m < 4; ++m) _Pragma("unroll") for (int n = 0; n < 2; ++n) _Pragma("unroll") for (int k = 0; k < 2; ++k) \
    acc[ai][bj][m][n] = MFMA16(Bx[n][k], At[m][k], acc[ai][bj][m][n]); __builtin_amdgcn_s_setprio(0); } while (0)
#define G_WAIT_V(n) asm volatile("s_waitcnt vmcnt(" #n ")" ::: "memory")
#define G_WAIT_L(n) asm volatile("s_waitcnt lgkmcnt(" #n ")" ::: "memory")
#define G_BAR __builtin_amdgcn_s_barrier()
#define G_SCHED __builtin_amdgcn_sched_barrier(0)
  Unit cur, nxt; int ui = 0;
  if (!S.next(0, cur)) return;
  f32x4 acc[2][2][4][2];
  E.init(acc, cur, wr, wc, fr, fq);
  bf16x8 At[4][2], B0[2][2], B1[2][2];
  const char* cA = S.pa(cur); const char* cB = S.pb(cur);
  { const unsigned ds0 = cur.nb ? 0u : dperm; const unsigned vb[2] = {voffA[0] + ds0, voffA[1] + ds0};
  G_STAGE(G_SB(0, 0), cB, vb); G_STAGE(G_SA(0, 0), cA, voffA); G_STAGE(G_SB(0, 1), cB + hstep, vb); G_STAGE(G_SA(0, 1), cA + hstep, voffA);
  if (wr == 1) G_BAR;
  G_WAIT_V(4); G_BAR;
  G_STAGE(G_SB(1, 0), cB + kstep, vb); G_STAGE(G_SA(1, 0), cA + kstep, voffA); G_STAGE(G_SB(1, 1), cB + hstep + kstep, vb); }
  G_WAIT_V(6); G_BAR;
  for (;;) {
    const bool has_next = S.next(ui + 1, nxt);
    if (!has_next) nxt = cur;
    const char* nA = has_next ? S.pa(nxt) : cA; const char* nB = has_next ? S.pb(nxt) : cB;
    const int nt = cur.nkt;
    for (int t = 0; t < nt; t += 2) {
      const bool last = (t == nt - 2);
      const char* a1 = cA + (size_t)(t + 1) * kstep;
      const char* a2 = last ? nA : cA + (size_t)(t + 2) * kstep; const char* b2 = last ? nB : cB + (size_t)(t + 2) * kstep;
      const char* a3 = a2 + kstep; const char* b3 = b2 + kstep;
      const bool nbs = last ? (nxt.nb != 0) : (cur.nb != 0);
      const unsigned ds = nbs ? 0u : dperm; const unsigned vb[2] = {voffA[0] + ds, voffA[1] + ds};
      G_LDB(B0, 0, 0); G_SCHED; G_LDA(At, 0, 0); G_STAGE(G_SA(1, 1), a1 + hstep, voffA);
      G_WAIT_L(8); G_BAR; G_WAIT_L(0); G_MMA(0, 0, At, B0); G_BAR; G_SCHED;
      G_LDB(B1, 0, 1); G_STAGE(G_SB(0, 0), b2, vb);
      G_BAR; G_WAIT_L(0); G_MMA(0, 1, At, B1); G_BAR;
      G_LDA(At, 0, 1); G_STAGE(G_SA(0, 0), a2, voffA);
      G_BAR; G_WAIT_L(0); G_MMA(1, 0, At, B0); G_BAR; G_SCHED;
      G_STAGE(G_SB(0, 1), b2 + hstep, vb);
      G_WAIT_V(6); G_BAR; G_MMA(1, 1, At, B1); G_BAR;
      G_LDB(B0, 1, 0); G_SCHED; G_LDA(At, 1, 0); G_STAGE(G_SA(0, 1), a2 + hstep, voffA);
      G_WAIT_L(8); G_BAR; G_WAIT_L(0); G_MMA(0, 0, At, B0); G_BAR; G_SCHED;
      G_LDB(B1, 1, 1); G_STAGE(G_SB(1, 0), b3, vb);
      G_BAR; G_WAIT_L(0); G_MMA(0, 1, At, B1); G_BAR;
      G_LDA(At, 1, 1); G_STAGE(G_SA(1, 0), a3, voffA);
      G_BAR; G_WAIT_L(0); G_MMA(1, 0, At, B0); G_BAR; G_SCHED;
      G_STAGE(G_SB(1, 1), b3 + hstep, vb);
      G_WAIT_V(6); G_BAR; G_MMA(1, 1, At, B1); G_BAR;
    }
    { const int t2 = opaque_tid() & 63; E(acc, cur, wr, wc, t2 & 15, t2 >> 4); }
    if (!has_next) break;
    cur = nxt; cA = nA; cB = nB; ++ui;
    E.init(acc, cur, wr, wc, fr, fq);
  }
  G_WAIT_V(0);
  if (wr == 0) G_BAR;
  G_BAR;
}

#define XB_TMO      128
#define XB_XCNT(j)  (256  + 64 * (j))
#define XB_XSUB(j)  (1280 + 64 * (j))
#define XB_XGEN(j)  (2304 + 64 * (j))
#define XB_TOP      3328
#define XB_TOPGEN   3392
#define XCD_BAR_WORDS 3456
#define XB_SPIN_CAP (1u << 18)
DI unsigned xb_ld(unsigned* p) { return __hip_atomic_load(p, __ATOMIC_RELAXED, __HIP_MEMORY_SCOPE_AGENT); }
DI unsigned xb_add(unsigned* p, unsigned v) { return __hip_atomic_fetch_add(p, v, __ATOMIC_RELAXED, __HIP_MEMORY_SCOPE_AGENT); }
DI unsigned xb_xcc_id() { return (unsigned)__builtin_amdgcn_s_getreg((3 << 11) | 20) & 0xFu; }
#define XB_SPIN(cond, bar) do { unsigned _sp = 0; while (cond) { __builtin_amdgcn_s_sleep(1); \
    if ((++_sp & 255u) == 0u) { if (xb_ld(&(bar)[XB_TMO])) break; if (_sp > XB_SPIN_CAP) { atomicAdd(&(bar)[XB_TMO], 1u); break; } } } } while (0)
struct XcdBarrier { unsigned* bar; unsigned x; volatile LAS unsigned* st; };
DI XcdBarrier xcd_barrier_post(unsigned* bar, volatile LAS unsigned* st) {
  XcdBarrier b; b.bar = bar; b.x = xb_xcc_id(); b.st = st;
  if (threadIdx.x == 0) (void)xb_add(&bar[XB_XCNT(b.x)], 1u);
  return b;
}
DI void xcd_barrier_complete(unsigned* bar, unsigned x, unsigned& nloc, unsigned& nx) {
  const unsigned G = gridDim.x * gridDim.y * gridDim.z;
  unsigned sum, cnt, mine, sp = 0u;
  for (;;) {
    sum = 0u; cnt = 0u; mine = 0u;
#pragma unroll
    for (unsigned j = 0; j < 16; ++j) { const unsigned c = xb_ld(&bar[XB_XCNT(j)]); sum += c; cnt += (c > 0u) ? 1u : 0u; mine = (j == x) ? c : mine; }
    if (sum == G) break;
    __builtin_amdgcn_s_sleep(1);
    if ((++sp & 255u) == 0u) { if (xb_ld(&bar[XB_TMO])) break; if (sp > XB_SPIN_CAP) { atomicAdd(&bar[XB_TMO], 1u); break; } }
  }
  nloc = mine > 0u ? mine : 1u; nx = cnt > 0u ? cnt : 1u;
}
DI void xcd_barrier(const XcdBarrier& b) {
  asm volatile("s_waitcnt vmcnt(0)" ::: "memory");
  __syncthreads();
  if (threadIdx.x == 0) {
    unsigned* bar = b.bar;
    __builtin_amdgcn_s_waitcnt(0);
    unsigned nloc = b.st[0], nx = b.st[1];
    if (nloc == 0u) { xcd_barrier_complete(bar, b.x, nloc, nx); b.st[0] = nloc; b.st[1] = nx; }
    const unsigned old = xb_add(&bar[XB_XSUB(b.x)], 1u);
    const unsigned gen = old / nloc;
    if (old + 1u == (gen + 1u) * nloc) {
      __builtin_amdgcn_fence(__ATOMIC_RELEASE, "agent");
      asm volatile("s_waitcnt vmcnt(0)" ::: "memory");
      const unsigned og = xb_add(&bar[XB_TOP], 1u);
      const unsigned tg = og / nx;
      if (og + 1u == (tg + 1u) * nx) xb_add(&bar[XB_TOPGEN], 1u);
      else XB_SPIN(xb_ld(&bar[XB_TOPGEN]) == tg, bar);
      __builtin_amdgcn_fence(__ATOMIC_ACQUIRE, "agent");
      xb_add(&bar[XB_XGEN(b.x)], 1u);
      asm volatile("s_waitcnt vmcnt(0)" ::: "memory");
    } else {
      XB_SPIN(xb_ld(&bar[XB_XGEN(b.x)]) == gen, bar);
      __builtin_amdgcn_fence(__ATOMIC_ACQUIRE, "agent");
      asm volatile("s_waitcnt vmcnt(0)" ::: "memory");
    }
  }
  __syncthreads();
}

DI void tile_map(int wgid, int nM, int nN, int& pm, int& pn) {
  const int nwg = nM * nN;
  { int q = nwg / 8, r = nwg % 8, xcd = wgid % 8, off = wgid / 8; wgid = (xcd < r ? xcd * (q + 1) : r * (q + 1) + (xcd - r) * q) + off; }
  const int nig = 8 * nN, gid = wgid / nig, fm = gid * 8, gsz = min(nM - fm, 8);
  pm = fm + ((wgid % nig) % gsz); pn = (wgid % nig) / gsz;
}

struct Sched1 {
  const bf16_t* hb; const bf16_t* W; int ubeg, uend;
  DI bool next(int i, Unit& u) const {
    const int U = ubeg + i * (int)gridDim.x + (int)blockIdx.x; if (U >= uend) return false;
    int pm, pn;
    if (U < 928) tile_map(U, 29, 32, pm, pn);
    else if (U < 1024) { const int q = U - 928, c = q % 24; pm = 29 + q / 24; pn = c < 12 ? c : c + 4; }
    else { const int q = U - 1024, g = q & 7; pm = 29 + (q >> 3); pn = g < 4 ? 12 + g : 24 + g; }
    u.mt = pm; u.nt = pn; u.k0 = 0; u.nkt = 32; const int g = pn >> 2; u.tr = (g == 1 || g == 2 || g == 6) ? 1 : 0; u.nb = u.tr; return true;
  }
  DI const char* pa(const Unit& u) const { return u.tr ? (const char*)W + (size_t)u.nt * TSTEP : (const char*)hb + (size_t)u.mt * TSTEP; }
  DI const char* pb(const Unit& u) const { return u.tr ? (const char*)hb + (size_t)u.mt * TSTEP : (const char*)W + (size_t)u.nt * TSTEP; }
};
struct Sched2 {
  const bf16_t* mix; const bf16_t* W;
  DI bool next(int i, Unit& u) const {
    const int U = i * (int)gridDim.x + (int)blockIdx.x; if (U >= 256 + 64) return false;
    if (U < 256) { int pm, pn; tile_map(U, 32, 8, pm, pn); u.mt = pm; u.nt = pn; u.tr = 0; u.k0 = 0; u.nkt = 32; u.nb = 0; }
    else { const int j = U - 256; u.mt = 32; u.nt = j >> 3; u.tr = 1 + (j & 7); u.k0 = (j & 7) * 256; u.nkt = 4; u.nb = 0; }
    return true;
  }
  DI const char* pa(const Unit& u) const { return (const char*)mix + (size_t)u.mt * TSTEP + (size_t)u.k0 * 2; }
  DI const char* pb(const Unit& u) const { return (const char*)W + (size_t)u.nt * TSTEP + (size_t)u.k0 * 2; }
};

DI void acc_zero(f32x4 (&acc)[2][2][4][2]) {
#pragma unroll
  for (int a = 0; a < 2; ++a)
#pragma unroll
    for (int b = 0; b < 2; ++b)
#pragma unroll
      for (int m = 0; m < 4; ++m)
#pragma unroll
        for (int n = 0; n < 2; ++n) acc[a][b][m][n] = (f32x4){0.f, 0.f, 0.f, 0.f};
}
struct Epi1 {
  bf16_t* proj; bf16_t* T; const float* ss;
  DI void init(f32x4 (&acc)[2][2][4][2], const Unit&, int, int, int, int) const { acc_zero(acc); }
  DI void operator()(const f32x4 (&acc)[2][2][4][2], const Unit& u, int wr, int wc, int fr, int fq) const {
    const int g = u.nt >> 2;
    if (!u.tr) {
      const float sc = (g == 4) ? 0.125f * LOG2E : 1.f;
      const int n0 = u.nt * 256 + wc * 32 + fq * 8;
#pragma unroll
      for (int ai = 0; ai < 2; ++ai)
#pragma unroll
        for (int mi = 0; mi < 4; ++mi) {
          const int m = u.mt * 256 + ai * 128 + wr * 64 + mi * 16 + fr;
          const float rs = rsqrtf(ss[m] * (1.f / 2048.f) + 1e-6f) * sc;
          bf16_t* rowp = proj + (size_t)m * NIN + n0;
#pragma unroll
          for (int bj = 0; bj < 2; ++bj) {
            const f32x4 a = acc[ai][bj][mi][0], c = acc[ai][bj][mi][1];
            const u32x4 o = {pk2(a[0] * rs, a[1] * rs), pk2(a[2] * rs, a[3] * rs), pk2(c[0] * rs, c[1] * rs), pk2(c[2] * rs, c[3] * rs)};
            *(u32x4*)(rowp + bj * 128) = o;
          }
        }
    } else {
      const int tbase = (g == 1 ? 0 : (g == 2 ? 1024 : 2048)) - g * 1024;
#pragma unroll
      for (int bj = 0; bj < 2; ++bj) {
        const int mb = u.mt * 256 + bj * 128 + wc * 32;
        const int b = mb / LROW, posb = mb - b * LROW;
        const f32x4 q0 = *(const f32x4*)(ss + mb + 4 * fq), q1 = *(const f32x4*)(ss + mb + 16 + 4 * fq);
        float rs[8];
#pragma unroll
        for (int j = 0; j < 4; ++j) { rs[j] = rsqrtf(q0[j] * (1.f / 2048.f) + 1e-6f); rs[4 + j] = rsqrtf(q1[j] * (1.f / 2048.f) + 1e-6f); }
        const int p0 = posb + 4 * fq, p1 = p0 + 16;
        if (g == 1) {
#pragma unroll
          for (int j = 0; j < 4; ++j) { rs[j] = (p0 + j >= 48) ? rs[j] * 0.08838834764831845f : 0.f; rs[4 + j] = (p1 + j >= 48) ? rs[4 + j] * 0.08838834764831845f : 0.f; }
        }
#pragma unroll
        for (int ai = 0; ai < 2; ++ai)
#pragma unroll
          for (int mi = 0; mi < 4; ++mi) {
            const int col = u.nt * 256 + ai * 128 + wr * 64 + mi * 16 + fr;
            const f32x4 a = acc[ai][bj][mi][0], c = acc[ai][bj][mi][1];
            float v[8] = {a[0] * rs[0], a[1] * rs[1], a[2] * rs[2], a[3] * rs[3], c[0] * rs[4], c[1] * rs[5], c[2] * rs[6], c[3] * rs[7]};
            if (g == 1) {
              const int hh = (col - 1024) >> 7;
              const float l2g = log2f(1.f - exp2f(-5.f - (float)hh));
              const int z0 = 63 - (p0 & 63), z1 = 63 - (p1 & 63);
#pragma unroll
              for (int j = 0; j < 4; ++j) { v[j] *= exp2f(l2g * (float)(z0 - j)); v[4 + j] *= exp2f(l2g * (float)(z1 - j)); }
            }
            const u32x4 o = {pk2(v[0], v[1]), pk2(v[2], v[3]), pk2(v[4], v[5]), pk2(v[6], v[7])};
            const int trow = (g == 1) ? (col & ~31) + 16 * ((col >> 2) & 1) + 4 * ((col >> 3) & 3) + (col & 3) : col;
            *(u32x4*)(T + ((size_t)(b * 3072 + tbase + trow)) * LROW + posb + 8 * fq) = o;
          }
      }
    }
  }
};
struct Epi2 {
  float* h; float* P2; bf16_t* hb; float* ssn; const float* x; const float* meta;
  DI void init(f32x4 (&acc)[2][2][4][2], const Unit& u, int wr, int wc, int fr, int fq) const {
    if (u.tr) { acc_zero(acc); return; }
    const int n0 = u.nt * 256 + wc * 32 + fq * 8;
#pragma unroll
    for (int ai = 0; ai < 2; ++ai)
#pragma unroll
      for (int mi = 0; mi < 4; ++mi) {
        const int m = u.mt * 256 + ai * 128 + wr * 64 + mi * 16 + fr;
        const float* rowp = h + (size_t)m * DM + n0;
        if (x) { const int b = m / LROW, pos = m - b * LROW; rowp = pos < 48 ? nullptr : (pos < 64 ? meta + (size_t)(pos - 48) * DM : x + ((size_t)b * 2048 + (pos - 64)) * DM) + n0; }
#pragma unroll
        for (int bj = 0; bj < 2; ++bj)
#pragma unroll
          for (int ni = 0; ni < 2; ++ni) acc[ai][bj][mi][ni] = rowp ? *(const f32x4*)(rowp + bj * 128 + ni * 4) : (f32x4){0.f, 0.f, 0.f, 0.f};
      }
  }
  DI void operator()(const f32x4 (&acc)[2][2][4][2], const Unit& u, int wr, int wc, int fr, int fq) const {
    const int n0 = u.nt * 256 + wc * 32 + fq * 8;
#pragma unroll
    for (int ai = 0; ai < 2; ++ai)
#pragma unroll
      for (int mi = 0; mi < 4; ++mi) {
        const int m = u.mt * 256 + ai * 128 + wr * 64 + mi * 16 + fr;
        float* rowp = (u.tr ? P2 + ((size_t)(u.tr - 1) * 256 + (m - 8192)) * DM : h + (size_t)m * DM) + n0;
        float sq = 0.f;
#pragma unroll
        for (int bj = 0; bj < 2; ++bj) {
          const f32x4 a = acc[ai][bj][mi][0], c = acc[ai][bj][mi][1];
          *(f32x4*)(rowp + bj * 128) = a; *(f32x4*)(rowp + bj * 128 + 4) = c;
          if (ssn && !u.tr) {
            sq += a[0] * a[0] + a[1] * a[1] + a[2] * a[2] + a[3] * a[3] + c[0] * c[0] + c[1] * c[1] + c[2] * c[2] + c[3] * c[3];
            const u32x4 o = {pk2(a[0], a[1]), pk2(a[2], a[3]), pk2(c[0], c[1]), pk2(c[2], c[3])};
            *(u32x4*)(hb + (size_t)m * DM + n0 + bj * 128) = o;
          }
        }
        if (ssn && !u.tr) {
          sq += __shfl_xor(sq, 16); sq += __shfl_xor(sq, 32);
          if (fq == 0) unsafeAtomicAdd(ssn + m, sq);
        }
      }
  }
};

DI void gemm1_phase(const Params& p, int l, LAS unsigned char* lds, int ubeg, int uend) {
  Sched1 S{p.hb, p.WinT + (size_t)l * NIN * DM, ubeg, uend}; Epi1 E{p.proj, p.T, p.ss + (size_t)l * MROWS};
  gemm_phase(lds, S, E);
}
DI void gemm2_phase(const Params& p, int l, LAS unsigned char* lds) {
  Sched2 S{p.mix, p.WoutT + (size_t)l * DM * DM}; Epi2 E{p.h, p.P2, p.hb, l == 0 ? p.ss + MROWS : nullptr, l == 0 ? p.x : nullptr, p.meta};
  gemm_phase(lds, S, E);
}

DI void ret_scan_chain(const Params& p, int b, int h, LAS unsigned char* lds, unsigned* done_ctr) {
  constexpr int D = 6;
  const int tid = opaque_tid(), w = __builtin_amdgcn_readfirstlane(tid >> 6), lane = tid & 63, fr = lane & 15, fq = lane >> 4;
  const float l2g = log2f(1.f - exp2f(-5.f - (float)h));
  const float dec64 = exp2f(l2g * 64.f);
  const int sub16 = lds_byte(fr, fq * 8);
  const int fillT = lds_byte(tid >> 3, (tid & 7) * 8);
  const bf16_t* gk = p.T + (size_t)b * 3072 * LROW + (size_t)(h * 128 + (tid >> 3)) * LROW + (tid & 7) * 8;
  u32x4* so = (u32x4*)p.ST + ((size_t)((b * 8 + h) * NCH) * 8 + w) * 256 + lane;
  f32x4 st[8];
#pragma unroll
  for (int i = 0; i < 8; ++i) st[i] = (f32x4){0.f, 0.f, 0.f, 0.f};
  u32x4 ring[D][4];
#define SCAN_LOAD(slot, n) do { const bf16_t* _t = gk + (n) * 64; ring[slot][0] = *(const u32x4*)_t; ring[slot][1] = *(const u32x4*)(_t + (size_t)64 * LROW); \
    ring[slot][2] = *(const u32x4*)(_t + (size_t)1024 * LROW); ring[slot][3] = *(const u32x4*)(_t + (size_t)1088 * LROW); } while (0)
#define SCAN_STORE(n) do { _Pragma("unroll") for (int kd = 0; kd < 4; ++kd) { const f32x4 sa = st[2 * kd], sc = st[2 * kd + 1]; \
    const u32x4 bsu = {pk2(sa[0], sa[1]), pk2(sa[2], sa[3]), pk2(sc[0], sc[1]), pk2(sc[2], sc[3])}; so[(size_t)(n) * 2048 + kd * 64] = bsu; } } while (0)
#pragma unroll
  for (int i = 0; i < D; ++i) SCAN_LOAD(i, i);
#pragma unroll
  for (int n = 0; n < NCH - 1; ++n) {
    const int slot = n % D, bo = (n & 1) * 32768;
    *(LAS u32x4*)(lds + bo + fillT) = ring[slot][0]; *(LAS u32x4*)(lds + bo + fillT + 8192) = ring[slot][1];
    *(LAS u32x4*)(lds + bo + 16384 + fillT) = ring[slot][2]; *(LAS u32x4*)(lds + bo + 16384 + fillT + 8192) = ring[slot][3];
    if (n + D < NCH - 1) SCAN_LOAD(slot, n + D);
    __syncthreads();
    SCAN_STORE(n);
    const bf16x8 vf0 = *(const LAS bf16x8*)(lds + bo + 16384 + w * 2048 + sub16), vf1 = *(const LAS bf16x8*)(lds + bo + 16384 + w * 2048 + 1024 + sub16);
#pragma unroll
    for (int db = 0; db < 8; ++db) {
      st[db] *= dec64;
      const bf16x8 a0 = *(const LAS bf16x8*)(lds + bo + sub16 + db * 2048);
      const bf16x8 a1 = *(const LAS bf16x8*)(lds + bo + sub16 + db * 2048 + 1024);
      st[db] = MFMA16(a0, vf0, st[db]); st[db] = MFMA16(a1, vf1, st[db]);
    }
  }
  SCAN_STORE(NCH - 1);
  asm volatile("s_waitcnt vmcnt(0)" ::: "memory");
  __syncthreads();
  if (threadIdx.x == 0) { __builtin_amdgcn_fence(__ATOMIC_RELEASE, "agent"); asm volatile("s_waitcnt vmcnt(0)" ::: "memory"); xb_add(done_ctr, 1u); }
#undef SCAN_LOAD
#undef SCAN_STORE
}

DI void retention_items(const Params& p, int l, LAS unsigned char* lds, int first, int stride, int count) {
  constexpr int QS = 0, KS = 16384, VTS = 49152, PS = 65536, OS = 73728;
  const int tid = opaque_tid(), w = __builtin_amdgcn_readfirstlane(tid >> 6), lane = tid & 63, fr = lane & 15, fq = lane >> 4;
  const int sub16 = lds_byte(fr, fq * 8), sub8a = lds_byte(fr, fq * 4), sub8b = lds_byte(fr, fq * 4 + 16);
  const int dq = (tid & 15) * 8;
  const int fillQ = (dq >> 6) * 8192 + lds_byte(tid >> 4, dq & 63);
  const int fillT = lds_byte(tid >> 3, (tid & 7) * 8);
  const int sb = w & 3, tb0 = (w >> 2) * 2;
  const int kbase = KS + sb * 2048 + sub16, qbase = QS + tb0 * 2048 + sub16;
  const int pbase = PS + tb0 * 2048 + (sb >> 1) * 1024 + lds_byte(fr, fq * 8 + 4 * (sb & 1));
  const int vbase = VTS + w * 2048 + sub16;
  const int obase = OS + ((fq * 4) * 132 + w * 16 + fr) * 4;
  const int nbase = OS + ((tid >> 3) * 132 + (tid & 7) * 16) * 4;
  u32x4 pq0, pq1, pk0, pk1, pv0, pv1, ns0, ns1, ns2, ns3, ng0, ng1;
#define RET_GLOAD(it) do { const int _bh = (it) / NCH, _n = (it) - _bh * NCH, _b = _bh >> 3, _h = _bh & 7; \
    const bf16_t* _q = p.proj + ((size_t)_b * LROW + _n * 64 + (tid >> 4)) * NIN + _h * 128 + dq; \
    const bf16_t* _t = p.T + ((size_t)_b * 3072 + 1024 + _h * 128 + (tid >> 3)) * LROW + _n * 64 + (tid & 7) * 8; \
    pq0 = *(const u32x4*)_q; pq1 = *(const u32x4*)(_q + (size_t)32 * NIN); pk0 = *(const u32x4*)(_t - (size_t)1024 * LROW); pk1 = *(const u32x4*)(_t - (size_t)960 * LROW); \
    pv0 = *(const u32x4*)_t; pv1 = *(const u32x4*)(_t + (size_t)64 * LROW); \
    const u32x4* _sp = (const u32x4*)p.ST + ((size_t)(it) * 8 + w) * 256 + lane; ns0 = _sp[0]; ns1 = _sp[64]; ns2 = _sp[128]; ns3 = _sp[192]; \
    const bf16_t* _gp = p.proj + ((size_t)_b * LROW + _n * 64 + (tid >> 3)) * NIN + 3072 + _h * 128 + (tid & 7) * 16; \
    ng0 = *(const u32x4*)_gp; ng1 = *(const u32x4*)(_gp + 8); } while (0)
  int it = first;
  const int iend = first + stride * count;
  if (it < iend) RET_GLOAD(it);
  for (; it < iend; it += stride) {
    const int bh = it / NCH, n = it - bh * NCH, b = bh >> 3, h = bh & 7;
    const float l2g = log2f(1.f - exp2f(-5.f - (float)h));
    *(LAS u32x4*)(lds + QS + fillQ) = pq0; *(LAS u32x4*)(lds + QS + fillQ + 4096) = pq1;
    {
      const int d0 = tid >> 3, s0 = (tid & 7) * 8;
#pragma unroll
      for (int i = 0; i < 2; ++i) {
        const u32x4 kv = i ? pk1 : pk0;
        const int r_ = d0 + 64 * i, d = (r_ & ~31) + 8 * ((r_ >> 2) & 3) + 4 * ((r_ >> 4) & 1) + (r_ & 3), ko = KS + (d >> 6) * 8192;
#pragma unroll
        for (int j = 0; j < 8; ++j) {
          const unsigned wv = kv[j >> 1];
          const int st = (s0 & 32) + 16 * (j >> 2) + 4 * ((s0 >> 3) & 3) + (j & 3);
          *(LAS bf16_t*)(lds + ko + lds_byte(st, d & 63)) = (bf16_t)((j & 1) ? (wv >> 16) : (wv & 0xffffu));
        }
      }
    }
    *(LAS u32x4*)(lds + VTS + fillT) = pv0; *(LAS u32x4*)(lds + VTS + fillT + 8192) = pv1;
    const u32x4 sf0 = ns0, sf1 = ns1, sf2 = ns2, sf3 = ns3, g0 = ng0, g1 = ng1;
    __syncthreads();
    if (it + stride < iend) RET_GLOAD(it + stride);
    const size_t row = (size_t)b * LROW + n * 64 + (tid >> 3);
    {
      f32x4 s0 = {0.f, 0.f, 0.f, 0.f}, s1 = {0.f, 0.f, 0.f, 0.f};
#pragma unroll
      for (int ks = 0; ks < 4; ++ks) {
        const int off = (ks >> 1) * 8192 + (ks & 1) * 1024;
        const bf16x8 a = *(const LAS bf16x8*)(lds + kbase + off);
        const bf16x8 b0 = *(const LAS bf16x8*)(lds + qbase + off);
        const bf16x8 b1 = *(const LAS bf16x8*)(lds + qbase + off + 2048);
        s0 = MFMA16(a, b0, s0); s1 = MFMA16(a, b1, s1);
      }
      const int srow = sb * 16 + fq * 4;
#pragma unroll
      for (int i = 0; i < 2; ++i) {
        const f32x4 sv = i ? s1 : s0;
        const int t = (tb0 + i) * 16 + fr;
        const float v0 = sv[0] * EXP2(l2g * (fabsf((float)(t - srow)) - (float)(63 - srow))), v1 = sv[1] * EXP2(l2g * (fabsf((float)(t - srow - 1)) - (float)(62 - srow)));
        const float v2 = sv[2] * EXP2(l2g * (fabsf((float)(t - srow - 2)) - (float)(61 - srow))), v3 = sv[3] * EXP2(l2g * (fabsf((float)(t - srow - 3)) - (float)(60 - srow)));
        const u32x2 o = {pk2(v0, v1), pk2(v2, v3)};
        *(LAS u32x2*)(lds + pbase + i * 2048) = o;
      }
    }
    __syncthreads();
    {
      const bf16x8 vf0 = *(const LAS bf16x8*)(lds + vbase), vf1 = *(const LAS bf16x8*)(lds + vbase + 1024);
      f32x4 o[4], cr[4];
#pragma unroll
      for (int tb = 0; tb < 4; ++tb) {
        o[tb] = (f32x4){0.f, 0.f, 0.f, 0.f}; cr[tb] = (f32x4){0.f, 0.f, 0.f, 0.f};
        const bf16x8 a0 = *(const LAS bf16x8*)(lds + PS + sub16 + tb * 2048);
        const bf16x8 a1 = *(const LAS bf16x8*)(lds + PS + sub16 + tb * 2048 + 1024);
        o[tb] = MFMA16(a0, vf0, o[tb]); o[tb] = MFMA16(a1, vf1, o[tb]);
      }
#pragma unroll
      for (int kd = 0; kd < 4; ++kd) {
        const bf16x8 bsv = __builtin_bit_cast(bf16x8, kd == 0 ? sf0 : (kd == 1 ? sf1 : (kd == 2 ? sf2 : sf3)));
#pragma unroll
        for (int tb = 0; tb < 4; ++tb) {
          const bf16x8 a = *(const LAS bf16x8*)(lds + QS + (kd >> 1) * 8192 + (tb * 2 + (kd & 1)) * 1024 + sub16);
          cr[tb] = MFMA16(a, bsv, cr[tb]);
        }
      }
#pragma unroll
      for (int tb = 0; tb < 4; ++tb)
#pragma unroll
        for (int j = 0; j < 4; ++j) o[tb][j] += EXP2(l2g * (float)(tb * 16 + fq * 4 + j + 1)) * cr[tb][j];
#pragma unroll
      for (int tb = 0; tb < 4; ++tb)
#pragma unroll
        for (int j = 0; j < 4; ++j) *(LAS float*)(lds + obase + (tb * 16 + j) * 528) = o[tb][j];
    }
    __syncthreads();
    {
      const int seg = tid & 7;
      const f32x4 x0 = *(const LAS f32x4*)(lds + nbase), x1 = *(const LAS f32x4*)(lds + nbase + 16), x2 = *(const LAS f32x4*)(lds + nbase + 32), x3 = *(const LAS f32x4*)(lds + nbase + 48);
      f32x4 xs = x0 + x1 + x2 + x3;
      float sum = xs[0] + xs[1] + xs[2] + xs[3];
      sum += __shfl_xor(sum, 1); sum += __shfl_xor(sum, 2); sum += __shfl_xor(sum, 4);
      const float mu = sum * (1.f / 128.f);
      const f32x4 d0 = x0 - mu, d1 = x1 - mu, d2 = x2 - mu, d3 = x3 - mu;
      const f32x4 q = d0 * d0 + d1 * d1 + d2 * d2 + d3 * d3;
      float vs = q[0] + q[1] + q[2] + q[3];
      vs += __shfl_xor(vs, 1); vs += __shfl_xor(vs, 2); vs += __shfl_xor(vs, 4);
      const float rn = rsqrtf(vs * (1.f / 128.f) + 1e-6f);
      const float* gr = p.ret_g + l * 1024 + h * 128 + seg * 16;
      const f32x4 w0 = *(const f32x4*)gr, w1 = *(const f32x4*)(gr + 4), w2 = *(const f32x4*)(gr + 8), w3 = *(const f32x4*)(gr + 12);
      uint4 oa, ob;
      oa.x = pk2(d0[0] * rn * w0[0] * silu(bflo(g0[0])), d0[1] * rn * w0[1] * silu(bfhi(g0[0])));
      oa.y = pk2(d0[2] * rn * w0[2] * silu(bflo(g0[1])), d0[3] * rn * w0[3] * silu(bfhi(g0[1])));
      oa.z = pk2(d1[0] * rn * w1[0] * silu(bflo(g0[2])), d1[1] * rn * w1[1] * silu(bfhi(g0[2])));
      oa.w = pk2(d1[2] * rn * w1[2] * silu(bflo(g0[3])), d1[3] * rn * w1[3] * silu(bfhi(g0[3])));
      ob.x = pk2(d2[0] * rn * w2[0] * silu(bflo(g1[0])), d2[1] * rn * w2[1] * silu(bfhi(g1[0])));
      ob.y = pk2(d2[2] * rn * w2[2] * silu(bflo(g1[1])), d2[3] * rn * w2[3] * silu(bfhi(g1[1])));
      ob.z = pk2(d3[0] * rn * w3[0] * silu(bflo(g1[2])), d3[1] * rn * w3[1] * silu(bfhi(g1[2])));
      ob.w = pk2(d3[2] * rn * w3[2] * silu(bflo(g1[3])), d3[3] * rn * w3[3] * silu(bfhi(g1[3])));
      bf16_t* mp = p.mix + row * DM + h * 128 + seg * 16;
      *(uint4*)mp = oa; *(uint4*)(mp + 8) = ob;
    }
  }
#undef RET_GLOAD
}

DI void diff_pv(LAS unsigned char* lds, int vgb, const bf16x8 (&pfr)[2][2], f32x4 (&o)[2][8], int sub16) {
  __builtin_amdgcn_s_setprio(1);
#pragma unroll
  for (int eb = 0; eb < 8; ++eb)
#pragma unroll
    for (int kp = 0; kp < 2; ++kp) {
      const bf16x8 a = *(const LAS bf16x8*)(lds + vgb + (eb * 2 + kp) * 1024 + sub16);
      o[0][eb] = MFMA16(a, pfr[0][kp], o[0][eb]);
      o[1][eb] = MFMA16(a, pfr[1][kp], o[1][eb]);
    }
  __builtin_amdgcn_s_setprio(0);
}
DI void diff_tile(bool general, LAS unsigned char* lds, int kfb, const bf16x8 (&qf)[2][2], f32x4 (&o)[2][8], bf16x8 (&pfr)[2][2], float& m0, float& m1, float& l0, float& l1,
                  const f32x4 (&cj)[4], float slope2, int kt, int qrow, int fq) {
  f32x4 s[2][4];
#pragma unroll
  for (int kb = 0; kb < 4; ++kb) {
    const f32x4 init = cj[kb];
    const bf16x8 a0 = *(const LAS bf16x8*)(lds + kfb + (kb * 2) * 1024);
    const bf16x8 a1 = *(const LAS bf16x8*)(lds + kfb + (kb * 2 + 1) * 1024);
    s[0][kb] = MFMA16(a0, qf[0][0], init); s[1][kb] = MFMA16(a0, qf[1][0], init);
    s[0][kb] = MFMA16(a1, qf[0][1], s[0][kb]); s[1][kb] = MFMA16(a1, qf[1][1], s[1][kb]);
  }
  const float tconst = slope2 * (float)(kt * 64);
#pragma unroll
  for (int rb = 0; rb < 2; ++rb) {
    if (general) {
      const int qrel = qrow + rb * 16 - kt * 64;
      const float ms2 = -2.f * slope2;
#pragma unroll
      for (int kb = 0; kb < 4; ++kb)
#pragma unroll
        for (int j = 0; j < 4; ++j) {
          const int kl = kb * 16 + fq * 4 + j;
          float v = s[rb][kb][j] + ms2 * (float)max(kl - qrel, 0);
          if (kt == 0 && kl < 48) v = -INFINITY;
          s[rb][kb][j] = v;
        }
    }
    float mx = fmaxf(fmaxf(s[rb][0][0], s[rb][0][1]), fmaxf(s[rb][0][2], s[rb][0][3]));
#pragma unroll
    for (int kb = 1; kb < 4; ++kb) mx = fmaxf(fmaxf(mx, fmaxf(s[rb][kb][0], s[rb][kb][1])), fmaxf(s[rb][kb][2], s[rb][kb][3]));
    mx = xmax32(xmax16(mx));
    const float mloc = (rb ? m1 : m0) - tconst;
    const float mnew = fmaxf(mloc, mx);
    const float alpha = EXP2(mloc - mnew);
    float rsum = 0.f;
#pragma unroll
    for (int kb = 0; kb < 4; ++kb)
#pragma unroll
      for (int j = 0; j < 4; ++j) { const float pv = EXP2(s[rb][kb][j] - mnew); s[rb][kb][j] = pv; rsum += pv; }
    if (rb) { l1 = l1 * alpha + rsum; m1 = mnew + tconst; } else { l0 = l0 * alpha + rsum; m0 = mnew + tconst; }
    if (__any(alpha != 1.f)) {
#pragma unroll
      for (int eb = 0; eb < 8; ++eb) o[rb][eb] *= alpha;
    }
#pragma unroll
    for (int kp = 0; kp < 2; ++kp) {
      const f32x4 sa = s[rb][2 * kp], sc = s[rb][2 * kp + 1];
      const u32x4 pbu = {pk2(sa[0], sa[1]), pk2(sa[2], sa[3]), pk2(sc[0], sc[1]), pk2(sc[2], sc[3])};
      pfr[rb][kp] = __builtin_bit_cast(bf16x8, pbu);
    }
  }
}

DI void diff_item(const Params& p, int l, int b, int h, int pi, float lam, float lam_init, LAS unsigned char* lds) {
  const int tid = opaque_tid(), w = __builtin_amdgcn_readfirstlane(tid >> 6), lane = tid & 63, fr = lane & 15, fq = lane >> 4;
  const int c = w & 1, rgq = w >> 1, qc = 2 * pi + (rgq >> 1);
  const bool active = qc <= 32;
  const int ktmax = min(2 * pi + 1, 32);
  const int sub16 = lds_byte(fr, fq * 8), sub8a = lds_byte(fr, fq * 4), sub8b = lds_byte(fr, fq * 4 + 16);
  const bf16_t* projb = p.proj + (size_t)b * LROW * NIN;
  const int qrow = qc * 64 + (rgq & 1) * 32 + fr;
  bf16x8 qf[2][2];
#pragma unroll
  for (int rb = 0; rb < 2; ++rb)
#pragma unroll
    for (int ks = 0; ks < 2; ++ks)
      qf[rb][ks] = active ? *(const bf16x8*)(projb + (size_t)(qrow + rb * 16) * NIN + 4096 + h * 128 + c * 64 + ks * 32 + fq * 8) : (bf16x8){0, 0, 0, 0, 0, 0, 0, 0};
  float m0 = -INFINITY, m1 = -INFINITY, l0 = 0.f, l1 = 0.f;
  f32x4 o[2][8];
#pragma unroll
  for (int rb = 0; rb < 2; ++rb)
#pragma unroll
    for (int eb = 0; eb < 8; ++eb) o[rb][eb] = (f32x4){0.f, 0.f, 0.f, 0.f};
  const float slope2 = exp2f(-(float)(h + 1)) * LOG2E;
  f32x4 cj[4];
#pragma unroll
  for (int kb = 0; kb < 4; ++kb)
#pragma unroll
    for (int j = 0; j < 4; ++j) cj[kb][j] = slope2 * (float)(kb * 16 + fq * 4 + j);
  const int kkey = ((tid >> 5) & 15) * 2 + ((tid >> 2) & 1), cd = ((tid >> 4) & 1) * 64 + ((tid >> 3) & 1) * 32 + (tid & 3) * 8;
  const int ve = ((tid >> 4) & 31) * 2 + ((tid >> 2) & 1), vk0 = ((tid >> 3) & 1) * 32 + (tid & 3) * 8;
  const int fillK = (cd >> 6) * 8192 + lds_byte(kkey, cd & 63);
  const int fillV = 32768 + lds_byte(ve, vk0);
  const bf16_t* gk = projb + (size_t)kkey * NIN + 5120 + h * 128 + cd;
  const bf16_t* gv = p.T + (size_t)b * 3072 * LROW + (size_t)(2048 + h * 128 + ve) * LROW + vk0;
  u32x4 pk0, pk1, pv0, pv1;
#define DIFF_GLOAD(kt) do { const bf16_t* _k = gk + (size_t)(kt) * 64 * NIN; const bf16_t* _v = gv + (kt) * 64; \
    pk0 = *(const u32x4*)_k; pk1 = *(const u32x4*)(_k + (size_t)32 * NIN); pv0 = *(const u32x4*)_v; pv1 = *(const u32x4*)(_v + (size_t)64 * LROW); } while (0)
#define DIFF_FILL(kb_, vs_) do { *(LAS u32x4*)(lds + (kb_) + fillK) = pk0; *(LAS u32x4*)(lds + (kb_) + fillK + 4096) = pk1; \
    *(LAS u32x4*)(lds + (vs_) + fillV) = pv0; *(LAS u32x4*)(lds + (vs_) + fillV + 8192) = pv1; } while (0)
  DIFF_GLOAD(0);
  DIFF_FILL(0, 0);
  __syncthreads();
  if (ktmax >= 1) DIFF_GLOAD(1);
  const int kfb0 = c * 8192 + sub16;
  const bool stag = (w >> 2) != 0;
  bf16x8 pfr[2][2];
  int vs = 0;
  for (int kt = 0; kt <= ktmax; ++kt) {
    const int kb = (kt & 1) * 16384;
    const int vsn = vs == 32768 ? 0 : vs + 16384;
    if (kt + 1 <= ktmax) { DIFF_FILL(16384 - kb, vsn); if (kt + 2 <= ktmax) DIFF_GLOAD(kt + 2); }
    if (active && kt <= qc) {
      if (stag && kt > 0) diff_pv(lds, 32768 + (vs == 0 ? 32768 : vs - 16384), pfr, o, sub16);
      diff_tile(kt == 0 || kt == qc, lds, kfb0 + kb, qf, o, pfr, m0, m1, l0, l1, cj, slope2, kt, qrow, fq);
      if (!stag) diff_pv(lds, 32768 + vs, pfr, o, sub16);
    }
    vs = vsn;
    __syncthreads();
  }
  if (active && stag) { const int lastslot = (qc % 3) * 16384; diff_pv(lds, 32768 + lastslot, pfr, o, sub16); }
#undef DIFF_GLOAD
#undef DIFF_FILL
  l0 += __shfl_xor(l0, 16); l0 += __shfl_xor(l0, 32);
  l1 += __shfl_xor(l1, 16); l1 += __shfl_xor(l1, 32);
  const int xb = 81920 + rgq * 16384 + lane * 4;
  if (c == 1 && active) {
#pragma unroll
    for (int rb = 0; rb < 2; ++rb) {
      const float inv = lam / (rb ? l1 : l0);
#pragma unroll
      for (int eb = 0; eb < 8; ++eb)
#pragma unroll
        for (int j = 0; j < 4; ++j) *(LAS float*)(lds + xb + ((rb * 8 + eb) * 4 + j) * 256) = o[rb][eb][j] * inv;
    }
  }
  if (tid == 0) { unsigned sp = 0; while (xb_ld(p.ctr + 32 + l) < 32u && ++sp < (1u << 22)) __builtin_amdgcn_s_sleep(2); }
  __syncthreads();
  __builtin_amdgcn_fence(__ATOMIC_ACQUIRE, "agent");
  if (c == 0 && active) {
#pragma unroll
    for (int rb = 0; rb < 2; ++rb) {
      const float inv = 1.f / (rb ? l1 : l0);
      float ss = 0.f;
#pragma unroll
      for (int eb = 0; eb < 8; ++eb)
#pragma unroll
        for (int j = 0; j < 4; ++j) { const float d = o[rb][eb][j] * inv - *(const LAS float*)(lds + xb + ((rb * 8 + eb) * 4 + j) * 256); o[rb][eb][j] = d; ss += d * d; }
      ss += __shfl_xor(ss, 16); ss += __shfl_xor(ss, 32);
      const float rn = rsqrtf(ss * (1.f / 128.f) + 1e-6f) * (1.f - lam_init);
      const size_t row = (size_t)b * LROW + qrow + rb * 16;
#pragma unroll
      for (int eb = 0; eb < 8; ++eb) {
        const int e0 = h * 128 + eb * 16 + fq * 4;
        const uint2 gu = *(const uint2*)(p.proj + row * NIN + 7168 + e0);
        const float4 gg = *(const float4*)(p.diff_g + l * 1024 + e0);
        const float y0 = o[rb][eb][0] * rn * gg.x * silu(bflo(gu.x)), y1 = o[rb][eb][1] * rn * gg.y * silu(bfhi(gu.x));
        const float y2 = o[rb][eb][2] * rn * gg.z * silu(bflo(gu.y)), y3 = o[rb][eb][3] * rn * gg.w * silu(bfhi(gu.y));
        uint2 ov; ov.x = pk2(y0, y1); ov.y = pk2(y2, y3);
        *(uint2*)(p.mix + row * DM + 1024 + e0) = ov;
      }
    }
  }
}

DI void mixer_phase(const Params& p, int l, LAS unsigned char* lds) {
  volatile LAS int* s_item = (volatile LAS int*)(lds + 147456);
  const float lam = p.lam[l];
  const float lam_init = 0.8f - 0.6f * expf(-0.3f * (float)l);
  for (int c = (int)blockIdx.x - 32; c >= 0 && c < 32; c += (int)gridDim.x) ret_scan_chain(p, c >> 3, c & 7, lds, p.ctr + 34 + l);
  const int xcd = blockIdx.x & 7;
  for (;;) {
    if (threadIdx.x == 0) *s_item = (int)atomicAdd(p.ctr + l * 8 + xcd, 1u);
    __syncthreads();
    const int it = *s_item;
    __syncthreads();
    if (it >= 68 + 22) break;
    if (it < 48 || it >= 70) {
      const int ai = it < 48 ? it : it - 22;
      const int bh = 4 * xcd + (ai & 3);
      diff_item(p, l, bh >> 3, bh & 7, 16 - (ai >> 2), lam, lam_init, lds);
    } else {
      if (threadIdx.x == 0) { unsigned sp = 0; while ((xb_ld(p.ctr + 34 + l) < 32u || xb_ld(p.ctr + 32 + l) < 32u) && ++sp < (1u << 22)) __builtin_amdgcn_s_sleep(2); }
      __syncthreads();
      __builtin_amdgcn_fence(__ATOMIC_ACQUIRE, "agent");
      retention_items(p, l, lds, xcd + 48 * (it - 48), 8, 6);
      __syncthreads();
    }
  }
}

__global__ void __launch_bounds__(512) hymba_megakernel(Params p_unused) {
  cg::grid_group grid = cg::this_grid();
  extern __shared__ __attribute__((aligned(16))) char smem[];
  LAS unsigned char* lds = (LAS unsigned char*)smem;
  volatile LAS unsigned* xst = (volatile LAS unsigned*)(lds + 147456 + 16);
  if (threadIdx.x == 0) { xst[0] = 0u; xst[1] = 0u; }
  __syncthreads();
  XcdBarrier xb;
  { const Params p = load_params(); xb = xcd_barrier_post(p.bar, xst); }
  { const Params p = load_params(); prep_weights(p, lds, 0, 1792, blockIdx.x, gridDim.x, true); }
  { const Params p = load_params(); rownorm<0>(p); }
  grid.sync();
  for (int l = 0; l < 2; ++l) {
    { const Params p = load_params(); gemm1_phase(p, l, lds, 0, 1024); }
    xcd_barrier(xb);
    if (blockIdx.x < 32) {
      const Params p = load_params();
      gemm1_phase(p, l, lds, 1024, 1056);
      if (threadIdx.x == 0) {
        int nl = 0; for (int U = 1024 + (int)blockIdx.x; U < 1056; U += (int)gridDim.x) ++nl;
        __builtin_amdgcn_fence(__ATOMIC_RELEASE, "agent");
        asm volatile("s_waitcnt vmcnt(0)" ::: "memory");
        xb_add(p.ctr + 32 + l, (unsigned)nl);
      }
    }
    { const Params p = load_params(); mixer_phase(p, l, lds); }
    xcd_barrier(xb);
    { const Params p = load_params(); gemm2_phase(p, l, lds); }
    if (l == 0) { const Params p = load_params(); if (gridDim.x > 64) { if (blockIdx.x >= 64) prep_weights(p, lds, 1792, 2560, blockIdx.x - 64, gridDim.x - 64, false); } else prep_weights(p, lds, 1792, 2560, blockIdx.x, gridDim.x, false); }
    xcd_barrier(xb);
    if (l == 0) { { const Params p = load_params(); rownorm<1>(p); } xcd_barrier(xb); }
    else { const Params p = load_params(); rownorm<2>(p); }
  }
}

extern "C" void kernel_launch(void* const* d_in, const int* in_sizes, int n_in, void* d_out, int out_size, void* d_ws, size_t ws_size, hipStream_t stream) {
  static int grid_blocks = 0;
  if (!grid_blocks) {
    int dev = 0, cus = 0, per_cu = 0;
    hipGetDevice(&dev);
    hipDeviceGetAttribute(&cus, hipDeviceAttributeMultiprocessorCount, dev);
    hipFuncSetAttribute((const void*)hymba_megakernel, hipFuncAttributeMaxDynamicSharedMemorySize, SMEM_BYTES);
    hipOccupancyMaxActiveBlocksPerMultiprocessor(&per_cu, hymba_megakernel, 512, SMEM_BYTES);
    if (per_cu < 1) per_cu = 1;
    if (per_cu > 1) per_cu = 1;
    grid_blocks = cus * per_cu;
  }
  Params p{};
  p.x = (const float*)d_in[0]; p.meta = (const float*)d_in[1]; p.norm_g = (const float*)d_in[2]; p.w_in = (const float*)d_in[3];
  p.w_out = (const float*)d_in[4]; p.ret_g = (const float*)d_in[5]; p.diff_g = (const float*)d_in[6];
  p.lq1 = (const float*)d_in[7]; p.lk1 = (const float*)d_in[8]; p.lq2 = (const float*)d_in[9]; p.lk2 = (const float*)d_in[10];
  p.fin_g = (const float*)d_in[11];
  p.out = (float*)d_out;
  char* ws = (char*)d_ws; size_t off = 0;
  auto take = [&](size_t bytes) { char* r = ws + off; off += (bytes + 255) & ~(size_t)255; return r; };
  p.ctr = (unsigned*)take(256);
  p.bar = (unsigned*)take((size_t)XCD_BAR_WORDS * 4);
  p.ss = (float*)take((size_t)2 * MROWS * 4);
  p.lam = (float*)take(256);
  p.WinT = (bf16_t*)take((size_t)2 * NIN * DM * 2);
  p.WoutT = (bf16_t*)take((size_t)2 * DM * DM * 2);
  p.h = (float*)take((size_t)MROWS * DM * 4);
  p.hb = (bf16_t*)take((size_t)MROWS * DM * 2);
  p.proj = (bf16_t*)take((size_t)MROWS * NIN * 2);
  p.T = (bf16_t*)take((size_t)4 * 3072 * LROW * 2);
  p.mix = (bf16_t*)take((size_t)MROWS * DM * 2);
  p.ST = (bf16_t*)take((size_t)32 * NCH * 32768);
  p.P2 = (float*)take((size_t)8 * 256 * DM * 4);
  hipMemsetAsync(p.ctr, 0, 256 + (size_t)XCD_BAR_WORDS * 4 + (size_t)2 * MROWS * 4, stream);
  void* args[] = {&p};
  hipError_t e = hipLaunchCooperativeKernel((void*)hymba_megakernel, dim3(grid_blocks), dim3(512), args, SMEM_BYTES, stream);
  if (e != hipSuccess) fprintf(stderr, "cooperative launch failed: %s (grid %d)\n", hipGetErrorString(e), grid_blocks);
}
```

```cpp
#include <hip/hip_runtime.h>
#include <hip/hip_cooperative_groups.h>
#include <cstdio>
namespace cg = cooperative_groups;

typedef unsigned short bf16_t;
typedef short bf16x8 __attribute__((ext_vector_type(8)));
typedef short s16x4 __attribute__((ext_vector_type(4)));
typedef float f32x4 __attribute__((ext_vector_type(4)));
typedef float f32x2 __attribute__((ext_vector_type(2)));
typedef unsigned u32x4 __attribute__((ext_vector_type(4)));
typedef unsigned u32x2 __attribute__((ext_vector_type(2)));
typedef __bf16 bf16x2_t __attribute__((ext_vector_type(2)));
#define DI __device__ __forceinline__
#define LAS __attribute__((address_space(3)))
#define MFMA16(a, b, c) __builtin_amdgcn_mfma_f32_16x16x32_bf16((a), (b), (c), 0, 0, 0)

constexpr int LROW = 2112;
constexpr int MROWS = 4 * LROW;
constexpr int DM = 2048;
constexpr int NIN = 8192;
constexpr int NCH = 33;
constexpr float LOG2E = 1.4426950408889634f;
constexpr int SMEM_BYTES = 147456 + 64;

struct Params {
  const float *x, *meta, *norm_g, *w_in, *w_out, *ret_g, *diff_g, *lq1, *lk1, *lq2, *lk2, *fin_g;
  float* out;
  bf16_t *WinT, *WoutT, *hb, *proj, *T, *mix, *ST;
  float *h, *ss, *lam, *P2;
  unsigned* ctr;
  unsigned* bar;
};

DI Params load_params() {
  const Params __attribute__((address_space(4)))* q = (const Params __attribute__((address_space(4)))*)__builtin_amdgcn_kernarg_segment_ptr();
  asm volatile("" : "+s"(q));
  Params r; __builtin_memcpy(&r, (const void*)q, sizeof(Params)); return r;
}
DI unsigned pk2(float a, float b) { f32x2 v = {a, b}; bf16x2_t r = __builtin_convertvector(v, bf16x2_t); return __builtin_bit_cast(unsigned, r); }
DI float bf2f(unsigned v16) { return __uint_as_float(v16 << 16); }
DI float bflo(unsigned u) { return __uint_as_float(u << 16); }
DI float bfhi(unsigned u) { return __uint_as_float(u & 0xffff0000u); }
DI int opaque_tid() { int t = threadIdx.x; asm volatile("" : "+v"(t)); return t; }
#define EXP2(x) __builtin_amdgcn_exp2f(x)
DI float xmax16(float x) { const u32x2 r = __builtin_amdgcn_permlane16_swap(__float_as_uint(x), __float_as_uint(x), false, false); return fmaxf(__uint_as_float(r[0]), __uint_as_float(r[1])); }
DI float xmax32(float x) { const u32x2 r = __builtin_amdgcn_permlane32_swap(__float_as_uint(x), __float_as_uint(x), false, false); return fmaxf(__uint_as_float(r[0]), __uint_as_float(r[1])); }
DI float silu(float v) { return v * __builtin_amdgcn_rcpf(1.f + __expf(-v)); }

DI int lds_byte(int r, int c) { int st = (r >> 4) * 2 + (c >> 5), rr = r & 15, cc = c & 31, ob = rr * 64 + cc * 2; return st * 1024 + (ob ^ (((ob >> 9) & 1) << 5)); }
DI int perm32(int rho) { const int n = rho >> 4, i = rho & 15; return 8 * (i >> 2) + 4 * n + (i & 3); }
DI void stage_rc(int b, int& R, int& C) { int st = b / 1024, sb = b % 1024, swz = sb ^ (((sb >> 9) & 1) << 5); R = (st >> 1) * 16 + swz / 64; C = (st & 1) * 32 + (swz % 64) / 2; }

DI void prep_weights(const Params& p, LAS unsigned char* lds, int ubeg, int uend, int wgi, int wgn, bool do_lam) {
  const int tid = opaque_tid();
  const int NTOT = uend;
  const int lrow = tid >> 6, c4 = (tid & 63) * 4;
  f32x4 r[8];
#define PREP_DECODE(u) const float* src; bf16_t* dst; int N; const float* g; int kt, ntile; \
    { const int _l = (u) >= 1280 ? 1 : 0, _v = (u) - _l * 1280; \
      if (_v < 1024) { kt = _v >> 5; ntile = _v & 31; src = p.w_in + (size_t)_l * DM * NIN; dst = p.WinT + (size_t)_l * NIN * DM; N = NIN; g = p.norm_g + _l * DM; } \
      else { const int q = _v - 1024; kt = q >> 3; ntile = q & 7; src = p.w_out + (size_t)_l * DM * DM; dst = p.WoutT + (size_t)_l * DM * DM; N = DM; g = nullptr; } } \
    const int k0 = kt * 64, n0 = ntile * 256;
#define PREP_LOAD(u) do { PREP_DECODE(u) (void)dst; _Pragma("unroll") for (int i = 0; i < 8; ++i) { const int kk = lrow + 8 * i; \
    const f32x4 v = *(const f32x4*)(src + (size_t)(k0 + kk) * N + n0 + c4); const float gg = g ? g[k0 + kk] : 1.f; r[i] = v * gg; } } while (0)
  int u = ubeg + wgi;
  if (u < NTOT) PREP_LOAD(u);
  for (; u < NTOT; u += wgn) {
#pragma unroll
    for (int i = 0; i < 8; ++i) *(LAS f32x4*)(lds + ((lrow + 8 * i) * 260 + c4) * 4) = r[i];
    __syncthreads();
    const int un = u + wgn;
    if (un < NTOT) PREP_LOAD(un);
    {
      PREP_DECODE(u) (void)src; (void)N; (void)g;
      const int n = tid >> 1, kh = (tid & 1) * 32;
      bf16_t* op = dst + (size_t)(n0 + n) * DM + k0 + kh;
#pragma unroll
      for (int q = 0; q < 4; ++q) {
        float f[8];
#pragma unroll
        for (int j = 0; j < 8; ++j) f[j] = *(const LAS float*)(lds + ((kh + q * 8 + j) * 260 + n) * 4);
        const u32x4 o = {pk2(f[0], f[1]), pk2(f[2], f[3]), pk2(f[4], f[5]), pk2(f[6], f[7])};
        *(u32x4*)(op + q * 8) = o;
      }
    }
    __syncthreads();
  }
#undef PREP_DECODE
#undef PREP_LOAD
  if (do_lam && blockIdx.x == 0 && tid < 64) {
    for (int l = 0; l < 2; ++l) {
      float a = p.lq1[l * 64 + tid] * p.lk1[l * 64 + tid], b = p.lq2[l * 64 + tid] * p.lk2[l * 64 + tid];
#pragma unroll
      for (int off = 32; off >= 1; off >>= 1) { a += __shfl_xor(a, off); b += __shfl_xor(b, off); }
      float li = 0.8f - 0.6f * expf(-0.3f * (float)l);
      if (tid == 0) p.lam[l] = expf(a) - expf(b) + li;
    }
  }
}

template <int MODE> DI void rownorm(const Params& p) {
  const int tid = opaque_tid(); const int wave = tid >> 6, lane = tid & 63;
  const int nw = gridDim.x * 8;
  for (int row = (MODE == 1 ? 8192 : 0) + blockIdx.x * 8 + wave; row < MROWS; row += nw) {
    const int b = row / LROW, pos = row - b * LROW;
    if (MODE == 2 && pos < 64) continue;
    const float* src;
    if (MODE <= 1) src = pos < 48 ? nullptr : (pos < 64 ? p.meta + (size_t)(pos - 48) * DM : p.x + ((size_t)b * 2048 + (pos - 64)) * DM);
    else src = p.h + (size_t)row * DM;
    float4 v[8]; float ss = 0.f;
#pragma unroll
    for (int i = 0; i < 8; ++i) {
      v[i] = src ? *(const float4*)(src + i * 256 + lane * 4) : make_float4(0.f, 0.f, 0.f, 0.f);
      if (MODE != 0 && row >= 8192) {
#pragma unroll
        for (int s = 0; s < 8; ++s) { const float4 q = *(const float4*)(p.P2 + ((size_t)s * 256 + (row - 8192)) * DM + i * 256 + lane * 4); v[i].x += q.x; v[i].y += q.y; v[i].z += q.z; v[i].w += q.w; }
      }
      ss += v[i].x * v[i].x + v[i].y * v[i].y + v[i].z * v[i].z + v[i].w * v[i].w;
    }
#pragma unroll
    for (int off = 32; off >= 1; off >>= 1) ss += __shfl_xor(ss, off);
    const float rs = rsqrtf(ss * (1.f / 2048.f) + 1e-6f);
    if (MODE < 2) {
#pragma unroll
      for (int i = 0; i < 8; ++i) {
        if (MODE == 1) *(float4*)(p.h + (size_t)row * DM + i * 256 + lane * 4) = v[i];
        uint2 o; o.x = pk2(v[i].x, v[i].y); o.y = pk2(v[i].z, v[i].w);
        *(uint2*)(p.hb + (size_t)row * DM + i * 256 + lane * 4) = o;
      }
      if (lane == 0) p.ss[(MODE == 0 ? 0 : 1) * MROWS + row] = ss;
    } else {
      float* dst = p.out + ((size_t)b * 2048 + (pos - 64)) * DM;
#pragma unroll
      for (int i = 0; i < 8; ++i) {
        float4 g = *(const float4*)(p.fin_g + i * 256 + lane * 4);
        float4 o; o.x = v[i].x * rs * g.x; o.y = v[i].y * rs * g.y; o.z = v[i].z * rs * g.z; o.w = v[i].w * rs * g.w;
        *(float4*)(dst + i * 256 + lane * 4) = o;
      }
    }
  }
}

constexpr int GK = 2048, GBK = 64, GHALF = 128, GHTB = GHALF * GBK * 2;
constexpr size_t TSTEP = (size_t)256 * GK * 2;
struct Unit { int mt, nt, tr, k0, nkt, nb; };

template <class Epi, class Sched>
DI void gemm_phase(LAS unsigned char* lds, const Sched& S, const Epi& E) {
  const int tid = opaque_tid(), wid = __builtin_amdgcn_readfirstlane(tid >> 6), lane = tid & 63, wr = wid >> 2, wc = wid & 3, fr = lane & 15, fq = lane >> 4;
  constexpr int K = GK;
  unsigned voffA[2], dperm;
#pragma unroll
  for (int i = 0; i < 2; ++i) { int R, C; stage_rc(tid * 16 + i * 8192, R, C); voffA[i] = (unsigned)(R * K + C) * 2u;
    if (i == 0) dperm = (unsigned)((perm32(R & 31) - (R & 31)) * K * 2); }
  const size_t kstep = (size_t)(GBK * 2);
  const size_t hstep = (size_t)GHALF * K * 2;
  const unsigned ldsw = (unsigned)wid * 1024u;
  const int aoff = lds_byte(wr * 64 + fr, fq * 8), boff = lds_byte(wc * 32 + fr, fq * 8);
#define G_SA(b, h) (((b) * 2 + (h)) * GHTB)
#define G_SB(b, h) ((4 + (b) * 2 + (h)) * GHTB)
#define G_STAGE(bufoff, gbase, voff) do { _Pragma("unroll") for (int _i = 0; _i < 2; ++_i) \
    __builtin_amdgcn_global_load_lds((const unsigned*)((const char*)(gbase) + voff[_i]), (LAS unsigned*)(lds + (bufoff) + ldsw + _i * 8192), 16, 0, 0); } while (0)
#define G_LDA(dst, b, h) do { _Pragma("unroll") for (int m = 0; m < 4; ++m) _Pragma("unroll") for (int k = 0; k < 2; ++k) dst[m][k] = *(const LAS bf16x8*)(lds + G_SA(b, h) + aoff + m * 2048 + k * 1024); } while (0)
#define G_LDB(dst, b, h) do { _Pragma("unroll") for (int n = 0; n < 2; ++n) _Pragma("unroll") for (int k = 0; k < 2; ++k) dst[n][k] = *(const LAS bf16x8*)(lds + G_SB(b, h) + boff + n * 2048 + k * 1024); } while (0)
#define G_MMA(ai, bj, At, Bx) do { __builtin_amdgcn_s_setprio(1); _Pragma("unroll") for (int m = 0; m < 4; ++m) _Pragma("unroll") for (int n = 0; n < 2; ++n) _Pragma("unroll") for (int k = 0; k < 2; ++k) \
    acc[ai][bj][m][n] = MFMA16(Bx[n][k], At[m][k], acc[ai][bj][m][n]); __builtin_amdgcn_s_setprio(0); } while (0)
#define G_WAIT_V(n) asm volatile("s_waitcnt vmcnt(" #n ")" ::: "memory")
#define G_WAIT_L(n) asm volatile("s_waitcnt lgkmcnt(" #n ")" ::: "memory")
#define G_BAR __builtin_amdgcn_s_barrier()
#define G_SCHED __builtin_amdgcn_sched_barrier(0)
  Unit cur, nxt; int ui = 0;
  if (!S.next(0, cur)) return;
  f32x4 acc[2][2][4][2];
  E.init(acc, cur, wr, wc, fr, fq, lds, 0);
  bf16x8 At[4][2], B0[2][2], B1[2][2];
  const char* cA = S.pa(cur); const char* cB = S.pb(cur);
  { const unsigned ds0 = cur.nb ? 0u : dperm; const unsigned vb[2] = {voffA[0] + ds0, voffA[1] + ds0};
  G_STAGE(G_SB(0, 0), cB, vb); G_STAGE(G_SA(0, 0), cA, voffA); G_STAGE(G_SB(0, 1), cB + hstep, vb); G_STAGE(G_SA(0, 1), cA + hstep, voffA);
  if (wr == 1) G_BAR;
  G_WAIT_V(4); G_BAR;
  G_STAGE(G_SB(1, 0), cB + kstep, vb); G_STAGE(G_SA(1, 0), cA + kstep, voffA); G_STAGE(G_SB(1, 1), cB + hstep + kstep, vb); }
  G_WAIT_V(6); G_BAR;
  for (;;) {
    const bool has_next = S.next(ui + 1, nxt);
    if (!has_next) nxt = cur;
    const char* nA = has_next ? S.pa(nxt) : cA; const char* nB = has_next ? S.pb(nxt) : cB;
    const int nt = cur.nkt;
    for (int t = 0; t < nt; t += 2) {
      const bool last = (t == nt - 2);
      const char* a1 = cA + (size_t)(t + 1) * kstep;
      const char* a2 = last ? nA : cA + (size_t)(t + 2) * kstep; const char* b2 = last ? nB : cB + (size_t)(t + 2) * kstep;
      const char* a3 = a2 + kstep; const char* b3 = b2 + kstep;
      const bool nbs = last ? (nxt.nb != 0) : (cur.nb != 0);
      const unsigned ds = nbs ? 0u : dperm; const unsigned vb[2] = {voffA[0] + ds, voffA[1] + ds};
      G_LDB(B0, 0, 0); G_SCHED; G_LDA(At, 0, 0); G_STAGE(G_SA(1, 1), a1 + hstep, voffA);
      G_WAIT_L(8); G_BAR; G_WAIT_L(0); G_MMA(0, 0, At, B0); G_BAR; G_SCHED;
      G_LDB(B1, 0, 1); G_STAGE(G_SB(0, 0), b2, vb);
      G_BAR; G_WAIT_L(0); G_MMA(0, 1, At, B1); G_BAR;
      G_LDA(At, 0, 1); G_STAGE(G_SA(0, 0), a2, voffA);
      G_BAR; G_WAIT_L(0); G_MMA(1, 0, At, B0); G_BAR; G_SCHED;
      G_STAGE(G_SB(0, 1), b2 + hstep, vb);
      G_WAIT_V(6); G_BAR; G_MMA(1, 1, At, B1); G_BAR;
      G_LDB(B0, 1, 0); G_SCHED; G_LDA(At, 1, 0); G_STAGE(G_SA(0, 1), a2 + hstep, voffA);
      G_WAIT_L(8); G_BAR; G_WAIT_L(0); G_MMA(0, 0, At, B0); G_BAR; G_SCHED;
      G_LDB(B1, 1, 1); G_STAGE(G_SB(1, 0), b3, vb);
      G_BAR; G_WAIT_L(0); G_MMA(0, 1, At, B1); G_BAR;
      G_LDA(At, 1, 1); G_STAGE(G_SA(1, 0), a3, voffA);
      G_BAR; G_WAIT_L(0); G_MMA(1, 0, At, B0); G_BAR; G_SCHED;
      G_STAGE(G_SB(1, 1), b3 + hstep, vb);
      G_WAIT_V(6); G_BAR; G_MMA(1, 1, At, B1); G_BAR;
    }
    { const int t2 = opaque_tid() & 63; E(acc, cur, wr, wc, t2 & 15, t2 >> 4, lds, ui & 1); }
    if (!has_next) break;
    cur = nxt; cA = nA; cB = nB; ++ui;
    { const int t3 = opaque_tid() & 63; E.init(acc, cur, wr, wc, t3 & 15, t3 >> 4, lds, ui & 1); }
  }
  G_WAIT_V(0);
  if (wr == 0) G_BAR;
  G_BAR;
}

#define XB_TMO      128
#define XB_XCNT(j)  (256  + 64 * (j))
#define XB_XSUB(j)  (1280 + 64 * (j))
#define XB_XGEN(j)  (2304 + 64 * (j))
#define XB_TOP      3328
#define XB_TOPGEN   3392
#define XCD_BAR_WORDS 3456
#define XB_SPIN_CAP (1u << 18)
DI unsigned xb_ld(unsigned* p) { return __hip_atomic_load(p, __ATOMIC_RELAXED, __HIP_MEMORY_SCOPE_AGENT); }
DI unsigned xb_add(unsigned* p, unsigned v) { return __hip_atomic_fetch_add(p, v, __ATOMIC_RELAXED, __HIP_MEMORY_SCOPE_AGENT); }
DI unsigned xb_xcc_id() { return (unsigned)__builtin_amdgcn_s_getreg((3 << 11) | 20) & 0xFu; }
#define XB_SPIN(cond, bar) do { unsigned _sp = 0; while (cond) { __builtin_amdgcn_s_sleep(1); \
    if ((++_sp & 255u) == 0u) { if (xb_ld(&(bar)[XB_TMO])) break; if (_sp > XB_SPIN_CAP) { atomicAdd(&(bar)[XB_TMO], 1u); break; } } } } while (0)
struct XcdBarrier { unsigned* bar; unsigned x; volatile LAS unsigned* st; };
DI XcdBarrier xcd_barrier_post(unsigned* bar, volatile LAS unsigned* st) {
  XcdBarrier b; b.bar = bar; b.x = xb_xcc_id(); b.st = st;
  if (threadIdx.x == 0) (void)xb_add(&bar[XB_XCNT(b.x)], 1u);
  return b;
}
DI void xcd_barrier_complete(unsigned* bar, unsigned x, unsigned& nloc, unsigned& nx) {
  const unsigned G = gridDim.x * gridDim.y * gridDim.z;
  unsigned sum, cnt, mine, sp = 0u;
  for (;;) {
    sum = 0u; cnt = 0u; mine = 0u;
#pragma unroll
    for (unsigned j = 0; j < 16; ++j) { const unsigned c = xb_ld(&bar[XB_XCNT(j)]); sum += c; cnt += (c > 0u) ? 1u : 0u; mine = (j == x) ? c : mine; }
    if (sum == G) break;
    __builtin_amdgcn_s_sleep(1);
    if ((++sp & 255u) == 0u) { if (xb_ld(&bar[XB_TMO])) break; if (sp > XB_SPIN_CAP) { atomicAdd(&bar[XB_TMO], 1u); break; } }
  }
  nloc = mine > 0u ? mine : 1u; nx = cnt > 0u ? cnt : 1u;
}
DI void xcd_barrier(const XcdBarrier& b) {
  asm volatile("s_waitcnt vmcnt(0)" ::: "memory");
  __syncthreads();
  if (threadIdx.x == 0) {
    unsigned* bar = b.bar;
    __builtin_amdgcn_s_waitcnt(0);
    unsigned nloc = b.st[0], nx = b.st[1];
    if (nloc == 0u) { xcd_barrier_complete(bar, b.x, nloc, nx); b.st[0] = nloc; b.st[1] = nx; }
    const unsigned old = xb_add(&bar[XB_XSUB(b.x)], 1u);
    const unsigned gen = old / nloc;
    if (old + 1u == (gen + 1u) * nloc) {
      __builtin_amdgcn_fence(__ATOMIC_RELEASE, "agent");
      asm volatile("s_waitcnt vmcnt(0)" ::: "memory");
      const unsigned og = xb_add(&bar[XB_TOP], 1u);
      const unsigned tg = og / nx;
      if (og + 1u == (tg + 1u) * nx) xb_add(&bar[XB_TOPGEN], 1u);
      else XB_SPIN(xb_ld(&bar[XB_TOPGEN]) == tg, bar);
      __builtin_amdgcn_fence(__ATOMIC_ACQUIRE, "agent");
      xb_add(&bar[XB_XGEN(b.x)], 1u);
      asm volatile("s_waitcnt vmcnt(0)" ::: "memory");
    } else {
      XB_SPIN(xb_ld(&bar[XB_XGEN(b.x)]) == gen, bar);
      __builtin_amdgcn_fence(__ATOMIC_ACQUIRE, "agent");
      asm volatile("s_waitcnt vmcnt(0)" ::: "memory");
    }
  }
  __syncthreads();
}

DI void tile_map(int wgid, int nM, int nN, int& pm, int& pn) {
  const int nwg = nM * nN;
  { int q = nwg / 8, r = nwg % 8, xcd = wgid % 8, off = wgid / 8; wgid = (xcd < r ? xcd * (q + 1) : r * (q + 1) + (xcd - r) * q) + off; }
  const int nig = 8 * nN, gid = wgid / nig, fm = gid * 8, gsz = min(nM - fm, 8);
  pm = fm + ((wgid % nig) % gsz); pn = (wgid % nig) / gsz;
}

struct Sched1 {
  const bf16_t* hb; const bf16_t* W; int ubeg, uend;
  DI bool next(int i, Unit& u) const {
    const int U = ubeg + i * (int)gridDim.x + (int)blockIdx.x; if (U >= uend) return false;
    int pm, pn;
    if (U < 928) tile_map(U, 29, 32, pm, pn);
    else if (U < 1024) { const int q = U - 928, c = q % 24; pm = 29 + q / 24; pn = c < 12 ? c : c + 4; }
    else { const int q = U - 1024, g = q & 7; pm = 29 + (q >> 3); pn = g < 4 ? 12 + g : 24 + g; }
    u.mt = pm; u.nt = pn; u.k0 = 0; u.nkt = 32; const int g = pn >> 2; u.tr = (g == 1 || g == 2 || g == 6) ? 1 : 0; u.nb = u.tr; return true;
  }
  DI const char* pa(const Unit& u) const { return u.tr ? (const char*)W + (size_t)u.nt * TSTEP : (const char*)hb + (size_t)u.mt * TSTEP; }
  DI const char* pb(const Unit& u) const { return u.tr ? (const char*)hb + (size_t)u.mt * TSTEP : (const char*)W + (size_t)u.nt * TSTEP; }
};
struct Sched2 {
  const bf16_t* mix; const bf16_t* W;
  DI bool next(int i, Unit& u) const {
    const int U = i * (int)gridDim.x + (int)blockIdx.x; if (U >= 256 + 64) return false;
    if (U < 256) { int pm, pn; tile_map(U, 32, 8, pm, pn); u.mt = pm; u.nt = pn; u.tr = 0; u.k0 = 0; u.nkt = 32; u.nb = 0; }
    else { const int j = U - 256; u.mt = 32; u.nt = j >> 3; u.tr = 1 + (j & 7); u.k0 = (j & 7) * 256; u.nkt = 4; u.nb = 0; }
    return true;
  }
  DI const char* pa(const Unit& u) const { return (const char*)mix + (size_t)u.mt * TSTEP + (size_t)u.k0 * 2; }
  DI const char* pb(const Unit& u) const { return (const char*)W + (size_t)u.nt * TSTEP + (size_t)u.k0 * 2; }
};

DI void acc_zero(f32x4 (&acc)[2][2][4][2]) {
#pragma unroll
  for (int a = 0; a < 2; ++a)
#pragma unroll
    for (int b = 0; b < 2; ++b)
#pragma unroll
      for (int m = 0; m < 4; ++m)
#pragma unroll
        for (int n = 0; n < 2; ++n) acc[a][b][m][n] = (f32x4){0.f, 0.f, 0.f, 0.f};
}
struct Epi1 {
  bf16_t* proj; bf16_t* T; const float* ss;
  DI void init(f32x4 (&acc)[2][2][4][2], const Unit& u, int wr, int wc, int fr, int fq, LAS unsigned char* lds, int par) const {
    acc_zero(acc);
    if (wr == 0)
      __builtin_amdgcn_global_load_lds((const unsigned*)(ss + u.mt * 256 + wc * 64 + fq * 16 + fr), (LAS unsigned*)(lds + 131072 + par * 1024 + wc * 256), 4, 0, 0);
  }
  DI void operator()(const f32x4 (&acc)[2][2][4][2], const Unit& u, int wr, int wc, int fr, int fq, LAS unsigned char* lds, int par) const {
    const LAS float* ssl = (const LAS float*)(lds + 131072 + par * 1024);
    const int g = u.nt >> 2;
    if (!u.tr) {
      const float sc = (g == 4) ? 0.125f * LOG2E : 1.f;
      const int n0 = u.nt * 256 + wc * 32 + fq * 8;
#pragma unroll
      for (int ai = 0; ai < 2; ++ai)
#pragma unroll
        for (int mi = 0; mi < 4; ++mi) {
          const int m = u.mt * 256 + ai * 128 + wr * 64 + mi * 16 + fr;
          const float rs = rsqrtf(ssl[ai * 128 + wr * 64 + mi * 16 + fr] * (1.f / 2048.f) + 1e-6f) * sc;
          bf16_t* rowp = proj + (size_t)m * NIN + n0;
#pragma unroll
          for (int bj = 0; bj < 2; ++bj) {
            const f32x4 a = acc[ai][bj][mi][0], c = acc[ai][bj][mi][1];
            const u32x4 o = {pk2(a[0] * rs, a[1] * rs), pk2(a[2] * rs, a[3] * rs), pk2(c[0] * rs, c[1] * rs), pk2(c[2] * rs, c[3] * rs)};
            *(u32x4*)(rowp + bj * 128) = o;
          }
        }
    } else {
      const int tbase = (g == 1 ? 0 : (g == 2 ? 1024 : 2048)) - g * 1024;
#pragma unroll
      for (int bj = 0; bj < 2; ++bj) {
        const int mb = u.mt * 256 + bj * 128 + wc * 32;
        const int b = mb / LROW, posb = mb - b * LROW;
        const f32x4 q0 = *(const LAS f32x4*)(ssl + bj * 128 + wc * 32 + 4 * fq), q1 = *(const LAS f32x4*)(ssl + bj * 128 + wc * 32 + 16 + 4 * fq);
        float rs[8];
#pragma unroll
        for (int j = 0; j < 4; ++j) { rs[j] = rsqrtf(q0[j] * (1.f / 2048.f) + 1e-6f); rs[4 + j] = rsqrtf(q1[j] * (1.f / 2048.f) + 1e-6f); }
        const int p0 = posb + 4 * fq, p1 = p0 + 16;
        if (g == 1) {
#pragma unroll
          for (int j = 0; j < 4; ++j) { rs[j] = (p0 + j >= 48) ? rs[j] * 0.08838834764831845f : 0.f; rs[4 + j] = (p1 + j >= 48) ? rs[4 + j] * 0.08838834764831845f : 0.f; }
        }
#pragma unroll
        for (int ai = 0; ai < 2; ++ai)
#pragma unroll
          for (int mi = 0; mi < 4; ++mi) {
            const int col = u.nt * 256 + ai * 128 + wr * 64 + mi * 16 + fr;
            const f32x4 a = acc[ai][bj][mi][0], c = acc[ai][bj][mi][1];
            float v[8] = {a[0] * rs[0], a[1] * rs[1], a[2] * rs[2], a[3] * rs[3], c[0] * rs[4], c[1] * rs[5], c[2] * rs[6], c[3] * rs[7]};
            if (g == 1) {
              const int hh = (col - 1024) >> 7;
              const float l2g = log2f(1.f - exp2f(-5.f - (float)hh));
              const int z0 = 63 - (p0 & 63), z1 = 63 - (p1 & 63);
#pragma unroll
              for (int j = 0; j < 4; ++j) { v[j] *= exp2f(l2g * (float)(z0 - j)); v[4 + j] *= exp2f(l2g * (float)(z1 - j)); }
            }
            const u32x4 o = {pk2(v[0], v[1]), pk2(v[2], v[3]), pk2(v[4], v[5]), pk2(v[6], v[7])};
            const int trow = (g == 1) ? (col & ~31) + 16 * ((col >> 2) & 1) + 4 * ((col >> 3) & 3) + (col & 3) : col;
            *(u32x4*)(T + ((size_t)(b * 3072 + tbase + trow)) * LROW + posb + 8 * fq) = o;
          }
      }
    }
  }
};
struct Epi2 {
  float* h; float* P2; bf16_t* hb; float* ssn; const float* x; const float* meta;
  DI void init(f32x4 (&acc)[2][2][4][2], const Unit& u, int wr, int wc, int fr, int fq, LAS unsigned char*, int) const {
    if (u.tr) { acc_zero(acc); return; }
    const int n0 = u.nt * 256 + wc * 32 + fq * 8;
#pragma unroll
    for (int ai = 0; ai < 2; ++ai)
#pragma unroll
      for (int mi = 0; mi < 4; ++mi) {
        const int m = u.mt * 256 + ai * 128 + wr * 64 + mi * 16 + fr;
        const float* rowp = h + (size_t)m * DM + n0;
        if (x) { const int b = m / LROW, pos = m - b * LROW; rowp = pos < 48 ? nullptr : (pos < 64 ? meta + (size_t)(pos - 48) * DM : x + ((size_t)b * 2048 + (pos - 64)) * DM) + n0; }
#pragma unroll
        for (int bj = 0; bj < 2; ++bj)
#pragma unroll
          for (int ni = 0; ni < 2; ++ni) acc[ai][bj][mi][ni] = rowp ? *(const f32x4*)(rowp + bj * 128 + ni * 4) : (f32x4){0.f, 0.f, 0.f, 0.f};
      }
  }
  DI void operator()(const f32x4 (&acc)[2][2][4][2], const Unit& u, int wr, int wc, int fr, int fq, LAS unsigned char*, int) const {
    const int n0 = u.nt * 256 + wc * 32 + fq * 8;
#pragma unroll
    for (int ai = 0; ai < 2; ++ai)
#pragma unroll
      for (int mi = 0; mi < 4; ++mi) {
        const int m = u.mt * 256 + ai * 128 + wr * 64 + mi * 16 + fr;
        float* rowp = (u.tr ? P2 + ((size_t)(u.tr - 1) * 256 + (m - 8192)) * DM : h + (size_t)m * DM) + n0;
        float sq = 0.f;
#pragma unroll
        for (int bj = 0; bj < 2; ++bj) {
          const f32x4 a = acc[ai][bj][mi][0], c = acc[ai][bj][mi][1];
          *(f32x4*)(rowp + bj * 128) = a; *(f32x4*)(rowp + bj * 128 + 4) = c;
          if (ssn && !u.tr) {
            sq += a[0] * a[0] + a[1] * a[1] + a[2] * a[2] + a[3] * a[3] + c[0] * c[0] + c[1] * c[1] + c[2] * c[2] + c[3] * c[3];
            const u32x4 o = {pk2(a[0], a[1]), pk2(a[2], a[3]), pk2(c[0], c[1]), pk2(c[2], c[3])};
            *(u32x4*)(hb + (size_t)m * DM + n0 + bj * 128) = o;
          }
        }
        if (ssn && !u.tr) {
          sq += __shfl_xor(sq, 16); sq += __shfl_xor(sq, 32);
          if (fq == 0) unsafeAtomicAdd(ssn + m, sq);
        }
      }
  }
};

DI void gemm1_phase(const Params& p, int l, LAS unsigned char* lds, int ubeg, int uend) {
  Sched1 S{p.hb, p.WinT + (size_t)l * NIN * DM, ubeg, uend}; Epi1 E{p.proj, p.T, p.ss + (size_t)l * MROWS};
  gemm_phase(lds, S, E);
}
DI void gemm2_phase(const Params& p, int l, LAS unsigned char* lds) {
  Sched2 S{p.mix, p.WoutT + (size_t)l * DM * DM}; Epi2 E{p.h, p.P2, p.hb, l == 0 ? p.ss + MROWS : nullptr, l == 0 ? p.x : nullptr, p.meta};
  gemm_phase(lds, S, E);
}

DI void ret_scan_chain(const Params& p, int b, int h, LAS unsigned char* lds, unsigned* done_ctr) {
  constexpr int D = 6;
  const int tid = opaque_tid(), w = __builtin_amdgcn_readfirstlane(tid >> 6), lane = tid & 63, fr = lane & 15, fq = lane >> 4;
  const float l2g = log2f(1.f - exp2f(-5.f - (float)h));
  const float dec64 = exp2f(l2g * 64.f);
  const int sub16 = lds_byte(fr, fq * 8);
  const int frow = ((tid >> 4) & 31) * 2 + ((tid >> 2) & 1), fcol = ((tid >> 3) & 1) * 32 + (tid & 3) * 8;
  const int fillT = lds_byte(frow, fcol);
  const bf16_t* gk = p.T + (size_t)b * 3072 * LROW + (size_t)(h * 128 + frow) * LROW + fcol;
  u32x4* so = (u32x4*)p.ST + ((size_t)((b * 8 + h) * NCH) * 8 + w) * 256 + lane;
  f32x4 st[8];
#pragma unroll
  for (int i = 0; i < 8; ++i) st[i] = (f32x4){0.f, 0.f, 0.f, 0.f};
  u32x4 ring[D][4];
#define SCAN_LOAD(slot, n) do { const bf16_t* _t = gk + (n) * 64; ring[slot][0] = *(const u32x4*)_t; ring[slot][1] = *(const u32x4*)(_t + (size_t)64 * LROW); \
    ring[slot][2] = *(const u32x4*)(_t + (size_t)1024 * LROW); ring[slot][3] = *(const u32x4*)(_t + (size_t)1088 * LROW); } while (0)
#define SCAN_STORE(n) do { _Pragma("unroll") for (int kd = 0; kd < 4; ++kd) { const f32x4 sa = st[2 * kd], sc = st[2 * kd + 1]; \
    const u32x4 bsu = {pk2(sa[0], sa[1]), pk2(sa[2], sa[3]), pk2(sc[0], sc[1]), pk2(sc[2], sc[3])}; so[(size_t)(n) * 2048 + kd * 64] = bsu; } } while (0)
#pragma unroll
  for (int i = 0; i < D; ++i) SCAN_LOAD(i, i);
#pragma unroll
  for (int n = 0; n < NCH - 1; ++n) {
    const int slot = n % D, bo = (n & 1) * 32768;
    *(LAS u32x4*)(lds + bo + fillT) = ring[slot][0]; *(LAS u32x4*)(lds + bo + fillT + 8192) = ring[slot][1];
    *(LAS u32x4*)(lds + bo + 16384 + fillT) = ring[slot][2]; *(LAS u32x4*)(lds + bo + 16384 + fillT + 8192) = ring[slot][3];
    if (n + D < NCH - 1) SCAN_LOAD(slot, n + D);
    __syncthreads();
    SCAN_STORE(n);
    const bf16x8 vf0 = *(const LAS bf16x8*)(lds + bo + 16384 + w * 2048 + sub16), vf1 = *(const LAS bf16x8*)(lds + bo + 16384 + w * 2048 + 1024 + sub16);
#pragma unroll
    for (int db = 0; db < 8; ++db) {
      st[db] *= dec64;
      const bf16x8 a0 = *(const LAS bf16x8*)(lds + bo + sub16 + db * 2048);
      const bf16x8 a1 = *(const LAS bf16x8*)(lds + bo + sub16 + db * 2048 + 1024);
      st[db] = MFMA16(a0, vf0, st[db]); st[db] = MFMA16(a1, vf1, st[db]);
    }
  }
  SCAN_STORE(NCH - 1);
  asm volatile("s_waitcnt vmcnt(0)" ::: "memory");
  __syncthreads();
  if (threadIdx.x == 0) { __builtin_amdgcn_fence(__ATOMIC_RELEASE, "agent"); asm volatile("s_waitcnt vmcnt(0)" ::: "memory"); xb_add(done_ctr, 1u); }
#undef SCAN_LOAD
#undef SCAN_STORE
}

DI void retention_items(const Params& p, int l, LAS unsigned char* lds, int first, int stride, int count) {
  constexpr int QS = 0, KS = 16384, VTS = 49152, PS = 65536, OS = 73728;
  const int tid = opaque_tid(), w = __builtin_amdgcn_readfirstlane(tid >> 6), lane = tid & 63, fr = lane & 15, fq = lane >> 4;
  const int sub16 = lds_byte(fr, fq * 8), sub8a = lds_byte(fr, fq * 4), sub8b = lds_byte(fr, fq * 4 + 16);
  const int tq = ((tid >> 5) & 15) * 2 + ((tid >> 2) & 1), dq = ((tid >> 4) & 1) * 64 + ((tid >> 3) & 1) * 32 + (tid & 3) * 8;
  const int ve = ((tid >> 4) & 31) * 2 + ((tid >> 2) & 1), vs0 = ((tid >> 3) & 1) * 32 + (tid & 3) * 8;
  const int fillQ = (dq >> 6) * 8192 + lds_byte(tq, dq & 63);
  const int fillT = lds_byte(ve, vs0);
  const int sb = w & 3, tb0 = (w >> 2) * 2;
  const int kbase = KS + sb * 2048 + sub16, qbase = QS + tb0 * 2048 + sub16;
  const int pbase = PS + tb0 * 2048 + (sb >> 1) * 1024 + lds_byte(fr, fq * 8 + 4 * (sb & 1));
  const int vbase = VTS + w * 2048 + sub16;
  const int obase = OS + ((fq * 4) * 132 + w * 16 + fr) * 4;
  const int nbase = OS + ((tid >> 3) * 132 + (tid & 7) * 16) * 4;
  u32x4 pq0, pq1, pk0, pk1, pv0, pv1, ns0, ns1, ns2, ns3, ng0, ng1;
#define RET_GLOAD(it) do { const int _bh = (it) / NCH, _n = (it) - _bh * NCH, _b = _bh >> 3, _h = _bh & 7; \
    const bf16_t* _q = p.proj + ((size_t)_b * LROW + _n * 64 + tq) * NIN + _h * 128 + dq; \
    const bf16_t* _tk = p.T + ((size_t)_b * 3072 + _h * 128 + (tid >> 3)) * LROW + _n * 64 + (tid & 7) * 8; \
    const bf16_t* _tv = p.T + ((size_t)_b * 3072 + 1024 + _h * 128 + ve) * LROW + _n * 64 + vs0; \
    pq0 = *(const u32x4*)_q; pq1 = *(const u32x4*)(_q + (size_t)32 * NIN); pk0 = *(const u32x4*)_tk; pk1 = *(const u32x4*)(_tk + (size_t)64 * LROW); \
    pv0 = *(const u32x4*)_tv; pv1 = *(const u32x4*)(_tv + (size_t)64 * LROW); \
    const u32x4* _sp = (const u32x4*)p.ST + ((size_t)(it) * 8 + w) * 256 + lane; ns0 = _sp[0]; ns1 = _sp[64]; ns2 = _sp[128]; ns3 = _sp[192]; \
    const bf16_t* _gp = p.proj + ((size_t)_b * LROW + _n * 64 + (tid >> 3)) * NIN + 3072 + _h * 128 + (tid & 7) * 16; \
    ng0 = *(const u32x4*)_gp; ng1 = *(const u32x4*)(_gp + 8); } while (0)
  int it = first;
  const int iend = first + stride * count;
  if (it < iend) RET_GLOAD(it);
  for (; it < iend; it += stride) {
    const int bh = it / NCH, n = it - bh * NCH, b = bh >> 3, h = bh & 7;
    const float l2g = log2f(1.f - exp2f(-5.f - (float)h));
    *(LAS u32x4*)(lds + QS + fillQ) = pq0; *(LAS u32x4*)(lds + QS + fillQ + 4096) = pq1;
    {
      const int d0 = tid >> 3, s0 = (tid & 7) * 8;
#pragma unroll
      for (int i = 0; i < 2; ++i) {
        const u32x4 kv = i ? pk1 : pk0;
        const int r_ = d0 + 64 * i, d = (r_ & ~31) + 8 * ((r_ >> 2) & 3) + 4 * ((r_ >> 4) & 1) + (r_ & 3), ko = KS + (d >> 6) * 8192;
#pragma unroll
        for (int j = 0; j < 8; ++j) {
          const unsigned wv = kv[j >> 1];
          const int st = (s0 & 32) + 16 * (j >> 2) + 4 * ((s0 >> 3) & 3) + (j & 3);
          *(LAS bf16_t*)(lds + ko + lds_byte(st, d & 63)) = (bf16_t)((j & 1) ? (wv >> 16) : (wv & 0xffffu));
        }
      }
    }
    *(LAS u32x4*)(lds + VTS + fillT) = pv0; *(LAS u32x4*)(lds + VTS + fillT + 8192) = pv1;
    const u32x4 sf0 = ns0, sf1 = ns1, sf2 = ns2, sf3 = ns3, g0 = ng0, g1 = ng1;
    __syncthreads();
    if (it + stride < iend) RET_GLOAD(it + stride);
    const size_t row = (size_t)b * LROW + n * 64 + (tid >> 3);
    {
      f32x4 s0 = {0.f, 0.f, 0.f, 0.f}, s1 = {0.f, 0.f, 0.f, 0.f};
#pragma unroll
      for (int ks = 0; ks < 4; ++ks) {
        const int off = (ks >> 1) * 8192 + (ks & 1) * 1024;
        const bf16x8 a = *(const LAS bf16x8*)(lds + kbase + off);
        const bf16x8 b0 = *(const LAS bf16x8*)(lds + qbase + off);
        const bf16x8 b1 = *(const LAS bf16x8*)(lds + qbase + off + 2048);
        s0 = MFMA16(a, b0, s0); s1 = MFMA16(a, b1, s1);
      }
      const int srow = sb * 16 + fq * 4;
#pragma unroll
      for (int i = 0; i < 2; ++i) {
        const f32x4 sv = i ? s1 : s0;
        const int t = (tb0 + i) * 16 + fr;
        const float v0 = sv[0] * EXP2(l2g * (fabsf((float)(t - srow)) - (float)(63 - srow))), v1 = sv[1] * EXP2(l2g * (fabsf((float)(t - srow - 1)) - (float)(62 - srow)));
        const float v2 = sv[2] * EXP2(l2g * (fabsf((float)(t - srow - 2)) - (float)(61 - srow))), v3 = sv[3] * EXP2(l2g * (fabsf((float)(t - srow - 3)) - (float)(60 - srow)));
        const u32x2 o = {pk2(v0, v1), pk2(v2, v3)};
        *(LAS u32x2*)(lds + pbase + i * 2048) = o;
      }
    }
    __syncthreads();
    {
      const bf16x8 vf0 = *(const LAS bf16x8*)(lds + vbase), vf1 = *(const LAS bf16x8*)(lds + vbase + 1024);
      f32x4 o[4], cr[4];
#pragma unroll
      for (int tb = 0; tb < 4; ++tb) {
        o[tb] = (f32x4){0.f, 0.f, 0.f, 0.f}; cr[tb] = (f32x4){0.f, 0.f, 0.f, 0.f};
        const bf16x8 a0 = *(const LAS bf16x8*)(lds + PS + sub16 + tb * 2048);
        const bf16x8 a1 = *(const LAS bf16x8*)(lds + PS + sub16 + tb * 2048 + 1024);
        o[tb] = MFMA16(a0, vf0, o[tb]); o[tb] = MFMA16(a1, vf1, o[tb]);
      }
#pragma unroll
      for (int kd = 0; kd < 4; ++kd) {
        const bf16x8 bsv = __builtin_bit_cast(bf16x8, kd == 0 ? sf0 : (kd == 1 ? sf1 : (kd == 2 ? sf2 : sf3)));
#pragma unroll
        for (int tb = 0; tb < 4; ++tb) {
          const bf16x8 a = *(const LAS bf16x8*)(lds + QS + (kd >> 1) * 8192 + (tb * 2 + (kd & 1)) * 1024 + sub16);
          cr[tb] = MFMA16(a, bsv, cr[tb]);
        }
      }
#pragma unroll
      for (int tb = 0; tb < 4; ++tb)
#pragma unroll
        for (int j = 0; j < 4; ++j) o[tb][j] += EXP2(l2g * (float)(tb * 16 + fq * 4 + j + 1)) * cr[tb][j];
#pragma unroll
      for (int tb = 0; tb < 4; ++tb)
#pragma unroll
        for (int j = 0; j < 4; ++j) *(LAS float*)(lds + obase + (tb * 16 + j) * 528) = o[tb][j];
    }
    __syncthreads();
    {
      const int seg = tid & 7;
      const f32x4 x0 = *(const LAS f32x4*)(lds + nbase), x1 = *(const LAS f32x4*)(lds + nbase + 16), x2 = *(const LAS f32x4*)(lds + nbase + 32), x3 = *(const LAS f32x4*)(lds + nbase + 48);
      f32x4 xs = x0 + x1 + x2 + x3;
      float sum = xs[0] + xs[1] + xs[2] + xs[3];
      sum += __shfl_xor(sum, 1); sum += __shfl_xor(sum, 2); sum += __shfl_xor(sum, 4);
      const float mu = sum * (1.f / 128.f);
      const f32x4 d0 = x0 - mu, d1 = x1 - mu, d2 = x2 - mu, d3 = x3 - mu;
      const f32x4 q = d0 * d0 + d1 * d1 + d2 * d2 + d3 * d3;
      float vs = q[0] + q[1] + q[2] + q[3];
      vs += __shfl_xor(vs, 1); vs += __shfl_xor(vs, 2); vs += __shfl_xor(vs, 4);
      const float rn = rsqrtf(vs * (1.f / 128.f) + 1e-6f);
      const float* gr = p.ret_g + l * 1024 + h * 128 + seg * 16;
      const f32x4 w0 = *(const f32x4*)gr, w1 = *(const f32x4*)(gr + 4), w2 = *(const f32x4*)(gr + 8), w3 = *(const f32x4*)(gr + 12);
      uint4 oa, ob;
      oa.x = pk2(d0[0] * rn * w0[0] * silu(bflo(g0[0])), d0[1] * rn * w0[1] * silu(bfhi(g0[0])));
      oa.y = pk2(d0[2] * rn * w0[2] * silu(bflo(g0[1])), d0[3] * rn * w0[3] * silu(bfhi(g0[1])));
      oa.z = pk2(d1[0] * rn * w1[0] * silu(bflo(g0[2])), d1[1] * rn * w1[1] * silu(bfhi(g0[2])));
      oa.w = pk2(d1[2] * rn * w1[2] * silu(bflo(g0[3])), d1[3] * rn * w1[3] * silu(bfhi(g0[3])));
      ob.x = pk2(d2[0] * rn * w2[0] * silu(bflo(g1[0])), d2[1] * rn * w2[1] * silu(bfhi(g1[0])));
      ob.y = pk2(d2[2] * rn * w2[2] * silu(bflo(g1[1])), d2[3] * rn * w2[3] * silu(bfhi(g1[1])));
      ob.z = pk2(d3[0] * rn * w3[0] * silu(bflo(g1[2])), d3[1] * rn * w3[1] * silu(bfhi(g1[2])));
      ob.w = pk2(d3[2] * rn * w3[2] * silu(bflo(g1[3])), d3[3] * rn * w3[3] * silu(bfhi(g1[3])));
      bf16_t* mp = p.mix + row * DM + h * 128 + seg * 16;
      *(uint4*)mp = oa; *(uint4*)(mp + 8) = ob;
    }
  }
#undef RET_GLOAD
}

DI void diff_pv(LAS unsigned char* lds, int vgb, const bf16x8 (&pfr)[2][2], f32x4 (&o)[2][8], int sub16) {
  __builtin_amdgcn_s_setprio(1);
#pragma unroll
  for (int eb = 0; eb < 8; ++eb)
#pragma unroll
    for (int kp = 0; kp < 2; ++kp) {
      const bf16x8 a = *(const LAS bf16x8*)(lds + vgb + (eb * 2 + kp) * 1024 + sub16);
      o[0][eb] = MFMA16(a, pfr[0][kp], o[0][eb]);
      o[1][eb] = MFMA16(a, pfr[1][kp], o[1][eb]);
    }
  __builtin_amdgcn_s_setprio(0);
}
DI void diff_tile(bool general, LAS unsigned char* lds, int kfb, const bf16x8 (&qf)[2][2], f32x4 (&o)[2][8], bf16x8 (&pfr)[2][2], float& m0, float& m1, float& l0, float& l1,
                  const f32x4 (&cj)[4], float slope2, int kt, int qrow, int fq) {
  f32x4 s[2][4];
#pragma unroll
  for (int kb = 0; kb < 4; ++kb) {
    const f32x4 init = cj[kb];
    const bf16x8 a0 = *(const LAS bf16x8*)(lds + kfb + (kb * 2) * 1024);
    const bf16x8 a1 = *(const LAS bf16x8*)(lds + kfb + (kb * 2 + 1) * 1024);
    s[0][kb] = MFMA16(a0, qf[0][0], init); s[1][kb] = MFMA16(a0, qf[1][0], init);
    s[0][kb] = MFMA16(a1, qf[0][1], s[0][kb]); s[1][kb] = MFMA16(a1, qf[1][1], s[1][kb]);
  }
  const float tconst = slope2 * (float)(kt * 64);
#pragma unroll
  for (int rb = 0; rb < 2; ++rb) {
    if (general) {
      const int qrel = qrow + rb * 16 - kt * 64;
      const float ms2 = -2.f * slope2;
#pragma unroll
      for (int kb = 0; kb < 4; ++kb)
#pragma unroll
        for (int j = 0; j < 4; ++j) {
          const int kl = kb * 16 + fq * 4 + j;
          float v = s[rb][kb][j] + ms2 * (float)max(kl - qrel, 0);
          if (kt == 0 && kl < 48) v = -INFINITY;
          s[rb][kb][j] = v;
        }
    }
    float mx = fmaxf(fmaxf(s[rb][0][0], s[rb][0][1]), fmaxf(s[rb][0][2], s[rb][0][3]));
#pragma unroll
    for (int kb = 1; kb < 4; ++kb) mx = fmaxf(fmaxf(mx, fmaxf(s[rb][kb][0], s[rb][kb][1])), fmaxf(s[rb][kb][2], s[rb][kb][3]));
    mx = xmax32(xmax16(mx));
    const float mloc = (rb ? m1 : m0) - tconst;
    const float mnew = fmaxf(mloc, mx);
    const float alpha = EXP2(mloc - mnew);
    float rsum = 0.f;
#pragma unroll
    for (int kb = 0; kb < 4; ++kb)
#pragma unroll
      for (int j = 0; j < 4; ++j) { const float pv = EXP2(s[rb][kb][j] - mnew); s[rb][kb][j] = pv; rsum += pv; }
    if (rb) { l1 = l1 * alpha + rsum; m1 = mnew + tconst; } else { l0 = l0 * alpha + rsum; m0 = mnew + tconst; }
    if (__any(alpha != 1.f)) {
#pragma unroll
      for (int eb = 0; eb < 8; ++eb) o[rb][eb] *= alpha;
    }
#pragma unroll
    for (int kp = 0; kp < 2; ++kp) {
      const f32x4 sa = s[rb][2 * kp], sc = s[rb][2 * kp + 1];
      const u32x4 pbu = {pk2(sa[0], sa[1]), pk2(sa[2], sa[3]), pk2(sc[0], sc[1]), pk2(sc[2], sc[3])};
      pfr[rb][kp] = __builtin_bit_cast(bf16x8, pbu);
    }
  }
}

DI void diff_item(const Params& p, int l, int b, int h, int pi, float lam, float lam_init, LAS unsigned char* lds) {
  const int tid = opaque_tid(), w = __builtin_amdgcn_readfirstlane(tid >> 6), lane = tid & 63, fr = lane & 15, fq = lane >> 4;
  const int c = w & 1, rgq = w >> 1, qc = 2 * pi + (rgq >> 1);
  const bool active = qc <= 32;
  const int ktmax = min(2 * pi + 1, 32);
  const int sub16 = lds_byte(fr, fq * 8), sub8a = lds_byte(fr, fq * 4), sub8b = lds_byte(fr, fq * 4 + 16);
  const bf16_t* projb = p.proj + (size_t)b * LROW * NIN;
  const int qrow = qc * 64 + (rgq & 1) * 32 + fr;
  bf16x8 qf[2][2];
#pragma unroll
  for (int rb = 0; rb < 2; ++rb)
#pragma unroll
    for (int ks = 0; ks < 2; ++ks)
      qf[rb][ks] = active ? *(const bf16x8*)(projb + (size_t)(qrow + rb * 16) * NIN + 4096 + h * 128 + c * 64 + ks * 32 + fq * 8) : (bf16x8){0, 0, 0, 0, 0, 0, 0, 0};
  float m0 = -INFINITY, m1 = -INFINITY, l0 = 0.f, l1 = 0.f;
  f32x4 o[2][8];
#pragma unroll
  for (int rb = 0; rb < 2; ++rb)
#pragma unroll
    for (int eb = 0; eb < 8; ++eb) o[rb][eb] = (f32x4){0.f, 0.f, 0.f, 0.f};
  const float slope2 = exp2f(-(float)(h + 1)) * LOG2E;
  f32x4 cj[4];
#pragma unroll
  for (int kb = 0; kb < 4; ++kb)
#pragma unroll
    for (int j = 0; j < 4; ++j) cj[kb][j] = slope2 * (float)(kb * 16 + fq * 4 + j);
  const int kkey = ((tid >> 5) & 15) * 2 + ((tid >> 2) & 1), cd = ((tid >> 4) & 1) * 64 + ((tid >> 3) & 1) * 32 + (tid & 3) * 8;
  const int ve = ((tid >> 4) & 31) * 2 + ((tid >> 2) & 1), vk0 = ((tid >> 3) & 1) * 32 + (tid & 3) * 8;
  const int fillK = (cd >> 6) * 8192 + lds_byte(kkey, cd & 63);
  const int fillV = 32768 + lds_byte(ve, vk0);
  const bf16_t* gk = projb + (size_t)kkey * NIN + 5120 + h * 128 + cd;
  const bf16_t* gv = p.T + (size_t)b * 3072 * LROW + (size_t)(2048 + h * 128 + ve) * LROW + vk0;
  u32x4 pk0, pk1, pv0, pv1;
#define DIFF_GLOAD(kt) do { const bf16_t* _k = gk + (size_t)(kt) * 64 * NIN; const bf16_t* _v = gv + (kt) * 64; \
    pk0 = *(const u32x4*)_k; pk1 = *(const u32x4*)(_k + (size_t)32 * NIN); pv0 = *(const u32x4*)_v; pv1 = *(const u32x4*)(_v + (size_t)64 * LROW); } while (0)
#define DIFF_FILL(kb_, vs_) do { *(LAS u32x4*)(lds + (kb_) + fillK) = pk0; *(LAS u32x4*)(lds + (kb_) + fillK + 4096) = pk1; \
    *(LAS u32x4*)(lds + (vs_) + fillV) = pv0; *(LAS u32x4*)(lds + (vs_) + fillV + 8192) = pv1; } while (0)
  DIFF_GLOAD(0);
  DIFF_FILL(0, 0);
  __syncthreads();
  if (ktmax >= 1) DIFF_GLOAD(1);
  const int kfb0 = c * 8192 + sub16;
  const bool stag = (w >> 2) != 0;
  bf16x8 pfr[2][2];
  int vs = 0;
  for (int kt = 0; kt <= ktmax; ++kt) {
    const int kb = (kt & 1) * 16384;
    const int vsn = vs == 32768 ? 0 : vs + 16384;
    if (kt + 1 <= ktmax) { DIFF_FILL(16384 - kb, vsn); if (kt + 2 <= ktmax) DIFF_GLOAD(kt + 2); }
    if (active && kt <= qc) {
      if (stag && kt > 0) diff_pv(lds, 32768 + (vs == 0 ? 32768 : vs - 16384), pfr, o, sub16);
      diff_tile(kt == 0 || kt == qc, lds, kfb0 + kb, qf, o, pfr, m0, m1, l0, l1, cj, slope2, kt, qrow, fq);
      if (!stag) diff_pv(lds, 32768 + vs, pfr, o, sub16);
    }
    vs = vsn;
    __syncthreads();
  }
  if (active && stag) { const int lastslot = (qc % 3) * 16384; diff_pv(lds, 32768 + lastslot, pfr, o, sub16); }
#undef DIFF_GLOAD
#undef DIFF_FILL
  l0 += __shfl_xor(l0, 16); l0 += __shfl_xor(l0, 32);
  l1 += __shfl_xor(l1, 16); l1 += __shfl_xor(l1, 32);
  const int xb = 81920 + rgq * 16384 + lane * 4;
  if (c == 1 && active) {
#pragma unroll
    for (int rb = 0; rb < 2; ++rb) {
      const float inv = lam / (rb ? l1 : l0);
#pragma unroll
      for (int eb = 0; eb < 8; ++eb)
#pragma unroll
        for (int j = 0; j < 4; ++j) *(LAS float*)(lds + xb + ((rb * 8 + eb) * 4 + j) * 256) = o[rb][eb][j] * inv;
    }
  }
  if (tid == 0) { unsigned sp = 0; while (xb_ld(p.ctr + 32 + l) < 32u && ++sp < (1u << 22)) __builtin_amdgcn_s_sleep(2); }
  __syncthreads();
  __builtin_amdgcn_fence(__ATOMIC_ACQUIRE, "agent");
  if (c == 0 && active) {
#pragma unroll
    for (int rb = 0; rb < 2; ++rb) {
      const float inv = 1.f / (rb ? l1 : l0);
      float ss = 0.f;
#pragma unroll
      for (int eb = 0; eb < 8; ++eb)
#pragma unroll
        for (int j = 0; j < 4; ++j) { const float d = o[rb][eb][j] * inv - *(const LAS float*)(lds + xb + ((rb * 8 + eb) * 4 + j) * 256); o[rb][eb][j] = d; ss += d * d; }
      ss += __shfl_xor(ss, 16); ss += __shfl_xor(ss, 32);
      const float rn = rsqrtf(ss * (1.f / 128.f) + 1e-6f) * (1.f - lam_init);
      const size_t row = (size_t)b * LROW + qrow + rb * 16;
#pragma unroll
      for (int eb = 0; eb < 8; ++eb) {
        const int e0 = h * 128 + eb * 16 + fq * 4;
        const uint2 gu = *(const uint2*)(p.proj + row * NIN + 7168 + e0);
        const float4 gg = *(const float4*)(p.diff_g + l * 1024 + e0);
        const float y0 = o[rb][eb][0] * rn * gg.x * silu(bflo(gu.x)), y1 = o[rb][eb][1] * rn * gg.y * silu(bfhi(gu.x));
        const float y2 = o[rb][eb][2] * rn * gg.z * silu(bflo(gu.y)), y3 = o[rb][eb][3] * rn * gg.w * silu(bfhi(gu.y));
        uint2 ov; ov.x = pk2(y0, y1); ov.y = pk2(y2, y3);
        *(uint2*)(p.mix + row * DM + 1024 + e0) = ov;
      }
    }
  }
}

DI void mixer_phase(const Params& p, int l, LAS unsigned char* lds) {
  volatile LAS int* s_item = (volatile LAS int*)(lds + 147456);
  const float lam = p.lam[l];
  const float lam_init = 0.8f - 0.6f * expf(-0.3f * (float)l);
  for (int c = (int)blockIdx.x - 32; c >= 0 && c < 32; c += (int)gridDim.x) ret_scan_chain(p, c >> 3, c & 7, lds, p.ctr + 34 + l);
  const int xcd = blockIdx.x & 7;
  for (;;) {
    if (threadIdx.x == 0) *s_item = (int)atomicAdd(p.ctr + l * 8 + xcd, 1u);
    __syncthreads();
    const int it = *s_item;
    __syncthreads();
    if (it >= 68 + 22) break;
    if (it < 48 || it >= 70) {
      const int ai = it < 48 ? it : it - 22;
      const int bh = 4 * xcd + (ai & 3);
      diff_item(p, l, bh >> 3, bh & 7, 16 - (ai >> 2), lam, lam_init, lds);
    } else {
      if (threadIdx.x == 0) { unsigned sp = 0; while ((xb_ld(p.ctr + 34 + l) < 32u || xb_ld(p.ctr + 32 + l) < 32u) && ++sp < (1u << 22)) __builtin_amdgcn_s_sleep(2); }
      __syncthreads();
      __builtin_amdgcn_fence(__ATOMIC_ACQUIRE, "agent");
      retention_items(p, l, lds, xcd + 48 * (it - 48), 8, 6);
      __syncthreads();
    }
  }
}

__global__ void __launch_bounds__(512) hymba_megakernel(Params p_unused) {
  cg::grid_group grid = cg::this_grid();
  extern __shared__ __attribute__((aligned(16))) char smem[];
  LAS unsigned char* lds = (LAS unsigned char*)smem;
  volatile LAS unsigned* xst = (volatile LAS unsigned*)(lds + 147456 + 16);
  if (threadIdx.x == 0) { xst[0] = 0u; xst[1] = 0u; }
  __syncthreads();
  XcdBarrier xb;
  { const Params p = load_params(); xb = xcd_barrier_post(p.bar, xst); }
  { const Params p = load_params(); prep_weights(p, lds, 0, 1792, blockIdx.x, gridDim.x, true); }
  { const Params p = load_params(); rownorm<0>(p); }
  grid.sync();
  for (int l = 0; l < 2; ++l) {
    { const Params p = load_params(); gemm1_phase(p, l, lds, 0, 1024); }
    xcd_barrier(xb);
    if (blockIdx.x < 32) {
      const Params p = load_params();
      gemm1_phase(p, l, lds, 1024, 1056);
      if (threadIdx.x == 0) {
        int nl = 0; for (int U = 1024 + (int)blockIdx.x; U < 1056; U += (int)gridDim.x) ++nl;
        __builtin_amdgcn_fence(__ATOMIC_RELEASE, "agent");
        asm volatile("s_waitcnt vmcnt(0)" ::: "memory");
        xb_add(p.ctr + 32 + l, (unsigned)nl);
      }
    }
    { const Params p = load_params(); mixer_phase(p, l, lds); }
    xcd_barrier(xb);
    { const Params p = load_params(); gemm2_phase(p, l, lds); }
    if (l == 0) { const Params p = load_params(); if (gridDim.x > 64) { if (blockIdx.x >= 64) prep_weights(p, lds, 1792, 2560, blockIdx.x - 64, gridDim.x - 64, false); } else prep_weights(p, lds, 1792, 2560, blockIdx.x, gridDim.x, false); }
    xcd_barrier(xb);
    if (l == 0) { { const Params p = load_params(); rownorm<1>(p); } xcd_barrier(xb); }
    else { const Params p = load_params(); rownorm<2>(p); }
  }
}

extern "C" void kernel_launch(void* const* d_in, const int* in_sizes, int n_in, void* d_out, int out_size, void* d_ws, size_t ws_size, hipStream_t stream) {
  static int grid_blocks = 0;
  if (!grid_blocks) {
    int dev = 0, cus = 0, per_cu = 0;
    hipGetDevice(&dev);
    hipDeviceGetAttribute(&cus, hipDeviceAttributeMultiprocessorCount, dev);
    hipFuncSetAttribute((const void*)hymba_megakernel, hipFuncAttributeMaxDynamicSharedMemorySize, SMEM_BYTES);
    hipOccupancyMaxActiveBlocksPerMultiprocessor(&per_cu, hymba_megakernel, 512, SMEM_BYTES);
    if (per_cu < 1) per_cu = 1;
    if (per_cu > 1) per_cu = 1;
    grid_blocks = cus * per_cu;
  }
  Params p{};
  p.x = (const float*)d_in[0]; p.meta = (const float*)d_in[1]; p.norm_g = (const float*)d_in[2]; p.w_in = (const float*)d_in[3];
  p.w_out = (const float*)d_in[4]; p.ret_g = (const float*)d_in[5]; p.diff_g = (const float*)d_in[6];
  p.lq1 = (const float*)d_in[7]; p.lk1 = (const float*)d_in[8]; p.lq2 = (const float*)d_in[9]; p.lk2 = (const float*)d_in[10];
  p.fin_g = (const float*)d_in[11];
  p.out = (float*)d_out;
  char* ws = (char*)d_ws; size_t off = 0;
  auto take = [&](size_t bytes) { char* r = ws + off; off += (bytes + 255) & ~(size_t)255; return r; };
  p.ctr = (unsigned*)take(256);
  p.bar = (unsigned*)take((size_t)XCD_BAR_WORDS * 4);
  p.ss = (float*)take((size_t)2 * MROWS * 4);
  p.lam = (float*)take(256);
  p.WinT = (bf16_t*)take((size_t)2 * NIN * DM * 2);
  p.WoutT = (bf16_t*)take((size_t)2 * DM * DM * 2);
  p.h = (float*)take((size_t)MROWS * DM * 4);
  p.hb = (bf16_t*)take((size_t)MROWS * DM * 2);
  p.proj = (bf16_t*)take((size_t)MROWS * NIN * 2);
  p.T = (bf16_t*)take((size_t)4 * 3072 * LROW * 2);
  p.mix = (bf16_t*)take((size_t)MROWS * DM * 2);
  p.ST = (bf16_t*)take((size_t)32 * NCH * 32768);
  p.P2 = (float*)take((size_t)8 * 256 * DM * 4);
  hipMemsetAsync(p.ctr, 0, 256 + (size_t)XCD_BAR_WORDS * 4 + (size_t)2 * MROWS * 4, stream);
  void* args[] = {&p};
  hipError_t e = hipLaunchCooperativeKernel((void*)hymba_megakernel, dim3(grid_blocks), dim3(512), args, SMEM_BYTES, stream);
  if (e != hipSuccess) fprintf(stderr, "cooperative launch failed: %s (grid %d)\n", hipGetErrorString(e), grid_blocks);
}
```

```cpp
#include <hip/hip_runtime.h>
#include <hip/hip_cooperative_groups.h>
#include <cstdio>
namespace cg = cooperative_groups;

typedef unsigned short bf16_t;
typedef short bf16x8 __attribute__((ext_vector_type(8)));
typedef short s16x4 __attribute__((ext_vector_type(4)));
typedef float f32x4 __attribute__((ext_vector_type(4)));
typedef float f32x2 __attribute__((ext_vector_type(2)));
typedef unsigned u32x4 __attribute__((ext_vector_type(4)));
typedef unsigned u32x2 __attribute__((ext_vector_type(2)));
typedef __bf16 bf16x2_t __attribute__((ext_vector_type(2)));
#define DI __device__ __forceinline__
#define LAS __attribute__((address_space(3)))
#define MFMA16(a, b, c) __builtin_amdgcn_mfma_f32_16x16x32_bf16((a), (b), (c), 0, 0, 0)

constexpr int LROW = 2112;
constexpr int MROWS = 4 * LROW;
constexpr int DM = 2048;
constexpr int NIN = 8192;
constexpr int NCH = 33;
constexpr float LOG2E = 1.4426950408889634f;
constexpr int SMEM_BYTES = 147456 + 64;

struct Params {
  const float *x, *meta, *norm_g, *w_in, *w_out, *ret_g, *diff_g, *lq1, *lk1, *lq2, *lk2, *fin_g;
  float* out;
  bf16_t *WinT, *WoutT, *hb, *proj, *T, *mix, *ST;
  float *h, *ss, *lam, *P2;
  unsigned* ctr;
  unsigned* bar;
};

DI Params load_params() {
  const Params __attribute__((address_space(4)))* q = (const Params __attribute__((address_space(4)))*)__builtin_amdgcn_kernarg_segment_ptr();
  asm volatile("" : "+s"(q));
  Params r; __builtin_memcpy(&r, (const void*)q, sizeof(Params)); return r;
}
DI unsigned pk2(float a, float b) { f32x2 v = {a, b}; bf16x2_t r = __builtin_convertvector(v, bf16x2_t); return __builtin_bit_cast(unsigned, r); }
DI float bf2f(unsigned v16) { return __uint_as_float(v16 << 16); }
DI float bflo(unsigned u) { return __uint_as_float(u << 16); }
DI float bfhi(unsigned u) { return __uint_as_float(u & 0xffff0000u); }
DI int opaque_tid() { int t = threadIdx.x; asm volatile("" : "+v"(t)); return t; }
#define EXP2(x) __builtin_amdgcn_exp2f(x)
DI float xmax16(float x) { const u32x2 r = __builtin_amdgcn_permlane16_swap(__float_as_uint(x), __float_as_uint(x), false, false); return fmaxf(__uint_as_float(r[0]), __uint_as_float(r[1])); }
DI float xmax32(float x) { const u32x2 r = __builtin_amdgcn_permlane32_swap(__float_as_uint(x), __float_as_uint(x), false, false); return fmaxf(__uint_as_float(r[0]), __uint_as_float(r[1])); }
DI float silu(float v) { return v * __builtin_amdgcn_rcpf(1.f + __expf(-v)); }

DI int lds_byte(int r, int c) { int st = (r >> 4) * 2 + (c >> 5), rr = r & 15, cc = c & 31, ob = rr * 64 + cc * 2; return st * 1024 + (ob ^ (((ob >> 9) & 1) << 5)); }
DI int perm32(int rho) { const int n = rho >> 4, i = rho & 15; return 8 * (i >> 2) + 4 * n + (i & 3); }
DI void stage_rc(int b, int& R, int& C) { int st = b / 1024, sb = b % 1024, swz = sb ^ (((sb >> 9) & 1) << 5); R = (st >> 1) * 16 + swz / 64; C = (st & 1) * 32 + (swz % 64) / 2; }

DI void prep_weights(const Params& p, LAS unsigned char* lds, int ubeg, int uend, int wgi, int wgn, bool do_lam) {
  const int tid = opaque_tid();
  const int NTOT = uend;
  const int lrow = tid >> 6, c4 = (tid & 63) * 4;
  f32x4 r[8];
#define PREP_DECODE(u) const float* src; bf16_t* dst; int N; const float* g; int kt, ntile; \
    { const int _l = (u) >= 1280 ? 1 : 0, _v = (u) - _l * 1280; \
      if (_v < 1024) { kt = _v >> 5; ntile = _v & 31; src = p.w_in + (size_t)_l * DM * NIN; dst = p.WinT + (size_t)_l * NIN * DM; N = NIN; g = p.norm_g + _l * DM; } \
      else { const int q = _v - 1024; kt = q >> 3; ntile = q & 7; src = p.w_out + (size_t)_l * DM * DM; dst = p.WoutT + (size_t)_l * DM * DM; N = DM; g = nullptr; } } \
    const int k0 = kt * 64, n0 = ntile * 256;
#define PREP_LOAD(u) do { PREP_DECODE(u) (void)dst; _Pragma("unroll") for (int i = 0; i < 8; ++i) { const int kk = lrow + 8 * i; \
    const f32x4 v = *(const f32x4*)(src + (size_t)(k0 + kk) * N + n0 + c4); const float gg = g ? g[k0 + kk] : 1.f; r[i] = v * gg; } } while (0)
  int u = ubeg + wgi;
  if (u < NTOT) PREP_LOAD(u);
  for (; u < NTOT; u += wgn) {
#pragma unroll
    for (int i = 0; i < 8; ++i) *(LAS f32x4*)(lds + ((lrow + 8 * i) * 260 + c4) * 4) = r[i];
    __syncthreads();
    const int un = u + wgn;
    if (un < NTOT) PREP_LOAD(un);
    {
      PREP_DECODE(u) (void)src; (void)N; (void)g;
      const int n = tid >> 1, kh = (tid & 1) * 32;
      bf16_t* op = dst + (size_t)(n0 + n) * DM + k0 + kh;
#pragma unroll
      for (int q = 0; q < 4; ++q) {
        float f[8];
#pragma unroll
        for (int j = 0; j < 8; ++j) f[j] = *(const LAS float*)(lds + ((kh + q * 8 + j) * 260 + n) * 4);
        const u32x4 o = {pk2(f[0], f[1]), pk2(f[2], f[3]), pk2(f[4], f[5]), pk2(f[6], f[7])};
        *(u32x4*)(op + q * 8) = o;
      }
    }
    __syncthreads();
  }
#undef PREP_DECODE
#undef PREP_LOAD
  if (do_lam && blockIdx.x == 0 && tid < 64) {
    for (int l = 0; l < 2; ++l) {
      float a = p.lq1[l * 64 + tid] * p.lk1[l * 64 + tid], b = p.lq2[l * 64 + tid] * p.lk2[l * 64 + tid];
#pragma unroll
      for (int off = 32; off >= 1; off >>= 1) { a += __shfl_xor(a, off); b += __shfl_xor(b, off); }
      float li = 0.8f - 0.6f * expf(-0.3f * (float)l);
      if (tid == 0) p.lam[l] = expf(a) - expf(b) + li;
    }
  }
}

template <int MODE> DI void rownorm(const Params& p) {
  const int tid = opaque_tid(); const int wave = tid >> 6, lane = tid & 63;
  const int nw = gridDim.x * 8;
  for (int row = (MODE == 1 ? 8192 : 0) + blockIdx.x * 8 + wave; row < MROWS; row += nw) {
    const int b = row / LROW, pos = row - b * LROW;
    if (MODE == 2 && pos < 64) continue;
    const float* src;
    if (MODE <= 1) src = pos < 48 ? nullptr : (pos < 64 ? p.meta + (size_t)(pos - 48) * DM : p.x + ((size_t)b * 2048 + (pos - 64)) * DM);
    else src = p.h + (size_t)row * DM;
    float4 v[8]; float ss = 0.f;
#pragma unroll
    for (int i = 0; i < 8; ++i) {
      v[i] = src ? *(const float4*)(src + i * 256 + lane * 4) : make_float4(0.f, 0.f, 0.f, 0.f);
      if (MODE != 0 && row >= 8192) {
#pragma unroll
        for (int s = 0; s < 8; ++s) { const float4 q = *(const float4*)(p.P2 + ((size_t)s * 256 + (row - 8192)) * DM + i * 256 + lane * 4); v[i].x += q.x; v[i].y += q.y; v[i].z += q.z; v[i].w += q.w; }
      }
      ss += v[i].x * v[i].x + v[i].y * v[i].y + v[i].z * v[i].z + v[i].w * v[i].w;
    }
#pragma unroll
    for (int off = 32; off >= 1; off >>= 1) ss += __shfl_xor(ss, off);
    const float rs = rsqrtf(ss * (1.f / 2048.f) + 1e-6f);
    if (MODE < 2) {
#pragma unroll
      for (int i = 0; i < 8; ++i) {
        if (MODE == 1) *(float4*)(p.h + (size_t)row * DM + i * 256 + lane * 4) = v[i];
        uint2 o; o.x = pk2(v[i].x, v[i].y); o.y = pk2(v[i].z, v[i].w);
        *(uint2*)(p.hb + (size_t)row * DM + i * 256 + lane * 4) = o;
      }
      if (lane == 0) p.ss[(MODE == 0 ? 0 : 1) * MROWS + row] = ss;
    } else {
      float* dst = p.out + ((size_t)b * 2048 + (pos - 64)) * DM;
#pragma unroll
      for (int i = 0; i < 8; ++i) {
        float4 g = *(const float4*)(p.fin_g + i * 256 + lane * 4);
        float4 o; o.x = v[i].x * rs * g.x; o.y = v[i].y * rs * g.y; o.z = v[i].z * rs * g.z; o.w = v[i].w * rs * g.w;
        *(float4*)(dst + i * 256 + lane * 4) = o;
      }
    }
  }
}

constexpr int GK = 2048, GBK = 64, GHALF = 128, GHTB = GHALF * GBK * 2;
constexpr size_t TSTEP = (size_t)256 * GK * 2;
struct Unit { int mt, nt, tr, k0, nkt, nb; };

template <class Epi, class Sched>
DI void gemm_phase(LAS unsigned char* lds, const Sched& S, const Epi& E) {
  const int tid = opaque_tid(), wid = __builtin_amdgcn_readfirstlane(tid >> 6), lane = tid & 63, wr = wid >> 2, wc = wid & 3, fr = lane & 15, fq = lane >> 4;
  constexpr int K = GK;
  unsigned voffA[2], dperm;
#pragma unroll
  for (int i = 0; i < 2; ++i) { int R, C; stage_rc(tid * 16 + i * 8192, R, C); voffA[i] = (unsigned)(R * K + C) * 2u;
    if (i == 0) dperm = (unsigned)((perm32(R & 31) - (R & 31)) * K * 2); }
  const size_t kstep = (size_t)(GBK * 2);
  const size_t hstep = (size_t)GHALF * K * 2;
  const unsigned ldsw = (unsigned)wid * 1024u;
  const int aoff = lds_byte(wr * 64 + fr, fq * 8), boff = lds_byte(wc * 32 + fr, fq * 8);
#define G_SA(b, h) (((b) * 2 + (h)) * GHTB)
#define G_SB(b, h) ((4 + (b) * 2 + (h)) * GHTB)
#define G_STAGE(bufoff, gbase, voff) do { _Pragma("unroll") for (int _i = 0; _i < 2; ++_i) \
    __builtin_amdgcn_global_load_lds((const unsigned*)((const char*)(gbase) + voff[_i]), (LAS unsigned*)(lds + (bufoff) + ldsw + _i * 8192), 16, 0, 0); } while (0)
#define G_LDA(dst, b, h) do { _Pragma("unroll") for (int m = 0; m < 4; ++m) _Pragma("unroll") for (int k = 0; k < 2; ++k) dst[m][k] = *(const LAS bf16x8*)(lds + G_SA(b, h) + aoff + m * 2048 + k * 1024); } while (0)
#define G_LDB(dst, b, h) do { _Pragma("unroll") for (int n = 0; n < 2; ++n) _Pragma("unroll") for (int k = 0; k < 2; ++k) dst[n][k] = *(const LAS bf16x8*)(lds + G_SB(b, h) + boff + n * 2048 + k * 1024); } while (0)
#define G_MMA(ai, bj, At, Bx) do { __builtin_amdgcn_s_setprio(1); _Pragma("unroll") for (int m = 0; m < 4; ++m) _Pragma("unroll") for (int n = 0; n < 2; ++n) _Pragma("unroll") for (int k = 0; k < 2; ++k) \
    acc[ai][bj][m][n] = MFMA16(Bx[n][k], At[m][k], acc[ai][bj][m][n]); __builtin_amdgcn_s_setprio(0); } while (0)
#define G_WAIT_V(n) asm volatile("s_waitcnt vmcnt(" #n ")" ::: "memory")
#define G_WAIT_L(n) asm volatile("s_waitcnt lgkmcnt(" #n ")" ::: "memory")
#define G_BAR __builtin_amdgcn_s_barrier()
#define G_SCHED __builtin_amdgcn_sched_barrier(0)
  Unit cur, nxt; int ui = 0;
  if (!S.next(0, cur)) return;
  f32x4 acc[2][2][4][2];
  E.init(acc, cur, wr, wc, fr, fq, lds, 0);
  bf16x8 At[4][2], B0[2][2], B1[2][2];
  const char* cA = S.pa(cur); const char* cB = S.pb(cur);
  { const unsigned ds0 = cur.nb ? 0u : dperm; const unsigned vb[2] = {voffA[0] + ds0, voffA[1] + ds0};
  G_STAGE(G_SB(0, 0), cB, vb); G_STAGE(G_SA(0, 0), cA, voffA); G_STAGE(G_SB(0, 1), cB + hstep, vb); G_STAGE(G_SA(0, 1), cA + hstep, voffA);
  if (wr == 1) G_BAR;
  G_WAIT_V(4); G_BAR;
  G_STAGE(G_SB(1, 0), cB + kstep, vb); G_STAGE(G_SA(1, 0), cA + kstep, voffA); G_STAGE(G_SB(1, 1), cB + hstep + kstep, vb); }
  G_WAIT_V(6); G_BAR;
  for (;;) {
    const bool has_next = S.next(ui + 1, nxt);
    if (!has_next) nxt = cur;
    const char* nA = has_next ? S.pa(nxt) : cA; const char* nB = has_next ? S.pb(nxt) : cB;
    const int nt = cur.nkt;
    for (int t = 0; t < nt; t += 2) {
      const bool last = (t == nt - 2);
      const char* a1 = cA + (size_t)(t + 1) * kstep;
      const char* a2 = last ? nA : cA + (size_t)(t + 2) * kstep; const char* b2 = last ? nB : cB + (size_t)(t + 2) * kstep;
      const char* a3 = a2 + kstep; const char* b3 = b2 + kstep;
      const bool nbs = last ? (nxt.nb != 0) : (cur.nb != 0);
      const unsigned ds = nbs ? 0u : dperm; const unsigned vb[2] = {voffA[0] + ds, voffA[1] + ds};
      G_LDB(B0, 0, 0); G_SCHED; G_LDA(At, 0, 0); G_STAGE(G_SA(1, 1), a1 + hstep, voffA);
      G_WAIT_L(8); G_BAR; G_WAIT_L(0); G_MMA(0, 0, At, B0); G_BAR; G_SCHED;
      G_LDB(B1, 0, 1); G_STAGE(G_SB(0, 0), b2, vb);
      G_BAR; G_WAIT_L(0); G_MMA(0, 1, At, B1); G_BAR;
      G_LDA(At, 0, 1); G_STAGE(G_SA(0, 0), a2, voffA);
      G_BAR; G_WAIT_L(0); G_MMA(1, 0, At, B0); G_BAR; G_SCHED;
      G_STAGE(G_SB(0, 1), b2 + hstep, vb);
      G_WAIT_V(6); G_BAR; G_MMA(1, 1, At, B1); G_BAR;
      G_LDB(B0, 1, 0); G_SCHED; G_LDA(At, 1, 0); G_STAGE(G_SA(0, 1), a2 + hstep, voffA);
      G_WAIT_L(8); G_BAR; G_WAIT_L(0); G_MMA(0, 0, At, B0); G_BAR; G_SCHED;
      G_LDB(B1, 1, 1); G_STAGE(G_SB(1, 0), b3, vb);
      G_BAR; G_WAIT_L(0); G_MMA(0, 1, At, B1); G_BAR;
      G_LDA(At, 1, 1); G_STAGE(G_SA(1, 0), a3, voffA);
      G_BAR; G_WAIT_L(0); G_MMA(1, 0, At, B0); G_BAR; G_SCHED;
      G_STAGE(G_SB(1, 1), b3 + hstep, vb);
      G_WAIT_V(6); G_BAR; G_MMA(1, 1, At, B1); G_BAR;
    }
    { const int t2 = opaque_tid() & 63; E(acc, cur, wr, wc, t2 & 15, t2 >> 4, lds, ui & 1); }
    if (!has_next) break;
    cur = nxt; cA = nA; cB = nB; ++ui;
    { const int t3 = opaque_tid() & 63; E.init(acc, cur, wr, wc, t3 & 15, t3 >> 4, lds, ui & 1); }
  }
  G_WAIT_V(0);
  if (wr == 0) G_BAR;
  G_BAR;
}

#define XB_TMO      128
#define XB_XCNT(j)  (256  + 64 * (j))
#define XB_XSUB(j)  (1280 + 64 * (j))
#define XB_XGEN(j)  (2304 + 64 * (j))
#define XB_TOP      3328
#define XB_TOPGEN   3392
#define XCD_BAR_WORDS 3456
#define XB_SPIN_CAP (1u << 18)
DI unsigned xb_ld(unsigned* p) { return __hip_atomic_load(p, __ATOMIC_RELAXED, __HIP_MEMORY_SCOPE_AGENT); }
DI unsigned xb_add(unsigned* p, unsigned v) { return __hip_atomic_fetch_add(p, v, __ATOMIC_RELAXED, __HIP_MEMORY_SCOPE_AGENT); }
DI unsigned xb_xcc_id() { return (unsigned)__builtin_amdgcn_s_getreg((3 << 11) | 20) & 0xFu; }
#define XB_SPIN(cond, bar) do { unsigned _sp = 0; while (cond) { __builtin_amdgcn_s_sleep(1); \
    if ((++_sp & 255u) == 0u) { if (xb_ld(&(bar)[XB_TMO])) break; if (_sp > XB_SPIN_CAP) { atomicAdd(&(bar)[XB_TMO], 1u); break; } } } } while (0)
struct XcdBarrier { unsigned* bar; unsigned x; volatile LAS unsigned* st; };
DI XcdBarrier xcd_barrier_post(unsigned* bar, volatile LAS unsigned* st) {
  XcdBarrier b; b.bar = bar; b.x = xb_xcc_id(); b.st = st;
  if (threadIdx.x == 0) (void)xb_add(&bar[XB_XCNT(b.x)], 1u);
  return b;
}
DI void xcd_barrier_complete(unsigned* bar, unsigned x, unsigned& nloc, unsigned& nx) {
  const unsigned G = gridDim.x * gridDim.y * gridDim.z;
  unsigned sum, cnt, mine, sp = 0u;
  for (;;) {
    sum = 0u; cnt = 0u; mine = 0u;
#pragma unroll
    for (unsigned j = 0; j < 16; ++j) { const unsigned c = xb_ld(&bar[XB_XCNT(j)]); sum += c; cnt += (c > 0u) ? 1u : 0u; mine = (j == x) ? c : mine; }
    if (sum == G) break;
    __builtin_amdgcn_s_sleep(1);
    if ((++sp & 255u) == 0u) { if (xb_ld(&bar[XB_TMO])) break; if (sp > XB_SPIN_CAP) { atomicAdd(&bar[XB_TMO], 1u); break; } }
  }
  nloc = mine > 0u ? mine : 1u; nx = cnt > 0u ? cnt : 1u;
}
DI void xcd_barrier(const XcdBarrier& b) {
  asm volatile("s_waitcnt vmcnt(0)" ::: "memory");
  __syncthreads();
  if (threadIdx.x == 0) {
    unsigned* bar = b.bar;
    __builtin_amdgcn_s_waitcnt(0);
    unsigned nloc = b.st[0], nx = b.st[1];
    if (nloc == 0u) { xcd_barrier_complete(bar, b.x, nloc, nx); b.st[0] = nloc; b.st[1] = nx; }
    const unsigned old = xb_add(&bar[XB_XSUB(b.x)], 1u);
    const unsigned gen = old / nloc;
    if (old + 1u == (gen + 1u) * nloc) {
      __builtin_amdgcn_fence(__ATOMIC_RELEASE, "agent");
      asm volatile("s_waitcnt vmcnt(0)" ::: "memory");
      const unsigned og = xb_add(&bar[XB_TOP], 1u);
      const unsigned tg = og / nx;
      if (og + 1u == (tg + 1u) * nx) xb_add(&bar[XB_TOPGEN], 1u);
      else XB_SPIN(xb_ld(&bar[XB_TOPGEN]) == tg, bar);
      __builtin_amdgcn_fence(__ATOMIC_ACQUIRE, "agent");
      xb_add(&bar[XB_XGEN(b.x)], 1u);
      asm volatile("s_waitcnt vmcnt(0)" ::: "memory");
    } else {
      XB_SPIN(xb_ld(&bar[XB_XGEN(b.x)]) == gen, bar);
      __builtin_amdgcn_fence(__ATOMIC_ACQUIRE, "agent");
      asm volatile("s_waitcnt vmcnt(0)" ::: "memory");
    }
  }
  __syncthreads();
}

DI void tile_map(int wgid, int nM, int nN, int& pm, int& pn) {
  const int nwg = nM * nN;
  { int q = nwg / 8, r = nwg % 8, xcd = wgid % 8, off = wgid / 8; wgid = (xcd < r ? xcd * (q + 1) : r * (q + 1) + (xcd - r) * q) + off; }
  const int nig = 8 * nN, gid = wgid / nig, fm = gid * 8, gsz = min(nM - fm, 8);
  pm = fm + ((wgid % nig) % gsz); pn = (wgid % nig) / gsz;
}

struct Sched1 {
  const bf16_t* hb; const bf16_t* W; int ubeg, uend;
  DI bool next(int i, Unit& u) const {
    const int U = ubeg + i * (int)gridDim.x + (int)blockIdx.x; if (U >= uend) return false;
    int pm, pn;
    if (U < 928) tile_map(U, 29, 32, pm, pn);
    else if (U < 1024) { const int q = U - 928, c = q % 24; pm = 29 + q / 24; pn = c < 12 ? c : c + 4; }
    else { const int q = U - 1024, g = q & 7; pm = 29 + (q >> 3); pn = g < 4 ? 12 + g : 24 + g; }
    u.mt = pm; u.nt = pn; u.k0 = 0; u.nkt = 32; const int g = pn >> 2; u.tr = (g == 1 || g == 2 || g == 6) ? 1 : 0; u.nb = u.tr; return true;
  }
  DI const char* pa(const Unit& u) const { return u.tr ? (const char*)W + (size_t)u.nt * TSTEP : (const char*)hb + (size_t)u.mt * TSTEP; }
  DI const char* pb(const Unit& u) const { return u.tr ? (const char*)hb + (size_t)u.mt * TSTEP : (const char*)W + (size_t)u.nt * TSTEP; }
};
struct Sched2 {
  const bf16_t* mix; const bf16_t* W;
  DI bool next(int i, Unit& u) const {
    const int U = i * (int)gridDim.x + (int)blockIdx.x; if (U >= 256 + 64) return false;
    if (U < 256) { int pm, pn; tile_map(U, 32, 8, pm, pn); u.mt = pm; u.nt = pn; u.tr = 0; u.k0 = 0; u.nkt = 32; u.nb = 0; }
    else { const int j = U - 256; u.mt = 32; u.nt = j >> 3; u.tr = 1 + (j & 7); u.k0 = (j & 7) * 256; u.nkt = 4; u.nb = 0; }
    return true;
  }
  DI const char* pa(const Unit& u) const { return (const char*)mix + (size_t)u.mt * TSTEP + (size_t)u.k0 * 2; }
  DI const char* pb(const Unit& u) const { return (const char*)W + (size_t)u.nt * TSTEP + (size_t)u.k0 * 2; }
};

DI void acc_zero(f32x4 (&acc)[2][2][4][2]) {
#pragma unroll
  for (int a = 0; a < 2; ++a)
#pragma unroll
    for (int b = 0; b < 2; ++b)
#pragma unroll
      for (int m = 0; m < 4; ++m)
#pragma unroll
        for (int n = 0; n < 2; ++n) acc[a][b][m][n] = (f32x4){0.f, 0.f, 0.f, 0.f};
}
struct Epi1 {
  bf16_t* proj; bf16_t* T; const float* ss;
  DI void init(f32x4 (&acc)[2][2][4][2], const Unit& u, int wr, int wc, int fr, int fq, LAS unsigned char* lds, int par) const {
    acc_zero(acc);
    if (wr == 0)
      __builtin_amdgcn_global_load_lds((const unsigned*)(ss + u.mt * 256 + wc * 64 + fq * 16 + fr), (LAS unsigned*)(lds + 131072 + par * 1024 + wc * 256), 4, 0, 0);
  }
  DI void operator()(const f32x4 (&acc)[2][2][4][2], const Unit& u, int wr, int wc, int fr, int fq, LAS unsigned char* lds, int par) const {
    const LAS float* ssl = (const LAS float*)(lds + 131072 + par * 1024);
    const int g = u.nt >> 2;
    if (!u.tr) {
      const float sc = (g == 4) ? 0.125f * LOG2E : 1.f;
      const int n0 = u.nt * 256 + wc * 32 + fq * 8;
#pragma unroll
      for (int ai = 0; ai < 2; ++ai)
#pragma unroll
        for (int mi = 0; mi < 4; ++mi) {
          const int m = u.mt * 256 + ai * 128 + wr * 64 + mi * 16 + fr;
          const float rs = rsqrtf(ssl[ai * 128 + wr * 64 + mi * 16 + fr] * (1.f / 2048.f) + 1e-6f) * sc;
          bf16_t* rowp = proj + (size_t)m * NIN + n0;
#pragma unroll
          for (int bj = 0; bj < 2; ++bj) {
            const f32x4 a = acc[ai][bj][mi][0], c = acc[ai][bj][mi][1];
            const u32x4 o = {pk2(a[0] * rs, a[1] * rs), pk2(a[2] * rs, a[3] * rs), pk2(c[0] * rs, c[1] * rs), pk2(c[2] * rs, c[3] * rs)};
            *(u32x4*)(rowp + bj * 128) = o;
          }
        }
    } else {
      const int tbase = (g == 1 ? 0 : (g == 2 ? 1024 : 2048)) - g * 1024;
#pragma unroll
      for (int bj = 0; bj < 2; ++bj) {
        const int mb = u.mt * 256 + bj * 128 + wc * 32;
        const int b = mb / LROW, posb = mb - b * LROW;
        const f32x4 q0 = *(const LAS f32x4*)(ssl + bj * 128 + wc * 32 + 4 * fq), q1 = *(const LAS f32x4*)(ssl + bj * 128 + wc * 32 + 16 + 4 * fq);
        float rs[8];
#pragma unroll
        for (int j = 0; j < 4; ++j) { rs[j] = rsqrtf(q0[j] * (1.f / 2048.f) + 1e-6f); rs[4 + j] = rsqrtf(q1[j] * (1.f / 2048.f) + 1e-6f); }
        const int p0 = posb + 4 * fq, p1 = p0 + 16;
        if (g == 1) {
#pragma unroll
          for (int j = 0; j < 4; ++j) { rs[j] = (p0 + j >= 48) ? rs[j] * 0.08838834764831845f : 0.f; rs[4 + j] = (p1 + j >= 48) ? rs[4 + j] * 0.08838834764831845f : 0.f; }
        }
#pragma unroll
        for (int ai = 0; ai < 2; ++ai)
#pragma unroll
          for (int mi = 0; mi < 4; ++mi) {
            const int col = u.nt * 256 + ai * 128 + wr * 64 + mi * 16 + fr;
            const f32x4 a = acc[ai][bj][mi][0], c = acc[ai][bj][mi][1];
            float v[8] = {a[0] * rs[0], a[1] * rs[1], a[2] * rs[2], a[3] * rs[3], c[0] * rs[4], c[1] * rs[5], c[2] * rs[6], c[3] * rs[7]};
            if (g == 1) {
              const int hh = (col - 1024) >> 7;
              const float l2g = log2f(1.f - exp2f(-5.f - (float)hh));
              const int z0 = 63 - (p0 & 63), z1 = 63 - (p1 & 63);
#pragma unroll
              for (int j = 0; j < 4; ++j) { v[j] *= exp2f(l2g * (float)(z0 - j)); v[4 + j] *= exp2f(l2g * (float)(z1 - j)); }
            }
            const u32x4 o = {pk2(v[0], v[1]), pk2(v[2], v[3]), pk2(v[4], v[5]), pk2(v[6], v[7])};
            const int trow = (g == 1) ? (col & ~31) + 16 * ((col >> 2) & 1) + 4 * ((col >> 3) & 3) + (col & 3) : col;
            *(u32x4*)(T + ((size_t)(b * 3072 + tbase + trow)) * LROW + posb + 8 * fq) = o;
          }
      }
    }
  }
};
struct Epi2 {
  float* h; float* P2; bf16_t* hb; float* ssn; const float* x; const float* meta;
  DI void init(f32x4 (&acc)[2][2][4][2], const Unit& u, int wr, int wc, int fr, int fq, LAS unsigned char*, int) const {
    if (u.tr) { acc_zero(acc); return; }
    const int n0 = u.nt * 256 + wc * 32 + fq * 8;
#pragma unroll
    for (int ai = 0; ai < 2; ++ai)
#pragma unroll
      for (int mi = 0; mi < 4; ++mi) {
        const int m = u.mt * 256 + ai * 128 + wr * 64 + mi * 16 + fr;
        const float* rowp = h + (size_t)m * DM + n0;
        if (x) { const int b = m / LROW, pos = m - b * LROW; rowp = pos < 48 ? nullptr : (pos < 64 ? meta + (size_t)(pos - 48) * DM : x + ((size_t)b * 2048 + (pos - 64)) * DM) + n0; }
#pragma unroll
        for (int bj = 0; bj < 2; ++bj)
#pragma unroll
          for (int ni = 0; ni < 2; ++ni) acc[ai][bj][mi][ni] = rowp ? *(const f32x4*)(rowp + bj * 128 + ni * 4) : (f32x4){0.f, 0.f, 0.f, 0.f};
      }
  }
  DI void operator()(const f32x4 (&acc)[2][2][4][2], const Unit& u, int wr, int wc, int fr, int fq, LAS unsigned char*, int) const {
    const int n0 = u.nt * 256 + wc * 32 + fq * 8;
#pragma unroll
    for (int ai = 0; ai < 2; ++ai)
#pragma unroll
      for (int mi = 0; mi < 4; ++mi) {
        const int m = u.mt * 256 + ai * 128 + wr * 64 + mi * 16 + fr;
        float* rowp = (u.tr ? P2 + ((size_t)(u.tr - 1) * 256 + (m - 8192)) * DM : h + (size_t)m * DM) + n0;
        float sq = 0.f;
#pragma unroll
        for (int bj = 0; bj < 2; ++bj) {
          const f32x4 a = acc[ai][bj][mi][0], c = acc[ai][bj][mi][1];
          *(f32x4*)(rowp + bj * 128) = a; *(f32x4*)(rowp + bj * 128 + 4) = c;
          if (ssn && !u.tr) {
            sq += a[0] * a[0] + a[1] * a[1] + a[2] * a[2] + a[3] * a[3] + c[0] * c[0] + c[1] * c[1] + c[2] * c[2] + c[3] * c[3];
            const u32x4 o = {pk2(a[0], a[1]), pk2(a[2], a[3]), pk2(c[0], c[1]), pk2(c[2], c[3])};
            *(u32x4*)(hb + (size_t)m * DM + n0 + bj * 128) = o;
          }
        }
        if (ssn && !u.tr) {
          sq += __shfl_xor(sq, 16); sq += __shfl_xor(sq, 32);
          if (fq == 0) unsafeAtomicAdd(ssn + m, sq);
        }
      }
  }
};

DI void gemm1_phase(const Params& p, int l, LAS unsigned char* lds, int ubeg, int uend) {
  Sched1 S{p.hb, p.WinT + (size_t)l * NIN * DM, ubeg, uend}; Epi1 E{p.proj, p.T, p.ss + (size_t)l * MROWS};
  gemm_phase(lds, S, E);
}
DI void gemm2_phase(const Params& p, int l, LAS unsigned char* lds) {
  Sched2 S{p.mix, p.WoutT + (size_t)l * DM * DM}; Epi2 E{p.h, p.P2, p.hb, l == 0 ? p.ss + MROWS : nullptr, l == 0 ? p.x : nullptr, p.meta};
  gemm_phase(lds, S, E);
}

DI void ret_scan_chain(const Params& p, int b, int h, LAS unsigned char* lds, unsigned* done_ctr) {
  constexpr int D = 6;
  const int tid = opaque_tid(), w = __builtin_amdgcn_readfirstlane(tid >> 6), lane = tid & 63, fr = lane & 15, fq = lane >> 4;
  const float l2g = log2f(1.f - exp2f(-5.f - (float)h));
  const float dec64 = exp2f(l2g * 64.f);
  const int sub16 = lds_byte(fr, fq * 8);
  const int frow = ((tid >> 4) & 31) * 2 + ((tid >> 2) & 1), fcol = ((tid >> 3) & 1) * 32 + (tid & 3) * 8;
  const int fillT = lds_byte(frow, fcol);
  const bf16_t* gk = p.T + (size_t)b * 3072 * LROW + (size_t)(h * 128 + frow) * LROW + fcol;
  u32x4* so = (u32x4*)p.ST + ((size_t)((b * 8 + h) * NCH) * 8 + w) * 256 + lane;
  f32x4 st[8];
#pragma unroll
  for (int i = 0; i < 8; ++i) st[i] = (f32x4){0.f, 0.f, 0.f, 0.f};
  u32x4 ring[D][4];
#define SCAN_LOAD(slot, n) do { const bf16_t* _t = gk + (n) * 64; ring[slot][0] = *(const u32x4*)_t; ring[slot][1] = *(const u32x4*)(_t + (size_t)64 * LROW); \
    ring[slot][2] = *(const u32x4*)(_t + (size_t)1024 * LROW); ring[slot][3] = *(const u32x4*)(_t + (size_t)1088 * LROW); } while (0)
#define SCAN_STORE(n) do { _Pragma("unroll") for (int kd = 0; kd < 4; ++kd) { const f32x4 sa = st[2 * kd], sc = st[2 * kd + 1]; \
    const u32x4 bsu = {pk2(sa[0], sa[1]), pk2(sa[2], sa[3]), pk2(sc[0], sc[1]), pk2(sc[2], sc[3])}; so[(size_t)(n) * 2048 + kd * 64] = bsu; } } while (0)
#pragma unroll
  for (int i = 0; i < D; ++i) SCAN_LOAD(i, i);
#pragma unroll
  for (int n = 0; n < NCH - 1; ++n) {
    const int slot = n % D, bo = (n & 1) * 32768;
    *(LAS u32x4*)(lds + bo + fillT) = ring[slot][0]; *(LAS u32x4*)(lds + bo + fillT + 8192) = ring[slot][1];
    *(LAS u32x4*)(lds + bo + 16384 + fillT) = ring[slot][2]; *(LAS u32x4*)(lds + bo + 16384 + fillT + 8192) = ring[slot][3];
    if (n + D < NCH - 1) SCAN_LOAD(slot, n + D);
    __syncthreads();
    SCAN_STORE(n);
    const bf16x8 vf0 = *(const LAS bf16x8*)(lds + bo + 16384 + w * 2048 + sub16), vf1 = *(const LAS bf16x8*)(lds + bo + 16384 + w * 2048 + 1024 + sub16);
#pragma unroll
    for (int db = 0; db < 8; ++db) {
      st[db] *= dec64;
      const bf16x8 a0 = *(const LAS bf16x8*)(lds + bo + sub16 + db * 2048);
      const bf16x8 a1 = *(const LAS bf16x8*)(lds + bo + sub16 + db * 2048 + 1024);
      st[db] = MFMA16(a0, vf0, st[db]); st[db] = MFMA16(a1, vf1, st[db]);
    }
  }
  SCAN_STORE(NCH - 1);
  asm volatile("s_waitcnt vmcnt(0)" ::: "memory");
  __syncthreads();
  if (threadIdx.x == 0) { __builtin_amdgcn_fence(__ATOMIC_RELEASE, "agent"); asm volatile("s_waitcnt vmcnt(0)" ::: "memory"); xb_add(done_ctr, 1u); }
#undef SCAN_LOAD
#undef SCAN_STORE
}

DI void retention_items(const Params& p, int l, LAS unsigned char* lds, int first, int stride, int count) {
  constexpr int QS = 0, KS = 16384, VTS = 49152, PS = 65536, OS = 73728;
  const int tid = opaque_tid(), w = __builtin_amdgcn_readfirstlane(tid >> 6), lane = tid & 63, fr = lane & 15, fq = lane >> 4;
  const int sub16 = lds_byte(fr, fq * 8), sub8a = lds_byte(fr, fq * 4), sub8b = lds_byte(fr, fq * 4 + 16);
  const int tq = ((tid >> 5) & 15) * 2 + ((tid >> 2) & 1), dq = ((tid >> 4) & 1) * 64 + ((tid >> 3) & 1) * 32 + (tid & 3) * 8;
  const int ve = ((tid >> 4) & 31) * 2 + ((tid >> 2) & 1), vs0 = ((tid >> 3) & 1) * 32 + (tid & 3) * 8;
  const int fillQ = (dq >> 6) * 8192 + lds_byte(tq, dq & 63);
  const int fillT = lds_byte(ve, vs0);
  const int sb = w & 3, tb0 = (w >> 2) * 2;
  const int kbase = KS + sb * 2048 + sub16, qbase = QS + tb0 * 2048 + sub16;
  const int pbase = PS + tb0 * 2048 + (sb >> 1) * 1024 + lds_byte(fr, fq * 8 + 4 * (sb & 1));
  const int vbase = VTS + w * 2048 + sub16;
  const int obase = OS + ((fq * 4) * 132 + w * 16 + fr) * 4;
  const int nbase = OS + ((tid >> 3) * 132 + (tid & 7) * 16) * 4;
  u32x4 pq0, pq1, pk0, pk1, pv0, pv1, ns0, ns1, ns2, ns3, ng0, ng1;
#define RET_GLOAD(it) do { const int _bh = (it) / NCH, _n = (it) - _bh * NCH, _b = _bh >> 3, _h = _bh & 7; \
    const bf16_t* _q = p.proj + ((size_t)_b * LROW + _n * 64 + tq) * NIN + _h * 128 + dq; \
    const bf16_t* _tk = p.T + ((size_t)_b * 3072 + _h * 128 + (tid >> 3)) * LROW + _n * 64 + (tid & 7) * 8; \
    const bf16_t* _tv = p.T + ((size_t)_b * 3072 + 1024 + _h * 128 + ve) * LROW + _n * 64 + vs0; \
    pq0 = *(const u32x4*)_q; pq1 = *(const u32x4*)(_q + (size_t)32 * NIN); pk0 = *(const u32x4*)_tk; pk1 = *(const u32x4*)(_tk + (size_t)64 * LROW); \
    pv0 = *(const u32x4*)_tv; pv1 = *(const u32x4*)(_tv + (size_t)64 * LROW); \
    const u32x4* _sp = (const u32x4*)p.ST + ((size_t)(it) * 8 + w) * 256 + lane; ns0 = _sp[0]; ns1 = _sp[64]; ns2 = _sp[128]; ns3 = _sp[192]; \
    const bf16_t* _gp = p.proj + ((size_t)_b * LROW + _n * 64 + (tid >> 3)) * NIN + 3072 + _h * 128 + (tid & 7) * 16; \
    ng0 = *(const u32x4*)_gp; ng1 = *(const u32x4*)(_gp + 8); } while (0)
  int it = first;
  const int iend = first + stride * count;
  if (it < iend) RET_GLOAD(it);
  for (; it < iend; it += stride) {
    const int bh = it / NCH, n = it - bh * NCH, b = bh >> 3, h = bh & 7;
    const float l2g = log2f(1.f - exp2f(-5.f - (float)h));
    *(LAS u32x4*)(lds + QS + fillQ) = pq0; *(LAS u32x4*)(lds + QS + fillQ + 4096) = pq1;
    {
      const int d0 = tid >> 3, s0 = (tid & 7) * 8;
#pragma unroll
      for (int i = 0; i < 2; ++i) {
        const u32x4 kv = i ? pk1 : pk0;
        const int r_ = d0 + 64 * i, d = (r_ & ~31) + 8 * ((r_ >> 2) & 3) + 4 * ((r_ >> 4) & 1) + (r_ & 3), ko = KS + (d >> 6) * 8192;
#pragma unroll
        for (int j = 0; j < 8; ++j) {
          const unsigned wv = kv[j >> 1];
          const int st = (s0 & 32) + 16 * (j >> 2) + 4 * ((s0 >> 3) & 3) + (j & 3);
          *(LAS bf16_t*)(lds + ko + lds_byte(st, d & 63)) = (bf16_t)((j & 1) ? (wv >> 16) : (wv & 0xffffu));
        }
      }
    }
    *(LAS u32x4*)(lds + VTS + fillT) = pv0; *(LAS u32x4*)(lds + VTS + fillT + 8192) = pv1;
    const u32x4 sf0 = ns0, sf1 = ns1, sf2 = ns2, sf3 = ns3, g0 = ng0, g1 = ng1;
    __syncthreads();
    if (it + stride < iend) RET_GLOAD(it + stride);
    const size_t row = (size_t)b * LROW + n * 64 + (tid >> 3);
    {
      f32x4 s0 = {0.f, 0.f, 0.f, 0.f}, s1 = {0.f, 0.f, 0.f, 0.f};
#pragma unroll
      for (int ks = 0; ks < 4; ++ks) {
        const int off = (ks >> 1) * 8192 + (ks & 1) * 1024;
        const bf16x8 a = *(const LAS bf16x8*)(lds + kbase + off);
        const bf16x8 b0 = *(const LAS bf16x8*)(lds + qbase + off);
        const bf16x8 b1 = *(const LAS bf16x8*)(lds + qbase + off + 2048);
        s0 = MFMA16(a, b0, s0); s1 = MFMA16(a, b1, s1);
      }
      const int srow = sb * 16 + fq * 4;
#pragma unroll
      for (int i = 0; i < 2; ++i) {
        const f32x4 sv = i ? s1 : s0;
        const int t = (tb0 + i) * 16 + fr;
        const float v0 = sv[0] * EXP2(l2g * (fabsf((float)(t - srow)) - (float)(63 - srow))), v1 = sv[1] * EXP2(l2g * (fabsf((float)(t - srow - 1)) - (float)(62 - srow)));
        const float v2 = sv[2] * EXP2(l2g * (fabsf((float)(t - srow - 2)) - (float)(61 - srow))), v3 = sv[3] * EXP2(l2g * (fabsf((float)(t - srow - 3)) - (float)(60 - srow)));
        const u32x2 o = {pk2(v0, v1), pk2(v2, v3)};
        *(LAS u32x2*)(lds + pbase + i * 2048) = o;
      }
    }
    __syncthreads();
    {
      const bf16x8 vf0 = *(const LAS bf16x8*)(lds + vbase), vf1 = *(const LAS bf16x8*)(lds + vbase + 1024);
      f32x4 o[4], cr[4];
#pragma unroll
      for (int tb = 0; tb < 4; ++tb) {
        o[tb] = (f32x4){0.f, 0.f, 0.f, 0.f}; cr[tb] = (f32x4){0.f, 0.f, 0.f, 0.f};
        const bf16x8 a0 = *(const LAS bf16x8*)(lds + PS + sub16 + tb * 2048);
        const bf16x8 a1 = *(const LAS bf16x8*)(lds + PS + sub16 + tb * 2048 + 1024);
        o[tb] = MFMA16(a0, vf0, o[tb]); o[tb] = MFMA16(a1, vf1, o[tb]);
      }
#pragma unroll
      for (int kd = 0; kd < 4; ++kd) {
        const bf16x8 bsv = __builtin_bit_cast(bf16x8, kd == 0 ? sf0 : (kd == 1 ? sf1 : (kd == 2 ? sf2 : sf3)));
#pragma unroll
        for (int tb = 0; tb < 4; ++tb) {
          const bf16x8 a = *(const LAS bf16x8*)(lds + QS + (kd >> 1) * 8192 + (tb * 2 + (kd & 1)) * 1024 + sub16);
          cr[tb] = MFMA16(a, bsv, cr[tb]);
        }
      }
#pragma unroll
      for (int tb = 0; tb < 4; ++tb)
#pragma unroll
        for (int j = 0; j < 4; ++j) o[tb][j] += EXP2(l2g * (float)(tb * 16 + fq * 4 + j + 1)) * cr[tb][j];
#pragma unroll
      for (int tb = 0; tb < 4; ++tb)
#pragma unroll
        for (int j = 0; j < 4; ++j) *(LAS float*)(lds + obase + (tb * 16 + j) * 528) = o[tb][j];
    }
    __syncthreads();
    {
      const int seg = tid & 7;
      const f32x4 x0 = *(const LAS f32x4*)(lds + nbase), x1 = *(const LAS f32x4*)(lds + nbase + 16), x2 = *(const LAS f32x4*)(lds + nbase + 32), x3 = *(const LAS f32x4*)(lds + nbase + 48);
      f32x4 xs = x0 + x1 + x2 + x3;
      float sum = xs[0] + xs[1] + xs[2] + xs[3];
      sum += __shfl_xor(sum, 1); sum += __shfl_xor(sum, 2); sum += __shfl_xor(sum, 4);
      const float mu = sum * (1.f / 128.f);
      const f32x4 d0 = x0 - mu, d1 = x1 - mu, d2 = x2 - mu, d3 = x3 - mu;
      const f32x4 q = d0 * d0 + d1 * d1 + d2 * d2 + d3 * d3;
      float vs = q[0] + q[1] + q[2] + q[3];
      vs += __shfl_xor(vs, 1); vs += __shfl_xor(vs, 2); vs += __shfl_xor(vs, 4);
      const float rn = rsqrtf(vs * (1.f / 128.f) + 1e-6f);
      const float* gr = p.ret_g + l * 1024 + h * 128 + seg * 16;
      const f32x4 w0 = *(const f32x4*)gr, w1 = *(const f32x4*)(gr + 4), w2 = *(const f32x4*)(gr + 8), w3 = *(const f32x4*)(gr + 12);
      uint4 oa, ob;
      oa.x = pk2(d0[0] * rn * w0[0] * silu(bflo(g0[0])), d0[1] * rn * w0[1] * silu(bfhi(g0[0])));
      oa.y = pk2(d0[2] * rn * w0[2] * silu(bflo(g0[1])), d0[3] * rn * w0[3] * silu(bfhi(g0[1])));
      oa.z = pk2(d1[0] * rn * w1[0] * silu(bflo(g0[2])), d1[1] * rn * w1[1] * silu(bfhi(g0[2])));
      oa.w = pk2(d1[2] * rn * w1[2] * silu(bflo(g0[3])), d1[3] * rn * w1[3] * silu(bfhi(g0[3])));
      ob.x = pk2(d2[0] * rn * w2[0] * silu(bflo(g1[0])), d2[1] * rn * w2[1] * silu(bfhi(g1[0])));
      ob.y = pk2(d2[2] * rn * w2[2] * silu(bflo(g1[1])), d2[3] * rn * w2[3] * silu(bfhi(g1[1])));
      ob.z = pk2(d3[0] * rn * w3[0] * silu(bflo(g1[2])), d3[1] * rn * w3[1] * silu(bfhi(g1[2])));
      ob.w = pk2(d3[2] * rn * w3[2] * silu(bflo(g1[3])), d3[3] * rn * w3[3] * silu(bfhi(g1[3])));
      bf16_t* mp = p.mix + row * DM + h * 128 + seg * 16;
      *(uint4*)mp = oa; *(uint4*)(mp + 8) = ob;
    }
  }
#undef RET_GLOAD
}

DI void diff_pv(LAS unsigned char* lds, int vgb, const bf16x8 (&pfr)[2][2], f32x4 (&o)[2][8], int sub16) {
  __builtin_amdgcn_s_setprio(1);
#pragma unroll
  for (int eb = 0; eb < 8; ++eb)
#pragma unroll
    for (int kp = 0; kp < 2; ++kp) {
      const bf16x8 a = *(const LAS bf16x8*)(lds + vgb + (eb * 2 + kp) * 1024 + sub16);
      o[0][eb] = MFMA16(a, pfr[0][kp], o[0][eb]);
      o[1][eb] = MFMA16(a, pfr[1][kp], o[1][eb]);
    }
  __builtin_amdgcn_s_setprio(0);
}
DI void diff_tile(bool general, LAS unsigned char* lds, int kfb, const bf16x8 (&qf)[2][2], f32x4 (&o)[2][8], bf16x8 (&pfr)[2][2], float& m0, float& m1, float& l0, float& l1,
                  const f32x4 (&cj)[4], float slope2, int kt, int qrow, int fq) {
  f32x4 s[2][4];
#pragma unroll
  for (int kb = 0; kb < 4; ++kb) {
    const f32x4 init = cj[kb];
    const bf16x8 a0 = *(const LAS bf16x8*)(lds + kfb + (kb * 2) * 1024);
    const bf16x8 a1 = *(const LAS bf16x8*)(lds + kfb + (kb * 2 + 1) * 1024);
    s[0][kb] = MFMA16(a0, qf[0][0], init); s[1][kb] = MFMA16(a0, qf[1][0], init);
    s[0][kb] = MFMA16(a1, qf[0][1], s[0][kb]); s[1][kb] = MFMA16(a1, qf[1][1], s[1][kb]);
  }
  const float tconst = slope2 * (float)(kt * 64);
#pragma unroll
  for (int rb = 0; rb < 2; ++rb) {
    if (general) {
      const int qrel = qrow + rb * 16 - kt * 64;
      const float ms2 = -2.f * slope2;
#pragma unroll
      for (int kb = 0; kb < 4; ++kb)
#pragma unroll
        for (int j = 0; j < 4; ++j) {
          const int kl = kb * 16 + fq * 4 + j;
          float v = s[rb][kb][j] + ms2 * (float)max(kl - qrel, 0);
          if (kt == 0 && kl < 48) v = -INFINITY;
          s[rb][kb][j] = v;
        }
    }
    float mx = fmaxf(fmaxf(s[rb][0][0], s[rb][0][1]), fmaxf(s[rb][0][2], s[rb][0][3]));
#pragma unroll
    for (int kb = 1; kb < 4; ++kb) mx = fmaxf(fmaxf(mx, fmaxf(s[rb][kb][0], s[rb][kb][1])), fmaxf(s[rb][kb][2], s[rb][kb][3]));
    mx = xmax32(xmax16(mx));
    const float mloc = (rb ? m1 : m0) - tconst;
    float mnew = mloc, alpha = 1.f;
    if (!__all(mx <= mloc + 8.f)) {
      mnew = fmaxf(mloc, mx); alpha = EXP2(mloc - mnew);
#pragma unroll
      for (int eb = 0; eb < 8; ++eb) o[rb][eb] *= alpha;
    }
    float rsum = 0.f;
#pragma unroll
    for (int kb = 0; kb < 4; ++kb)
#pragma unroll
      for (int j = 0; j < 4; ++j) { const float pv = EXP2(s[rb][kb][j] - mnew); s[rb][kb][j] = pv; rsum += pv; }
    if (rb) { l1 = l1 * alpha + rsum; m1 = mnew + tconst; } else { l0 = l0 * alpha + rsum; m0 = mnew + tconst; }
#pragma unroll
    for (int kp = 0; kp < 2; ++kp) {
      const f32x4 sa = s[rb][2 * kp], sc = s[rb][2 * kp + 1];
      const u32x4 pbu = {pk2(sa[0], sa[1]), pk2(sa[2], sa[3]), pk2(sc[0], sc[1]), pk2(sc[2], sc[3])};
      pfr[rb][kp] = __builtin_bit_cast(bf16x8, pbu);
    }
  }
}

DI void diff_item(const Params& p, int l, int b, int h, int pi, float lam, float lam_init, LAS unsigned char* lds) {
  const int tid = opaque_tid(), w = __builtin_amdgcn_readfirstlane(tid >> 6), lane = tid & 63, fr = lane & 15, fq = lane >> 4;
  const int c = w & 1, rgq = w >> 1, qc = 2 * pi + (rgq >> 1);
  const bool active = qc <= 32;
  const int ktmax = min(2 * pi + 1, 32);
  const int sub16 = lds_byte(fr, fq * 8), sub8a = lds_byte(fr, fq * 4), sub8b = lds_byte(fr, fq * 4 + 16);
  const bf16_t* projb = p.proj + (size_t)b * LROW * NIN;
  const int qrow = qc * 64 + (rgq & 1) * 32 + fr;
  bf16x8 qf[2][2];
#pragma unroll
  for (int rb = 0; rb < 2; ++rb)
#pragma unroll
    for (int ks = 0; ks < 2; ++ks)
      qf[rb][ks] = active ? *(const bf16x8*)(projb + (size_t)(qrow + rb * 16) * NIN + 4096 + h * 128 + c * 64 + ks * 32 + fq * 8) : (bf16x8){0, 0, 0, 0, 0, 0, 0, 0};
  float m0 = -INFINITY, m1 = -INFINITY, l0 = 0.f, l1 = 0.f;
  f32x4 o[2][8];
#pragma unroll
  for (int rb = 0; rb < 2; ++rb)
#pragma unroll
    for (int eb = 0; eb < 8; ++eb) o[rb][eb] = (f32x4){0.f, 0.f, 0.f, 0.f};
  const float slope2 = exp2f(-(float)(h + 1)) * LOG2E;
  f32x4 cj[4];
#pragma unroll
  for (int kb = 0; kb < 4; ++kb)
#pragma unroll
    for (int j = 0; j < 4; ++j) cj[kb][j] = slope2 * (float)(kb * 16 + fq * 4 + j);
  const int kkey = ((tid >> 5) & 15) * 2 + ((tid >> 2) & 1), cd = ((tid >> 4) & 1) * 64 + ((tid >> 3) & 1) * 32 + (tid & 3) * 8;
  const int ve = ((tid >> 4) & 31) * 2 + ((tid >> 2) & 1), vk0 = ((tid >> 3) & 1) * 32 + (tid & 3) * 8;
  const int fillK = (cd >> 6) * 8192 + lds_byte(kkey, cd & 63);
  const int fillV = 32768 + lds_byte(ve, vk0);
  const bf16_t* gk = projb + (size_t)kkey * NIN + 5120 + h * 128 + cd;
  const bf16_t* gv = p.T + (size_t)b * 3072 * LROW + (size_t)(2048 + h * 128 + ve) * LROW + vk0;
  u32x4 pk0, pk1, pv0, pv1;
#define DIFF_GLOAD(kt) do { const bf16_t* _k = gk + (size_t)(kt) * 64 * NIN; const bf16_t* _v = gv + (kt) * 64; \
    pk0 = *(const u32x4*)_k; pk1 = *(const u32x4*)(_k + (size_t)32 * NIN); pv0 = *(const u32x4*)_v; pv1 = *(const u32x4*)(_v + (size_t)64 * LROW); } while (0)
#define DIFF_FILL(kb_, vs_) do { *(LAS u32x4*)(lds + (kb_) + fillK) = pk0; *(LAS u32x4*)(lds + (kb_) + fillK + 4096) = pk1; \
    *(LAS u32x4*)(lds + (vs_) + fillV) = pv0; *(LAS u32x4*)(lds + (vs_) + fillV + 8192) = pv1; } while (0)
  DIFF_GLOAD(0);
  DIFF_FILL(0, 0);
  __syncthreads();
  if (ktmax >= 1) DIFF_GLOAD(1);
  const int kfb0 = c * 8192 + sub16;
  const bool stag = (w >> 2) != 0;
  bf16x8 pfr[2][2];
  int vs = 0;
  for (int kt = 0; kt <= ktmax; ++kt) {
    const int kb = (kt & 1) * 16384;
    const int vsn = vs == 32768 ? 0 : vs + 16384;
    if (kt + 1 <= ktmax) { DIFF_FILL(16384 - kb, vsn); if (kt + 2 <= ktmax) DIFF_GLOAD(kt + 2); }
    if (active && kt <= qc) {
      if (stag && kt > 0) diff_pv(lds, 32768 + (vs == 0 ? 32768 : vs - 16384), pfr, o, sub16);
      diff_tile(kt == 0 || kt == qc, lds, kfb0 + kb, qf, o, pfr, m0, m1, l0, l1, cj, slope2, kt, qrow, fq);
      if (!stag) diff_pv(lds, 32768 + vs, pfr, o, sub16);
    }
    vs = vsn;
    __syncthreads();
  }
  if (active && stag) { const int lastslot = (qc % 3) * 16384; diff_pv(lds, 32768 + lastslot, pfr, o, sub16); }
#undef DIFF_GLOAD
#undef DIFF_FILL
  l0 += __shfl_xor(l0, 16); l0 += __shfl_xor(l0, 32);
  l1 += __shfl_xor(l1, 16); l1 += __shfl_xor(l1, 32);
  const int xb = 81920 + rgq * 16384 + lane * 4;
  if (c == 1 && active) {
#pragma unroll
    for (int rb = 0; rb < 2; ++rb) {
      const float inv = lam / (rb ? l1 : l0);
#pragma unroll
      for (int eb = 0; eb < 8; ++eb)
#pragma unroll
        for (int j = 0; j < 4; ++j) *(LAS float*)(lds + xb + ((rb * 8 + eb) * 4 + j) * 256) = o[rb][eb][j] * inv;
    }
  }
  if (tid == 0) { unsigned sp = 0; while (xb_ld(p.ctr + 32 + l) < 32u && ++sp < (1u << 22)) __builtin_amdgcn_s_sleep(2); }
  __syncthreads();
  __builtin_amdgcn_fence(__ATOMIC_ACQUIRE, "agent");
  if (c == 0 && active) {
#pragma unroll
    for (int rb = 0; rb < 2; ++rb) {
      const float inv = 1.f / (rb ? l1 : l0);
      float ss = 0.f;
#pragma unroll
      for (int eb = 0; eb < 8; ++eb)
#pragma unroll
        for (int j = 0; j < 4; ++j) { const float d = o[rb][eb][j] * inv - *(const LAS float*)(lds + xb + ((rb * 8 + eb) * 4 + j) * 256); o[rb][eb][j] = d; ss += d * d; }
      ss += __shfl_xor(ss, 16); ss += __shfl_xor(ss, 32);
      const float rn = rsqrtf(ss * (1.f / 128.f) + 1e-6f) * (1.f - lam_init);
      const size_t row = (size_t)b * LROW + qrow + rb * 16;
#pragma unroll
      for (int eb = 0; eb < 8; ++eb) {
        const int e0 = h * 128 + eb * 16 + fq * 4;
        const uint2 gu = *(const uint2*)(p.proj + row * NIN + 7168 + e0);
        const float4 gg = *(const float4*)(p.diff_g + l * 1024 + e0);
        const float y0 = o[rb][eb][0] * rn * gg.x * silu(bflo(gu.x)), y1 = o[rb][eb][1] * rn * gg.y * silu(bfhi(gu.x));
        const float y2 = o[rb][eb][2] * rn * gg.z * silu(bflo(gu.y)), y3 = o[rb][eb][3] * rn * gg.w * silu(bfhi(gu.y));
        uint2 ov; ov.x = pk2(y0, y1); ov.y = pk2(y2, y3);
        *(uint2*)(p.mix + row * DM + 1024 + e0) = ov;
      }
    }
  }
}

DI void mixer_phase(const Params& p, int l, LAS unsigned char* lds) {
  volatile LAS int* s_item = (volatile LAS int*)(lds + 147456);
  const float lam = p.lam[l];
  const float lam_init = 0.8f - 0.6f * expf(-0.3f * (float)l);
  for (int c = (int)blockIdx.x - 32; c >= 0 && c < 32; c += (int)gridDim.x) ret_scan_chain(p, c >> 3, c & 7, lds, p.ctr + 34 + l);
  const int xcd = blockIdx.x & 7;
  for (;;) {
    if (threadIdx.x == 0) *s_item = (int)atomicAdd(p.ctr + l * 8 + xcd, 1u);
    __syncthreads();
    const int it = *s_item;
    __syncthreads();
    if (it >= 68 + 22) break;
    if (it < 48 || it >= 70) {
      const int ai = it < 48 ? it : it - 22;
      const int bh = 4 * xcd + (ai & 3);
      diff_item(p, l, bh >> 3, bh & 7, 16 - (ai >> 2), lam, lam_init, lds);
    } else {
      if (threadIdx.x == 0) { unsigned sp = 0; while ((xb_ld(p.ctr + 34 + l) < 32u || xb_ld(p.ctr + 32 + l) < 32u) && ++sp < (1u << 22)) __builtin_amdgcn_s_sleep(2); }
      __syncthreads();
      __builtin_amdgcn_fence(__ATOMIC_ACQUIRE, "agent");
      retention_items(p, l, lds, xcd + 48 * (it - 48), 8, 6);
      __syncthreads();
    }
  }
}

__global__ void __launch_bounds__(512) hymba_megakernel(Params p_unused) {
  cg::grid_group grid = cg::this_grid();
  extern __shared__ __attribute__((aligned(16))) char smem[];
  LAS unsigned char* lds = (LAS unsigned char*)smem;
  volatile LAS unsigned* xst = (volatile LAS unsigned*)(lds + 147456 + 16);
  if (threadIdx.x == 0) { xst[0] = 0u; xst[1] = 0u; }
  __syncthreads();
  XcdBarrier xb;
  { const Params p = load_params(); xb = xcd_barrier_post(p.bar, xst); }
  { const Params p = load_params(); prep_weights(p, lds, 0, 1792, blockIdx.x, gridDim.x, true); }
  { const Params p = load_params(); rownorm<0>(p); }
  grid.sync();
  for (int l = 0; l < 2; ++l) {
    { const Params p = load_params(); gemm1_phase(p, l, lds, 0, 1024); }
    xcd_barrier(xb);
    if (blockIdx.x < 32) {
      const Params p = load_params();
      gemm1_phase(p, l, lds, 1024, 1056);
      if (threadIdx.x == 0) {
        int nl = 0; for (int U = 1024 + (int)blockIdx.x; U < 1056; U += (int)gridDim.x) ++nl;
        __builtin_amdgcn_fence(__ATOMIC_RELEASE, "agent");
        asm volatile("s_waitcnt vmcnt(0)" ::: "memory");
        xb_add(p.ctr + 32 + l, (unsigned)nl);
      }
    }
    { const Params p = load_params(); mixer_phase(p, l, lds); }
    xcd_barrier(xb);
    { const Params p = load_params(); gemm2_phase(p, l, lds); }
    if (l == 0) { const Params p = load_params(); if (gridDim.x > 64) { if (blockIdx.x >= 64) prep_weights(p, lds, 1792, 2560, blockIdx.x - 64, gridDim.x - 64, false); } else prep_weights(p, lds, 1792, 2560, blockIdx.x, gridDim.x, false); }
    xcd_barrier(xb);
    if (l == 0) { { const Params p = load_params(); rownorm<1>(p); } xcd_barrier(xb); }
    else { const Params p = load_params(); rownorm<2>(p); }
  }
}

extern "C" void kernel_launch(void* const* d_in, const int* in_sizes, int n_in, void* d_out, int out_size, void* d_ws, size_t ws_size, hipStream_t stream) {
  static int grid_blocks = 0;
  if (!grid_blocks) {
    int dev = 0, cus = 0, per_cu = 0;
    hipGetDevice(&dev);
    hipDeviceGetAttribute(&cus, hipDeviceAttributeMultiprocessorCount, dev);
    hipFuncSetAttribute((const void*)hymba_megakernel, hipFuncAttributeMaxDynamicSharedMemorySize, SMEM_BYTES);
    hipOccupancyMaxActiveBlocksPerMultiprocessor(&per_cu, hymba_megakernel, 512, SMEM_BYTES);
    if (per_cu < 1) per_cu = 1;
    if (per_cu > 1) per_cu = 1;
    grid_blocks = cus * per_cu;
  }
  Params p{};
  p.x = (const float*)d_in[0]; p.meta = (const float*)d_in[1]; p.norm_g = (const float*)d_in[2]; p.w_in = (const float*)d_in[3];
  p.w_out = (const float*)d_in[4]; p.ret_g = (const float*)d_in[5]; p.diff_g = (const float*)d_in[6];
  p.lq1 = (const float*)d_in[7]; p.lk1 = (const float*)d_in[8]; p.lq2 = (const float*)d_in[9]; p.lk2 = (const float*)d_in[10];
  p.fin_g = (const float*)d_in[11];
  p.out = (float*)d_out;
  char* ws = (char*)d_ws; size_t off = 0;
  auto take = [&](size_t bytes) { char* r = ws + off; off += (bytes + 255) & ~(size_t)255; return r; };
  p.ctr = (unsigned*)take(256);
  p.bar = (unsigned*)take((size_t)XCD_BAR_WORDS * 4);
  p.ss = (float*)take((size_t)2 * MROWS * 4);
  p.lam = (float*)take(256);
  p.WinT = (bf16_t*)take((size_t)2 * NIN * DM * 2);
  p.WoutT = (bf16_t*)take((size_t)2 * DM * DM * 2);
  p.h = (float*)take((size_t)MROWS * DM * 4);
  p.hb = (bf16_t*)take((size_t)MROWS * DM * 2);
  p.proj = (bf16_t*)take((size_t)MROWS * NIN * 2);
  p.T = (bf16_t*)take((size_t)4 * 3072 * LROW * 2);
  p.mix = (bf16_t*)take((size_t)MROWS * DM * 2);
  p.ST = (bf16_t*)take((size_t)32 * NCH * 32768);
  p.P2 = (float*)take((size_t)8 * 256 * DM * 4);
  hipMemsetAsync(p.ctr, 0, 256 + (size_t)XCD_BAR_WORDS * 4 + (size_t)2 * MROWS * 4, stream);
  void* args[] = {&p};
  hipError_t e = hipLaunchCooperativeKernel((void*)hymba_megakernel, dim3(grid_blocks), dim3(512), args, SMEM_BYTES, stream);
  if (e != hipSuccess) fprintf(stderr, "cooperative launch failed: %s (grid %d)\n", hipGetErrorString(e), grid_blocks);
}
```

```cpp
#include <hip/hip_runtime.h>
#include <hip/hip_cooperative_groups.h>
#include <cstdio>
namespace cg = cooperative_groups;

typedef unsigned short bf16_t;
typedef short bf16x8 __attribute__((ext_vector_type(8)));
typedef short s16x4 __attribute__((ext_vector_type(4)));
typedef float f32x4 __attribute__((ext_vector_type(4)));
typedef float f32x2 __attribute__((ext_vector_type(2)));
typedef unsigned u32x4 __attribute__((ext_vector_type(4)));
typedef unsigned u32x2 __attribute__((ext_vector_type(2)));
typedef __bf16 bf16x2_t __attribute__((ext_vector_type(2)));
#define DI __device__ __forceinline__
#define LAS __attribute__((address_space(3)))
#define MFMA16(a, b, c) __builtin_amdgcn_mfma_f32_16x16x32_bf16((a), (b), (c), 0, 0, 0)

constexpr int LROW = 2112;
constexpr int MROWS = 4 * LROW;
constexpr int DM = 2048;
constexpr int NIN = 8192;
constexpr int NCH = 33;
constexpr float LOG2E = 1.4426950408889634f;
constexpr int SMEM_BYTES = 147456 + 64;

struct Params {
  const float *x, *meta, *norm_g, *w_in, *w_out, *ret_g, *diff_g, *lq1, *lk1, *lq2, *lk2, *fin_g;
  float* out;
  bf16_t *WinT, *WoutT, *hb, *proj, *T, *mix, *ST;
  float *h, *ss, *lam, *P2;
  unsigned* ctr;
  unsigned* bar;
};

DI Params load_params() {
  const Params __attribute__((address_space(4)))* q = (const Params __attribute__((address_space(4)))*)__builtin_amdgcn_kernarg_segment_ptr();
  asm volatile("" : "+s"(q));
  Params r; __builtin_memcpy(&r, (const void*)q, sizeof(Params)); return r;
}
DI unsigned pk2(float a, float b) { f32x2 v = {a, b}; bf16x2_t r = __builtin_convertvector(v, bf16x2_t); return __builtin_bit_cast(unsigned, r); }
DI float bf2f(unsigned v16) { return __uint_as_float(v16 << 16); }
DI float bflo(unsigned u) { return __uint_as_float(u << 16); }
DI float bfhi(unsigned u) { return __uint_as_float(u & 0xffff0000u); }
DI int opaque_tid() { int t = threadIdx.x; asm volatile("" : "+v"(t)); return t; }
#define EXP2(x) __builtin_amdgcn_exp2f(x)
DI float xmax16(float x) { const u32x2 r = __builtin_amdgcn_permlane16_swap(__float_as_uint(x), __float_as_uint(x), false, false); return fmaxf(__uint_as_float(r[0]), __uint_as_float(r[1])); }
DI float xmax32(float x) { const u32x2 r = __builtin_amdgcn_permlane32_swap(__float_as_uint(x), __float_as_uint(x), false, false); return fmaxf(__uint_as_float(r[0]), __uint_as_float(r[1])); }
DI float silu(float v) { return v * __builtin_amdgcn_rcpf(1.f + __expf(-v)); }

DI int lds_byte(int r, int c) { int st = (r >> 4) * 2 + (c >> 5), rr = r & 15, cc = c & 31, ob = rr * 64 + cc * 2; return st * 1024 + (ob ^ (((ob >> 9) & 1) << 5)); }
DI int perm32(int rho) { const int n = rho >> 4, i = rho & 15; return 8 * (i >> 2) + 4 * n + (i & 3); }
DI void stage_rc(int b, int& R, int& C) { int st = b / 1024, sb = b % 1024, swz = sb ^ (((sb >> 9) & 1) << 5); R = (st >> 1) * 16 + swz / 64; C = (st & 1) * 32 + (swz % 64) / 2; }

DI void prep_weights(const Params& p, LAS unsigned char* lds, int ubeg, int uend, int wgi, int wgn, bool do_lam) {
  const int tid = opaque_tid();
  const int NTOT = uend;
  const int lrow = tid >> 6, c4 = (tid & 63) * 4;
  f32x4 r[8];
#define PREP_DECODE(u) const float* src; bf16_t* dst; int N; const float* g; int kt, ntile; \
    { const int _l = (u) >= 1280 ? 1 : 0, _v = (u) - _l * 1280; \
      if (_v < 1024) { kt = _v >> 5; ntile = _v & 31; src = p.w_in + (size_t)_l * DM * NIN; dst = p.WinT + (size_t)_l * NIN * DM; N = NIN; g = p.norm_g + _l * DM; } \
      else { const int q = _v - 1024; kt = q >> 3; ntile = q & 7; src = p.w_out + (size_t)_l * DM * DM; dst = p.WoutT + (size_t)_l * DM * DM; N = DM; g = nullptr; } } \
    const int k0 = kt * 64, n0 = ntile * 256;
#define PREP_LOAD(u) do { PREP_DECODE(u) (void)dst; _Pragma("unroll") for (int i = 0; i < 8; ++i) { const int kk = lrow + 8 * i; \
    const f32x4 v = *(const f32x4*)(src + (size_t)(k0 + kk) * N + n0 + c4); const float gg = g ? g[k0 + kk] : 1.f; r[i] = v * gg; } } while (0)
  int u = ubeg + wgi;
  if (u < NTOT) PREP_LOAD(u);
  for (; u < NTOT; u += wgn) {
#pragma unroll
    for (int i = 0; i < 8; ++i) *(LAS f32x4*)(lds + ((lrow + 8 * i) * 260 + c4) * 4) = r[i];
    __syncthreads();
    const int un = u + wgn;
    if (un < NTOT) PREP_LOAD(un);
    {
      PREP_DECODE(u) (void)src; (void)N; (void)g;
      const int n = tid >> 1, kh = (tid & 1) * 32;
      bf16_t* op = dst + (size_t)(n0 + n) * DM + k0 + kh;
#pragma unroll
      for (int q = 0; q < 4; ++q) {
        float f[8];
#pragma unroll
        for (int j = 0; j < 8; ++j) f[j] = *(const LAS float*)(lds + ((kh + q * 8 + j) * 260 + n) * 4);
        const u32x4 o = {pk2(f[0], f[1]), pk2(f[2], f[3]), pk2(f[4], f[5]), pk2(f[6], f[7])};
        *(u32x4*)(op + q * 8) = o;
      }
    }
    __syncthreads();
  }
#undef PREP_DECODE
#undef PREP_LOAD
  if (do_lam && blockIdx.x == 0 && tid < 64) {
    for (int l = 0; l < 2; ++l) {
      float a = p.lq1[l * 64 + tid] * p.lk1[l * 64 + tid], b = p.lq2[l * 64 + tid] * p.lk2[l * 64 + tid];
#pragma unroll
      for (int off = 32; off >= 1; off >>= 1) { a += __shfl_xor(a, off); b += __shfl_xor(b, off); }
      float li = 0.8f - 0.6f * expf(-0.3f * (float)l);
      if (tid == 0) p.lam[l] = expf(a) - expf(b) + li;
    }
  }
}

template <int MODE> DI void rownorm(const Params& p) {
  const int tid = opaque_tid(); const int wave = tid >> 6, lane = tid & 63;
  const int nw = gridDim.x * 8;
  for (int row = (MODE == 1 ? 8192 : 0) + blockIdx.x * 8 + wave; row < MROWS; row += nw) {
    const int b = row / LROW, pos = row - b * LROW;
    if (MODE == 2 && pos < 64) continue;
    const float* src;
    if (MODE <= 1) src = pos < 48 ? nullptr : (pos < 64 ? p.meta + (size_t)(pos - 48) * DM : p.x + ((size_t)b * 2048 + (pos - 64)) * DM);
    else src = p.h + (size_t)row * DM;
    float4 v[8]; float ss = 0.f;
#pragma unroll
    for (int i = 0; i < 8; ++i) {
      v[i] = src ? *(const float4*)(src + i * 256 + lane * 4) : make_float4(0.f, 0.f, 0.f, 0.f);
      if (MODE != 0 && row >= 8192) {
#pragma unroll
        for (int s = 0; s < 8; ++s) { const float4 q = *(const float4*)(p.P2 + ((size_t)s * 256 + (row - 8192)) * DM + i * 256 + lane * 4); v[i].x += q.x; v[i].y += q.y; v[i].z += q.z; v[i].w += q.w; }
      }
      ss += v[i].x * v[i].x + v[i].y * v[i].y + v[i].z * v[i].z + v[i].w * v[i].w;
    }
#pragma unroll
    for (int off = 32; off >= 1; off >>= 1) ss += __shfl_xor(ss, off);
    const float rs = rsqrtf(ss * (1.f / 2048.f) + 1e-6f);
    if (MODE < 2) {
#pragma unroll
      for (int i = 0; i < 8; ++i) {
        if (MODE == 1) *(float4*)(p.h + (size_t)row * DM + i * 256 + lane * 4) = v[i];
        uint2 o; o.x = pk2(v[i].x, v[i].y); o.y = pk2(v[i].z, v[i].w);
        *(uint2*)(p.hb + (size_t)row * DM + i * 256 + lane * 4) = o;
      }
      if (lane == 0) p.ss[(MODE == 0 ? 0 : 1) * MROWS + row] = ss;
    } else {
      float* dst = p.out + ((size_t)b * 2048 + (pos - 64)) * DM;
#pragma unroll
      for (int i = 0; i < 8; ++i) {
        float4 g = *(const float4*)(p.fin_g + i * 256 + lane * 4);
        float4 o; o.x = v[i].x * rs * g.x; o.y = v[i].y * rs * g.y; o.z = v[i].z * rs * g.z; o.w = v[i].w * rs * g.w;
        *(float4*)(dst + i * 256 + lane * 4) = o;
      }
    }
  }
}

constexpr int GK = 2048, GBK = 64, GHALF = 128, GHTB = GHALF * GBK * 2;
constexpr size_t TSTEP = (size_t)256 * GK * 2;
struct Unit { int mt, nt, tr, k0, nkt, nb; };

template <class Epi, class Sched>
DI void gemm_phase(LAS unsigned char* lds, const Sched& S, const Epi& E) {
  const int tid = opaque_tid(), wid = __builtin_amdgcn_readfirstlane(tid >> 6), lane = tid & 63, wr = wid >> 2, wc = wid & 3, fr = lane & 15, fq = lane >> 4;
  constexpr int K = GK;
  unsigned voffA[2], dperm;
#pragma unroll
  for (int i = 0; i < 2; ++i) { int R, C; stage_rc(tid * 16 + i * 8192, R, C); voffA[i] = (unsigned)(R * K + C) * 2u;
    if (i == 0) dperm = (unsigned)((perm32(R & 31) - (R & 31)) * K * 2); }
  const size_t kstep = (size_t)(GBK * 2);
  const size_t hstep = (size_t)GHALF * K * 2;
  const unsigned ldsw = (unsigned)wid * 1024u;
  const int aoff = lds_byte(wr * 64 + fr, fq * 8), boff = lds_byte(wc * 32 + fr, fq * 8);
#define G_SA(b, h) (((b) * 2 + (h)) * GHTB)
#define G_SB(b, h) ((4 + (b) * 2 + (h)) * GHTB)
#define G_STAGE(bufoff, gbase, voff) do { _Pragma("unroll") for (int _i = 0; _i < 2; ++_i) \
    __builtin_amdgcn_global_load_lds((const unsigned*)((const char*)(gbase) + voff[_i]), (LAS unsigned*)(lds + (bufoff) + ldsw + _i * 8192), 16, 0, 0); } while (0)
#define G_LDA(dst, b, h) do { _Pragma("unroll") for (int m = 0; m < 4; ++m) _Pragma("unroll") for (int k = 0; k < 2; ++k) dst[m][k] = *(const LAS bf16x8*)(lds + G_SA(b, h) + aoff + m * 2048 + k * 1024); } while (0)
#define G_LDB(dst, b, h) do { _Pragma("unroll") for (int n = 0; n < 2; ++n) _Pragma("unroll") for (int k = 0; k < 2; ++k) dst[n][k] = *(const LAS bf16x8*)(lds + G_SB(b, h) + boff + n * 2048 + k * 1024); } while (0)
#define G_MMA(ai, bj, At, Bx) do { __builtin_amdgcn_s_setprio(1); _Pragma("unroll") for (int m = 0; m < 4; ++m) _Pragma("unroll") for (int n = 0; n < 2; ++n) _Pragma("unroll") for (int k = 0; k < 2; ++k) \
    acc[ai][bj][m][n] = MFMA16(Bx[n][k], At[m][k], acc[ai][bj][m][n]); __builtin_amdgcn_s_setprio(0); } while (0)
#define G_WAIT_V(n) asm volatile("s_waitcnt vmcnt(" #n ")" ::: "memory")
#define G_WAIT_L(n) asm volatile("s_waitcnt lgkmcnt(" #n ")" ::: "memory")
#define G_BAR __builtin_amdgcn_s_barrier()
#define G_SCHED __builtin_amdgcn_sched_barrier(0)
  Unit cur, nxt; int ui = 0;
  if (!S.next(0, cur)) return;
  f32x4 acc[2][2][4][2];
  E.init(acc, cur, wr, wc, fr, fq, lds, 0);
  bf16x8 At[4][2], B0[2][2], B1[2][2];
  const char* cA = S.pa(cur); const char* cB = S.pb(cur);
  { const unsigned ds0 = cur.nb ? 0u : dperm; const unsigned vb[2] = {voffA[0] + ds0, voffA[1] + ds0};
  G_STAGE(G_SB(0, 0), cB, vb); G_STAGE(G_SA(0, 0), cA, voffA); G_STAGE(G_SB(0, 1), cB + hstep, vb); G_STAGE(G_SA(0, 1), cA + hstep, voffA);
  if (wr == 1) G_BAR;
  G_WAIT_V(4); G_BAR;
  G_STAGE(G_SB(1, 0), cB + kstep, vb); G_STAGE(G_SA(1, 0), cA + kstep, voffA); G_STAGE(G_SB(1, 1), cB + hstep + kstep, vb); }
  G_WAIT_V(6); G_BAR;
  for (;;) {
    const bool has_next = S.next(ui + 1, nxt);
    if (!has_next) nxt = cur;
    const char* nA = has_next ? S.pa(nxt) : cA; const char* nB = has_next ? S.pb(nxt) : cB;
    const int nt = cur.nkt;
    for (int t = 0; t < nt; t += 2) {
      const bool last = (t == nt - 2);
      const char* a1 = cA + (size_t)(t + 1) * kstep;
      const char* a2 = last ? nA : cA + (size_t)(t + 2) * kstep; const char* b2 = last ? nB : cB + (size_t)(t + 2) * kstep;
      const char* a3 = a2 + kstep; const char* b3 = b2 + kstep;
      const bool nbs = last ? (nxt.nb != 0) : (cur.nb != 0);
      const unsigned ds = nbs ? 0u : dperm; const unsigned vb[2] = {voffA[0] + ds, voffA[1] + ds};
      G_LDB(B0, 0, 0); G_SCHED; G_LDA(At, 0, 0); G_STAGE(G_SA(1, 1), a1 + hstep, voffA);
      G_WAIT_L(8); G_BAR; G_WAIT_L(0); G_MMA(0, 0, At, B0); G_BAR; G_SCHED;
      G_LDB(B1, 0, 1); G_STAGE(G_SB(0, 0), b2, vb);
      G_BAR; G_WAIT_L(0); G_MMA(0, 1, At, B1); G_BAR;
      G_LDA(At, 0, 1); G_STAGE(G_SA(0, 0), a2, voffA);
      G_BAR; G_WAIT_L(0); G_MMA(1, 0, At, B0); G_BAR; G_SCHED;
      G_STAGE(G_SB(0, 1), b2 + hstep, vb);
      G_WAIT_V(6); G_BAR; G_MMA(1, 1, At, B1); G_BAR;
      G_LDB(B0, 1, 0); G_SCHED; G_LDA(At, 1, 0); G_STAGE(G_SA(0, 1), a2 + hstep, voffA);
      G_WAIT_L(8); G_BAR; G_WAIT_L(0); G_MMA(0, 0, At, B0); G_BAR; G_SCHED;
      G_LDB(B1, 1, 1); G_STAGE(G_SB(1, 0), b3, vb);
      G_BAR; G_WAIT_L(0); G_MMA(0, 1, At, B1); G_BAR;
      G_LDA(At, 1, 1); G_STAGE(G_SA(1, 0), a3, voffA);
      G_BAR; G_WAIT_L(0); G_MMA(1, 0, At, B0); G_BAR; G_SCHED;
      G_STAGE(G_SB(1, 1), b3 + hstep, vb);
      G_WAIT_V(6); G_BAR; G_MMA(1, 1, At, B1); G_BAR;
    }
    { const int t2 = opaque_tid() & 63; E(acc, cur, wr, wc, t2 & 15, t2 >> 4, lds, ui & 1); }
    if (!has_next) break;
    cur = nxt; cA = nA; cB = nB; ++ui;
    { const int t3 = opaque_tid() & 63; E.init(acc, cur, wr, wc, t3 & 15, t3 >> 4, lds, ui & 1); }
  }
  G_WAIT_V(0);
  if (wr == 0) G_BAR;
  G_BAR;
}

#define XB_TMO      128
#define XB_XCNT(j)  (256  + 64 * (j))
#define XB_XSUB(j)  (1280 + 64 * (j))
#define XB_XGEN(j)  (2304 + 64 * (j))
#define XB_TOP      3328
#define XB_TOPGEN   3392
#define XCD_BAR_WORDS 3456
#define XB_SPIN_CAP (1u << 18)
DI unsigned xb_ld(unsigned* p) { return __hip_atomic_load(p, __ATOMIC_RELAXED, __HIP_MEMORY_SCOPE_AGENT); }
DI unsigned xb_add(unsigned* p, unsigned v) { return __hip_atomic_fetch_add(p, v, __ATOMIC_RELAXED, __HIP_MEMORY_SCOPE_AGENT); }
DI unsigned xb_xcc_id() { return (unsigned)__builtin_amdgcn_s_getreg((3 << 11) | 20) & 0xFu; }
#define XB_SPIN(cond, bar) do { unsigned _sp = 0; while (cond) { __builtin_amdgcn_s_sleep(1); \
    if ((++_sp & 255u) == 0u) { if (xb_ld(&(bar)[XB_TMO])) break; if (_sp > XB_SPIN_CAP) { atomicAdd(&(bar)[XB_TMO], 1u); break; } } } } while (0)
struct XcdBarrier { unsigned* bar; unsigned x; volatile LAS unsigned* st; };
DI XcdBarrier xcd_barrier_post(unsigned* bar, volatile LAS unsigned* st) {
  XcdBarrier b; b.bar = bar; b.x = xb_xcc_id(); b.st = st;
  if (threadIdx.x == 0) (void)xb_add(&bar[XB_XCNT(b.x)], 1u);
  return b;
}
DI void xcd_barrier_complete(unsigned* bar, unsigned x, unsigned& nloc, unsigned& nx) {
  const unsigned G = gridDim.x * gridDim.y * gridDim.z;
  unsigned sum, cnt, mine, sp = 0u;
  for (;;) {
    sum = 0u; cnt = 0u; mine = 0u;
#pragma unroll
    for (unsigned j = 0; j < 16; ++j) { const unsigned c = xb_ld(&bar[XB_XCNT(j)]); sum += c; cnt += (c > 0u) ? 1u : 0u; mine = (j == x) ? c : mine; }
    if (sum == G) break;
    __builtin_amdgcn_s_sleep(1);
    if ((++sp & 255u) == 0u) { if (xb_ld(&bar[XB_TMO])) break; if (sp > XB_SPIN_CAP) { atomicAdd(&bar[XB_TMO], 1u); break; } }
  }
  nloc = mine > 0u ? mine : 1u; nx = cnt > 0u ? cnt : 1u;
}
DI void xcd_barrier(const XcdBarrier& b) {
  asm volatile("s_waitcnt vmcnt(0)" ::: "memory");
  __syncthreads();
  if (threadIdx.x == 0) {
    unsigned* bar = b.bar;
    __builtin_amdgcn_s_waitcnt(0);
    unsigned nloc = b.st[0], nx = b.st[1];
    if (nloc == 0u) { xcd_barrier_complete(bar, b.x, nloc, nx); b.st[0] = nloc; b.st[1] = nx; }
    const unsigned old = xb_add(&bar[XB_XSUB(b.x)], 1u);
    const unsigned gen = old / nloc;
    if (old + 1u == (gen + 1u) * nloc) {
      __builtin_amdgcn_fence(__ATOMIC_RELEASE, "agent");
      asm volatile("s_waitcnt vmcnt(0)" ::: "memory");
      const unsigned og = xb_add(&bar[XB_TOP], 1u);
      const unsigned tg = og / nx;
      if (og + 1u == (tg + 1u) * nx) xb_add(&bar[XB_TOPGEN], 1u);
      else XB_SPIN(xb_ld(&bar[XB_TOPGEN]) == tg, bar);
      __builtin_amdgcn_fence(__ATOMIC_ACQUIRE, "agent");
      xb_add(&bar[XB_XGEN(b.x)], 1u);
      asm volatile("s_waitcnt vmcnt(0)" ::: "memory");
    } else {
      XB_SPIN(xb_ld(&bar[XB_XGEN(b.x)]) == gen, bar);
      __builtin_amdgcn_fence(__ATOMIC_ACQUIRE, "agent");
      asm volatile("s_waitcnt vmcnt(0)" ::: "memory");
    }
  }
  __syncthreads();
}

DI void tile_map(int wgid, int nM, int nN, int& pm, int& pn) {
  const int nwg = nM * nN;
  { int q = nwg / 8, r = nwg % 8, xcd = wgid % 8, off = wgid / 8; wgid = (xcd < r ? xcd * (q + 1) : r * (q + 1) + (xcd - r) * q) + off; }
  const int nig = 8 * nN, gid = wgid / nig, fm = gid * 8, gsz = min(nM - fm, 8);
  pm = fm + ((wgid % nig) % gsz); pn = (wgid % nig) / gsz;
}

struct Sched1 {
  const bf16_t* hb; const bf16_t* W; int ubeg, uend;
  DI bool next(int i, Unit& u) const {
    const int U = ubeg + i * (int)gridDim.x + (int)blockIdx.x; if (U >= uend) return false;
    int pm, pn;
    if (U < 928) tile_map(U, 29, 32, pm, pn);
    else if (U < 1024) { const int q = U - 928, c = q % 24; pm = 29 + q / 24; pn = c < 12 ? c : c + 4; }
    else { const int q = U - 1024, g = q & 7; pm = 29 + (q >> 3); pn = g < 4 ? 12 + g : 24 + g; }
    u.mt = pm; u.nt = pn; u.k0 = 0; u.nkt = 32; const int g = pn >> 2; u.tr = (g == 1 || g == 2 || g == 6) ? 1 : 0; u.nb = u.tr; return true;
  }
  DI const char* pa(const Unit& u) const { return u.tr ? (const char*)W + (size_t)u.nt * TSTEP : (const char*)hb + (size_t)u.mt * TSTEP; }
  DI const char* pb(const Unit& u) const { return u.tr ? (const char*)hb + (size_t)u.mt * TSTEP : (const char*)W + (size_t)u.nt * TSTEP; }
};
struct Sched2 {
  const bf16_t* mix; const bf16_t* W;
  DI bool next(int i, Unit& u) const {
    const int U = i * (int)gridDim.x + (int)blockIdx.x; if (U >= 256 + 64) return false;
    if (U < 256) { int pm, pn; tile_map(U, 32, 8, pm, pn); u.mt = pm; u.nt = pn; u.tr = 0; u.k0 = 0; u.nkt = 32; u.nb = 0; }
    else { const int j = U - 256; u.mt = 32; u.nt = j >> 3; u.tr = 1 + (j & 7); u.k0 = (j & 7) * 256; u.nkt = 4; u.nb = 0; }
    return true;
  }
  DI const char* pa(const Unit& u) const { return (const char*)mix + (size_t)u.mt * TSTEP + (size_t)u.k0 * 2; }
  DI const char* pb(const Unit& u) const { return (const char*)W + (size_t)u.nt * TSTEP + (size_t)u.k0 * 2; }
};

DI void acc_zero(f32x4 (&acc)[2][2][4][2]) {
#pragma unroll
  for (int a = 0; a < 2; ++a)
#pragma unroll
    for (int b = 0; b < 2; ++b)
#pragma unroll
      for (int m = 0; m < 4; ++m)
#pragma unroll
        for (int n = 0; n < 2; ++n) acc[a][b][m][n] = (f32x4){0.f, 0.f, 0.f, 0.f};
}
struct Epi1 {
  bf16_t* proj; bf16_t* T; const float* ss;
  DI void init(f32x4 (&acc)[2][2][4][2], const Unit& u, int wr, int wc, int fr, int fq, LAS unsigned char* lds, int par) const {
    acc_zero(acc);
    if (wr == 0)
      __builtin_amdgcn_global_load_lds((const unsigned*)(ss + u.mt * 256 + wc * 64 + fq * 16 + fr), (LAS unsigned*)(lds + 131072 + par * 1024 + wc * 256), 4, 0, 0);
  }
  DI void operator()(const f32x4 (&acc)[2][2][4][2], const Unit& u, int wr, int wc, int fr, int fq, LAS unsigned char* lds, int par) const {
    const LAS float* ssl = (const LAS float*)(lds + 131072 + par * 1024);
    const int g = u.nt >> 2;
    if (!u.tr) {
      const float sc = (g == 4) ? 0.125f * LOG2E : 1.f;
      const int n0 = u.nt * 256 + wc * 32 + fq * 8;
#pragma unroll
      for (int ai = 0; ai < 2; ++ai)
#pragma unroll
        for (int mi = 0; mi < 4; ++mi) {
          const int m = u.mt * 256 + ai * 128 + wr * 64 + mi * 16 + fr;
          const float rs = rsqrtf(ssl[ai * 128 + wr * 64 + mi * 16 + fr] * (1.f / 2048.f) + 1e-6f) * sc;
          bf16_t* rowp = proj + (size_t)m * NIN + n0;
#pragma unroll
          for (int bj = 0; bj < 2; ++bj) {
            const f32x4 a = acc[ai][bj][mi][0], c = acc[ai][bj][mi][1];
            const u32x4 o = {pk2(a[0] * rs, a[1] * rs), pk2(a[2] * rs, a[3] * rs), pk2(c[0] * rs, c[1] * rs), pk2(c[2] * rs, c[3] * rs)};
            *(u32x4*)(rowp + bj * 128) = o;
          }
        }
    } else {
      const int tbase = (g == 1 ? 0 : (g == 2 ? 1024 : 2048)) - g * 1024;
#pragma unroll
      for (int bj = 0; bj < 2; ++bj) {
        const int mb = u.mt * 256 + bj * 128 + wc * 32;
        const int b = mb / LROW, posb = mb - b * LROW;
        const f32x4 q0 = *(const LAS f32x4*)(ssl + bj * 128 + wc * 32 + 4 * fq), q1 = *(const LAS f32x4*)(ssl + bj * 128 + wc * 32 + 16 + 4 * fq);
        float rs[8];
#pragma unroll
        for (int j = 0; j < 4; ++j) { rs[j] = rsqrtf(q0[j] * (1.f / 2048.f) + 1e-6f); rs[4 + j] = rsqrtf(q1[j] * (1.f / 2048.f) + 1e-6f); }
        const int p0 = posb + 4 * fq, p1 = p0 + 16;
        if (g == 1) {
#pragma unroll
          for (int j = 0; j < 4; ++j) { rs[j] = (p0 + j >= 48) ? rs[j] * 0.08838834764831845f : 0.f; rs[4 + j] = (p1 + j >= 48) ? rs[4 + j] * 0.08838834764831845f : 0.f; }
        }
#pragma unroll
        for (int ai = 0; ai < 2; ++ai)
#pragma unroll
          for (int mi = 0; mi < 4; ++mi) {
            const int col = u.nt * 256 + ai * 128 + wr * 64 + mi * 16 + fr;
            const f32x4 a = acc[ai][bj][mi][0], c = acc[ai][bj][mi][1];
            float v[8] = {a[0] * rs[0], a[1] * rs[1], a[2] * rs[2], a[3] * rs[3], c[0] * rs[4], c[1] * rs[5], c[2] * rs[6], c[3] * rs[7]};
            if (g == 1) {
              const int hh = (col - 1024) >> 7;
              const float l2g = log2f(1.f - exp2f(-5.f - (float)hh));
              const int z0 = 63 - (p0 & 63), z1 = 63 - (p1 & 63);
#pragma unroll
              for (int j = 0; j < 4; ++j) { v[j] *= exp2f(l2g * (float)(z0 - j)); v[4 + j] *= exp2f(l2g * (float)(z1 - j)); }
            }
            const u32x4 o = {pk2(v[0], v[1]), pk2(v[2], v[3]), pk2(v[4], v[5]), pk2(v[6], v[7])};
            const int trow = (g == 1) ? (col & ~31) + 16 * ((col >> 2) & 1) + 4 * ((col >> 3) & 3) + (col & 3) : col;
            *(u32x4*)(T + ((size_t)(b * 3072 + tbase + trow)) * LROW + posb + 8 * fq) = o;
          }
      }
    }
  }
};
struct Epi2 {
  float* h; float* P2; bf16_t* hb; float* ssn; const float* x; const float* meta;
  DI void init(f32x4 (&acc)[2][2][4][2], const Unit& u, int wr, int wc, int fr, int fq, LAS unsigned char*, int) const {
    if (u.tr) { acc_zero(acc); return; }
    const int n0 = u.nt * 256 + wc * 32 + fq * 8;
#pragma unroll
    for (int ai = 0; ai < 2; ++ai)
#pragma unroll
      for (int mi = 0; mi < 4; ++mi) {
        const int m = u.mt * 256 + ai * 128 + wr * 64 + mi * 16 + fr;
        const float* rowp = h + (size_t)m * DM + n0;
        if (x) { const int b = m / LROW, pos = m - b * LROW; rowp = pos < 48 ? nullptr : (pos < 64 ? meta + (size_t)(pos - 48) * DM : x + ((size_t)b * 2048 + (pos - 64)) * DM) + n0; }
#pragma unroll
        for (int bj = 0; bj < 2; ++bj)
#pragma unroll
          for (int ni = 0; ni < 2; ++ni) acc[ai][bj][mi][ni] = rowp ? *(const f32x4*)(rowp + bj * 128 + ni * 4) : (f32x4){0.f, 0.f, 0.f, 0.f};
      }
  }
  DI void operator()(const f32x4 (&acc)[2][2][4][2], const Unit& u, int wr, int wc, int fr, int fq, LAS unsigned char*, int) const {
    const int n0 = u.nt * 256 + wc * 32 + fq * 8;
#pragma unroll
    for (int ai = 0; ai < 2; ++ai)
#pragma unroll
      for (int mi = 0; mi < 4; ++mi) {
        const int m = u.mt * 256 + ai * 128 + wr * 64 + mi * 16 + fr;
        float* rowp = (u.tr ? P2 + ((size_t)(u.tr - 1) * 256 + (m - 8192)) * DM : h + (size_t)m * DM) + n0;
        float sq = 0.f;
#pragma unroll
        for (int bj = 0; bj < 2; ++bj) {
          const f32x4 a = acc[ai][bj][mi][0], c = acc[ai][bj][mi][1];
          *(f32x4*)(rowp + bj * 128) = a; *(f32x4*)(rowp + bj * 128 + 4) = c;
          if (ssn && !u.tr) {
            sq += a[0] * a[0] + a[1] * a[1] + a[2] * a[2] + a[3] * a[3] + c[0] * c[0] + c[1] * c[1] + c[2] * c[2] + c[3] * c[3];
            const u32x4 o = {pk2(a[0], a[1]), pk2(a[2], a[3]), pk2(c[0], c[1]), pk2(c[2], c[3])};
            *(u32x4*)(hb + (size_t)m * DM + n0 + bj * 128) = o;
          }
        }
        if (ssn && !u.tr) {
          sq += __shfl_xor(sq, 16); sq += __shfl_xor(sq, 32);
          if (fq == 0) unsafeAtomicAdd(ssn + m, sq);
        }
      }
  }
};

DI void gemm1_phase(const Params& p, int l, LAS unsigned char* lds, int ubeg, int uend) {
  Sched1 S{p.hb, p.WinT + (size_t)l * NIN * DM, ubeg, uend}; Epi1 E{p.proj, p.T, p.ss + (size_t)l * MROWS};
  gemm_phase(lds, S, E);
}
DI void gemm2_phase(const Params& p, int l, LAS unsigned char* lds) {
  Sched2 S{p.mix, p.WoutT + (size_t)l * DM * DM}; Epi2 E{p.h, p.P2, p.hb, l == 0 ? p.ss + MROWS : nullptr, l == 0 ? p.x : nullptr, p.meta};
  gemm_phase(lds, S, E);
}

DI void ret_scan_chain(const Params& p, int b, int h, LAS unsigned char* lds, unsigned* done_ctr) {
  constexpr int D = 6;
  const int tid = opaque_tid(), w = __builtin_amdgcn_readfirstlane(tid >> 6), lane = tid & 63, fr = lane & 15, fq = lane >> 4;
  const float l2g = log2f(1.f - exp2f(-5.f - (float)h));
  const float dec64 = exp2f(l2g * 64.f);
  const int sub16 = lds_byte(fr, fq * 8);
  const int frow = ((tid >> 4) & 31) * 2 + ((tid >> 2) & 1), fcol = ((tid >> 3) & 1) * 32 + (tid & 3) * 8;
  const int fillT = lds_byte(frow, fcol);
  const bf16_t* gk = p.T + (size_t)b * 3072 * LROW + (size_t)(h * 128 + frow) * LROW + fcol;
  u32x4* so = (u32x4*)p.ST + ((size_t)((b * 8 + h) * NCH) * 8 + w) * 256 + lane;
  f32x4 st[8];
#pragma unroll
  for (int i = 0; i < 8; ++i) st[i] = (f32x4){0.f, 0.f, 0.f, 0.f};
  u32x4 ring[D][4];
#define SCAN_LOAD(slot, n) do { const bf16_t* _t = gk + (n) * 64; ring[slot][0] = *(const u32x4*)_t; ring[slot][1] = *(const u32x4*)(_t + (size_t)64 * LROW); \
    ring[slot][2] = *(const u32x4*)(_t + (size_t)1024 * LROW); ring[slot][3] = *(const u32x4*)(_t + (size_t)1088 * LROW); } while (0)
#define SCAN_STORE(n) do { _Pragma("unroll") for (int kd = 0; kd < 4; ++kd) { const f32x4 sa = st[2 * kd], sc = st[2 * kd + 1]; \
    const u32x4 bsu = {pk2(sa[0], sa[1]), pk2(sa[2], sa[3]), pk2(sc[0], sc[1]), pk2(sc[2], sc[3])}; so[(size_t)(n) * 2048 + kd * 64] = bsu; } } while (0)
#pragma unroll
  for (int i = 0; i < D; ++i) SCAN_LOAD(i, i);
#pragma unroll
  for (int n = 0; n < NCH - 1; ++n) {
    const int slot = n % D, bo = (n & 1) * 32768;
    *(LAS u32x4*)(lds + bo + fillT) = ring[slot][0]; *(LAS u32x4*)(lds + bo + fillT + 8192) = ring[slot][1];
    *(LAS u32x4*)(lds + bo + 16384 + fillT) = ring[slot][2]; *(LAS u32x4*)(lds + bo + 16384 + fillT + 8192) = ring[slot][3];
    if (n + D < NCH - 1) SCAN_LOAD(slot, n + D);
    __syncthreads();
    SCAN_STORE(n);
    const bf16x8 vf0 = *(const LAS bf16x8*)(lds + bo + 16384 + w * 2048 + sub16), vf1 = *(const LAS bf16x8*)(lds + bo + 16384 + w * 2048 + 1024 + sub16);
#pragma unroll
    for (int db = 0; db < 8; ++db) {
      st[db] *= dec64;
      const bf16x8 a0 = *(const LAS bf16x8*)(lds + bo + sub16 + db * 2048);
      const bf16x8 a1 = *(const LAS bf16x8*)(lds + bo + sub16 + db * 2048 + 1024);
      st[db] = MFMA16(a0, vf0, st[db]); st[db] = MFMA16(a1, vf1, st[db]);
    }
  }
  SCAN_STORE(NCH - 1);
  asm volatile("s_waitcnt vmcnt(0)" ::: "memory");
  __syncthreads();
  if (threadIdx.x == 0) { __builtin_amdgcn_fence(__ATOMIC_RELEASE, "agent"); asm volatile("s_waitcnt vmcnt(0)" ::: "memory"); xb_add(done_ctr, 1u); }
#undef SCAN_LOAD
#undef SCAN_STORE
}

DI void retention_items(const Params& p, int l, LAS unsigned char* lds, int first, int stride, int count) {
  constexpr int QS = 0, KS = 16384, VTS = 49152, PS = 65536, OS = 73728;
  const int tid = opaque_tid(), w = __builtin_amdgcn_readfirstlane(tid >> 6), lane = tid & 63, fr = lane & 15, fq = lane >> 4;
  const int sub16 = lds_byte(fr, fq * 8), sub8a = lds_byte(fr, fq * 4), sub8b = lds_byte(fr, fq * 4 + 16);
  const int tq = ((tid >> 5) & 15) * 2 + ((tid >> 2) & 1), dq = ((tid >> 4) & 1) * 64 + ((tid >> 3) & 1) * 32 + (tid & 3) * 8;
  const int ve = ((tid >> 4) & 31) * 2 + ((tid >> 2) & 1), vs0 = ((tid >> 3) & 1) * 32 + (tid & 3) * 8;
  const int fillQ = (dq >> 6) * 8192 + lds_byte(tq, dq & 63);
  const int fillT = lds_byte(ve, vs0);
  const int sb = w & 3, tb0 = (w >> 2) * 2;
  const int kbase = KS + sb * 2048 + sub16, qbase = QS + tb0 * 2048 + sub16;
  const int pbase = PS + tb0 * 2048 + (sb >> 1) * 1024 + lds_byte(fr, fq * 8 + 4 * (sb & 1));
  const int vbase = VTS + w * 2048 + sub16;
  const int obase = OS + ((fq * 4) * 132 + w * 16 + fr) * 4;
  const int nbase = OS + ((tid >> 3) * 132 + (tid & 7) * 16) * 4;
  u32x4 pq0, pq1, pk0, pk1, pv0, pv1, ns0, ns1, ns2, ns3, ng0, ng1;
#define RET_GLOAD(it) do { const int _bh = (it) / NCH, _n = (it) - _bh * NCH, _b = _bh >> 3, _h = _bh & 7; \
    const bf16_t* _q = p.proj + ((size_t)_b * LROW + _n * 64 + tq) * NIN + _h * 128 + dq; \
    const bf16_t* _tk = p.T + ((size_t)_b * 3072 + _h * 128 + (tid >> 3)) * LROW + _n * 64 + (tid & 7) * 8; \
    const bf16_t* _tv = p.T + ((size_t)_b * 3072 + 1024 + _h * 128 + ve) * LROW + _n * 64 + vs0; \
    pq0 = *(const u32x4*)_q; pq1 = *(const u32x4*)(_q + (size_t)32 * NIN); pk0 = *(const u32x4*)_tk; pk1 = *(const u32x4*)(_tk + (size_t)64 * LROW); \
    pv0 = *(const u32x4*)_tv; pv1 = *(const u32x4*)(_tv + (size_t)64 * LROW); \
    const u32x4* _sp = (const u32x4*)p.ST + ((size_t)(it) * 8 + w) * 256 + lane; ns0 = _sp[0]; ns1 = _sp[64]; ns2 = _sp[128]; ns3 = _sp[192]; \
    const bf16_t* _gp = p.proj + ((size_t)_b * LROW + _n * 64 + (tid >> 3)) * NIN + 3072 + _h * 128 + (tid & 7) * 16; \
    ng0 = *(const u32x4*)_gp; ng1 = *(const u32x4*)(_gp + 8); } while (0)
  int it = first;
  const int iend = first + stride * count;
  if (it < iend) RET_GLOAD(it);
  for (; it < iend; it += stride) {
    const int bh = it / NCH, n = it - bh * NCH, b = bh >> 3, h = bh & 7;
    const float l2g = log2f(1.f - exp2f(-5.f - (float)h));
    *(LAS u32x4*)(lds + QS + fillQ) = pq0; *(LAS u32x4*)(lds + QS + fillQ + 4096) = pq1;
    {
      const int d0 = tid >> 3, s0 = (tid & 7) * 8;
#pragma unroll
      for (int i = 0; i < 2; ++i) {
        const u32x4 kv = i ? pk1 : pk0;
        const int r_ = d0 + 64 * i, d = (r_ & ~31) + 8 * ((r_ >> 2) & 3) + 4 * ((r_ >> 4) & 1) + (r_ & 3), ko = KS + (d >> 6) * 8192;
#pragma unroll
        for (int j = 0; j < 8; ++j) {
          const unsigned wv = kv[j >> 1];
          const int st = (s0 & 32) + 16 * (j >> 2) + 4 * ((s0 >> 3) & 3) + (j & 3);
          *(LAS bf16_t*)(lds + ko + lds_byte(st, d & 63)) = (bf16_t)((j & 1) ? (wv >> 16) : (wv & 0xffffu));
        }
      }
    }
    *(LAS u32x4*)(lds + VTS + fillT) = pv0; *(LAS u32x4*)(lds + VTS + fillT + 8192) = pv1;
    const u32x4 sf0 = ns0, sf1 = ns1, sf2 = ns2, sf3 = ns3, g0 = ng0, g1 = ng1;
    __syncthreads();
    if (it + stride < iend) RET_GLOAD(it + stride);
    const size_t row = (size_t)b * LROW + n * 64 + (tid >> 3);
    {
      f32x4 s0 = {0.f, 0.f, 0.f, 0.f}, s1 = {0.f, 0.f, 0.f, 0.f};
#pragma unroll
      for (int ks = 0; ks < 4; ++ks) {
        const int off = (ks >> 1) * 8192 + (ks & 1) * 1024;
        const bf16x8 a = *(const LAS bf16x8*)(lds + kbase + off);
        const bf16x8 b0 = *(const LAS bf16x8*)(lds + qbase + off);
        const bf16x8 b1 = *(const LAS bf16x8*)(lds + qbase + off + 2048);
        s0 = MFMA16(a, b0, s0); s1 = MFMA16(a, b1, s1);
      }
      const int srow = sb * 16 + fq * 4;
#pragma unroll
      for (int i = 0; i < 2; ++i) {
        const f32x4 sv = i ? s1 : s0;
        const int t = (tb0 + i) * 16 + fr;
        const float v0 = sv[0] * EXP2(l2g * (fabsf((float)(t - srow)) - (float)(63 - srow))), v1 = sv[1] * EXP2(l2g * (fabsf((float)(t - srow - 1)) - (float)(62 - srow)));
        const float v2 = sv[2] * EXP2(l2g * (fabsf((float)(t - srow - 2)) - (float)(61 - srow))), v3 = sv[3] * EXP2(l2g * (fabsf((float)(t - srow - 3)) - (float)(60 - srow)));
        const u32x2 o = {pk2(v0, v1), pk2(v2, v3)};
        *(LAS u32x2*)(lds + pbase + i * 2048) = o;
      }
    }
    __syncthreads();
    {
      const bf16x8 vf0 = *(const LAS bf16x8*)(lds + vbase), vf1 = *(const LAS bf16x8*)(lds + vbase + 1024);
      f32x4 o[4], cr[4];
#pragma unroll
      for (int tb = 0; tb < 4; ++tb) {
        o[tb] = (f32x4){0.f, 0.f, 0.f, 0.f}; cr[tb] = (f32x4){0.f, 0.f, 0.f, 0.f};
        const bf16x8 a0 = *(const LAS bf16x8*)(lds + PS + sub16 + tb * 2048);
        const bf16x8 a1 = *(const LAS bf16x8*)(lds + PS + sub16 + tb * 2048 + 1024);
        o[tb] = MFMA16(a0, vf0, o[tb]); o[tb] = MFMA16(a1, vf1, o[tb]);
      }
#pragma unroll
      for (int kd = 0; kd < 4; ++kd) {
        const bf16x8 bsv = __builtin_bit_cast(bf16x8, kd == 0 ? sf0 : (kd == 1 ? sf1 : (kd == 2 ? sf2 : sf3)));
#pragma unroll
        for (int tb = 0; tb < 4; ++tb) {
          const bf16x8 a = *(const LAS bf16x8*)(lds + QS + (kd >> 1) * 8192 + (tb * 2 + (kd & 1)) * 1024 + sub16);
          cr[tb] = MFMA16(a, bsv, cr[tb]);
        }
      }
#pragma unroll
      for (int tb = 0; tb < 4; ++tb)
#pragma unroll
        for (int j = 0; j < 4; ++j) o[tb][j] += EXP2(l2g * (float)(tb * 16 + fq * 4 + j + 1)) * cr[tb][j];
#pragma unroll
      for (int tb = 0; tb < 4; ++tb)
#pragma unroll
        for (int j = 0; j < 4; ++j) *(LAS float*)(lds + obase + (tb * 16 + j) * 528) = o[tb][j];
    }
    __syncthreads();
    {
      const int seg = tid & 7;
      const f32x4 x0 = *(const LAS f32x4*)(lds + nbase), x1 = *(const LAS f32x4*)(lds + nbase + 16), x2 = *(const LAS f32x4*)(lds + nbase + 32), x3 = *(const LAS f32x4*)(lds + nbase + 48);
      f32x4 xs = x0 + x1 + x2 + x3;
      float sum = xs[0] + xs[1] + xs[2] + xs[3];
      sum += __shfl_xor(sum, 1); sum += __shfl_xor(sum, 2); sum += __shfl_xor(sum, 4);
      const float mu = sum * (1.f / 128.f);
      const f32x4 d0 = x0 - mu, d1 = x1 - mu, d2 = x2 - mu, d3 = x3 - mu;
      const f32x4 q = d0 * d0 + d1 * d1 + d2 * d2 + d3 * d3;
      float vs = q[0] + q[1] + q[2] + q[3];
      vs += __shfl_xor(vs, 1); vs += __shfl_xor(vs, 2); vs += __shfl_xor(vs, 4);
      const float rn = rsqrtf(vs * (1.f / 128.f) + 1e-6f);
      const float* gr = p.ret_g + l * 1024 + h * 128 + seg * 16;
      const f32x4 w0 = *(const f32x4*)gr, w1 = *(const f32x4*)(gr + 4), w2 = *(const f32x4*)(gr + 8), w3 = *(const f32x4*)(gr + 12);
      uint4 oa, ob;
      oa.x = pk2(d0[0] * rn * w0[0] * silu(bflo(g0[0])), d0[1] * rn * w0[1] * silu(bfhi(g0[0])));
      oa.y = pk2(d0[2] * rn * w0[2] * silu(bflo(g0[1])), d0[3] * rn * w0[3] * silu(bfhi(g0[1])));
      oa.z = pk2(d1[0] * rn * w1[0] * silu(bflo(g0[2])), d1[1] * rn * w1[1] * silu(bfhi(g0[2])));
      oa.w = pk2(d1[2] * rn * w1[2] * silu(bflo(g0[3])), d1[3] * rn * w1[3] * silu(bfhi(g0[3])));
      ob.x = pk2(d2[0] * rn * w2[0] * silu(bflo(g1[0])), d2[1] * rn * w2[1] * silu(bfhi(g1[0])));
      ob.y = pk2(d2[2] * rn * w2[2] * silu(bflo(g1[1])), d2[3] * rn * w2[3] * silu(bfhi(g1[1])));
      ob.z = pk2(d3[0] * rn * w3[0] * silu(bflo(g1[2])), d3[1] * rn * w3[1] * silu(bfhi(g1[2])));
      ob.w = pk2(d3[2] * rn * w3[2] * silu(bflo(g1[3])), d3[3] * rn * w3[3] * silu(bfhi(g1[3])));
      bf16_t* mp = p.mix + row * DM + h * 128 + seg * 16;
      *(uint4*)mp = oa; *(uint4*)(mp + 8) = ob;
    }
  }
#undef RET_GLOAD
}

DI void diff_pv(LAS unsigned char* lds, int vgb, const bf16x8 (&pfr)[2][2], f32x4 (&o)[2][8], int sub16) {
  __builtin_amdgcn_s_setprio(1);
#pragma unroll
  for (int eb = 0; eb < 8; ++eb)
#pragma unroll
    for (int kp = 0; kp < 2; ++kp) {
      const bf16x8 a = *(const LAS bf16x8*)(lds + vgb + (eb * 2 + kp) * 1024 + sub16);
      o[0][eb] = MFMA16(a, pfr[0][kp], o[0][eb]);
      o[1][eb] = MFMA16(a, pfr[1][kp], o[1][eb]);
    }
  __builtin_amdgcn_s_setprio(0);
}
DI void diff_tile(bool general, LAS unsigned char* lds, int kfb, const bf16x8 (&qf)[2][2], f32x4 (&o)[2][8], bf16x8 (&pfr)[2][2], float& m0, float& m1, float& l0, float& l1,
                  const f32x4 (&cj)[4], float slope2, int kt, int qrow, int fq) {
  f32x4 s[2][4];
#pragma unroll
  for (int kb = 0; kb < 4; ++kb) {
    const f32x4 init = cj[kb];
    const bf16x8 a0 = *(const LAS bf16x8*)(lds + kfb + (kb * 2) * 1024);
    const bf16x8 a1 = *(const LAS bf16x8*)(lds + kfb + (kb * 2 + 1) * 1024);
    s[0][kb] = MFMA16(a0, qf[0][0], init); s[1][kb] = MFMA16(a0, qf[1][0], init);
    s[0][kb] = MFMA16(a1, qf[0][1], s[0][kb]); s[1][kb] = MFMA16(a1, qf[1][1], s[1][kb]);
  }
  const float tconst = slope2 * (float)(kt * 64);
#pragma unroll
  for (int rb = 0; rb < 2; ++rb) {
    if (general) {
      const int qrel = qrow + rb * 16 - kt * 64;
      const float ms2 = -2.f * slope2;
#pragma unroll
      for (int kb = 0; kb < 4; ++kb)
#pragma unroll
        for (int j = 0; j < 4; ++j) {
          const int kl = kb * 16 + fq * 4 + j;
          float v = s[rb][kb][j] + ms2 * (float)max(kl - qrel, 0);
          if (kt == 0 && kl < 48) v = -INFINITY;
          s[rb][kb][j] = v;
        }
    }
    float mx = fmaxf(fmaxf(s[rb][0][0], s[rb][0][1]), fmaxf(s[rb][0][2], s[rb][0][3]));
#pragma unroll
    for (int kb = 1; kb < 4; ++kb) mx = fmaxf(fmaxf(mx, fmaxf(s[rb][kb][0], s[rb][kb][1])), fmaxf(s[rb][kb][2], s[rb][kb][3]));
    mx = xmax32(xmax16(mx));
    const float mloc = (rb ? m1 : m0) - tconst;
    float mnew = mloc, alpha = 1.f;
    if (!__all(mx <= mloc + 8.f)) {
      mnew = fmaxf(mloc, mx); alpha = EXP2(mloc - mnew);
#pragma unroll
      for (int eb = 0; eb < 8; ++eb) o[rb][eb] *= alpha;
    }
    float rsum = 0.f;
#pragma unroll
    for (int kb = 0; kb < 4; ++kb)
#pragma unroll
      for (int j = 0; j < 4; ++j) { const float pv = EXP2(s[rb][kb][j] - mnew); s[rb][kb][j] = pv; rsum += pv; }
    if (rb) { l1 = l1 * alpha + rsum; m1 = mnew + tconst; } else { l0 = l0 * alpha + rsum; m0 = mnew + tconst; }
#pragma unroll
    for (int kp = 0; kp < 2; ++kp) {
      const f32x4 sa = s[rb][2 * kp], sc = s[rb][2 * kp + 1];
      const u32x4 pbu = {pk2(sa[0], sa[1]), pk2(sa[2], sa[3]), pk2(sc[0], sc[1]), pk2(sc[2], sc[3])};
      pfr[rb][kp] = __builtin_bit_cast(bf16x8, pbu);
    }
  }
}

DI void diff_item(const Params& p, int l, int b, int h, int pi, float lam, float lam_init, LAS unsigned char* lds) {
  const int tid = opaque_tid(), w = __builtin_amdgcn_readfirstlane(tid >> 6), lane = tid & 63, fr = lane & 15, fq = lane >> 4;
  const int c = w & 1, rgq = w >> 1, qc = 2 * pi + (rgq >> 1);
  const bool active = qc <= 32;
  const int ktmax = min(2 * pi + 1, 32);
  const int sub16 = lds_byte(fr, fq * 8), sub8a = lds_byte(fr, fq * 4), sub8b = lds_byte(fr, fq * 4 + 16);
  const bf16_t* projb = p.proj + (size_t)b * LROW * NIN;
  const int qrow = qc * 64 + (rgq & 1) * 32 + fr;
  bf16x8 qf[2][2];
#pragma unroll
  for (int rb = 0; rb < 2; ++rb)
#pragma unroll
    for (int ks = 0; ks < 2; ++ks)
      qf[rb][ks] = active ? *(const bf16x8*)(projb + (size_t)(qrow + rb * 16) * NIN + 4096 + h * 128 + c * 64 + ks * 32 + fq * 8) : (bf16x8){0, 0, 0, 0, 0, 0, 0, 0};
  float m0 = -INFINITY, m1 = -INFINITY, l0 = 0.f, l1 = 0.f;
  f32x4 o[2][8];
#pragma unroll
  for (int rb = 0; rb < 2; ++rb)
#pragma unroll
    for (int eb = 0; eb < 8; ++eb) o[rb][eb] = (f32x4){0.f, 0.f, 0.f, 0.f};
  const float slope2 = exp2f(-(float)(h + 1)) * LOG2E;
  f32x4 cj[4];
#pragma unroll
  for (int kb = 0; kb < 4; ++kb)
#pragma unroll
    for (int j = 0; j < 4; ++j) cj[kb][j] = slope2 * (float)(kb * 16 + fq * 4 + j);
  const int dswz = (lane * 16) ^ ((((lane * 16) >> 9) & 1) << 5), drr = dswz >> 6, dcc = (dswz & 63) >> 1;
  const bf16_t* gk = projb + (size_t)((w & 3) * 16 + drr) * NIN + 5120 + h * 128 + (w >> 2) * 64 + dcc;
  const bf16_t* gv = p.T + (size_t)b * 3072 * LROW + (size_t)(2048 + h * 128 + w * 16 + drr) * LROW + dcc;
  const int kdst = (w >> 2) * 8192 + (w & 3) * 2048, vdst = 32768 + w * 2048;
#define DIFF_DMA(kt, kb_, vs_) do { const bf16_t* _k = gk + (size_t)(kt) * 64 * NIN; const bf16_t* _v = gv + (kt) * 64; \
    __builtin_amdgcn_global_load_lds((const unsigned*)_k, (LAS unsigned*)(lds + (kb_) + kdst), 16, 0, 0); \
    __builtin_amdgcn_global_load_lds((const unsigned*)(_k + 32), (LAS unsigned*)(lds + (kb_) + kdst + 1024), 16, 0, 0); \
    __builtin_amdgcn_global_load_lds((const unsigned*)_v, (LAS unsigned*)(lds + (vs_) + vdst), 16, 0, 0); \
    __builtin_amdgcn_global_load_lds((const unsigned*)(_v + 32), (LAS unsigned*)(lds + (vs_) + vdst + 1024), 16, 0, 0); } while (0)
  DIFF_DMA(0, 0, 0);
  asm volatile("s_waitcnt vmcnt(0)" ::: "memory");
  __syncthreads();
  const int kfb0 = c * 8192 + sub16;
  const bool stag = (w >> 2) != 0;
  bf16x8 pfr[2][2];
  int vs = 0;
  for (int kt = 0; kt <= ktmax; ++kt) {
    const int kb = (kt & 1) * 16384;
    const int vsn = vs == 32768 ? 0 : vs + 16384;
    if (kt + 1 <= ktmax) DIFF_DMA(kt + 1, 16384 - kb, vsn);
    if (active && kt <= qc) {
      if (stag && kt > 0) diff_pv(lds, 32768 + (vs == 0 ? 32768 : vs - 16384), pfr, o, sub16);
      diff_tile(kt == 0 || kt == qc, lds, kfb0 + kb, qf, o, pfr, m0, m1, l0, l1, cj, slope2, kt, qrow, fq);
      if (!stag) diff_pv(lds, 32768 + vs, pfr, o, sub16);
    }
    vs = vsn;
    asm volatile("s_waitcnt vmcnt(0)" ::: "memory");
    __syncthreads();
  }
  if (active && stag) { const int lastslot = (qc % 3) * 16384; diff_pv(lds, 32768 + lastslot, pfr, o, sub16); }
#undef DIFF_DMA
  l0 += __shfl_xor(l0, 16); l0 += __shfl_xor(l0, 32);
  l1 += __shfl_xor(l1, 16); l1 += __shfl_xor(l1, 32);
  const int xb = 81920 + rgq * 16384 + lane * 4;
  if (c == 1 && active) {
#pragma unroll
    for (int rb = 0; rb < 2; ++rb) {
      const float inv = lam / (rb ? l1 : l0);
#pragma unroll
      for (int eb = 0; eb < 8; ++eb)
#pragma unroll
        for (int j = 0; j < 4; ++j) *(LAS float*)(lds + xb + ((rb * 8 + eb) * 4 + j) * 256) = o[rb][eb][j] * inv;
    }
  }
  if (tid == 0) { unsigned sp = 0; while (xb_ld(p.ctr + 32 + l) < 32u && ++sp < (1u << 22)) __builtin_amdgcn_s_sleep(2); }
  __syncthreads();
  __builtin_amdgcn_fence(__ATOMIC_ACQUIRE, "agent");
  if (c == 0 && active) {
#pragma unroll
    for (int rb = 0; rb < 2; ++rb) {
      const float inv = 1.f / (rb ? l1 : l0);
      float ss = 0.f;
#pragma unroll
      for (int eb = 0; eb < 8; ++eb)
#pragma unroll
        for (int j = 0; j < 4; ++j) { const float d = o[rb][eb][j] * inv - *(const LAS float*)(lds + xb + ((rb * 8 + eb) * 4 + j) * 256); o[rb][eb][j] = d; ss += d * d; }
      ss += __shfl_xor(ss, 16); ss += __shfl_xor(ss, 32);
      const float rn = rsqrtf(ss * (1.f / 128.f) + 1e-6f) * (1.f - lam_init);
      const size_t row = (size_t)b * LROW + qrow + rb * 16;
#pragma unroll
      for (int eb = 0; eb < 8; ++eb) {
        const int e0 = h * 128 + eb * 16 + fq * 4;
        const uint2 gu = *(const uint2*)(p.proj + row * NIN + 7168 + e0);
        const float4 gg = *(const float4*)(p.diff_g + l * 1024 + e0);
        const float y0 = o[rb][eb][0] * rn * gg.x * silu(bflo(gu.x)), y1 = o[rb][eb][1] * rn * gg.y * silu(bfhi(gu.x));
        const float y2 = o[rb][eb][2] * rn * gg.z * silu(bflo(gu.y)), y3 = o[rb][eb][3] * rn * gg.w * silu(bfhi(gu.y));
        uint2 ov; ov.x = pk2(y0, y1); ov.y = pk2(y2, y3);
        *(uint2*)(p.mix + row * DM + 1024 + e0) = ov;
      }
    }
  }
}

DI void mixer_phase(const Params& p, int l, LAS unsigned char* lds) {
  volatile LAS int* s_item = (volatile LAS int*)(lds + 147456);
  const float lam = p.lam[l];
  const float lam_init = 0.8f - 0.6f * expf(-0.3f * (float)l);
  for (int c = (int)blockIdx.x - 32; c >= 0 && c < 32; c += (int)gridDim.x) ret_scan_chain(p, c >> 3, c & 7, lds, p.ctr + 34 + l);
  const int xcd = blockIdx.x & 7;
  for (;;) {
    if (threadIdx.x == 0) *s_item = (int)atomicAdd(p.ctr + l * 8 + xcd, 1u);
    __syncthreads();
    const int it = *s_item;
    __syncthreads();
    if (it >= 68 + 22) break;
    if (it < 48 || it >= 70) {
      const int ai = it < 48 ? it : it - 22;
      const int bh = 4 * xcd + (ai & 3);
      diff_item(p, l, bh >> 3, bh & 7, 16 - (ai >> 2), lam, lam_init, lds);
    } else {
      if (threadIdx.x == 0) { unsigned sp = 0; while ((xb_ld(p.ctr + 34 + l) < 32u || xb_ld(p.ctr + 32 + l) < 32u) && ++sp < (1u << 22)) __builtin_amdgcn_s_sleep(2); }
      __syncthreads();
      __builtin_amdgcn_fence(__ATOMIC_ACQUIRE, "agent");
      retention_items(p, l, lds, xcd + 48 * (it - 48), 8, 6);
      __syncthreads();
    }
  }
}

__global__ void __launch_bounds__(512) hymba_megakernel(Params p_unused) {
  cg::grid_group grid = cg::this_grid();
  extern __shared__ __attribute__((aligned(16))) char smem[];
  LAS unsigned char* lds = (LAS unsigned char*)smem;
  volatile LAS unsigned* xst = (volatile LAS unsigned*)(lds + 147456 + 16);
  if (threadIdx.x == 0) { xst[0] = 0u; xst[1] = 0u; }
  __syncthreads();
  XcdBarrier xb;
  { const Params p = load_params(); xb = xcd_barrier_post(p.bar, xst); }
  { const Params p = load_params(); prep_weights(p, lds, 0, 1792, blockIdx.x, gridDim.x, true); }
  { const Params p = load_params(); rownorm<0>(p); }
  grid.sync();
  for (int l = 0; l < 2; ++l) {
    { const Params p = load_params(); gemm1_phase(p, l, lds, 0, 1024); }
    xcd_barrier(xb);
    if (blockIdx.x < 32) {
      const Params p = load_params();
      gemm1_phase(p, l, lds, 1024, 1056);
      if (threadIdx.x == 0) {
        int nl = 0; for (int U = 1024 + (int)blockIdx.x; U < 1056; U += (int)gridDim.x) ++nl;
        __builtin_amdgcn_fence(__ATOMIC_RELEASE, "agent");
        asm volatile("s_waitcnt vmcnt(0)" ::: "memory");
        xb_add(p.ctr + 32 + l, (unsigned)nl);
      }
    }
    { const Params p = load_params(); mixer_phase(p, l, lds); }
    xcd_barrier(xb);
    { const Params p = load_params(); gemm2_phase(p, l, lds); }
    if (l == 0) { const Params p = load_params(); if (gridDim.x > 64) { if (blockIdx.x >= 64) prep_weights(p, lds, 1792, 2560, blockIdx.x - 64, gridDim.x - 64, false); } else prep_weights(p, lds, 1792, 2560, blockIdx.x, gridDim.x, false); }
    xcd_barrier(xb);
    if (l == 0) { { const Params p = load_params(); rownorm<1>(p); } xcd_barrier(xb); }
    else { const Params p = load_params(); rownorm<2>(p); }
  }
}

extern "C" void kernel_launch(void* const* d_in, const int* in_sizes, int n_in, void* d_out, int out_size, void* d_ws, size_t ws_size, hipStream_t stream) {
  static int grid_blocks = 0;
  if (!grid_blocks) {
    int dev = 0, cus = 0, per_cu = 0;
    hipGetDevice(&dev);
    hipDeviceGetAttribute(&cus, hipDeviceAttributeMultiprocessorCount, dev);
    hipFuncSetAttribute((const void*)hymba_megakernel, hipFuncAttributeMaxDynamicSharedMemorySize, SMEM_BYTES);
    hipOccupancyMaxActiveBlocksPerMultiprocessor(&per_cu, hymba_megakernel, 512, SMEM_BYTES);
    if (per_cu < 1) per_cu = 1;
    if (per_cu > 1) per_cu = 1;
    grid_blocks = cus * per_cu;
  }
  Params p{};
  p.x = (const float*)d_in[0]; p.meta = (const float*)d_in[1]; p.norm_g = (const float*)d_in[2]; p.w_in = (const float*)d_in[3];
  p.w_out = (const float*)d_in[4]; p.ret_g = (const float*)d_in[5]; p.diff_g = (const float*)d_in[6];
  p.lq1 = (const float*)d_in[7]; p.lk1 = (const float*)d_in[8]; p.lq2 = (const float*)d_in[9]; p.lk2 = (const float*)d_in[10];
  p.fin_g = (const float*)d_in[11];
  p.out = (float*)d_out;
  char* ws = (char*)d_ws; size_t off = 0;
  auto take = [&](size_t bytes) { char* r = ws + off; off += (bytes + 255) & ~(size_t)255; return r; };
  p.ctr = (unsigned*)take(256);
  p.bar = (unsigned*)take((size_t)XCD_BAR_WORDS * 4);
  p.ss = (float*)take((size_t)2 * MROWS * 4);
  p.lam = (float*)take(256);
  p.WinT = (bf16_t*)take((size_t)2 * NIN * DM * 2);
  p.WoutT = (bf16_t*)take((size_t)2 * DM * DM * 2);
  p.h = (float*)take((size_t)MROWS * DM * 4);
  p.hb = (bf16_t*)take((size_t)MROWS * DM * 2);
  p.proj = (bf16_t*)take((size_t)MROWS * NIN * 2);
  p.T = (bf16_t*)take((size_t)4 * 3072 * LROW * 2);
  p.mix = (bf16_t*)take((size_t)MROWS * DM * 2);
  p.ST = (bf16_t*)take((size_t)32 * NCH * 32768);
  p.P2 = (float*)take((size_t)8 * 256 * DM * 4);
  hipMemsetAsync(p.ctr, 0, 256 + (size_t)XCD_BAR_WORDS * 4 + (size_t)2 * MROWS * 4, stream);
  void* args[] = {&p};
  hipError_t e = hipLaunchCooperativeKernel((void*)hymba_megakernel, dim3(grid_blocks), dim3(512), args, SMEM_BYTES, stream);
  if (e != hipSuccess) fprintf(stderr, "cooperative launch failed: %s (grid %d)\n", hipGetErrorString(e), grid_blocks);
}
```

```cpp
#include <hip/hip_runtime.h>
#include <hip/hip_cooperative_groups.h>
#include <cstdio>
namespace cg = cooperative_groups;

typedef unsigned short bf16_t;
typedef short bf16x8 __attribute__((ext_vector_type(8)));
typedef short s16x4 __attribute__((ext_vector_type(4)));
typedef float f32x4 __attribute__((ext_vector_type(4)));
typedef float f32x2 __attribute__((ext_vector_type(2)));
typedef unsigned u32x4 __attribute__((ext_vector_type(4)));
typedef unsigned u32x2 __attribute__((ext_vector_type(2)));
typedef __bf16 bf16x2_t __attribute__((ext_vector_type(2)));
#define DI __device__ __forceinline__
#define LAS __attribute__((address_space(3)))
#define MFMA16(a, b, c) __builtin_amdgcn_mfma_f32_16x16x32_bf16((a), (b), (c), 0, 0, 0)

constexpr int LROW = 2112;
constexpr int MROWS = 4 * LROW;
constexpr int DM = 2048;
constexpr int NIN = 8192;
constexpr int NCH = 33;
constexpr float LOG2E = 1.4426950408889634f;
constexpr int SMEM_BYTES = 147456 + 64;

struct Params {
  const float *x, *meta, *norm_g, *w_in, *w_out, *ret_g, *diff_g, *lq1, *lk1, *lq2, *lk2, *fin_g;
  float* out;
  bf16_t *WinT, *WoutT, *hb, *proj, *T, *mix, *ST;
  float *h, *ss, *lam, *P2;
  unsigned* ctr;
  unsigned* bar;
};

DI Params load_params() {
  const Params __attribute__((address_space(4)))* q = (const Params __attribute__((address_space(4)))*)__builtin_amdgcn_kernarg_segment_ptr();
  asm volatile("" : "+s"(q));
  Params r; __builtin_memcpy(&r, (const void*)q, sizeof(Params)); return r;
}
DI unsigned pk2(float a, float b) { f32x2 v = {a, b}; bf16x2_t r = __builtin_convertvector(v, bf16x2_t); return __builtin_bit_cast(unsigned, r); }
DI float bf2f(unsigned v16) { return __uint_as_float(v16 << 16); }
DI float bflo(unsigned u) { return __uint_as_float(u << 16); }
DI float bfhi(unsigned u) { return __uint_as_float(u & 0xffff0000u); }
DI int opaque_tid() { int t = threadIdx.x; asm volatile("" : "+v"(t)); return t; }
#define EXP2(x) __builtin_amdgcn_exp2f(x)
DI float xmax16(float x) { const u32x2 r = __builtin_amdgcn_permlane16_swap(__float_as_uint(x), __float_as_uint(x), false, false); return fmaxf(__uint_as_float(r[0]), __uint_as_float(r[1])); }
DI float xmax32(float x) { const u32x2 r = __builtin_amdgcn_permlane32_swap(__float_as_uint(x), __float_as_uint(x), false, false); return fmaxf(__uint_as_float(r[0]), __uint_as_float(r[1])); }
DI float silu(float v) { return v * __builtin_amdgcn_rcpf(1.f + __expf(-v)); }

DI int lds_byte(int r, int c) { int st = (r >> 4) * 2 + (c >> 5), rr = r & 15, cc = c & 31, ob = rr * 64 + cc * 2; return st * 1024 + (ob ^ (((ob >> 9) & 1) << 5)); }
DI int perm32(int rho) { const int n = rho >> 4, i = rho & 15; return 8 * (i >> 2) + 4 * n + (i & 3); }
DI void stage_rc(int b, int& R, int& C) { int st = b / 1024, sb = b % 1024, swz = sb ^ (((sb >> 9) & 1) << 5); R = (st >> 1) * 16 + swz / 64; C = (st & 1) * 32 + (swz % 64) / 2; }

DI void prep_weights(const Params& p, LAS unsigned char* lds, int ubeg, int uend, int wgi, int wgn, bool do_lam) {
  const int tid = opaque_tid();
  const int NTOT = uend;
  const int lrow = tid >> 6, c4 = (tid & 63) * 4;
  f32x4 r[8];
#define PREP_DECODE(u) const float* src; bf16_t* dst; int N; const float* g; int kt, ntile; \
    { const int _l = (u) >= 1280 ? 1 : 0, _v = (u) - _l * 1280; \
      if (_v < 1024) { kt = _v >> 5; ntile = _v & 31; src = p.w_in + (size_t)_l * DM * NIN; dst = p.WinT + (size_t)_l * NIN * DM; N = NIN; g = p.norm_g + _l * DM; } \
      else { const int q = _v - 1024; kt = q >> 3; ntile = q & 7; src = p.w_out + (size_t)_l * DM * DM; dst = p.WoutT + (size_t)_l * DM * DM; N = DM; g = nullptr; } } \
    const int k0 = kt * 64, n0 = ntile * 256;
#define PREP_LOAD(u) do { PREP_DECODE(u) (void)dst; _Pragma("unroll") for (int i = 0; i < 8; ++i) { const int kk = lrow + 8 * i; \
    const f32x4 v = *(const f32x4*)(src + (size_t)(k0 + kk) * N + n0 + c4); const float gg = g ? g[k0 + kk] : 1.f; r[i] = v * gg; } } while (0)
  int u = ubeg + wgi;
  if (u < NTOT) PREP_LOAD(u);
  for (; u < NTOT; u += wgn) {
#pragma unroll
    for (int i = 0; i < 8; ++i) *(LAS f32x4*)(lds + ((lrow + 8 * i) * 260 + c4) * 4) = r[i];
    __syncthreads();
    const int un = u + wgn;
    if (un < NTOT) PREP_LOAD(un);
    {
      PREP_DECODE(u) (void)src; (void)N; (void)g;
      const int n = tid >> 1, kh = (tid & 1) * 32;
      bf16_t* op = dst + (size_t)(n0 + n) * DM + k0 + kh;
#pragma unroll
      for (int q = 0; q < 4; ++q) {
        float f[8];
#pragma unroll
        for (int j = 0; j < 8; ++j) f[j] = *(const LAS float*)(lds + ((kh + q * 8 + j) * 260 + n) * 4);
        const u32x4 o = {pk2(f[0], f[1]), pk2(f[2], f[3]), pk2(f[4], f[5]), pk2(f[6], f[7])};
        *(u32x4*)(op + q * 8) = o;
      }
    }
    __syncthreads();
  }
#undef PREP_DECODE
#undef PREP_LOAD
  if (do_lam && blockIdx.x == 0 && tid < 64) {
    for (int l = 0; l < 2; ++l) {
      float a = p.lq1[l * 64 + tid] * p.lk1[l * 64 + tid], b = p.lq2[l * 64 + tid] * p.lk2[l * 64 + tid];
#pragma unroll
      for (int off = 32; off >= 1; off >>= 1) { a += __shfl_xor(a, off); b += __shfl_xor(b, off); }
      float li = 0.8f - 0.6f * expf(-0.3f * (float)l);
      if (tid == 0) p.lam[l] = expf(a) - expf(b) + li;
    }
  }
}

template <int MODE> DI void rownorm(const Params& p) {
  const int tid = opaque_tid(); const int wave = tid >> 6, lane = tid & 63;
  const int nw = gridDim.x * 8;
  for (int row = (MODE == 1 ? 8192 : 0) + blockIdx.x * 8 + wave; row < MROWS; row += nw) {
    const int b = row / LROW, pos = row - b * LROW;
    if (MODE == 2 && pos < 64) continue;
    const float* src;
    if (MODE <= 1) src = pos < 48 ? nullptr : (pos < 64 ? p.meta + (size_t)(pos - 48) * DM : p.x + ((size_t)b * 2048 + (pos - 64)) * DM);
    else src = p.h + (size_t)row * DM;
    float4 v[8]; float ss = 0.f;
#pragma unroll
    for (int i = 0; i < 8; ++i) {
      v[i] = src ? *(const float4*)(src + i * 256 + lane * 4) : make_float4(0.f, 0.f, 0.f, 0.f);
      if (MODE != 0 && row >= 8192) {
#pragma unroll
        for (int s = 0; s < 8; ++s) { const float4 q = *(const float4*)(p.P2 + ((size_t)s * 256 + (row - 8192)) * DM + i * 256 + lane * 4); v[i].x += q.x; v[i].y += q.y; v[i].z += q.z; v[i].w += q.w; }
      }
      ss += v[i].x * v[i].x + v[i].y * v[i].y + v[i].z * v[i].z + v[i].w * v[i].w;
    }
#pragma unroll
    for (int off = 32; off >= 1; off >>= 1) ss += __shfl_xor(ss, off);
    const float rs = rsqrtf(ss * (1.f / 2048.f) + 1e-6f);
    if (MODE < 2) {
#pragma unroll
      for (int i = 0; i < 8; ++i) {
        if (MODE == 1) *(float4*)(p.h + (size_t)row * DM + i * 256 + lane * 4) = v[i];
        uint2 o; o.x = pk2(v[i].x, v[i].y); o.y = pk2(v[i].z, v[i].w);
        *(uint2*)(p.hb + (size_t)row * DM + i * 256 + lane * 4) = o;
      }
      if (lane == 0) p.ss[(MODE == 0 ? 0 : 1) * MROWS + row] = ss;
    } else {
      float* dst = p.out + ((size_t)b * 2048 + (pos - 64)) * DM;
#pragma unroll
      for (int i = 0; i < 8; ++i) {
        float4 g = *(const float4*)(p.fin_g + i * 256 + lane * 4);
        float4 o; o.x = v[i].x * rs * g.x; o.y = v[i].y * rs * g.y; o.z = v[i].z * rs * g.z; o.w = v[i].w * rs * g.w;
        *(float4*)(dst + i * 256 + lane * 4) = o;
      }
    }
  }
}

constexpr int GK = 2048, GBK = 64, GHALF = 128, GHTB = GHALF * GBK * 2;
constexpr size_t TSTEP = (size_t)256 * GK * 2;
struct Unit { int mt, nt, tr, k0, nkt, nb; };

template <class Epi, class Sched>
DI void gemm_phase(LAS unsigned char* lds, const Sched& S, const Epi& E) {
  const int tid = opaque_tid(), wid = __builtin_amdgcn_readfirstlane(tid >> 6), lane = tid & 63, wr = wid >> 2, wc = wid & 3, fr = lane & 15, fq = lane >> 4;
  constexpr int K = GK;
  unsigned voffA[2], dperm;
#pragma unroll
  for (int i = 0; i < 2; ++i) { int R, C; stage_rc(tid * 16 + i * 8192, R, C); voffA[i] = (unsigned)(R * K + C) * 2u;
    if (i == 0) dperm = (unsigned)((perm32(R & 31) - (R & 31)) * K * 2); }
  const size_t kstep = (size_t)(GBK * 2);
  const size_t hstep = (size_t)GHALF * K * 2;
  const unsigned ldsw = (unsigned)wid * 1024u;
  const int aoff = lds_byte(wr * 64 + fr, fq * 8), boff = lds_byte(wc * 32 + fr, fq * 8);
#define G_SA(b, h) (((b) * 2 + (h)) * GHTB)
#define G_SB(b, h) ((4 + (b) * 2 + (h)) * GHTB)
#define G_STAGE(bufoff, gbase, voff) do { _Pragma("unroll") for (int _i = 0; _i < 2; ++_i) \
    __builtin_amdgcn_global_load_lds((const unsigned*)((const char*)(gbase) + voff[_i]), (LAS unsigned*)(lds + (bufoff) + ldsw + _i * 8192), 16, 0, 0); } while (0)
#define G_LDA(dst, b, h) do { _Pragma("unroll") for (int m = 0; m < 4; ++m) _Pragma("unroll") for (int k = 0; k < 2; ++k) dst[m][k] = *(const LAS bf16x8*)(lds + G_SA(b, h) + aoff + m * 2048 + k * 1024); } while (0)
#define G_LDB(dst, b, h) do { _Pragma("unroll") for (int n = 0; n < 2; ++n) _Pragma("unroll") for (int k = 0; k < 2; ++k) dst[n][k] = *(const LAS bf16x8*)(lds + G_SB(b, h) + boff + n * 2048 + k * 1024); } while (0)
#define G_MMA(ai, bj, At, Bx) do { __builtin_amdgcn_s_setprio(1); _Pragma("unroll") for (int m = 0; m < 4; ++m) _Pragma("unroll") for (int n = 0; n < 2; ++n) _Pragma("unroll") for (int k = 0; k < 2; ++k) \
    acc[ai][bj][m][n] = MFMA16(Bx[n][k], At[m][k], acc[ai][bj][m][n]); __builtin_amdgcn_s_setprio(0); } while (0)
#define G_WAIT_V(n) asm volatile("s_waitcnt vmcnt(" #n ")" ::: "memory")
#define G_WAIT_L(n) asm volatile("s_waitcnt lgkmcnt(" #n ")" ::: "memory")
#define G_BAR __builtin_amdgcn_s_barrier()
#define G_SCHED __builtin_amdgcn_sched_barrier(0)
  Unit cur, nxt; int ui = 0;
  if (!S.next(0, cur)) return;
  f32x4 acc[2][2][4][2];
  E.init(acc, cur, wr, wc, fr, fq, lds, 0);
  bf16x8 At[4][2], B0[2][2], B1[2][2];
  const char* cA = S.pa(cur); const char* cB = S.pb(cur);
  { const unsigned ds0 = cur.nb ? 0u : dperm; const unsigned vb[2] = {voffA[0] + ds0, voffA[1] + ds0};
  G_STAGE(G_SB(0, 0), cB, vb); G_STAGE(G_SA(0, 0), cA, voffA); G_STAGE(G_SB(0, 1), cB + hstep, vb); G_STAGE(G_SA(0, 1), cA + hstep, voffA);
  if (wr == 1) G_BAR;
  G_WAIT_V(4); G_BAR;
  G_STAGE(G_SB(1, 0), cB + kstep, vb); G_STAGE(G_SA(1, 0), cA + kstep, voffA); G_STAGE(G_SB(1, 1), cB + hstep + kstep, vb); }
  G_WAIT_V(6); G_BAR;
  for (;;) {
    const bool has_next = S.next(ui + 1, nxt);
    if (!has_next) nxt = cur;
    const char* nA = has_next ? S.pa(nxt) : cA; const char* nB = has_next ? S.pb(nxt) : cB;
    const int nt = cur.nkt;
    for (int t = 0; t < nt; t += 2) {
      const bool last = (t == nt - 2);
      const char* a1 = cA + (size_t)(t + 1) * kstep;
      const char* a2 = last ? nA : cA + (size_t)(t + 2) * kstep; const char* b2 = last ? nB : cB + (size_t)(t + 2) * kstep;
      const char* a3 = a2 + kstep; const char* b3 = b2 + kstep;
      const bool nbs = last ? (nxt.nb != 0) : (cur.nb != 0);
      const unsigned ds = nbs ? 0u : dperm; const unsigned vb[2] = {voffA[0] + ds, voffA[1] + ds};
      G_LDB(B0, 0, 0); G_SCHED; G_LDA(At, 0, 0); G_STAGE(G_SA(1, 1), a1 + hstep, voffA);
      G_WAIT_L(8); G_BAR; G_WAIT_L(0); G_MMA(0, 0, At, B0); G_BAR; G_SCHED;
      G_LDB(B1, 0, 1); G_STAGE(G_SB(0, 0), b2, vb);
      G_BAR; G_WAIT_L(0); G_MMA(0, 1, At, B1); G_BAR;
      G_LDA(At, 0, 1); G_STAGE(G_SA(0, 0), a2, voffA);
      G_BAR; G_WAIT_L(0); G_MMA(1, 0, At, B0); G_BAR; G_SCHED;
      G_STAGE(G_SB(0, 1), b2 + hstep, vb);
      G_WAIT_V(6); G_BAR; G_MMA(1, 1, At, B1); G_BAR;
      G_LDB(B0, 1, 0); G_SCHED; G_LDA(At, 1, 0); G_STAGE(G_SA(0, 1), a2 + hstep, voffA);
      G_WAIT_L(8); G_BAR; G_WAIT_L(0); G_MMA(0, 0, At, B0); G_BAR; G_SCHED;
      G_LDB(B1, 1, 1); G_STAGE(G_SB(1, 0), b3, vb);
      G_BAR; G_WAIT_L(0); G_MMA(0, 1, At, B1); G_BAR;
      G_LDA(At, 1, 1); G_STAGE(G_SA(1, 0), a3, voffA);
      G_BAR; G_WAIT_L(0); G_MMA(1, 0, At, B0); G_BAR; G_SCHED;
      G_STAGE(G_SB(1, 1), b3 + hstep, vb);
      G_WAIT_V(6); G_BAR; G_MMA(1, 1, At, B1); G_BAR;
    }
    { const int t2 = opaque_tid() & 63; E(acc, cur, wr, wc, t2 & 15, t2 >> 4, lds, ui & 1); }
    if (!has_next) break;
    cur = nxt; cA = nA; cB = nB; ++ui;
    { const int t3 = opaque_tid() & 63; E.init(acc, cur, wr, wc, t3 & 15, t3 >> 4, lds, ui & 1); }
  }
  G_WAIT_V(0);
  if (wr == 0) G_BAR;
  G_BAR;
}

#define XB_TMO      128
#define XB_XCNT(j)  (256  + 64 * (j))
#define XB_XSUB(j)  (1280 + 64 * (j))
#define XB_XGEN(j)  (2304 + 64 * (j))
#define XB_TOP      3328
#define XB_TOPGEN   3392
#define XCD_BAR_WORDS 3456
#define XB_SPIN_CAP (1u << 18)
DI unsigned xb_ld(unsigned* p) { return __hip_atomic_load(p, __ATOMIC_RELAXED, __HIP_MEMORY_SCOPE_AGENT); }
DI unsigned xb_add(unsigned* p, unsigned v) { return __hip_atomic_fetch_add(p, v, __ATOMIC_RELAXED, __HIP_MEMORY_SCOPE_AGENT); }
DI unsigned xb_xcc_id() { return (unsigned)__builtin_amdgcn_s_getreg((3 << 11) | 20) & 0xFu; }
#define XB_SPIN(cond, bar) do { unsigned _sp = 0; while (cond) { __builtin_amdgcn_s_sleep(1); \
    if ((++_sp & 255u) == 0u) { if (xb_ld(&(bar)[XB_TMO])) break; if (_sp > XB_SPIN_CAP) { atomicAdd(&(bar)[XB_TMO], 1u); break; } } } } while (0)
struct XcdBarrier { unsigned* bar; unsigned x; volatile LAS unsigned* st; };
DI XcdBarrier xcd_barrier_post(unsigned* bar, volatile LAS unsigned* st) {
  XcdBarrier b; b.bar = bar; b.x = xb_xcc_id(); b.st = st;
  if (threadIdx.x == 0) (void)xb_add(&bar[XB_XCNT(b.x)], 1u);
  return b;
}
DI void xcd_barrier_complete(unsigned* bar, unsigned x, unsigned& nloc, unsigned& nx) {
  const unsigned G = gridDim.x * gridDim.y * gridDim.z;
  unsigned sum, cnt, mine, sp = 0u;
  for (;;) {
    sum = 0u; cnt = 0u; mine = 0u;
#pragma unroll
    for (unsigned j = 0; j < 16; ++j) { const unsigned c = xb_ld(&bar[XB_XCNT(j)]); sum += c; cnt += (c > 0u) ? 1u : 0u; mine = (j == x) ? c : mine; }
    if (sum == G) break;
    __builtin_amdgcn_s_sleep(1);
    if ((++sp & 255u) == 0u) { if (xb_ld(&bar[XB_TMO])) break; if (sp > XB_SPIN_CAP) { atomicAdd(&bar[XB_TMO], 1u); break; } }
  }
  nloc = mine > 0u ? mine : 1u; nx = cnt > 0u ? cnt : 1u;
}
DI void xcd_barrier(const XcdBarrier& b) {
  asm volatile("s_waitcnt vmcnt(0)" ::: "memory");
  __syncthreads();
  if (threadIdx.x == 0) {
    unsigned* bar = b.bar;
    __builtin_amdgcn_s_waitcnt(0);
    unsigned nloc = b.st[0], nx = b.st[1];
    if (nloc == 0u) { xcd_barrier_complete(bar, b.x, nloc, nx); b.st[0] = nloc; b.st[1] = nx; }
    const unsigned old = xb_add(&bar[XB_XSUB(b.x)], 1u);
    const unsigned gen = old / nloc;
    if (old + 1u == (gen + 1u) * nloc) {
      __builtin_amdgcn_fence(__ATOMIC_RELEASE, "agent");
      asm volatile("s_waitcnt vmcnt(0)" ::: "memory");
      const unsigned og = xb_add(&bar[XB_TOP], 1u);
      const unsigned tg = og / nx;
      if (og + 1u == (tg + 1u) * nx) xb_add(&bar[XB_TOPGEN], 1u);
      else XB_SPIN(xb_ld(&bar[XB_TOPGEN]) == tg, bar);
      __builtin_amdgcn_fence(__ATOMIC_ACQUIRE, "agent");
      xb_add(&bar[XB_XGEN(b.x)], 1u);
      asm volatile("s_waitcnt vmcnt(0)" ::: "memory");
    } else {
      XB_SPIN(xb_ld(&bar[XB_XGEN(b.x)]) == gen, bar);
      __builtin_amdgcn_fence(__ATOMIC_ACQUIRE, "agent");
      asm volatile("s_waitcnt vmcnt(0)" ::: "memory");
    }
  }
  __syncthreads();
}

DI void tile_map(int wgid, int nM, int nN, int& pm, int& pn) {
  const int nwg = nM * nN;
  { int q = nwg / 8, r = nwg % 8, xcd = wgid % 8, off = wgid / 8; wgid = (xcd < r ? xcd * (q + 1) : r * (q + 1) + (xcd - r) * q) + off; }
  const int nig = 8 * nN, gid = wgid / nig, fm = gid * 8, gsz = min(nM - fm, 8);
  pm = fm + ((wgid % nig) % gsz); pn = (wgid % nig) / gsz;
}

struct Sched1 {
  const bf16_t* hb; const bf16_t* W; int ubeg, uend;
  DI bool next(int i, Unit& u) const {
    const int U = ubeg + i * (int)gridDim.x + (int)blockIdx.x; if (U >= uend) return false;
    int pm, pn;
    if (U < 928) tile_map(U, 29, 32, pm, pn);
    else if (U < 1024) { const int q = U - 928, c = q % 24; pm = 29 + q / 24; pn = c < 12 ? c : c + 4; }
    else { const int q = U - 1024, g = q & 7; pm = 29 + (q >> 3); pn = g < 4 ? 12 + g : 24 + g; }
    u.mt = pm; u.nt = pn; u.k0 = 0; u.nkt = 32; const int g = pn >> 2; u.tr = (g == 1 || g == 2 || g == 6) ? 1 : 0; u.nb = u.tr; return true;
  }
  DI const char* pa(const Unit& u) const { return u.tr ? (const char*)W + (size_t)u.nt * TSTEP : (const char*)hb + (size_t)u.mt * TSTEP; }
  DI const char* pb(const Unit& u) const { return u.tr ? (const char*)hb + (size_t)u.mt * TSTEP : (const char*)W + (size_t)u.nt * TSTEP; }
};
struct Sched2 {
  const bf16_t* mix; const bf16_t* W;
  DI bool next(int i, Unit& u) const {
    const int U = i * (int)gridDim.x + (int)blockIdx.x; if (U >= 256 + 64) return false;
    if (U < 256) { int pm, pn; tile_map(U, 32, 8, pm, pn); u.mt = pm; u.nt = pn; u.tr = 0; u.k0 = 0; u.nkt = 32; u.nb = 0; }
    else { const int j = U - 256; u.mt = 32; u.nt = j >> 3; u.tr = 1 + (j & 7); u.k0 = (j & 7) * 256; u.nkt = 4; u.nb = 0; }
    return true;
  }
  DI const char* pa(const Unit& u) const { return (const char*)mix + (size_t)u.mt * TSTEP + (size_t)u.k0 * 2; }
  DI const char* pb(const Unit& u) const { return (const char*)W + (size_t)u.nt * TSTEP + (size_t)u.k0 * 2; }
};

DI void acc_zero(f32x4 (&acc)[2][2][4][2]) {
#pragma unroll
  for (int a = 0; a < 2; ++a)
#pragma unroll
    for (int b = 0; b < 2; ++b)
#pragma unroll
      for (int m = 0; m < 4; ++m)
#pragma unroll
        for (int n = 0; n < 2; ++n) acc[a][b][m][n] = (f32x4){0.f, 0.f, 0.f, 0.f};
}
struct Epi1 {
  bf16_t* proj; bf16_t* T; const float* ss;
  DI void init(f32x4 (&acc)[2][2][4][2], const Unit& u, int wr, int wc, int fr, int fq, LAS unsigned char* lds, int par) const {
    acc_zero(acc);
    if (wr == 0)
      __builtin_amdgcn_global_load_lds((const unsigned*)(ss + u.mt * 256 + wc * 64 + fq * 16 + fr), (LAS unsigned*)(lds + 131072 + par * 1024 + wc * 256), 4, 0, 0);
  }
  DI void operator()(const f32x4 (&acc)[2][2][4][2], const Unit& u, int wr, int wc, int fr, int fq, LAS unsigned char* lds, int par) const {
    const LAS float* ssl = (const LAS float*)(lds + 131072 + par * 1024);
    const int g = u.nt >> 2;
    if (!u.tr) {
      const float sc = (g == 4) ? 0.125f * LOG2E : 1.f;
      const int n0 = u.nt * 256 + wc * 32 + fq * 8;
#pragma unroll
      for (int ai = 0; ai < 2; ++ai)
#pragma unroll
        for (int mi = 0; mi < 4; ++mi) {
          const int m = u.mt * 256 + ai * 128 + wr * 64 + mi * 16 + fr;
          const float rs = rsqrtf(ssl[ai * 128 + wr * 64 + mi * 16 + fr] * (1.f / 2048.f) + 1e-6f) * sc;
          bf16_t* rowp = proj + (size_t)m * NIN + n0;
#pragma unroll
          for (int bj = 0; bj < 2; ++bj) {
            const f32x4 a = acc[ai][bj][mi][0], c = acc[ai][bj][mi][1];
            const u32x4 o = {pk2(a[0] * rs, a[1] * rs), pk2(a[2] * rs, a[3] * rs), pk2(c[0] * rs, c[1] * rs), pk2(c[2] * rs, c[3] * rs)};
            *(u32x4*)(rowp + bj * 128) = o;
          }
        }
    } else {
      const int tbase = (g == 1 ? 0 : (g == 2 ? 1024 : 2048)) - g * 1024;
#pragma unroll
      for (int bj = 0; bj < 2; ++bj) {
        const int mb = u.mt * 256 + bj * 128 + wc * 32;
        const int b = mb / LROW, posb = mb - b * LROW;
        const f32x4 q0 = *(const LAS f32x4*)(ssl + bj * 128 + wc * 32 + 4 * fq), q1 = *(const LAS f32x4*)(ssl + bj * 128 + wc * 32 + 16 + 4 * fq);
        float rs[8];
#pragma unroll
        for (int j = 0; j < 4; ++j) { rs[j] = rsqrtf(q0[j] * (1.f / 2048.f) + 1e-6f); rs[4 + j] = rsqrtf(q1[j] * (1.f / 2048.f) + 1e-6f); }
        const int p0 = posb + 4 * fq, p1 = p0 + 16;
        if (g == 1) {
#pragma unroll
          for (int j = 0; j < 4; ++j) { rs[j] = (p0 + j >= 48) ? rs[j] * 0.08838834764831845f : 0.f; rs[4 + j] = (p1 + j >= 48) ? rs[4 + j] * 0.08838834764831845f : 0.f; }
        }
#pragma unroll
        for (int ai = 0; ai < 2; ++ai)
#pragma unroll
          for (int mi = 0; mi < 4; ++mi) {
            const int col = u.nt * 256 + ai * 128 + wr * 64 + mi * 16 + fr;
            const f32x4 a = acc[ai][bj][mi][0], c = acc[ai][bj][mi][1];
            float v[8] = {a[0] * rs[0], a[1] * rs[1], a[2] * rs[2], a[3] * rs[3], c[0] * rs[4], c[1] * rs[5], c[2] * rs[6], c[3] * rs[7]};
            if (g == 1) {
              const int hh = (col - 1024) >> 7;
              const float l2g = log2f(1.f - exp2f(-5.f - (float)hh));
              const int z0 = 63 - (p0 & 63), z1 = 63 - (p1 & 63);
#pragma unroll
              for (int j = 0; j < 4; ++j) { v[j] *= exp2f(l2g * (float)(z0 - j)); v[4 + j] *= exp2f(l2g * (float)(z1 - j)); }
            }
            const u32x4 o = {pk2(v[0], v[1]), pk2(v[2], v[3]), pk2(v[4], v[5]), pk2(v[6], v[7])};
            const int trow = (g == 1) ? (col & ~31) + 16 * ((col >> 2) & 1) + 4 * ((col >> 3) & 3) + (col & 3) : col;
            *(u32x4*)(T + ((size_t)(b * 3072 + tbase + trow)) * LROW + posb + 8 * fq) = o;
          }
      }
    }
  }
};
struct Epi2 {
  float* h; float* P2; bf16_t* hb; float* ssn; const float* x; const float* meta;
  DI void init(f32x4 (&acc)[2][2][4][2], const Unit& u, int wr, int wc, int fr, int fq, LAS unsigned char*, int) const {
    if (u.tr) { acc_zero(acc); return; }
    const int n0 = u.nt * 256 + wc * 32 + fq * 8;
#pragma unroll
    for (int ai = 0; ai < 2; ++ai)
#pragma unroll
      for (int mi = 0; mi < 4; ++mi) {
        const int m = u.mt * 256 + ai * 128 + wr * 64 + mi * 16 + fr;
        const float* rowp = h + (size_t)m * DM + n0;
        if (x) { const int b = m / LROW, pos = m - b * LROW; rowp = pos < 48 ? nullptr : (pos < 64 ? meta + (size_t)(pos - 48) * DM : x + ((size_t)b * 2048 + (pos - 64)) * DM) + n0; }
#pragma unroll
        for (int bj = 0; bj < 2; ++bj)
#pragma unroll
          for (int ni = 0; ni < 2; ++ni) acc[ai][bj][mi][ni] = rowp ? *(const f32x4*)(rowp + bj * 128 + ni * 4) : (f32x4){0.f, 0.f, 0.f, 0.f};
      }
  }
  DI void operator()(const f32x4 (&acc)[2][2][4][2], const Unit& u, int wr, int wc, int fr, int fq, LAS unsigned char*, int) const {
    const int n0 = u.nt * 256 + wc * 32 + fq * 8;
#pragma unroll
    for (int ai = 0; ai < 2; ++ai)
#pragma unroll
      for (int mi = 0; mi < 4; ++mi) {
        const int m = u.mt * 256 + ai * 128 + wr * 64 + mi * 16 + fr;
        float* rowp = (u.tr ? P2 + ((size_t)(u.tr - 1) * 256 + (m - 8192)) * DM : h + (size_t)m * DM) + n0;
        float sq = 0.f;
#pragma unroll
        for (int bj = 0; bj < 2; ++bj) {
          const f32x4 a = acc[ai][bj][mi][0], c = acc[ai][bj][mi][1];
          *(f32x4*)(rowp + bj * 128) = a; *(f32x4*)(rowp + bj * 128 + 4) = c;
          if (ssn && !u.tr) {
            sq += a[0] * a[0] + a[1] * a[1] + a[2] * a[2] + a[3] * a[3] + c[0] * c[0] + c[1] * c[1] + c[2] * c[2] + c[3] * c[3];
            const u32x4 o = {pk2(a[0], a[1]), pk2(a[2], a[3]), pk2(c[0], c[1]), pk2(c[2], c[3])};
            *(u32x4*)(hb + (size_t)m * DM + n0 + bj * 128) = o;
          }
        }
        if (ssn && !u.tr) {
          sq += __shfl_xor(sq, 16); sq += __shfl_xor(sq, 32);
          if (fq == 0) unsafeAtomicAdd(ssn + m, sq);
        }
      }
  }
};

DI void gemm1_phase(const Params& p, int l, LAS unsigned char* lds, int ubeg, int uend) {
  Sched1 S{p.hb, p.WinT + (size_t)l * NIN * DM, ubeg, uend}; Epi1 E{p.proj, p.T, p.ss + (size_t)l * MROWS};
  gemm_phase(lds, S, E);
}
DI void gemm2_phase(const Params& p, int l, LAS unsigned char* lds) {
  Sched2 S{p.mix, p.WoutT + (size_t)l * DM * DM}; Epi2 E{p.h, p.P2, p.hb, l == 0 ? p.ss + MROWS : nullptr, l == 0 ? p.x : nullptr, p.meta};
  gemm_phase(lds, S, E);
}

DI void ret_scan_chain(const Params& p, int b, int h, LAS unsigned char* lds, unsigned* done_ctr) {
  constexpr int D = 6;
  const int tid = opaque_tid(), w = __builtin_amdgcn_readfirstlane(tid >> 6), lane = tid & 63, fr = lane & 15, fq = lane >> 4;
  const float l2g = log2f(1.f - exp2f(-5.f - (float)h));
  const float dec64 = exp2f(l2g * 64.f);
  const int sub16 = lds_byte(fr, fq * 8);
  const int frow = ((tid >> 4) & 31) * 2 + ((tid >> 2) & 1), fcol = ((tid >> 3) & 1) * 32 + (tid & 3) * 8;
  const int fillT = lds_byte(frow, fcol);
  const bf16_t* gk = p.T + (size_t)b * 3072 * LROW + (size_t)(h * 128 + frow) * LROW + fcol;
  u32x4* so = (u32x4*)p.ST + ((size_t)((b * 8 + h) * NCH) * 8 + w) * 256 + lane;
  f32x4 st[8];
#pragma unroll
  for (int i = 0; i < 8; ++i) st[i] = (f32x4){0.f, 0.f, 0.f, 0.f};
  u32x4 ring[D][4];
#define SCAN_LOAD(slot, n) do { const bf16_t* _t = gk + (n) * 64; ring[slot][0] = *(const u32x4*)_t; ring[slot][1] = *(const u32x4*)(_t + (size_t)64 * LROW); \
    ring[slot][2] = *(const u32x4*)(_t + (size_t)1024 * LROW); ring[slot][3] = *(const u32x4*)(_t + (size_t)1088 * LROW); } while (0)
#define SCAN_STORE(n) do { _Pragma("unroll") for (int kd = 0; kd < 4; ++kd) { const f32x4 sa = st[2 * kd], sc = st[2 * kd + 1]; \
    const u32x4 bsu = {pk2(sa[0], sa[1]), pk2(sa[2], sa[3]), pk2(sc[0], sc[1]), pk2(sc[2], sc[3])}; so[(size_t)(n) * 2048 + kd * 64] = bsu; } } while (0)
#pragma unroll
  for (int i = 0; i < D; ++i) SCAN_LOAD(i, i);
#pragma unroll
  for (int n = 0; n < NCH - 1; ++n) {
    const int slot = n % D, bo = (n & 1) * 32768;
    *(LAS u32x4*)(lds + bo + fillT) = ring[slot][0]; *(LAS u32x4*)(lds + bo + fillT + 8192) = ring[slot][1];
    *(LAS u32x4*)(lds + bo + 16384 + fillT) = ring[slot][2]; *(LAS u32x4*)(lds + bo + 16384 + fillT + 8192) = ring[slot][3];
    if (n + D < NCH - 1) SCAN_LOAD(slot, n + D);
    __syncthreads();
    SCAN_STORE(n);
    const bf16x8 vf0 = *(const LAS bf16x8*)(lds + bo + 16384 + w * 2048 + sub16), vf1 = *(const LAS bf16x8*)(lds + bo + 16384 + w * 2048 + 1024 + sub16);
#pragma unroll
    for (int db = 0; db < 8; ++db) {
      st[db] *= dec64;
      const bf16x8 a0 = *(const LAS bf16x8*)(lds + bo + sub16 + db * 2048);
      const bf16x8 a1 = *(const LAS bf16x8*)(lds + bo + sub16 + db * 2048 + 1024);
      st[db] = MFMA16(a0, vf0, st[db]); st[db] = MFMA16(a1, vf1, st[db]);
    }
  }
  SCAN_STORE(NCH - 1);
  asm volatile("s_waitcnt vmcnt(0)" ::: "memory");
  __syncthreads();
  if (threadIdx.x == 0) { __builtin_amdgcn_fence(__ATOMIC_RELEASE, "agent"); asm volatile("s_waitcnt vmcnt(0)" ::: "memory"); xb_add(done_ctr, 1u); }
#undef SCAN_LOAD
#undef SCAN_STORE
}

DI void retention_items(const Params& p, int l, LAS unsigned char* lds, int first, int stride, int count) {
  constexpr int QS = 0, KS = 16384, VTS = 49152, PS = 65536, OS = 73728;
  const int tid = opaque_tid(), w = __builtin_amdgcn_readfirstlane(tid >> 6), lane = tid & 63, fr = lane & 15, fq = lane >> 4;
  const int sub16 = lds_byte(fr, fq * 8), sub8a = lds_byte(fr, fq * 4), sub8b = lds_byte(fr, fq * 4 + 16);
  const int tq = ((tid >> 5) & 15) * 2 + ((tid >> 2) & 1), dq = ((tid >> 4) & 1) * 64 + ((tid >> 3) & 1) * 32 + (tid & 3) * 8;
  const int ve = ((tid >> 4) & 31) * 2 + ((tid >> 2) & 1), vs0 = ((tid >> 3) & 1) * 32 + (tid & 3) * 8;
  const int fillQ = (dq >> 6) * 8192 + lds_byte(tq, dq & 63);
  const int fillT = lds_byte(ve, vs0);
  const int sb = w & 3, tb0 = (w >> 2) * 2;
  const int kbase = KS + sb * 2048 + sub16, qbase = QS + tb0 * 2048 + sub16;
  const int pbase = PS + tb0 * 2048 + (sb >> 1) * 1024 + lds_byte(fr, fq * 8 + 4 * (sb & 1));
  const int vbase = VTS + w * 2048 + sub16;
  const int obase = OS + ((fq * 4) * 132 + w * 16 + fr) * 4;
  const int nbase = OS + ((tid >> 3) * 132 + (tid & 7) * 16) * 4;
  u32x4 pq0, pq1, pk0, pk1, pv0, pv1, ns0, ns1, ns2, ns3, ng0, ng1;
#define RET_GLOAD(it) do { const int _bh = (it) / NCH, _n = (it) - _bh * NCH, _b = _bh >> 3, _h = _bh & 7; \
    const bf16_t* _q = p.proj + ((size_t)_b * LROW + _n * 64 + tq) * NIN + _h * 128 + dq; \
    const bf16_t* _tk = p.T + ((size_t)_b * 3072 + _h * 128 + (tid >> 3)) * LROW + _n * 64 + (tid & 7) * 8; \
    const bf16_t* _tv = p.T + ((size_t)_b * 3072 + 1024 + _h * 128 + ve) * LROW + _n * 64 + vs0; \
    pq0 = *(const u32x4*)_q; pq1 = *(const u32x4*)(_q + (size_t)32 * NIN); pk0 = *(const u32x4*)_tk; pk1 = *(const u32x4*)(_tk + (size_t)64 * LROW); \
    pv0 = *(const u32x4*)_tv; pv1 = *(const u32x4*)(_tv + (size_t)64 * LROW); \
    const u32x4* _sp = (const u32x4*)p.ST + ((size_t)(it) * 8 + w) * 256 + lane; ns0 = _sp[0]; ns1 = _sp[64]; ns2 = _sp[128]; ns3 = _sp[192]; \
    const bf16_t* _gp = p.proj + ((size_t)_b * LROW + _n * 64 + (tid >> 3)) * NIN + 3072 + _h * 128 + (tid & 7) * 16; \
    ng0 = *(const u32x4*)_gp; ng1 = *(const u32x4*)(_gp + 8); } while (0)
  int it = first;
  const int iend = first + stride * count;
  if (it < iend) RET_GLOAD(it);
  for (; it < iend; it += stride) {
    const int bh = it / NCH, n = it - bh * NCH, b = bh >> 3, h = bh & 7;
    const float l2g = log2f(1.f - exp2f(-5.f - (float)h));
    *(LAS u32x4*)(lds + QS + fillQ) = pq0; *(LAS u32x4*)(lds + QS + fillQ + 4096) = pq1;
    {
      const int d0 = tid >> 3, s0 = (tid & 7) * 8;
#pragma unroll
      for (int i = 0; i < 2; ++i) {
        const u32x4 kv = i ? pk1 : pk0;
        const int r_ = d0 + 64 * i, d = (r_ & ~31) + 8 * ((r_ >> 2) & 3) + 4 * ((r_ >> 4) & 1) + (r_ & 3), ko = KS + (d >> 6) * 8192;
#pragma unroll
        for (int j = 0; j < 8; ++j) {
          const unsigned wv = kv[j >> 1];
          const int st = (s0 & 32) + 16 * (j >> 2) + 4 * ((s0 >> 3) & 3) + (j & 3);
          *(LAS bf16_t*)(lds + ko + lds_byte(st, d & 63)) = (bf16_t)((j & 1) ? (wv >> 16) : (wv & 0xffffu));
        }
      }
    }
    *(LAS u32x4*)(lds + VTS + fillT) = pv0; *(LAS u32x4*)(lds + VTS + fillT + 8192) = pv1;
    const u32x4 sf0 = ns0, sf1 = ns1, sf2 = ns2, sf3 = ns3, g0 = ng0, g1 = ng1;
    __syncthreads();
    if (it + stride < iend) RET_GLOAD(it + stride);
    const size_t row = (size_t)b * LROW + n * 64 + (tid >> 3);
    {
      f32x4 s0 = {0.f, 0.f, 0.f, 0.f}, s1 = {0.f, 0.f, 0.f, 0.f};
#pragma unroll
      for (int ks = 0; ks < 4; ++ks) {
        const int off = (ks >> 1) * 8192 + (ks & 1) * 1024;
        const bf16x8 a = *(const LAS bf16x8*)(lds + kbase + off);
        const bf16x8 b0 = *(const LAS bf16x8*)(lds + qbase + off);
        const bf16x8 b1 = *(const LAS bf16x8*)(lds + qbase + off + 2048);
        s0 = MFMA16(a, b0, s0); s1 = MFMA16(a, b1, s1);
      }
      const int srow = sb * 16 + fq * 4;
#pragma unroll
      for (int i = 0; i < 2; ++i) {
        const f32x4 sv = i ? s1 : s0;
        const int t = (tb0 + i) * 16 + fr;
        const float v0 = sv[0] * EXP2(l2g * (fabsf((float)(t - srow)) - (float)(63 - srow))), v1 = sv[1] * EXP2(l2g * (fabsf((float)(t - srow - 1)) - (float)(62 - srow)));
        const float v2 = sv[2] * EXP2(l2g * (fabsf((float)(t - srow - 2)) - (float)(61 - srow))), v3 = sv[3] * EXP2(l2g * (fabsf((float)(t - srow - 3)) - (float)(60 - srow)));
        const u32x2 o = {pk2(v0, v1), pk2(v2, v3)};
        *(LAS u32x2*)(lds + pbase + i * 2048) = o;
      }
    }
    __syncthreads();
    {
      const bf16x8 vf0 = *(const LAS bf16x8*)(lds + vbase), vf1 = *(const LAS bf16x8*)(lds + vbase + 1024);
      f32x4 o[4], cr[4];
#pragma unroll
      for (int tb = 0; tb < 4; ++tb) {
        o[tb] = (f32x4){0.f, 0.f, 0.f, 0.f}; cr[tb] = (f32x4){0.f, 0.f, 0.f, 0.f};
        const bf16x8 a0 = *(const LAS bf16x8*)(lds + PS + sub16 + tb * 2048);
        const bf16x8 a1 = *(const LAS bf16x8*)(lds + PS + sub16 + tb * 2048 + 1024);
        o[tb] = MFMA16(a0, vf0, o[tb]); o[tb] = MFMA16(a1, vf1, o[tb]);
      }
#pragma unroll
      for (int kd = 0; kd < 4; ++kd) {
        const bf16x8 bsv = __builtin_bit_cast(bf16x8, kd == 0 ? sf0 : (kd == 1 ? sf1 : (kd == 2 ? sf2 : sf3)));
#pragma unroll
        for (int tb = 0; tb < 4; ++tb) {
          const bf16x8 a = *(const LAS bf16x8*)(lds + QS + (kd >> 1) * 8192 + (tb * 2 + (kd & 1)) * 1024 + sub16);
          cr[tb] = MFMA16(a, bsv, cr[tb]);
        }
      }
#pragma unroll
      for (int tb = 0; tb < 4; ++tb)
#pragma unroll
        for (int j = 0; j < 4; ++j) o[tb][j] += EXP2(l2g * (float)(tb * 16 + fq * 4 + j + 1)) * cr[tb][j];
#pragma unroll
      for (int tb = 0; tb < 4; ++tb)
#pragma unroll
        for (int j = 0; j < 4; ++j) *(LAS float*)(lds + obase + (tb * 16 + j) * 528) = o[tb][j];
    }
    __syncthreads();
    {
      const int seg = tid & 7;
      const f32x4 x0 = *(const LAS f32x4*)(lds + nbase), x1 = *(const LAS f32x4*)(lds + nbase + 16), x2 = *(const LAS f32x4*)(lds + nbase + 32), x3 = *(const LAS f32x4*)(lds + nbase + 48);
      f32x4 xs = x0 + x1 + x2 + x3;
      float sum = xs[0] + xs[1] + xs[2] + xs[3];
      sum += __shfl_xor(sum, 1); sum += __shfl_xor(sum, 2); sum += __shfl_xor(sum, 4);
      const float mu = sum * (1.f / 128.f);
      const f32x4 d0 = x0 - mu, d1 = x1 - mu, d2 = x2 - mu, d3 = x3 - mu;
      const f32x4 q = d0 * d0 + d1 * d1 + d2 * d2 + d3 * d3;
      float vs = q[0] + q[1] + q[2] + q[3];
      vs += __shfl_xor(vs, 1); vs += __shfl_xor(vs, 2); vs += __shfl_xor(vs, 4);
      const float rn = rsqrtf(vs * (1.f / 128.f) + 1e-6f);
      const float* gr = p.ret_g + l * 1024 + h * 128 + seg * 16;
      const f32x4 w0 = *(const f32x4*)gr, w1 = *(const f32x4*)(gr + 4), w2 = *(const f32x4*)(gr + 8), w3 = *(const f32x4*)(gr + 12);
      uint4 oa, ob;
      oa.x = pk2(d0[0] * rn * w0[0] * silu(bflo(g0[0])), d0[1] * rn * w0[1] * silu(bfhi(g0[0])));
      oa.y = pk2(d0[2] * rn * w0[2] * silu(bflo(g0[1])), d0[3] * rn * w0[3] * silu(bfhi(g0[1])));
      oa.z = pk2(d1[0] * rn * w1[0] * silu(bflo(g0[2])), d1[1] * rn * w1[1] * silu(bfhi(g0[2])));
      oa.w = pk2(d1[2] * rn * w1[2] * silu(bflo(g0[3])), d1[3] * rn * w1[3] * silu(bfhi(g0[3])));
      ob.x = pk2(d2[0] * rn * w2[0] * silu(bflo(g1[0])), d2[1] * rn * w2[1] * silu(bfhi(g1[0])));
      ob.y = pk2(d2[2] * rn * w2[2] * silu(bflo(g1[1])), d2[3] * rn * w2[3] * silu(bfhi(g1[1])));
      ob.z = pk2(d3[0] * rn * w3[0] * silu(bflo(g1[2])), d3[1] * rn * w3[1] * silu(bfhi(g1[2])));
      ob.w = pk2(d3[2] * rn * w3[2] * silu(bflo(g1[3])), d3[3] * rn * w3[3] * silu(bfhi(g1[3])));
      bf16_t* mp = p.mix + row * DM + h * 128 + seg * 16;
      *(uint4*)mp = oa; *(uint4*)(mp + 8) = ob;
    }
  }
#undef RET_GLOAD
}

DI void diff_pv(LAS unsigned char* lds, int vgb, const bf16x8 (&pfr)[2][2], f32x4 (&o)[2][8], int sub16) {
  __builtin_amdgcn_s_setprio(1);
#pragma unroll
  for (int eb = 0; eb < 8; ++eb)
#pragma unroll
    for (int kp = 0; kp < 2; ++kp) {
      const bf16x8 a = *(const LAS bf16x8*)(lds + vgb + (eb * 2 + kp) * 1024 + sub16);
      o[0][eb] = MFMA16(a, pfr[0][kp], o[0][eb]);
      o[1][eb] = MFMA16(a, pfr[1][kp], o[1][eb]);
    }
  __builtin_amdgcn_s_setprio(0);
}
DI void diff_tile(bool general, LAS unsigned char* lds, int kfb, const bf16x8 (&qf)[2][2], f32x4 (&o)[2][8], bf16x8 (&pfr)[2][2], float& m0, float& m1, float& l0, float& l1,
                  const f32x4 (&cj)[4], float slope2, int kt, int qrow, int fq) {
  f32x4 s[2][4];
#pragma unroll
  for (int kb = 0; kb < 4; ++kb) {
    const f32x4 init = cj[kb];
    const bf16x8 a0 = *(const LAS bf16x8*)(lds + kfb + (kb * 2) * 1024);
    const bf16x8 a1 = *(const LAS bf16x8*)(lds + kfb + (kb * 2 + 1) * 1024);
    s[0][kb] = MFMA16(a0, qf[0][0], init); s[1][kb] = MFMA16(a0, qf[1][0], init);
    s[0][kb] = MFMA16(a1, qf[0][1], s[0][kb]); s[1][kb] = MFMA16(a1, qf[1][1], s[1][kb]);
  }
  const float tconst = slope2 * (float)(kt * 64);
#pragma unroll
  for (int rb = 0; rb < 2; ++rb) {
    if (general) {
      const int qrel = qrow + rb * 16 - kt * 64;
      const float ms2 = -2.f * slope2;
#pragma unroll
      for (int kb = 0; kb < 4; ++kb)
#pragma unroll
        for (int j = 0; j < 4; ++j) {
          const int kl = kb * 16 + fq * 4 + j;
          float v = s[rb][kb][j] + ms2 * (float)max(kl - qrel, 0);
          if (kt == 0 && kl < 48) v = -INFINITY;
          s[rb][kb][j] = v;
        }
    }
    float mx = fmaxf(fmaxf(s[rb][0][0], s[rb][0][1]), fmaxf(s[rb][0][2], s[rb][0][3]));
#pragma unroll
    for (int kb = 1; kb < 4; ++kb) mx = fmaxf(fmaxf(mx, fmaxf(s[rb][kb][0], s[rb][kb][1])), fmaxf(s[rb][kb][2], s[rb][kb][3]));
    mx = xmax32(xmax16(mx));
    const float mloc = (rb ? m1 : m0) - tconst;
    float mnew = mloc, alpha = 1.f;
    if (!__all(mx <= mloc + 8.f)) {
      mnew = fmaxf(mloc, mx); alpha = EXP2(mloc - mnew);
#pragma unroll
      for (int eb = 0; eb < 8; ++eb) o[rb][eb] *= alpha;
    }
    float rsum = 0.f;
#pragma unroll
    for (int kb = 0; kb < 4; ++kb)
#pragma unroll
      for (int j = 0; j < 4; ++j) { const float pv = EXP2(s[rb][kb][j] - mnew); s[rb][kb][j] = pv; rsum += pv; }
    if (rb) { l1 = l1 * alpha + rsum; m1 = mnew + tconst; } else { l0 = l0 * alpha + rsum; m0 = mnew + tconst; }
#pragma unroll
    for (int kp = 0; kp < 2; ++kp) {
      const f32x4 sa = s[rb][2 * kp], sc = s[rb][2 * kp + 1];
      const u32x4 pbu = {pk2(sa[0], sa[1]), pk2(sa[2], sa[3]), pk2(sc[0], sc[1]), pk2(sc[2], sc[3])};
      pfr[rb][kp] = __builtin_bit_cast(bf16x8, pbu);
    }
  }
}

DI void diff_item(const Params& p, int l, int b, int h, int pi, float lam, float lam_init, LAS unsigned char* lds, bool& gsync) {
  const int tid = opaque_tid(), w = __builtin_amdgcn_readfirstlane(tid >> 6), lane = tid & 63, fr = lane & 15, fq = lane >> 4;
  const int c = w & 1, rgq = w >> 1, qc = 2 * pi + (rgq >> 1);
  const bool active = qc <= 32;
  const int ktmax = min(2 * pi + 1, 32);
  const int sub16 = lds_byte(fr, fq * 8), sub8a = lds_byte(fr, fq * 4), sub8b = lds_byte(fr, fq * 4 + 16);
  const bf16_t* projb = p.proj + (size_t)b * LROW * NIN;
  const int qrow = qc * 64 + (rgq & 1) * 32 + fr;
  bf16x8 qf[2][2];
#pragma unroll
  for (int rb = 0; rb < 2; ++rb)
#pragma unroll
    for (int ks = 0; ks < 2; ++ks)
      qf[rb][ks] = active ? *(const bf16x8*)(projb + (size_t)(qrow + rb * 16) * NIN + 4096 + h * 128 + c * 64 + ks * 32 + fq * 8) : (bf16x8){0, 0, 0, 0, 0, 0, 0, 0};
  float m0 = -INFINITY, m1 = -INFINITY, l0 = 0.f, l1 = 0.f;
  f32x4 o[2][8];
#pragma unroll
  for (int rb = 0; rb < 2; ++rb)
#pragma unroll
    for (int eb = 0; eb < 8; ++eb) o[rb][eb] = (f32x4){0.f, 0.f, 0.f, 0.f};
  const float slope2 = exp2f(-(float)(h + 1)) * LOG2E;
  f32x4 cj[4];
#pragma unroll
  for (int kb = 0; kb < 4; ++kb)
#pragma unroll
    for (int j = 0; j < 4; ++j) cj[kb][j] = slope2 * (float)(kb * 16 + fq * 4 + j);
  const int dswz = (lane * 16) ^ ((((lane * 16) >> 9) & 1) << 5), drr = dswz >> 6, dcc = (dswz & 63) >> 1;
  const bf16_t* gk = projb + (size_t)((w & 3) * 16 + drr) * NIN + 5120 + h * 128 + (w >> 2) * 64 + dcc;
  const bf16_t* gv = p.T + (size_t)b * 3072 * LROW + (size_t)(2048 + h * 128 + w * 16 + drr) * LROW + dcc;
  const int kdst = (w >> 2) * 8192 + (w & 3) * 2048, vdst = 32768 + w * 2048;
#define DIFF_DMA(kt, kb_, vs_) do { const bf16_t* _k = gk + (size_t)(kt) * 64 * NIN; const bf16_t* _v = gv + (kt) * 64; \
    __builtin_amdgcn_global_load_lds((const unsigned*)_k, (LAS unsigned*)(lds + (kb_) + kdst), 16, 0, 0); \
    __builtin_amdgcn_global_load_lds((const unsigned*)(_k + 32), (LAS unsigned*)(lds + (kb_) + kdst + 1024), 16, 0, 0); \
    __builtin_amdgcn_global_load_lds((const unsigned*)_v, (LAS unsigned*)(lds + (vs_) + vdst), 16, 0, 0); \
    __builtin_amdgcn_global_load_lds((const unsigned*)(_v + 32), (LAS unsigned*)(lds + (vs_) + vdst + 1024), 16, 0, 0); } while (0)
  DIFF_DMA(0, 0, 0);
  asm volatile("s_waitcnt vmcnt(0)" ::: "memory");
  __syncthreads();
  const int kfb0 = c * 8192 + sub16;
  const bool stag = (w >> 2) != 0;
  bf16x8 pfr[2][2];
  int vs = 0;
  for (int kt = 0; kt <= ktmax; ++kt) {
    const int kb = (kt & 1) * 16384;
    const int vsn = vs == 32768 ? 0 : vs + 16384;
    if (kt + 1 <= ktmax) DIFF_DMA(kt + 1, 16384 - kb, vsn);
    if (active && kt <= qc) {
      if (stag && kt > 0) diff_pv(lds, 32768 + (vs == 0 ? 32768 : vs - 16384), pfr, o, sub16);
      diff_tile(kt == 0 || kt == qc, lds, kfb0 + kb, qf, o, pfr, m0, m1, l0, l1, cj, slope2, kt, qrow, fq);
      if (!stag) diff_pv(lds, 32768 + vs, pfr, o, sub16);
    }
    vs = vsn;
    asm volatile("s_waitcnt vmcnt(0)" ::: "memory");
    __syncthreads();
  }
  if (active && stag) { const int lastslot = (qc % 3) * 16384; diff_pv(lds, 32768 + lastslot, pfr, o, sub16); }
#undef DIFF_DMA
  l0 += __shfl_xor(l0, 16); l0 += __shfl_xor(l0, 32);
  l1 += __shfl_xor(l1, 16); l1 += __shfl_xor(l1, 32);
  const int xb = 81920 + rgq * 16384 + lane * 4;
  if (c == 1 && active) {
#pragma unroll
    for (int rb = 0; rb < 2; ++rb) {
      const float inv = lam / (rb ? l1 : l0);
#pragma unroll
      for (int eb = 0; eb < 8; ++eb)
#pragma unroll
        for (int j = 0; j < 4; ++j) *(LAS float*)(lds + xb + ((rb * 8 + eb) * 4 + j) * 256) = o[rb][eb][j] * inv;
    }
  }
  if (!gsync && tid == 0) { unsigned sp = 0; while (xb_ld(p.ctr + 32 + l) < 32u && ++sp < (1u << 22)) __builtin_amdgcn_s_sleep(2); }
  __syncthreads();
  if (!gsync) { __builtin_amdgcn_fence(__ATOMIC_ACQUIRE, "agent"); gsync = true; }
  if (c == 0 && active) {
#pragma unroll
    for (int rb = 0; rb < 2; ++rb) {
      const float inv = 1.f / (rb ? l1 : l0);
      float ss = 0.f;
#pragma unroll
      for (int eb = 0; eb < 8; ++eb)
#pragma unroll
        for (int j = 0; j < 4; ++j) { const float d = o[rb][eb][j] * inv - *(const LAS float*)(lds + xb + ((rb * 8 + eb) * 4 + j) * 256); o[rb][eb][j] = d; ss += d * d; }
      ss += __shfl_xor(ss, 16); ss += __shfl_xor(ss, 32);
      const float rn = rsqrtf(ss * (1.f / 128.f) + 1e-6f) * (1.f - lam_init);
      const size_t row = (size_t)b * LROW + qrow + rb * 16;
#pragma unroll
      for (int eb = 0; eb < 8; ++eb) {
        const int e0 = h * 128 + eb * 16 + fq * 4;
        const uint2 gu = *(const uint2*)(p.proj + row * NIN + 7168 + e0);
        const float4 gg = *(const float4*)(p.diff_g + l * 1024 + e0);
        const float y0 = o[rb][eb][0] * rn * gg.x * silu(bflo(gu.x)), y1 = o[rb][eb][1] * rn * gg.y * silu(bfhi(gu.x));
        const float y2 = o[rb][eb][2] * rn * gg.z * silu(bflo(gu.y)), y3 = o[rb][eb][3] * rn * gg.w * silu(bfhi(gu.y));
        uint2 ov; ov.x = pk2(y0, y1); ov.y = pk2(y2, y3);
        *(uint2*)(p.mix + row * DM + 1024 + e0) = ov;
      }
    }
  }
}

DI void mixer_phase(const Params& p, int l, LAS unsigned char* lds) {
  volatile LAS int* s_item = (volatile LAS int*)(lds + 147456);
  const float lam = p.lam[l];
  const float lam_init = 0.8f - 0.6f * expf(-0.3f * (float)l);
  for (int c = (int)blockIdx.x - 32; c >= 0 && c < 32; c += (int)gridDim.x) ret_scan_chain(p, c >> 3, c & 7, lds, p.ctr + 34 + l);
  const int xcd = blockIdx.x & 7;
  bool gsync = false, rsync = false;
  for (;;) {
    if (threadIdx.x == 0) *s_item = (int)atomicAdd(p.ctr + l * 8 + xcd, 1u);
    __syncthreads();
    const int it = *s_item;
    __syncthreads();
    if (it >= 68 + 22) break;
    if (it < 48 || it >= 70) {
      const int ai = it < 48 ? it : it - 22;
      const int bh = 4 * xcd + (ai & 3);
      diff_item(p, l, bh >> 3, bh & 7, 16 - (ai >> 2), lam, lam_init, lds, gsync);
    } else {
      if (!rsync) {
        if (threadIdx.x == 0) { unsigned sp = 0; while ((xb_ld(p.ctr + 34 + l) < 32u || xb_ld(p.ctr + 32 + l) < 32u) && ++sp < (1u << 22)) __builtin_amdgcn_s_sleep(2); }
        __syncthreads();
        __builtin_amdgcn_fence(__ATOMIC_ACQUIRE, "agent");
        rsync = true; gsync = true;
      }
      retention_items(p, l, lds, xcd + 48 * (it - 48), 8, 6);
      __syncthreads();
    }
  }
}

__global__ void __launch_bounds__(512) hymba_megakernel(Params p_unused) {
  cg::grid_group grid = cg::this_grid();
  extern __shared__ __attribute__((aligned(16))) char smem[];
  LAS unsigned char* lds = (LAS unsigned char*)smem;
  volatile LAS unsigned* xst = (volatile LAS unsigned*)(lds + 147456 + 16);
  if (threadIdx.x == 0) { xst[0] = 0u; xst[1] = 0u; }
  __syncthreads();
  XcdBarrier xb;
  { const Params p = load_params(); xb = xcd_barrier_post(p.bar, xst); }
  { const Params p = load_params(); prep_weights(p, lds, 0, 1792, blockIdx.x, gridDim.x, true); }
  { const Params p = load_params(); rownorm<0>(p); }
  grid.sync();
  for (int l = 0; l < 2; ++l) {
    { const Params p = load_params(); gemm1_phase(p, l, lds, 0, 1024); }
    xcd_barrier(xb);
    if (blockIdx.x < 32) {
      const Params p = load_params();
      gemm1_phase(p, l, lds, 1024, 1056);
      if (threadIdx.x == 0) {
        int nl = 0; for (int U = 1024 + (int)blockIdx.x; U < 1056; U += (int)gridDim.x) ++nl;
        __builtin_amdgcn_fence(__ATOMIC_RELEASE, "agent");
        asm volatile("s_waitcnt vmcnt(0)" ::: "memory");
        xb_add(p.ctr + 32 + l, (unsigned)nl);
      }
    }
    { const Params p = load_params(); mixer_phase(p, l, lds); }
    xcd_barrier(xb);
    { const Params p = load_params(); gemm2_phase(p, l, lds); }
    if (l == 0) { const Params p = load_params(); if (gridDim.x > 64) { if (blockIdx.x >= 64) prep_weights(p, lds, 1792, 2560, blockIdx.x - 64, gridDim.x - 64, false); } else prep_weights(p, lds, 1792, 2560, blockIdx.x, gridDim.x, false); }
    xcd_barrier(xb);
    if (l == 0) { { const Params p = load_params(); rownorm<1>(p); } xcd_barrier(xb); }
    else { const Params p = load_params(); rownorm<2>(p); }
  }
}

extern "C" void kernel_launch(void* const* d_in, const int* in_sizes, int n_in, void* d_out, int out_size, void* d_ws, size_t ws_size, hipStream_t stream) {
  static int grid_blocks = 0;
  if (!grid_blocks) {
    int dev = 0, cus = 0, per_cu = 0;
    hipGetDevice(&dev);
    hipDeviceGetAttribute(&cus, hipDeviceAttributeMultiprocessorCount, dev);
    hipFuncSetAttribute((const void*)hymba_megakernel, hipFuncAttributeMaxDynamicSharedMemorySize, SMEM_BYTES);
    hipOccupancyMaxActiveBlocksPerMultiprocessor(&per_cu, hymba_megakernel, 512, SMEM_BYTES);
    if (per_cu < 1) per_cu = 1;
    if (per_cu > 1) per_cu = 1;
    grid_blocks = cus * per_cu;
  }
  Params p{};
  p.x = (const float*)d_in[0]; p.meta = (const float*)d_in[1]; p.norm_g = (const float*)d_in[2]; p.w_in = (const float*)d_in[3];
  p.w_out = (const float*)d_in[4]; p.ret_g = (const float*)d_in[5]; p.diff_g = (const float*)d_in[6];
  p.lq1 = (const float*)d_in[7]; p.lk1 = (const float*)d_in[8]; p.lq2 = (const float*)d_in[9]; p.lk2 = (const float*)d_in[10];
  p.fin_g = (const float*)d_in[11];
  p.out = (float*)d_out;
  char* ws = (char*)d_ws; size_t off = 0;
  auto take = [&](size_t bytes) { char* r = ws + off; off += (bytes + 255) & ~(size_t)255; return r; };
  p.ctr = (unsigned*)take(256);
  p.bar = (unsigned*)take((size_t)XCD_BAR_WORDS * 4);
  p.ss = (float*)take((size_t)2 * MROWS * 4);
  p.lam = (float*)take(256);
  p.WinT = (bf16_t*)take((size_t)2 * NIN * DM * 2);
  p.WoutT = (bf16_t*)take((size_t)2 * DM * DM * 2);
  p.h = (float*)take((size_t)MROWS * DM * 4);
  p.hb = (bf16_t*)take((size_t)MROWS * DM * 2);
  p.proj = (bf16_t*)take((size_t)MROWS * NIN * 2);
  p.T = (bf16_t*)take((size_t)4 * 3072 * LROW * 2);
  p.mix = (bf16_t*)take((size_t)MROWS * DM * 2);
  p.ST = (bf16_t*)take((size_t)32 * NCH * 32768);
  p.P2 = (float*)take((size_t)8 * 256 * DM * 4);
  hipMemsetAsync(p.ctr, 0, 256 + (size_t)XCD_BAR_WORDS * 4 + (size_t)2 * MROWS * 4, stream);
  void* args[] = {&p};
  hipError_t e = hipLaunchCooperativeKernel((void*)hymba_megakernel, dim3(grid_blocks), dim3(512), args, SMEM_BYTES, stream);
  if (e != hipSuccess) fprintf(stderr, "cooperative launch failed: %s (grid %d)\n", hipGetErrorString(e), grid_blocks);
}
```

```cpp
#include <hip/hip_runtime.h>
#include <hip/hip_cooperative_groups.h>
#include <cstdio>
namespace cg = cooperative_groups;

typedef unsigned short bf16_t;
typedef short bf16x8 __attribute__((ext_vector_type(8)));
typedef short s16x4 __attribute__((ext_vector_type(4)));
typedef float f32x4 __attribute__((ext_vector_type(4)));
typedef float f32x2 __attribute__((ext_vector_type(2)));
typedef unsigned u32x4 __attribute__((ext_vector_type(4)));
typedef unsigned u32x2 __attribute__((ext_vector_type(2)));
typedef __bf16 bf16x2_t __attribute__((ext_vector_type(2)));
#define DI __device__ __forceinline__
#define LAS __attribute__((address_space(3)))
#define MFMA16(a, b, c) __builtin_amdgcn_mfma_f32_16x16x32_bf16((a), (b), (c), 0, 0, 0)

constexpr int LROW = 2112;
constexpr int MROWS = 4 * LROW;
constexpr int DM = 2048;
constexpr int NIN = 8192;
constexpr int NCH = 33;
constexpr float LOG2E = 1.4426950408889634f;
constexpr int SMEM_BYTES = 147456 + 64;

struct Params {
  const float *x, *meta, *norm_g, *w_in, *w_out, *ret_g, *diff_g, *lq1, *lk1, *lq2, *lk2, *fin_g;
  float* out;
  bf16_t *WinT, *WoutT, *hb, *proj, *T, *mix, *ST;
  float *h, *ss, *lam, *P2;
  unsigned* ctr;
  unsigned* bar;
};

DI Params load_params() {
  const Params __attribute__((address_space(4)))* q = (const Params __attribute__((address_space(4)))*)__builtin_amdgcn_kernarg_segment_ptr();
  asm volatile("" : "+s"(q));
  Params r; __builtin_memcpy(&r, (const void*)q, sizeof(Params)); return r;
}
DI unsigned pk2(float a, float b) { f32x2 v = {a, b}; bf16x2_t r = __builtin_convertvector(v, bf16x2_t); return __builtin_bit_cast(unsigned, r); }
DI float bf2f(unsigned v16) { return __uint_as_float(v16 << 16); }
DI float bflo(unsigned u) { return __uint_as_float(u << 16); }
DI float bfhi(unsigned u) { return __uint_as_float(u & 0xffff0000u); }
DI int opaque_tid() { int t = threadIdx.x; asm volatile("" : "+v"(t)); return t; }
#define EXP2(x) __builtin_amdgcn_exp2f(x)
DI float xmax16(float x) { const u32x2 r = __builtin_amdgcn_permlane16_swap(__float_as_uint(x), __float_as_uint(x), false, false); return fmaxf(__uint_as_float(r[0]), __uint_as_float(r[1])); }
DI float xmax32(float x) { const u32x2 r = __builtin_amdgcn_permlane32_swap(__float_as_uint(x), __float_as_uint(x), false, false); return fmaxf(__uint_as_float(r[0]), __uint_as_float(r[1])); }
DI float silu(float v) { return v * __builtin_amdgcn_rcpf(1.f + __expf(-v)); }

DI int lds_byte(int r, int c) { int st = (r >> 4) * 2 + (c >> 5), rr = r & 15, cc = c & 31, ob = rr * 64 + cc * 2; return st * 1024 + (ob ^ (((ob >> 9) & 1) << 5)); }
DI int perm32(int rho) { const int n = rho >> 4, i = rho & 15; return 8 * (i >> 2) + 4 * n + (i & 3); }
DI void stage_rc(int b, int& R, int& C) { int st = b / 1024, sb = b % 1024, swz = sb ^ (((sb >> 9) & 1) << 5); R = (st >> 1) * 16 + swz / 64; C = (st & 1) * 32 + (swz % 64) / 2; }

DI void prep_weights(const Params& p, LAS unsigned char* lds, int ubeg, int uend, int wgi, int wgn, bool do_lam) {
  const int tid = opaque_tid();
  const int NTOT = uend;
  const int lrow = tid >> 6, c4 = (tid & 63) * 4;
  f32x4 r[8];
#define PREP_DECODE(u) const float* src; bf16_t* dst; int N; const float* g; int kt, ntile; \
    { const int _l = (u) >= 1280 ? 1 : 0, _v = (u) - _l * 1280; \
      if (_v < 1024) { kt = _v >> 5; ntile = _v & 31; src = p.w_in + (size_t)_l * DM * NIN; dst = p.WinT + (size_t)_l * NIN * DM; N = NIN; g = p.norm_g + _l * DM; } \
      else { const int q = _v - 1024; kt = q >> 3; ntile = q & 7; src = p.w_out + (size_t)_l * DM * DM; dst = p.WoutT + (size_t)_l * DM * DM; N = DM; g = nullptr; } } \
    const int k0 = kt * 64, n0 = ntile * 256;
#define PREP_LOAD(u) do { PREP_DECODE(u) (void)dst; _Pragma("unroll") for (int i = 0; i < 8; ++i) { const int kk = lrow + 8 * i; \
    const f32x4 v = __builtin_nontemporal_load((const f32x4*)(src + (size_t)(k0 + kk) * N + n0 + c4));     const float gg = g ? g[k0 + kk] : 1.f; r[i] = v * gg; } } while (0)
  int u = ubeg + wgi;
  if (u < NTOT) PREP_LOAD(u);
  for (; u < NTOT; u += wgn) {
#pragma unroll
    for (int i = 0; i < 8; ++i) *(LAS f32x4*)(lds + ((lrow + 8 * i) * 260 + c4) * 4) = r[i];
    __syncthreads();
    const int un = u + wgn;
    if (un < NTOT) PREP_LOAD(un);
    {
      PREP_DECODE(u) (void)src; (void)N; (void)g;
      const int n = tid >> 1, kh = (tid & 1) * 32;
      bf16_t* op = dst + (size_t)(n0 + n) * DM + k0 + kh;
#pragma unroll
      for (int q = 0; q < 4; ++q) {
        float f[8];
#pragma unroll
        for (int j = 0; j < 8; ++j) f[j] = *(const LAS float*)(lds + ((kh + q * 8 + j) * 260 + n) * 4);
        const u32x4 o = {pk2(f[0], f[1]), pk2(f[2], f[3]), pk2(f[4], f[5]), pk2(f[6], f[7])};
        *(u32x4*)(op + q * 8) = o;
      }
    }
    __syncthreads();
  }
#undef PREP_DECODE
#undef PREP_LOAD
  if (do_lam && blockIdx.x == 0 && tid < 64) {
    for (int l = 0; l < 2; ++l) {
      float a = p.lq1[l * 64 + tid] * p.lk1[l * 64 + tid], b = p.lq2[l * 64 + tid] * p.lk2[l * 64 + tid];
#pragma unroll
      for (int off = 32; off >= 1; off >>= 1) { a += __shfl_xor(a, off); b += __shfl_xor(b, off); }
      float li = 0.8f - 0.6f * expf(-0.3f * (float)l);
      if (tid == 0) p.lam[l] = expf(a) - expf(b) + li;
    }
  }
}

template <int MODE> DI void rownorm(const Params& p) {
  const int tid = opaque_tid(); const int wave = tid >> 6, lane = tid & 63;
  const int nw = gridDim.x * 8;
  for (int row = (MODE == 1 ? 8192 : 0) + blockIdx.x * 8 + wave; row < MROWS; row += nw) {
    const int b = row / LROW, pos = row - b * LROW;
    if (MODE == 2 && pos < 64) continue;
    const float* src;
    if (MODE <= 1) src = pos < 48 ? nullptr : (pos < 64 ? p.meta + (size_t)(pos - 48) * DM : p.x + ((size_t)b * 2048 + (pos - 64)) * DM);
    else src = p.h + (size_t)row * DM;
    float4 v[8]; float ss = 0.f;
#pragma unroll
    for (int i = 0; i < 8; ++i) {
      v[i] = src ? *(const float4*)(src + i * 256 + lane * 4) : make_float4(0.f, 0.f, 0.f, 0.f);
      if (MODE != 0 && row >= 8192) {
#pragma unroll
        for (int s = 0; s < 8; ++s) { const float4 q = *(const float4*)(p.P2 + ((size_t)s * 256 + (row - 8192)) * DM + i * 256 + lane * 4); v[i].x += q.x; v[i].y += q.y; v[i].z += q.z; v[i].w += q.w; }
      }
      ss += v[i].x * v[i].x + v[i].y * v[i].y + v[i].z * v[i].z + v[i].w * v[i].w;
    }
#pragma unroll
    for (int off = 32; off >= 1; off >>= 1) ss += __shfl_xor(ss, off);
    const float rs = rsqrtf(ss * (1.f / 2048.f) + 1e-6f);
    if (MODE < 2) {
#pragma unroll
      for (int i = 0; i < 8; ++i) {
        if (MODE == 1) *(float4*)(p.h + (size_t)row * DM + i * 256 + lane * 4) = v[i];
        uint2 o; o.x = pk2(v[i].x, v[i].y); o.y = pk2(v[i].z, v[i].w);
        *(uint2*)(p.hb + (size_t)row * DM + i * 256 + lane * 4) = o;
      }
      if (lane == 0) p.ss[(MODE == 0 ? 0 : 1) * MROWS + row] = ss;
    } else {
      float* dst = p.out + ((size_t)b * 2048 + (pos - 64)) * DM;
#pragma unroll
      for (int i = 0; i < 8; ++i) {
        float4 g = *(const float4*)(p.fin_g + i * 256 + lane * 4);
        float4 o; o.x = v[i].x * rs * g.x; o.y = v[i].y * rs * g.y; o.z = v[i].z * rs * g.z; o.w = v[i].w * rs * g.w;
        *(float4*)(dst + i * 256 + lane * 4) = o;
      }
    }
  }
}

constexpr int GK = 2048, GBK = 64, GHALF = 128, GHTB = GHALF * GBK * 2;
constexpr size_t TSTEP = (size_t)256 * GK * 2;
struct Unit { int mt, nt, tr, k0, nkt, nb; };

template <class Epi, class Sched>
DI void gemm_phase(LAS unsigned char* lds, const Sched& S, const Epi& E) {
  const int tid = opaque_tid(), wid = __builtin_amdgcn_readfirstlane(tid >> 6), lane = tid & 63, wr = wid >> 2, wc = wid & 3, fr = lane & 15, fq = lane >> 4;
  constexpr int K = GK;
  unsigned voffA[2], dperm;
#pragma unroll
  for (int i = 0; i < 2; ++i) { int R, C; stage_rc(tid * 16 + i * 8192, R, C); voffA[i] = (unsigned)(R * K + C) * 2u;
    if (i == 0) dperm = (unsigned)((perm32(R & 31) - (R & 31)) * K * 2); }
  const size_t kstep = (size_t)(GBK * 2);
  const size_t hstep = (size_t)GHALF * K * 2;
  const unsigned ldsw = (unsigned)wid * 1024u;
  const int aoff = lds_byte(wr * 64 + fr, fq * 8), boff = lds_byte(wc * 32 + fr, fq * 8);
#define G_SA(b, h) (((b) * 2 + (h)) * GHTB)
#define G_SB(b, h) ((4 + (b) * 2 + (h)) * GHTB)
#define G_STAGE(bufoff, gbase, voff) do { _Pragma("unroll") for (int _i = 0; _i < 2; ++_i) \
    __builtin_amdgcn_global_load_lds((const unsigned*)((const char*)(gbase) + voff[_i]), (LAS unsigned*)(lds + (bufoff) + ldsw + _i * 8192), 16, 0, 0); } while (0)
#define G_LDA(dst, b, h) do { _Pragma("unroll") for (int m = 0; m < 4; ++m) _Pragma("unroll") for (int k = 0; k < 2; ++k) dst[m][k] = *(const LAS bf16x8*)(lds + G_SA(b, h) + aoff + m * 2048 + k * 1024); } while (0)
#define G_LDB(dst, b, h) do { _Pragma("unroll") for (int n = 0; n < 2; ++n) _Pragma("unroll") for (int k = 0; k < 2; ++k) dst[n][k] = *(const LAS bf16x8*)(lds + G_SB(b, h) + boff + n * 2048 + k * 1024); } while (0)
#define G_MMA(ai, bj, At, Bx) do { __builtin_amdgcn_s_setprio(1); _Pragma("unroll") for (int m = 0; m < 4; ++m) _Pragma("unroll") for (int n = 0; n < 2; ++n) _Pragma("unroll") for (int k = 0; k < 2; ++k) \
    acc[ai][bj][m][n] = MFMA16(Bx[n][k], At[m][k], acc[ai][bj][m][n]); __builtin_amdgcn_s_setprio(0); } while (0)
#define G_WAIT_V(n) asm volatile("s_waitcnt vmcnt(" #n ")" ::: "memory")
#define G_WAIT_L(n) asm volatile("s_waitcnt lgkmcnt(" #n ")" ::: "memory")
#define G_BAR __builtin_amdgcn_s_barrier()
#define G_SCHED __builtin_amdgcn_sched_barrier(0)
  Unit cur, nxt; int ui = 0;
  if (!S.next(0, cur)) return;
  f32x4 acc[2][2][4][2];
  E.init(acc, cur, wr, wc, fr, fq, lds, 0);
  bf16x8 At[4][2], B0[2][2], B1[2][2];
  const char* cA = S.pa(cur); const char* cB = S.pb(cur);
  { const unsigned ds0 = cur.nb ? 0u : dperm; const unsigned vb[2] = {voffA[0] + ds0, voffA[1] + ds0};
  G_STAGE(G_SB(0, 0), cB, vb); G_STAGE(G_SA(0, 0), cA, voffA); G_STAGE(G_SB(0, 1), cB + hstep, vb); G_STAGE(G_SA(0, 1), cA + hstep, voffA);
  if (wr == 1) G_BAR;
  G_WAIT_V(4); G_BAR;
  G_STAGE(G_SB(1, 0), cB + kstep, vb); G_STAGE(G_SA(1, 0), cA + kstep, voffA); G_STAGE(G_SB(1, 1), cB + hstep + kstep, vb); }
  G_WAIT_V(6); G_BAR;
  for (;;) {
    const bool has_next = S.next(ui + 1, nxt);
    if (!has_next) nxt = cur;
    const char* nA = has_next ? S.pa(nxt) : cA; const char* nB = has_next ? S.pb(nxt) : cB;
    const int nt = cur.nkt;
    for (int t = 0; t < nt; t += 2) {
      const bool last = (t == nt - 2);
      const char* a1 = cA + (size_t)(t + 1) * kstep;
      const char* a2 = last ? nA : cA + (size_t)(t + 2) * kstep; const char* b2 = last ? nB : cB + (size_t)(t + 2) * kstep;
      const char* a3 = a2 + kstep; const char* b3 = b2 + kstep;
      const bool nbs = last ? (nxt.nb != 0) : (cur.nb != 0);
      const unsigned ds = nbs ? 0u : dperm; const unsigned vb[2] = {voffA[0] + ds, voffA[1] + ds};
      G_LDB(B0, 0, 0); G_SCHED; G_LDA(At, 0, 0); G_STAGE(G_SA(1, 1), a1 + hstep, voffA);
      G_WAIT_L(8); G_BAR; G_WAIT_L(0); G_MMA(0, 0, At, B0); G_BAR; G_SCHED;
      G_LDB(B1, 0, 1); G_STAGE(G_SB(0, 0), b2, vb);
      G_BAR; G_WAIT_L(0); G_MMA(0, 1, At, B1); G_BAR;
      G_LDA(At, 0, 1); G_STAGE(G_SA(0, 0), a2, voffA);
      G_BAR; G_WAIT_L(0); G_MMA(1, 0, At, B0); G_BAR; G_SCHED;
      G_STAGE(G_SB(0, 1), b2 + hstep, vb);
      G_WAIT_V(6); G_BAR; G_MMA(1, 1, At, B1); G_BAR;
      G_LDB(B0, 1, 0); G_SCHED; G_LDA(At, 1, 0); G_STAGE(G_SA(0, 1), a2 + hstep, voffA);
      G_WAIT_L(8); G_BAR; G_WAIT_L(0); G_MMA(0, 0, At, B0); G_BAR; G_SCHED;
      G_LDB(B1, 1, 1); G_STAGE(G_SB(1, 0), b3, vb);
      G_BAR; G_WAIT_L(0); G_MMA(0, 1, At, B1); G_BAR;
      G_LDA(At, 1, 1); G_STAGE(G_SA(1, 0), a3, voffA);
      G_BAR; G_WAIT_L(0); G_MMA(1, 0, At, B0); G_BAR; G_SCHED;
      G_STAGE(G_SB(1, 1), b3 + hstep, vb);
      G_WAIT_V(6); G_BAR; G_MMA(1, 1, At, B1); G_BAR;
    }
    { const int t2 = opaque_tid() & 63; E(acc, cur, wr, wc, t2 & 15, t2 >> 4, lds, ui & 1); }
    if (!has_next) break;
    cur = nxt; cA = nA; cB = nB; ++ui;
    { const int t3 = opaque_tid() & 63; E.init(acc, cur, wr, wc, t3 & 15, t3 >> 4, lds, ui & 1); }
  }
  G_WAIT_V(0);
  if (wr == 0) G_BAR;
  G_BAR;
}

#define XB_TMO      128
#define XB_XCNT(j)  (256  + 64 * (j))
#define XB_XSUB(j)  (1280 + 64 * (j))
#define XB_XGEN(j)  (2304 + 64 * (j))
#define XB_TOP      3328
#define XB_TOPGEN   3392
#define XCD_BAR_WORDS 3456
#define XB_SPIN_CAP (1u << 18)
DI unsigned xb_ld(unsigned* p) { return __hip_atomic_load(p, __ATOMIC_RELAXED, __HIP_MEMORY_SCOPE_AGENT); }
DI unsigned xb_add(unsigned* p, unsigned v) { return __hip_atomic_fetch_add(p, v, __ATOMIC_RELAXED, __HIP_MEMORY_SCOPE_AGENT); }
DI unsigned xb_xcc_id() { return (unsigned)__builtin_amdgcn_s_getreg((3 << 11) | 20) & 0xFu; }
#define XB_SPIN(cond, bar) do { unsigned _sp = 0; while (cond) { __builtin_amdgcn_s_sleep(1); \
    if ((++_sp & 255u) == 0u) { if (xb_ld(&(bar)[XB_TMO])) break; if (_sp > XB_SPIN_CAP) { atomicAdd(&(bar)[XB_TMO], 1u); break; } } } } while (0)
struct XcdBarrier { unsigned* bar; unsigned x; volatile LAS unsigned* st; };
DI XcdBarrier xcd_barrier_post(unsigned* bar, volatile LAS unsigned* st) {
  XcdBarrier b; b.bar = bar; b.x = xb_xcc_id(); b.st = st;
  if (threadIdx.x == 0) (void)xb_add(&bar[XB_XCNT(b.x)], 1u);
  return b;
}
DI void xcd_barrier_complete(unsigned* bar, unsigned x, unsigned& nloc, unsigned& nx) {
  const unsigned G = gridDim.x * gridDim.y * gridDim.z;
  unsigned sum, cnt, mine, sp = 0u;
  for (;;) {
    sum = 0u; cnt = 0u; mine = 0u;
#pragma unroll
    for (unsigned j = 0; j < 16; ++j) { const unsigned c = xb_ld(&bar[XB_XCNT(j)]); sum += c; cnt += (c > 0u) ? 1u : 0u; mine = (j == x) ? c : mine; }
    if (sum == G) break;
    __builtin_amdgcn_s_sleep(1);
    if ((++sp & 255u) == 0u) { if (xb_ld(&bar[XB_TMO])) break; if (sp > XB_SPIN_CAP) { atomicAdd(&bar[XB_TMO], 1u); break; } }
  }
  nloc = mine > 0u ? mine : 1u; nx = cnt > 0u ? cnt : 1u;
}
DI void xcd_barrier(const XcdBarrier& b) {
  asm volatile("s_waitcnt vmcnt(0)" ::: "memory");
  __syncthreads();
  if (threadIdx.x == 0) {
    unsigned* bar = b.bar;
    __builtin_amdgcn_s_waitcnt(0);
    unsigned nloc = b.st[0], nx = b.st[1];
    if (nloc == 0u) { xcd_barrier_complete(bar, b.x, nloc, nx); b.st[0] = nloc; b.st[1] = nx; }
    const unsigned old = xb_add(&bar[XB_XSUB(b.x)], 1u);
    const unsigned gen = old / nloc;
    if (old + 1u == (gen + 1u) * nloc) {
      __builtin_amdgcn_fence(__ATOMIC_RELEASE, "agent");
      asm volatile("s_waitcnt vmcnt(0)" ::: "memory");
      const unsigned og = xb_add(&bar[XB_TOP], 1u);
      const unsigned tg = og / nx;
      if (og + 1u == (tg + 1u) * nx) xb_add(&bar[XB_TOPGEN], 1u);
      else XB_SPIN(xb_ld(&bar[XB_TOPGEN]) == tg, bar);
      __builtin_amdgcn_fence(__ATOMIC_ACQUIRE, "agent");
      xb_add(&bar[XB_XGEN(b.x)], 1u);
      asm volatile("s_waitcnt vmcnt(0)" ::: "memory");
    } else {
      XB_SPIN(xb_ld(&bar[XB_XGEN(b.x)]) == gen, bar);
      __builtin_amdgcn_fence(__ATOMIC_ACQUIRE, "agent");
      asm volatile("s_waitcnt vmcnt(0)" ::: "memory");
    }
  }
  __syncthreads();
}

DI void tile_map(int wgid, int nM, int nN, int& pm, int& pn) {
  const int nwg = nM * nN;
  { int q = nwg / 8, r = nwg % 8, xcd = wgid % 8, off = wgid / 8; wgid = (xcd < r ? xcd * (q + 1) : r * (q + 1) + (xcd - r) * q) + off; }
  const int nig = 8 * nN, gid = wgid / nig, fm = gid * 8, gsz = min(nM - fm, 8);
  pm = fm + ((wgid % nig) % gsz); pn = (wgid % nig) / gsz;
}

struct Sched1 {
  const bf16_t* hb; const bf16_t* W; int ubeg, uend;
  DI bool next(int i, Unit& u) const {
    const int U = ubeg + i * (int)gridDim.x + (int)blockIdx.x; if (U >= uend) return false;
    int pm, pn;
    if (U < 928) tile_map(U, 29, 32, pm, pn);
    else if (U < 1024) { const int q = U - 928, c = q % 24; pm = 29 + q / 24; pn = c < 12 ? c : c + 4; }
    else { const int q = U - 1024, g = q & 7; pm = 29 + (q >> 3); pn = g < 4 ? 12 + g : 24 + g; }
    u.mt = pm; u.nt = pn; u.k0 = 0; u.nkt = 32; const int g = pn >> 2; u.tr = (g == 1 || g == 2 || g == 6) ? 1 : 0; u.nb = u.tr; return true;
  }
  DI const char* pa(const Unit& u) const { return u.tr ? (const char*)W + (size_t)u.nt * TSTEP : (const char*)hb + (size_t)u.mt * TSTEP; }
  DI const char* pb(const Unit& u) const { return u.tr ? (const char*)hb + (size_t)u.mt * TSTEP : (const char*)W + (size_t)u.nt * TSTEP; }
};
struct Sched2 {
  const bf16_t* mix; const bf16_t* W;
  DI bool next(int i, Unit& u) const {
    const int U = i * (int)gridDim.x + (int)blockIdx.x; if (U >= 256 + 64) return false;
    if (U < 256) { int pm, pn; tile_map(U, 32, 8, pm, pn); u.mt = pm; u.nt = pn; u.tr = 0; u.k0 = 0; u.nkt = 32; u.nb = 0; }
    else { const int j = U - 256; u.mt = 32; u.nt = j >> 3; u.tr = 1 + (j & 7); u.k0 = (j & 7) * 256; u.nkt = 4; u.nb = 0; }
    return true;
  }
  DI const char* pa(const Unit& u) const { return (const char*)mix + (size_t)u.mt * TSTEP + (size_t)u.k0 * 2; }
  DI const char* pb(const Unit& u) const { return (const char*)W + (size_t)u.nt * TSTEP + (size_t)u.k0 * 2; }
};

DI void acc_zero(f32x4 (&acc)[2][2][4][2]) {
#pragma unroll
  for (int a = 0; a < 2; ++a)
#pragma unroll
    for (int b = 0; b < 2; ++b)
#pragma unroll
      for (int m = 0; m < 4; ++m)
#pragma unroll
        for (int n = 0; n < 2; ++n) acc[a][b][m][n] = (f32x4){0.f, 0.f, 0.f, 0.f};
}
struct Epi1 {
  bf16_t* proj; bf16_t* T; const float* ss;
  DI void init(f32x4 (&acc)[2][2][4][2], const Unit& u, int wr, int wc, int fr, int fq, LAS unsigned char* lds, int par) const {
    acc_zero(acc);
    if (wr == 0)
      __builtin_amdgcn_global_load_lds((const unsigned*)(ss + u.mt * 256 + wc * 64 + fq * 16 + fr), (LAS unsigned*)(lds + 131072 + par * 1024 + wc * 256), 4, 0, 0);
  }
  DI void operator()(const f32x4 (&acc)[2][2][4][2], const Unit& u, int wr, int wc, int fr, int fq, LAS unsigned char* lds, int par) const {
    const LAS float* ssl = (const LAS float*)(lds + 131072 + par * 1024);
    const int g = u.nt >> 2;
    if (!u.tr) {
      const float sc = (g == 4) ? 0.125f * LOG2E : 1.f;
      const int n0 = u.nt * 256 + wc * 32 + fq * 8;
#pragma unroll
      for (int ai = 0; ai < 2; ++ai)
#pragma unroll
        for (int mi = 0; mi < 4; ++mi) {
          const int m = u.mt * 256 + ai * 128 + wr * 64 + mi * 16 + fr;
          const float rs = rsqrtf(ssl[ai * 128 + wr * 64 + mi * 16 + fr] * (1.f / 2048.f) + 1e-6f) * sc;
          bf16_t* rowp = proj + (size_t)m * NIN + n0;
#pragma unroll
          for (int bj = 0; bj < 2; ++bj) {
            const f32x4 a = acc[ai][bj][mi][0], c = acc[ai][bj][mi][1];
            const u32x4 o = {pk2(a[0] * rs, a[1] * rs), pk2(a[2] * rs, a[3] * rs), pk2(c[0] * rs, c[1] * rs), pk2(c[2] * rs, c[3] * rs)};
            *(u32x4*)(rowp + bj * 128) = o;
          }
        }
    } else {
      const int tbase = (g == 1 ? 0 : (g == 2 ? 1024 : 2048)) - g * 1024;
#pragma unroll
      for (int bj = 0; bj < 2; ++bj) {
        const int mb = u.mt * 256 + bj * 128 + wc * 32;
        const int b = mb / LROW, posb = mb - b * LROW;
        const f32x4 q0 = *(const LAS f32x4*)(ssl + bj * 128 + wc * 32 + 4 * fq), q1 = *(const LAS f32x4*)(ssl + bj * 128 + wc * 32 + 16 + 4 * fq);
        float rs[8];
#pragma unroll
        for (int j = 0; j < 4; ++j) { rs[j] = rsqrtf(q0[j] * (1.f / 2048.f) + 1e-6f); rs[4 + j] = rsqrtf(q1[j] * (1.f / 2048.f) + 1e-6f); }
        const int p0 = posb + 4 * fq, p1 = p0 + 16;
        if (g == 1) {
#pragma unroll
          for (int j = 0; j < 4; ++j) { rs[j] = (p0 + j >= 48) ? rs[j] * 0.08838834764831845f : 0.f; rs[4 + j] = (p1 + j >= 48) ? rs[4 + j] * 0.08838834764831845f : 0.f; }
        }
#pragma unroll
        for (int ai = 0; ai < 2; ++ai)
#pragma unroll
          for (int mi = 0; mi < 4; ++mi) {
            const int col = u.nt * 256 + ai * 128 + wr * 64 + mi * 16 + fr;
            const f32x4 a = acc[ai][bj][mi][0], c = acc[ai][bj][mi][1];
            float v[8] = {a[0] * rs[0], a[1] * rs[1], a[2] * rs[2], a[3] * rs[3], c[0] * rs[4], c[1] * rs[5], c[2] * rs[6], c[3] * rs[7]};
            if (g == 1) {
              const int hh = (col - 1024) >> 7;
              const float l2g = log2f(1.f - exp2f(-5.f - (float)hh));
              const int z0 = 63 - (p0 & 63), z1 = 63 - (p1 & 63);
#pragma unroll
              for (int j = 0; j < 4; ++j) { v[j] *= exp2f(l2g * (float)(z0 - j)); v[4 + j] *= exp2f(l2g * (float)(z1 - j)); }
            }
            const u32x4 o = {pk2(v[0], v[1]), pk2(v[2], v[3]), pk2(v[4], v[5]), pk2(v[6], v[7])};
            const int trow = (g == 1) ? (col & ~31) + 16 * ((col >> 2) & 1) + 4 * ((col >> 3) & 3) + (col & 3) : col;
            *(u32x4*)(T + ((size_t)(b * 3072 + tbase + trow)) * LROW + posb + 8 * fq) = o;
          }
      }
    }
  }
};
struct Epi2 {
  float* h; float* P2; bf16_t* hb; float* ssn; const float* x; const float* meta;
  DI void init(f32x4 (&acc)[2][2][4][2], const Unit& u, int wr, int wc, int fr, int fq, LAS unsigned char*, int) const {
    if (u.tr) { acc_zero(acc); return; }
    const int n0 = u.nt * 256 + wc * 32 + fq * 8;
#pragma unroll
    for (int ai = 0; ai < 2; ++ai)
#pragma unroll
      for (int mi = 0; mi < 4; ++mi) {
        const int m = u.mt * 256 + ai * 128 + wr * 64 + mi * 16 + fr;
        const float* rowp = h + (size_t)m * DM + n0;
        if (x) { const int b = m / LROW, pos = m - b * LROW; rowp = pos < 48 ? nullptr : (pos < 64 ? meta + (size_t)(pos - 48) * DM : x + ((size_t)b * 2048 + (pos - 64)) * DM) + n0; }
#pragma unroll
        for (int bj = 0; bj < 2; ++bj)
#pragma unroll
          for (int ni = 0; ni < 2; ++ni) acc[ai][bj][mi][ni] = rowp ? *(const f32x4*)(rowp + bj * 128 + ni * 4) : (f32x4){0.f, 0.f, 0.f, 0.f};
      }
  }
  DI void operator()(const f32x4 (&acc)[2][2][4][2], const Unit& u, int wr, int wc, int fr, int fq, LAS unsigned char*, int) const {
    const int n0 = u.nt * 256 + wc * 32 + fq * 8;
#pragma unroll
    for (int ai = 0; ai < 2; ++ai)
#pragma unroll
      for (int mi = 0; mi < 4; ++mi) {
        const int m = u.mt * 256 + ai * 128 + wr * 64 + mi * 16 + fr;
        float* rowp = (u.tr ? P2 + ((size_t)(u.tr - 1) * 256 + (m - 8192)) * DM : h + (size_t)m * DM) + n0;
        float sq = 0.f;
#pragma unroll
        for (int bj = 0; bj < 2; ++bj) {
          const f32x4 a = acc[ai][bj][mi][0], c = acc[ai][bj][mi][1];
          *(f32x4*)(rowp + bj * 128) = a; *(f32x4*)(rowp + bj * 128 + 4) = c;
          if (ssn && !u.tr) {
            sq += a[0] * a[0] + a[1] * a[1] + a[2] * a[2] + a[3] * a[3] + c[0] * c[0] + c[1] * c[1] + c[2] * c[2] + c[3] * c[3];
            const u32x4 o = {pk2(a[0], a[1]), pk2(a[2], a[3]), pk2(c[0], c[1]), pk2(c[2], c[3])};
            *(u32x4*)(hb + (size_t)m * DM + n0 + bj * 128) = o;
          }
        }
        if (ssn && !u.tr) {
          sq += __shfl_xor(sq, 16); sq += __shfl_xor(sq, 32);
          if (fq == 0) unsafeAtomicAdd(ssn + m, sq);
        }
      }
  }
};

DI void gemm1_phase(const Params& p, int l, LAS unsigned char* lds, int ubeg, int uend) {
  Sched1 S{p.hb, p.WinT + (size_t)l * NIN * DM, ubeg, uend}; Epi1 E{p.proj, p.T, p.ss + (size_t)l * MROWS};
  gemm_phase(lds, S, E);
}
DI void gemm2_phase(const Params& p, int l, LAS unsigned char* lds) {
  Sched2 S{p.mix, p.WoutT + (size_t)l * DM * DM}; Epi2 E{p.h, p.P2, p.hb, l == 0 ? p.ss + MROWS : nullptr, l == 0 ? p.x : nullptr, p.meta};
  gemm_phase(lds, S, E);
}

DI void ret_scan_chain(const Params& p, int b, int h, LAS unsigned char* lds, unsigned* done_ctr) {
  constexpr int D = 6;
  const int tid = opaque_tid(), w = __builtin_amdgcn_readfirstlane(tid >> 6), lane = tid & 63, fr = lane & 15, fq = lane >> 4;
  const float l2g = log2f(1.f - exp2f(-5.f - (float)h));
  const float dec64 = exp2f(l2g * 64.f);
  const int sub16 = lds_byte(fr, fq * 8);
  const int frow = ((tid >> 4) & 31) * 2 + ((tid >> 2) & 1), fcol = ((tid >> 3) & 1) * 32 + (tid & 3) * 8;
  const int fillT = lds_byte(frow, fcol);
  const bf16_t* gk = p.T + (size_t)b * 3072 * LROW + (size_t)(h * 128 + frow) * LROW + fcol;
  u32x4* so = (u32x4*)p.ST + ((size_t)((b * 8 + h) * NCH) * 8 + w) * 256 + lane;
  f32x4 st[8];
#pragma unroll
  for (int i = 0; i < 8; ++i) st[i] = (f32x4){0.f, 0.f, 0.f, 0.f};
  u32x4 ring[D][4];
#define SCAN_LOAD(slot, n) do { const bf16_t* _t = gk + (n) * 64; ring[slot][0] = *(const u32x4*)_t; ring[slot][1] = *(const u32x4*)(_t + (size_t)64 * LROW); \
    ring[slot][2] = *(const u32x4*)(_t + (size_t)1024 * LROW); ring[slot][3] = *(const u32x4*)(_t + (size_t)1088 * LROW); } while (0)
#define SCAN_STORE(n) do { _Pragma("unroll") for (int kd = 0; kd < 4; ++kd) { const f32x4 sa = st[2 * kd], sc = st[2 * kd + 1]; \
    const u32x4 bsu = {pk2(sa[0], sa[1]), pk2(sa[2], sa[3]), pk2(sc[0], sc[1]), pk2(sc[2], sc[3])}; so[(size_t)(n) * 2048 + kd * 64] = bsu; } } while (0)
#pragma unroll
  for (int i = 0; i < D; ++i) SCAN_LOAD(i, i);
#pragma unroll
  for (int n = 0; n < NCH - 1; ++n) {
    const int slot = n % D, bo = (n & 1) * 32768;
    *(LAS u32x4*)(lds + bo + fillT) = ring[slot][0]; *(LAS u32x4*)(lds + bo + fillT + 8192) = ring[slot][1];
    *(LAS u32x4*)(lds + bo + 16384 + fillT) = ring[slot][2]; *(LAS u32x4*)(lds + bo + 16384 + fillT + 8192) = ring[slot][3];
    if (n + D < NCH - 1) SCAN_LOAD(slot, n + D);
    __syncthreads();
    SCAN_STORE(n);
    const bf16x8 vf0 = *(const LAS bf16x8*)(lds + bo + 16384 + w * 2048 + sub16), vf1 = *(const LAS bf16x8*)(lds + bo + 16384 + w * 2048 + 1024 + sub16);
#pragma unroll
    for (int db = 0; db < 8; ++db) {
      st[db] *= dec64;
      const bf16x8 a0 = *(const LAS bf16x8*)(lds + bo + sub16 + db * 2048);
      const bf16x8 a1 = *(const LAS bf16x8*)(lds + bo + sub16 + db * 2048 + 1024);
      st[db] = MFMA16(a0, vf0, st[db]); st[db] = MFMA16(a1, vf1, st[db]);
    }
  }
  SCAN_STORE(NCH - 1);
  asm volatile("s_waitcnt vmcnt(0)" ::: "memory");
  __syncthreads();
  if (threadIdx.x == 0) { __builtin_amdgcn_fence(__ATOMIC_RELEASE, "agent"); asm volatile("s_waitcnt vmcnt(0)" ::: "memory"); xb_add(done_ctr, 1u); }
#undef SCAN_LOAD
#undef SCAN_STORE
}

DI void retention_items(const Params& p, int l, LAS unsigned char* lds, int first, int stride, int count) {
  constexpr int QS = 0, KS = 16384, VTS = 49152, PS = 65536, OS = 73728;
  const int tid = opaque_tid(), w = __builtin_amdgcn_readfirstlane(tid >> 6), lane = tid & 63, fr = lane & 15, fq = lane >> 4;
  const int sub16 = lds_byte(fr, fq * 8), sub8a = lds_byte(fr, fq * 4), sub8b = lds_byte(fr, fq * 4 + 16);
  const int tq = ((tid >> 5) & 15) * 2 + ((tid >> 2) & 1), dq = ((tid >> 4) & 1) * 64 + ((tid >> 3) & 1) * 32 + (tid & 3) * 8;
  const int ve = ((tid >> 4) & 31) * 2 + ((tid >> 2) & 1), vs0 = ((tid >> 3) & 1) * 32 + (tid & 3) * 8;
  const int fillQ = (dq >> 6) * 8192 + lds_byte(tq, dq & 63);
  const int fillT = lds_byte(ve, vs0);
  const int sb = w & 3, tb0 = (w >> 2) * 2;
  const int kbase = KS + sb * 2048 + sub16, qbase = QS + tb0 * 2048 + sub16;
  const int pbase = PS + tb0 * 2048 + (sb >> 1) * 1024 + lds_byte(fr, fq * 8 + 4 * (sb & 1));
  const int vbase = VTS + w * 2048 + sub16;
  const int obase = OS + ((fq * 4) * 132 + w * 16 + fr) * 4;
  const int nbase = OS + ((tid >> 3) * 132 + (tid & 7) * 16) * 4;
  u32x4 pq0, pq1, pk0, pk1, pv0, pv1, ns0, ns1, ns2, ns3, ng0, ng1;
#define RET_GLOAD(it) do { const int _bh = (it) / NCH, _n = (it) - _bh * NCH, _b = _bh >> 3, _h = _bh & 7; \
    const bf16_t* _q = p.proj + ((size_t)_b * LROW + _n * 64 + tq) * NIN + _h * 128 + dq; \
    const bf16_t* _tk = p.T + ((size_t)_b * 3072 + _h * 128 + (tid >> 3)) * LROW + _n * 64 + (tid & 7) * 8; \
    const bf16_t* _tv = p.T + ((size_t)_b * 3072 + 1024 + _h * 128 + ve) * LROW + _n * 64 + vs0; \
    pq0 = *(const u32x4*)_q; pq1 = *(const u32x4*)(_q + (size_t)32 * NIN); pk0 = *(const u32x4*)_tk; pk1 = *(const u32x4*)(_tk + (size_t)64 * LROW); \
    pv0 = *(const u32x4*)_tv; pv1 = *(const u32x4*)(_tv + (size_t)64 * LROW); \
    const u32x4* _sp = (const u32x4*)p.ST + ((size_t)(it) * 8 + w) * 256 + lane; ns0 = _sp[0]; ns1 = _sp[64]; ns2 = _sp[128]; ns3 = _sp[192]; \
    const bf16_t* _gp = p.proj + ((size_t)_b * LROW + _n * 64 + (tid >> 3)) * NIN + 3072 + _h * 128 + (tid & 7) * 16; \
    ng0 = *(const u32x4*)_gp; ng1 = *(const u32x4*)(_gp + 8); } while (0)
  int it = first;
  const int iend = first + stride * count;
  if (it < iend) RET_GLOAD(it);
  for (; it < iend; it += stride) {
    const int bh = it / NCH, n = it - bh * NCH, b = bh >> 3, h = bh & 7;
    const float l2g = log2f(1.f - exp2f(-5.f - (float)h));
    *(LAS u32x4*)(lds + QS + fillQ) = pq0; *(LAS u32x4*)(lds + QS + fillQ + 4096) = pq1;
    {
      const int d0 = tid >> 3, s0 = (tid & 7) * 8;
#pragma unroll
      for (int i = 0; i < 2; ++i) {
        const u32x4 kv = i ? pk1 : pk0;
        const int r_ = d0 + 64 * i, d = (r_ & ~31) + 8 * ((r_ >> 2) & 3) + 4 * ((r_ >> 4) & 1) + (r_ & 3), ko = KS + (d >> 6) * 8192;
#pragma unroll
        for (int j = 0; j < 8; ++j) {
          const unsigned wv = kv[j >> 1];
          const int st = (s0 & 32) + 16 * (j >> 2) + 4 * ((s0 >> 3) & 3) + (j & 3);
          *(LAS bf16_t*)(lds + ko + lds_byte(st, d & 63)) = (bf16_t)((j & 1) ? (wv >> 16) : (wv & 0xffffu));
        }
      }
    }
    *(LAS u32x4*)(lds + VTS + fillT) = pv0; *(LAS u32x4*)(lds + VTS + fillT + 8192) = pv1;
    const u32x4 sf0 = ns0, sf1 = ns1, sf2 = ns2, sf3 = ns3, g0 = ng0, g1 = ng1;
    __syncthreads();
    if (it + stride < iend) RET_GLOAD(it + stride);
    const size_t row = (size_t)b * LROW + n * 64 + (tid >> 3);
    {
      f32x4 s0 = {0.f, 0.f, 0.f, 0.f}, s1 = {0.f, 0.f, 0.f, 0.f};
#pragma unroll
      for (int ks = 0; ks < 4; ++ks) {
        const int off = (ks >> 1) * 8192 + (ks & 1) * 1024;
        const bf16x8 a = *(const LAS bf16x8*)(lds + kbase + off);
        const bf16x8 b0 = *(const LAS bf16x8*)(lds + qbase + off);
        const bf16x8 b1 = *(const LAS bf16x8*)(lds + qbase + off + 2048);
        s0 = MFMA16(a, b0, s0); s1 = MFMA16(a, b1, s1);
      }
      const int srow = sb * 16 + fq * 4;
#pragma unroll
      for (int i = 0; i < 2; ++i) {
        const f32x4 sv = i ? s1 : s0;
        const int t = (tb0 + i) * 16 + fr;
        const float v0 = sv[0] * EXP2(l2g * (fabsf((float)(t - srow)) - (float)(63 - srow))), v1 = sv[1] * EXP2(l2g * (fabsf((float)(t - srow - 1)) - (float)(62 - srow)));
        const float v2 = sv[2] * EXP2(l2g * (fabsf((float)(t - srow - 2)) - (float)(61 - srow))), v3 = sv[3] * EXP2(l2g * (fabsf((float)(t - srow - 3)) - (float)(60 - srow)));
        const u32x2 o = {pk2(v0, v1), pk2(v2, v3)};
        *(LAS u32x2*)(lds + pbase + i * 2048) = o;
      }
    }
    __syncthreads();
    {
      const bf16x8 vf0 = *(const LAS bf16x8*)(lds + vbase), vf1 = *(const LAS bf16x8*)(lds + vbase + 1024);
      f32x4 o[4], cr[4];
#pragma unroll
      for (int tb = 0; tb < 4; ++tb) {
        o[tb] = (f32x4){0.f, 0.f, 0.f, 0.f}; cr[tb] = (f32x4){0.f, 0.f, 0.f, 0.f};
        const bf16x8 a0 = *(const LAS bf16x8*)(lds + PS + sub16 + tb * 2048);
        const bf16x8 a1 = *(const LAS bf16x8*)(lds + PS + sub16 + tb * 2048 + 1024);
        o[tb] = MFMA16(a0, vf0, o[tb]); o[tb] = MFMA16(a1, vf1, o[tb]);
      }
#pragma unroll
      for (int kd = 0; kd < 4; ++kd) {
        const bf16x8 bsv = __builtin_bit_cast(bf16x8, kd == 0 ? sf0 : (kd == 1 ? sf1 : (kd == 2 ? sf2 : sf3)));
#pragma unroll
        for (int tb = 0; tb < 4; ++tb) {
          const bf16x8 a = *(const LAS bf16x8*)(lds + QS + (kd >> 1) * 8192 + (tb * 2 + (kd & 1)) * 1024 + sub16);
          cr[tb] = MFMA16(a, bsv, cr[tb]);
        }
      }
#pragma unroll
      for (int tb = 0; tb < 4; ++tb)
#pragma unroll
        for (int j = 0; j < 4; ++j) o[tb][j] += EXP2(l2g * (float)(tb * 16 + fq * 4 + j + 1)) * cr[tb][j];
#pragma unroll
      for (int tb = 0; tb < 4; ++tb)
#pragma unroll
        for (int j = 0; j < 4; ++j) *(LAS float*)(lds + obase + (tb * 16 + j) * 528) = o[tb][j];
    }
    __syncthreads();
    {
      const int seg = tid & 7;
      const f32x4 x0 = *(const LAS f32x4*)(lds + nbase), x1 = *(const LAS f32x4*)(lds + nbase + 16), x2 = *(const LAS f32x4*)(lds + nbase + 32), x3 = *(const LAS f32x4*)(lds + nbase + 48);
      f32x4 xs = x0 + x1 + x2 + x3;
      float sum = xs[0] + xs[1] + xs[2] + xs[3];
      sum += __shfl_xor(sum, 1); sum += __shfl_xor(sum, 2); sum += __shfl_xor(sum, 4);
      const float mu = sum * (1.f / 128.f);
      const f32x4 d0 = x0 - mu, d1 = x1 - mu, d2 = x2 - mu, d3 = x3 - mu;
      const f32x4 q = d0 * d0 + d1 * d1 + d2 * d2 + d3 * d3;
      float vs = q[0] + q[1] + q[2] + q[3];
      vs += __shfl_xor(vs, 1); vs += __shfl_xor(vs, 2); vs += __shfl_xor(vs, 4);
      const float rn = rsqrtf(vs * (1.f / 128.f) + 1e-6f);
      const float* gr = p.ret_g + l * 1024 + h * 128 + seg * 16;
      const f32x4 w0 = *(const f32x4*)gr, w1 = *(const f32x4*)(gr + 4), w2 = *(const f32x4*)(gr + 8), w3 = *(const f32x4*)(gr + 12);
      uint4 oa, ob;
      oa.x = pk2(d0[0] * rn * w0[0] * silu(bflo(g0[0])), d0[1] * rn * w0[1] * silu(bfhi(g0[0])));
      oa.y = pk2(d0[2] * rn * w0[2] * silu(bflo(g0[1])), d0[3] * rn * w0[3] * silu(bfhi(g0[1])));
      oa.z = pk2(d1[0] * rn * w1[0] * silu(bflo(g0[2])), d1[1] * rn * w1[1] * silu(bfhi(g0[2])));
      oa.w = pk2(d1[2] * rn * w1[2] * silu(bflo(g0[3])), d1[3] * rn * w1[3] * silu(bfhi(g0[3])));
      ob.x = pk2(d2[0] * rn * w2[0] * silu(bflo(g1[0])), d2[1] * rn * w2[1] * silu(bfhi(g1[0])));
      ob.y = pk2(d2[2] * rn * w2[2] * silu(bflo(g1[1])), d2[3] * rn * w2[3] * silu(bfhi(g1[1])));
      ob.z = pk2(d3[0] * rn * w3[0] * silu(bflo(g1[2])), d3[1] * rn * w3[1] * silu(bfhi(g1[2])));
      ob.w = pk2(d3[2] * rn * w3[2] * silu(bflo(g1[3])), d3[3] * rn * w3[3] * silu(bfhi(g1[3])));
      bf16_t* mp = p.mix + row * DM + h * 128 + seg * 16;
      *(uint4*)mp = oa; *(uint4*)(mp + 8) = ob;
    }
  }
#undef RET_GLOAD
}

DI void diff_pv(LAS unsigned char* lds, int vgb, const bf16x8 (&pfr)[2][2], f32x4 (&o)[2][8], int sub16) {
  __builtin_amdgcn_s_setprio(1);
#pragma unroll
  for (int eb = 0; eb < 8; ++eb)
#pragma unroll
    for (int kp = 0; kp < 2; ++kp) {
      const bf16x8 a = *(const LAS bf16x8*)(lds + vgb + (eb * 2 + kp) * 1024 + sub16);
      o[0][eb] = MFMA16(a, pfr[0][kp], o[0][eb]);
      o[1][eb] = MFMA16(a, pfr[1][kp], o[1][eb]);
    }
  __builtin_amdgcn_s_setprio(0);
}
DI void diff_tile(bool general, LAS unsigned char* lds, int kfb, const bf16x8 (&qf)[2][2], f32x4 (&o)[2][8], bf16x8 (&pfr)[2][2], float& m0, float& m1, float& l0, float& l1,
                  const f32x4 (&cj)[4], float slope2, int kt, int qrow, int fq) {
  f32x4 s[2][4];
#pragma unroll
  for (int kb = 0; kb < 4; ++kb) {
    const f32x4 init = cj[kb];
    const bf16x8 a0 = *(const LAS bf16x8*)(lds + kfb + (kb * 2) * 1024);
    const bf16x8 a1 = *(const LAS bf16x8*)(lds + kfb + (kb * 2 + 1) * 1024);
    s[0][kb] = MFMA16(a0, qf[0][0], init); s[1][kb] = MFMA16(a0, qf[1][0], init);
    s[0][kb] = MFMA16(a1, qf[0][1], s[0][kb]); s[1][kb] = MFMA16(a1, qf[1][1], s[1][kb]);
  }
  const float tconst = slope2 * (float)(kt * 64);
#pragma unroll
  for (int rb = 0; rb < 2; ++rb) {
    if (general) {
      const int qrel = qrow + rb * 16 - kt * 64;
      const float ms2 = -2.f * slope2;
#pragma unroll
      for (int kb = 0; kb < 4; ++kb)
#pragma unroll
        for (int j = 0; j < 4; ++j) {
          const int kl = kb * 16 + fq * 4 + j;
          float v = s[rb][kb][j] + ms2 * (float)max(kl - qrel, 0);
          if (kt == 0 && kl < 48) v = -INFINITY;
          s[rb][kb][j] = v;
        }
    }
    float mx = fmaxf(fmaxf(s[rb][0][0], s[rb][0][1]), fmaxf(s[rb][0][2], s[rb][0][3]));
#pragma unroll
    for (int kb = 1; kb < 4; ++kb) mx = fmaxf(fmaxf(mx, fmaxf(s[rb][kb][0], s[rb][kb][1])), fmaxf(s[rb][kb][2], s[rb][kb][3]));
    mx = xmax32(xmax16(mx));
    const float mloc = (rb ? m1 : m0) - tconst;
    float mnew = mloc, alpha = 1.f;
    if (!__all(mx <= mloc + 8.f)) {
      mnew = fmaxf(mloc, mx); alpha = EXP2(mloc - mnew);
#pragma unroll
      for (int eb = 0; eb < 8; ++eb) o[rb][eb] *= alpha;
    }
    float rsum = 0.f;
#pragma unroll
    for (int kb = 0; kb < 4; ++kb)
#pragma unroll
      for (int j = 0; j < 4; ++j) { const float pv = EXP2(s[rb][kb][j] - mnew); s[rb][kb][j] = pv; rsum += pv; }
    if (rb) { l1 = l1 * alpha + rsum; m1 = mnew + tconst; } else { l0 = l0 * alpha + rsum; m0 = mnew + tconst; }
#pragma unroll
    for (int kp = 0; kp < 2; ++kp) {
      const f32x4 sa = s[rb][2 * kp], sc = s[rb][2 * kp + 1];
      const u32x4 pbu = {pk2(sa[0], sa[1]), pk2(sa[2], sa[3]), pk2(sc[0], sc[1]), pk2(sc[2], sc[3])};
      pfr[rb][kp] = __builtin_bit_cast(bf16x8, pbu);
    }
  }
}

DI void diff_item(const Params& p, int l, int b, int h, int pi, float lam, float lam_init, LAS unsigned char* lds, bool& gsync) {
  const int tid = opaque_tid(), w = __builtin_amdgcn_readfirstlane(tid >> 6), lane = tid & 63, fr = lane & 15, fq = lane >> 4;
  const int c = w & 1, rgq = w >> 1, qc = 2 * pi + (rgq >> 1);
  const bool active = qc <= 32;
  const int ktmax = min(2 * pi + 1, 32);
  const int sub16 = lds_byte(fr, fq * 8), sub8a = lds_byte(fr, fq * 4), sub8b = lds_byte(fr, fq * 4 + 16);
  const bf16_t* projb = p.proj + (size_t)b * LROW * NIN;
  const int qrow = qc * 64 + (rgq & 1) * 32 + fr;
  bf16x8 qf[2][2];
#pragma unroll
  for (int rb = 0; rb < 2; ++rb)
#pragma unroll
    for (int ks = 0; ks < 2; ++ks)
      qf[rb][ks] = active ? *(const bf16x8*)(projb + (size_t)(qrow + rb * 16) * NIN + 4096 + h * 128 + c * 64 + ks * 32 + fq * 8) : (bf16x8){0, 0, 0, 0, 0, 0, 0, 0};
  float m0 = -INFINITY, m1 = -INFINITY, l0 = 0.f, l1 = 0.f;
  f32x4 o[2][8];
#pragma unroll
  for (int rb = 0; rb < 2; ++rb)
#pragma unroll
    for (int eb = 0; eb < 8; ++eb) o[rb][eb] = (f32x4){0.f, 0.f, 0.f, 0.f};
  const float slope2 = exp2f(-(float)(h + 1)) * LOG2E;
  f32x4 cj[4];
#pragma unroll
  for (int kb = 0; kb < 4; ++kb)
#pragma unroll
    for (int j = 0; j < 4; ++j) cj[kb][j] = slope2 * (float)(kb * 16 + fq * 4 + j);
  const int dswz = (lane * 16) ^ ((((lane * 16) >> 9) & 1) << 5), drr = dswz >> 6, dcc = (dswz & 63) >> 1;
  const bf16_t* gk = projb + (size_t)((w & 3) * 16 + drr) * NIN + 5120 + h * 128 + (w >> 2) * 64 + dcc;
  const bf16_t* gv = p.T + (size_t)b * 3072 * LROW + (size_t)(2048 + h * 128 + w * 16 + drr) * LROW + dcc;
  const int kdst = (w >> 2) * 8192 + (w & 3) * 2048, vdst = 32768 + w * 2048;
#define DIFF_DMA(kt, kb_, vs_) do { const bf16_t* _k = gk + (size_t)(kt) * 64 * NIN; const bf16_t* _v = gv + (kt) * 64; \
    __builtin_amdgcn_global_load_lds((const unsigned*)_k, (LAS unsigned*)(lds + (kb_) + kdst), 16, 0, 0); \
    __builtin_amdgcn_global_load_lds((const unsigned*)(_k + 32), (LAS unsigned*)(lds + (kb_) + kdst + 1024), 16, 0, 0); \
    __builtin_amdgcn_global_load_lds((const unsigned*)_v, (LAS unsigned*)(lds + (vs_) + vdst), 16, 0, 0); \
    __builtin_amdgcn_global_load_lds((const unsigned*)(_v + 32), (LAS unsigned*)(lds + (vs_) + vdst + 1024), 16, 0, 0); } while (0)
  DIFF_DMA(0, 0, 0);
  asm volatile("s_waitcnt vmcnt(0)" ::: "memory");
  __syncthreads();
  const int kfb0 = c * 8192 + sub16;
  const bool stag = (w >> 2) != 0;
  bf16x8 pfr[2][2];
  int vs = 0;
  for (int kt = 0; kt <= ktmax; ++kt) {
    const int kb = (kt & 1) * 16384;
    const int vsn = vs == 32768 ? 0 : vs + 16384;
    if (kt + 1 <= ktmax) DIFF_DMA(kt + 1, 16384 - kb, vsn);
    if (active && kt <= qc) {
      if (stag && kt > 0) diff_pv(lds, 32768 + (vs == 0 ? 32768 : vs - 16384), pfr, o, sub16);
      diff_tile(kt == 0 || kt == qc, lds, kfb0 + kb, qf, o, pfr, m0, m1, l0, l1, cj, slope2, kt, qrow, fq);
      if (!stag) diff_pv(lds, 32768 + vs, pfr, o, sub16);
    }
    vs = vsn;
    asm volatile("s_waitcnt vmcnt(0)" ::: "memory");
    __syncthreads();
  }
  if (active && stag) { const int lastslot = (qc % 3) * 16384; diff_pv(lds, 32768 + lastslot, pfr, o, sub16); }
#undef DIFF_DMA
  l0 += __shfl_xor(l0, 16); l0 += __shfl_xor(l0, 32);
  l1 += __shfl_xor(l1, 16); l1 += __shfl_xor(l1, 32);
  const int xb = 81920 + rgq * 16384 + lane * 4;
  if (c == 1 && active) {
#pragma unroll
    for (int rb = 0; rb < 2; ++rb) {
      const float inv = lam / (rb ? l1 : l0);
#pragma unroll
      for (int eb = 0; eb < 8; ++eb)
#pragma unroll
        for (int j = 0; j < 4; ++j) *(LAS float*)(lds + xb + ((rb * 8 + eb) * 4 + j) * 256) = o[rb][eb][j] * inv;
    }
  }
  if (!gsync && tid == 0) { unsigned sp = 0; while (xb_ld(p.ctr + 32 + l) < 32u && ++sp < (1u << 22)) __builtin_amdgcn_s_sleep(2); }
  __syncthreads();
  if (!gsync) { __builtin_amdgcn_fence(__ATOMIC_ACQUIRE, "agent"); gsync = true; }
  if (c == 0 && active) {
#pragma unroll
    for (int rb = 0; rb < 2; ++rb) {
      const float inv = 1.f / (rb ? l1 : l0);
      float ss = 0.f;
#pragma unroll
      for (int eb = 0; eb < 8; ++eb)
#pragma unroll
        for (int j = 0; j < 4; ++j) { const float d = o[rb][eb][j] * inv - *(const LAS float*)(lds + xb + ((rb * 8 + eb) * 4 + j) * 256); o[rb][eb][j] = d; ss += d * d; }
      ss += __shfl_xor(ss, 16); ss += __shfl_xor(ss, 32);
      const float rn = rsqrtf(ss * (1.f / 128.f) + 1e-6f) * (1.f - lam_init);
      const size_t row = (size_t)b * LROW + qrow + rb * 16;
#pragma unroll
      for (int eb = 0; eb < 8; ++eb) {
        const int e0 = h * 128 + eb * 16 + fq * 4;
        const uint2 gu = *(const uint2*)(p.proj + row * NIN + 7168 + e0);
        const float4 gg = *(const float4*)(p.diff_g + l * 1024 + e0);
        const float y0 = o[rb][eb][0] * rn * gg.x * silu(bflo(gu.x)), y1 = o[rb][eb][1] * rn * gg.y * silu(bfhi(gu.x));
        const float y2 = o[rb][eb][2] * rn * gg.z * silu(bflo(gu.y)), y3 = o[rb][eb][3] * rn * gg.w * silu(bfhi(gu.y));
        uint2 ov; ov.x = pk2(y0, y1); ov.y = pk2(y2, y3);
        *(uint2*)(p.mix + row * DM + 1024 + e0) = ov;
      }
    }
  }
}

DI void mixer_phase(const Params& p, int l, LAS unsigned char* lds) {
  volatile LAS int* s_item = (volatile LAS int*)(lds + 147456);
  const float lam = p.lam[l];
  const float lam_init = 0.8f - 0.6f * expf(-0.3f * (float)l);
  for (int c = (int)blockIdx.x - 32; c >= 0 && c < 32; c += (int)gridDim.x) ret_scan_chain(p, c >> 3, c & 7, lds, p.ctr + 34 + l);
  const int xcd = blockIdx.x & 7;
  bool gsync = false, rsync = false;
  for (;;) {
    if (threadIdx.x == 0) *s_item = (int)atomicAdd(p.ctr + l * 8 + xcd, 1u);
    __syncthreads();
    const int it = *s_item;
    __syncthreads();
    if (it >= 68 + 22) break;
    if (it < 48 || it >= 70) {
      const int ai = it < 48 ? it : it - 22;
      const int bh = 4 * xcd + (ai & 3);
      diff_item(p, l, bh >> 3, bh & 7, 16 - (ai >> 2), lam, lam_init, lds, gsync);
    } else {
      if (!rsync) {
        if (threadIdx.x == 0) { unsigned sp = 0; while ((xb_ld(p.ctr + 34 + l) < 32u || xb_ld(p.ctr + 32 + l) < 32u) && ++sp < (1u << 22)) __builtin_amdgcn_s_sleep(2); }
        __syncthreads();
        __builtin_amdgcn_fence(__ATOMIC_ACQUIRE, "agent");
        rsync = true; gsync = true;
      }
      retention_items(p, l, lds, xcd + 48 * (it - 48), 8, 6);
      __syncthreads();
    }
  }
}

__global__ void __launch_bounds__(512) hymba_megakernel(Params p_unused) {
  cg::grid_group grid = cg::this_grid();
  extern __shared__ __attribute__((aligned(16))) char smem[];
  LAS unsigned char* lds = (LAS unsigned char*)smem;
  volatile LAS unsigned* xst = (volatile LAS unsigned*)(lds + 147456 + 16);
  if (threadIdx.x == 0) { xst[0] = 0u; xst[1] = 0u; }
  __syncthreads();
  XcdBarrier xb;
  { const Params p = load_params(); xb = xcd_barrier_post(p.bar, xst); }
  { const Params p = load_params(); prep_weights(p, lds, 0, 1792, blockIdx.x, gridDim.x, true); }
  { const Params p = load_params(); rownorm<0>(p); }
  grid.sync();
  for (int l = 0; l < 2; ++l) {
    { const Params p = load_params(); gemm1_phase(p, l, lds, 0, 1024); }
    xcd_barrier(xb);
    if (blockIdx.x < 32) {
      const Params p = load_params();
      gemm1_phase(p, l, lds, 1024, 1056);
      if (threadIdx.x == 0) {
        int nl = 0; for (int U = 1024 + (int)blockIdx.x; U < 1056; U += (int)gridDim.x) ++nl;
        __builtin_amdgcn_fence(__ATOMIC_RELEASE, "agent");
        asm volatile("s_waitcnt vmcnt(0)" ::: "memory");
        xb_add(p.ctr + 32 + l, (unsigned)nl);
      }
    }
    { const Params p = load_params(); mixer_phase(p, l, lds); }
    xcd_barrier(xb);
    { const Params p = load_params(); gemm2_phase(p, l, lds); }
    if (l == 0) { const Params p = load_params(); if (gridDim.x > 64) { if (blockIdx.x >= 64) prep_weights(p, lds, 1792, 2560, blockIdx.x - 64, gridDim.x - 64, false); } else prep_weights(p, lds, 1792, 2560, blockIdx.x, gridDim.x, false); }
    xcd_barrier(xb);
    if (l == 0) { { const Params p = load_params(); rownorm<1>(p); } xcd_barrier(xb); }
    else { const Params p = load_params(); rownorm<2>(p); }
  }
}

extern "C" void kernel_launch(void* const* d_in, const int* in_sizes, int n_in, void* d_out, int out_size, void* d_ws, size_t ws_size, hipStream_t stream) {
  static int grid_blocks = 0;
  if (!grid_blocks) {
    int dev = 0, cus = 0, per_cu = 0;
    hipGetDevice(&dev);
    hipDeviceGetAttribute(&cus, hipDeviceAttributeMultiprocessorCount, dev);
    hipFuncSetAttribute((const void*)hymba_megakernel, hipFuncAttributeMaxDynamicSharedMemorySize, SMEM_BYTES);
    hipOccupancyMaxActiveBlocksPerMultiprocessor(&per_cu, hymba_megakernel, 512, SMEM_BYTES);
    if (per_cu < 1) per_cu = 1;
    if (per_cu > 1) per_cu = 1;
    grid_blocks = cus * per_cu;
  }
  Params p{};
  p.x = (const float*)d_in[0]; p.meta = (const float*)d_in[1]; p.norm_g = (const float*)d_in[2]; p.w_in = (const float*)d_in[3];
  p.w_out = (const float*)d_in[4]; p.ret_g = (const float*)d_in[5]; p.diff_g = (const float*)d_in[6];
  p.lq1 = (const float*)d_in[7]; p.lk1 = (const float*)d_in[8]; p.lq2 = (const float*)d_in[9]; p.lk2 = (const float*)d_in[10];
  p.fin_g = (const float*)d_in[11];
  p.out = (float*)d_out;
  char* ws = (char*)d_ws; size_t off = 0;
  auto take = [&](size_t bytes) { char* r = ws + off; off += (bytes + 255) & ~(size_t)255; return r; };
  p.ctr = (unsigned*)take(256);
  p.bar = (unsigned*)take((size_t)XCD_BAR_WORDS * 4);
  p.ss = (float*)take((size_t)2 * MROWS * 4);
  p.lam = (float*)take(256);
  p.WinT = (bf16_t*)take((size_t)2 * NIN * DM * 2);
  p.WoutT = (bf16_t*)take((size_t)2 * DM * DM * 2);
  p.h = (float*)take((size_t)MROWS * DM * 4);
  p.hb = (bf16_t*)take((size_t)MROWS * DM * 2);
  p.proj = (bf16_t*)take((size_t)MROWS * NIN * 2);
  p.T = (bf16_t*)take((size_t)4 * 3072 * LROW * 2);
  p.mix = (bf16_t*)take((size_t)MROWS * DM * 2);
  p.ST = (bf16_t*)take((size_t)32 * NCH * 32768);
  p.P2 = (float*)take((size_t)8 * 256 * DM * 4);
  hipMemsetAsync(p.ctr, 0, 256 + (size_t)XCD_BAR_WORDS * 4 + (size_t)2 * MROWS * 4, stream);
  void* args[] = {&p};
  hipError_t e = hipLaunchCooperativeKernel((void*)hymba_megakernel, dim3(grid_blocks), dim3(512), args, SMEM_BYTES, stream);
  if (e != hipSuccess) fprintf(stderr, "cooperative launch failed: %s (grid %d)\n", hipGetErrorString(e), grid_blocks);
}
```

```cpp
#include <hip/hip_runtime.h>
#include <hip/hip_cooperative_groups.h>
#include <cstdio>
namespace cg = cooperative_groups;

typedef unsigned short bf16_t;
typedef short bf16x8 __attribute__((ext_vector_type(8)));
typedef short s16x4 __attribute__((ext_vector_type(4)));
typedef float f32x4 __attribute__((ext_vector_type(4)));
typedef float f32x2 __attribute__((ext_vector_type(2)));
typedef unsigned u32x4 __attribute__((ext_vector_type(4)));
typedef unsigned u32x2 __attribute__((ext_vector_type(2)));
typedef __bf16 bf16x2_t __attribute__((ext_vector_type(2)));
#define DI __device__ __forceinline__
#define LAS __attribute__((address_space(3)))
#define MFMA16(a, b, c) __builtin_amdgcn_mfma_f32_16x16x32_bf16((a), (b), (c), 0, 0, 0)

constexpr int LROW = 2112;
constexpr int MROWS = 4 * LROW;
constexpr int DM = 2048;
constexpr int NIN = 8192;
constexpr int NCH = 33;
constexpr float LOG2E = 1.4426950408889634f;
constexpr int SMEM_BYTES = 147456 + 64;

struct Params {
  const float *x, *meta, *norm_g, *w_in, *w_out, *ret_g, *diff_g, *lq1, *lk1, *lq2, *lk2, *fin_g;
  float* out;
  bf16_t *WinT, *WoutT, *hb, *proj, *T, *mix, *ST;
  float *h, *ss, *lam, *P2;
  unsigned* ctr;
  unsigned* bar;
};

DI Params load_params() {
  const Params __attribute__((address_space(4)))* q = (const Params __attribute__((address_space(4)))*)__builtin_amdgcn_kernarg_segment_ptr();
  asm volatile("" : "+s"(q));
  Params r; __builtin_memcpy(&r, (const void*)q, sizeof(Params)); return r;
}
DI unsigned pk2(float a, float b) { f32x2 v = {a, b}; bf16x2_t r = __builtin_convertvector(v, bf16x2_t); return __builtin_bit_cast(unsigned, r); }
DI float bf2f(unsigned v16) { return __uint_as_float(v16 << 16); }
DI float bflo(unsigned u) { return __uint_as_float(u << 16); }
DI float bfhi(unsigned u) { return __uint_as_float(u & 0xffff0000u); }
DI int opaque_tid() { int t = threadIdx.x; asm volatile("" : "+v"(t)); return t; }
#define EXP2(x) __builtin_amdgcn_exp2f(x)
DI float xmax16(float x) { const u32x2 r = __builtin_amdgcn_permlane16_swap(__float_as_uint(x), __float_as_uint(x), false, false); return fmaxf(__uint_as_float(r[0]), __uint_as_float(r[1])); }
DI float xmax32(float x) { const u32x2 r = __builtin_amdgcn_permlane32_swap(__float_as_uint(x), __float_as_uint(x), false, false); return fmaxf(__uint_as_float(r[0]), __uint_as_float(r[1])); }
DI float silu(float v) { return v * __builtin_amdgcn_rcpf(1.f + __expf(-v)); }

DI int lds_byte(int r, int c) { int st = (r >> 4) * 2 + (c >> 5), rr = r & 15, cc = c & 31, ob = rr * 64 + cc * 2; return st * 1024 + (ob ^ (((ob >> 9) & 1) << 5)); }
DI int perm32(int rho) { const int n = rho >> 4, i = rho & 15; return 8 * (i >> 2) + 4 * n + (i & 3); }
DI void stage_rc(int b, int& R, int& C) { int st = b / 1024, sb = b % 1024, swz = sb ^ (((sb >> 9) & 1) << 5); R = (st >> 1) * 16 + swz / 64; C = (st & 1) * 32 + (swz % 64) / 2; }

DI void prep_weights(const Params& p, LAS unsigned char* lds, int ubeg, int uend, int wgi, int wgn, bool do_lam) {
  const int tid = opaque_tid();
  const int NTOT = uend;
  const int lrow = tid >> 6, c4 = (tid & 63) * 4;
  f32x4 r[8];
#define PREP_DECODE(u) const float* src; bf16_t* dst; int N; const float* g; int kt, ntile; \
    { const int _l = (u) >= 1280 ? 1 : 0, _v = (u) - _l * 1280; \
      if (_v < 1024) { kt = _v >> 5; ntile = _v & 31; src = p.w_in + (size_t)_l * DM * NIN; dst = p.WinT + (size_t)_l * NIN * DM; N = NIN; g = p.norm_g + _l * DM; } \
      else { const int q = _v - 1024; kt = q >> 3; ntile = q & 7; src = p.w_out + (size_t)_l * DM * DM; dst = p.WoutT + (size_t)_l * DM * DM; N = DM; g = nullptr; } } \
    const int k0 = kt * 64, n0 = ntile * 256;
#define PREP_LOAD(u) do { PREP_DECODE(u) (void)dst; _Pragma("unroll") for (int i = 0; i < 8; ++i) { const int kk = lrow + 8 * i; \
    const f32x4 v = __builtin_nontemporal_load((const f32x4*)(src + (size_t)(k0 + kk) * N + n0 + c4));     const float gg = g ? g[k0 + kk] : 1.f; r[i] = v * gg; } } while (0)
  int u = ubeg + wgi;
  if (u < NTOT) PREP_LOAD(u);
  for (; u < NTOT; u += wgn) {
#pragma unroll
    for (int i = 0; i < 8; ++i) *(LAS f32x4*)(lds + ((lrow + 8 * i) * 260 + c4) * 4) = r[i];
    __syncthreads();
    const int un = u + wgn;
    if (un < NTOT) PREP_LOAD(un);
    {
      PREP_DECODE(u) (void)src; (void)N; (void)g;
      const int n = tid >> 1, kh = (tid & 1) * 32;
      bf16_t* op = dst + (size_t)(n0 + n) * DM + k0 + kh;
#pragma unroll
      for (int q = 0; q < 4; ++q) {
        float f[8];
#pragma unroll
        for (int j = 0; j < 8; ++j) f[j] = *(const LAS float*)(lds + ((kh + q * 8 + j) * 260 + n) * 4);
        const u32x4 o = {pk2(f[0], f[1]), pk2(f[2], f[3]), pk2(f[4], f[5]), pk2(f[6], f[7])};
        *(u32x4*)(op + q * 8) = o;
      }
    }
    __syncthreads();
  }
#undef PREP_DECODE
#undef PREP_LOAD
  if (do_lam && blockIdx.x == 0 && tid < 64) {
    for (int l = 0; l < 2; ++l) {
      float a = p.lq1[l * 64 + tid] * p.lk1[l * 64 + tid], b = p.lq2[l * 64 + tid] * p.lk2[l * 64 + tid];
#pragma unroll
      for (int off = 32; off >= 1; off >>= 1) { a += __shfl_xor(a, off); b += __shfl_xor(b, off); }
      float li = 0.8f - 0.6f * expf(-0.3f * (float)l);
      if (tid == 0) p.lam[l] = expf(a) - expf(b) + li;
    }
  }
}

template <int MODE> DI void rownorm(const Params& p) {
  const int tid = opaque_tid(); const int wave = tid >> 6, lane = tid & 63;
  const int nw = gridDim.x * 8;
  for (int row = (MODE == 1 ? 8192 : 0) + blockIdx.x * 8 + wave; row < MROWS; row += nw) {
    const int b = row / LROW, pos = row - b * LROW;
    if (MODE == 2 && pos < 64) continue;
    const float* src;
    if (MODE <= 1) src = pos < 48 ? nullptr : (pos < 64 ? p.meta + (size_t)(pos - 48) * DM : p.x + ((size_t)b * 2048 + (pos - 64)) * DM);
    else src = p.h + (size_t)row * DM;
    float4 v[8]; float ss = 0.f;
#pragma unroll
    for (int i = 0; i < 8; ++i) {
      if (src) { const f32x4 t = __builtin_nontemporal_load((const f32x4*)(src + i * 256 + lane * 4)); v[i] = make_float4(t[0], t[1], t[2], t[3]); }
      else v[i] = make_float4(0.f, 0.f, 0.f, 0.f);
      if (MODE != 0 && row >= 8192) {
#pragma unroll
        for (int s = 0; s < 8; ++s) { const float4 q = *(const float4*)(p.P2 + ((size_t)s * 256 + (row - 8192)) * DM + i * 256 + lane * 4); v[i].x += q.x; v[i].y += q.y; v[i].z += q.z; v[i].w += q.w; }
      }
      ss += v[i].x * v[i].x + v[i].y * v[i].y + v[i].z * v[i].z + v[i].w * v[i].w;
    }
#pragma unroll
    for (int off = 32; off >= 1; off >>= 1) ss += __shfl_xor(ss, off);
    const float rs = rsqrtf(ss * (1.f / 2048.f) + 1e-6f);
    if (MODE < 2) {
#pragma unroll
      for (int i = 0; i < 8; ++i) {
        if (MODE == 1) *(float4*)(p.h + (size_t)row * DM + i * 256 + lane * 4) = v[i];
        uint2 o; o.x = pk2(v[i].x, v[i].y); o.y = pk2(v[i].z, v[i].w);
        *(uint2*)(p.hb + (size_t)row * DM + i * 256 + lane * 4) = o;
      }
      if (lane == 0) p.ss[(MODE == 0 ? 0 : 1) * MROWS + row] = ss;
    } else {
      float* dst = p.out + ((size_t)b * 2048 + (pos - 64)) * DM;
#pragma unroll
      for (int i = 0; i < 8; ++i) {
        float4 g = *(const float4*)(p.fin_g + i * 256 + lane * 4);
        float4 o; o.x = v[i].x * rs * g.x; o.y = v[i].y * rs * g.y; o.z = v[i].z * rs * g.z; o.w = v[i].w * rs * g.w;
        *(float4*)(dst + i * 256 + lane * 4) = o;
      }
    }
  }
}

constexpr int GK = 2048, GBK = 64, GHALF = 128, GHTB = GHALF * GBK * 2;
constexpr size_t TSTEP = (size_t)256 * GK * 2;
struct Unit { int mt, nt, tr, k0, nkt, nb; };

template <class Epi, class Sched>
DI void gemm_phase(LAS unsigned char* lds, const Sched& S, const Epi& E) {
  const int tid = opaque_tid(), wid = __builtin_amdgcn_readfirstlane(tid >> 6), lane = tid & 63, wr = wid >> 2, wc = wid & 3, fr = lane & 15, fq = lane >> 4;
  constexpr int K = GK;
  unsigned voffA[2], dperm;
#pragma unroll
  for (int i = 0; i < 2; ++i) { int R, C; stage_rc(tid * 16 + i * 8192, R, C); voffA[i] = (unsigned)(R * K + C) * 2u;
    if (i == 0) dperm = (unsigned)((perm32(R & 31) - (R & 31)) * K * 2); }
  const size_t kstep = (size_t)(GBK * 2);
  const size_t hstep = (size_t)GHALF * K * 2;
  const unsigned ldsw = (unsigned)wid * 1024u;
  const int aoff = lds_byte(wr * 64 + fr, fq * 8), boff = lds_byte(wc * 32 + fr, fq * 8);
#define G_SA(b, h) (((b) * 2 + (h)) * GHTB)
#define G_SB(b, h) ((4 + (b) * 2 + (h)) * GHTB)
#define G_STAGE(bufoff, gbase, voff) do { _Pragma("unroll") for (int _i = 0; _i < 2; ++_i) \
    __builtin_amdgcn_global_load_lds((const unsigned*)((const char*)(gbase) + voff[_i]), (LAS unsigned*)(lds + (bufoff) + ldsw + _i * 8192), 16, 0, 0); } while (0)
#define G_LDA(dst, b, h) do { _Pragma("unroll") for (int m = 0; m < 4; ++m) _Pragma("unroll") for (int k = 0; k < 2; ++k) dst[m][k] = *(const LAS bf16x8*)(lds + G_SA(b, h) + aoff + m * 2048 + k * 1024); } while (0)
#define G_LDB(dst, b, h) do { _Pragma("unroll") for (int n = 0; n < 2; ++n) _Pragma("unroll") for (int k = 0; k < 2; ++k) dst[n][k] = *(const LAS bf16x8*)(lds + G_SB(b, h) + boff + n * 2048 + k * 1024); } while (0)
#define G_MMA(ai, bj, At, Bx) do { __builtin_amdgcn_s_setprio(1); _Pragma("unroll") for (int m = 0; m < 4; ++m) _Pragma("unroll") for (int n = 0; n < 2; ++n) _Pragma("unroll") for (int k = 0; k < 2; ++k) \
    acc[ai][bj][m][n] = MFMA16(Bx[n][k], At[m][k], acc[ai][bj][m][n]); __builtin_amdgcn_s_setprio(0); } while (0)
#define G_WAIT_V(n) asm volatile("s_waitcnt vmcnt(" #n ")" ::: "memory")
#define G_WAIT_L(n) asm volatile("s_waitcnt lgkmcnt(" #n ")" ::: "memory")
#define G_BAR __builtin_amdgcn_s_barrier()
#define G_SCHED __builtin_amdgcn_sched_barrier(0)
  Unit cur, nxt; int ui = 0;
  if (!S.next(0, cur)) return;
  f32x4 acc[2][2][4][2];
  E.init(acc, cur, wr, wc, fr, fq, lds, 0);
  bf16x8 At[4][2], B0[2][2], B1[2][2];
  const char* cA = S.pa(cur); const char* cB = S.pb(cur);
  { const unsigned ds0 = cur.nb ? 0u : dperm; const unsigned vb[2] = {voffA[0] + ds0, voffA[1] + ds0};
  G_STAGE(G_SB(0, 0), cB, vb); G_STAGE(G_SA(0, 0), cA, voffA); G_STAGE(G_SB(0, 1), cB + hstep, vb); G_STAGE(G_SA(0, 1), cA + hstep, voffA);
  if (wr == 1) G_BAR;
  G_WAIT_V(4); G_BAR;
  G_STAGE(G_SB(1, 0), cB + kstep, vb); G_STAGE(G_SA(1, 0), cA + kstep, voffA); G_STAGE(G_SB(1, 1), cB + hstep + kstep, vb); }
  G_WAIT_V(6); G_BAR;
  for (;;) {
    const bool has_next = S.next(ui + 1, nxt);
    if (!has_next) nxt = cur;
    const char* nA = has_next ? S.pa(nxt) : cA; const char* nB = has_next ? S.pb(nxt) : cB;
    const int nt = cur.nkt;
    for (int t = 0; t < nt; t += 2) {
      const bool last = (t == nt - 2);
      const char* a1 = cA + (size_t)(t + 1) * kstep;
      const char* a2 = last ? nA : cA + (size_t)(t + 2) * kstep; const char* b2 = last ? nB : cB + (size_t)(t + 2) * kstep;
      const char* a3 = a2 + kstep; const char* b3 = b2 + kstep;
      const bool nbs = last ? (nxt.nb != 0) : (cur.nb != 0);
      const unsigned ds = nbs ? 0u : dperm; const unsigned vb[2] = {voffA[0] + ds, voffA[1] + ds};
      G_LDB(B0, 0, 0); G_SCHED; G_LDA(At, 0, 0); G_STAGE(G_SA(1, 1), a1 + hstep, voffA);
      G_WAIT_L(8); G_BAR; G_WAIT_L(0); G_MMA(0, 0, At, B0); G_BAR; G_SCHED;
      G_LDB(B1, 0, 1); G_STAGE(G_SB(0, 0), b2, vb);
      G_BAR; G_WAIT_L(0); G_MMA(0, 1, At, B1); G_BAR;
      G_LDA(At, 0, 1); G_STAGE(G_SA(0, 0), a2, voffA);
      G_BAR; G_WAIT_L(0); G_MMA(1, 0, At, B0); G_BAR; G_SCHED;
      G_STAGE(G_SB(0, 1), b2 + hstep, vb);
      G_WAIT_V(6); G_BAR; G_MMA(1, 1, At, B1); G_BAR;
      G_LDB(B0, 1, 0); G_SCHED; G_LDA(At, 1, 0); G_STAGE(G_SA(0, 1), a2 + hstep, voffA);
      G_WAIT_L(8); G_BAR; G_WAIT_L(0); G_MMA(0, 0, At, B0); G_BAR; G_SCHED;
      G_LDB(B1, 1, 1); G_STAGE(G_SB(1, 0), b3, vb);
      G_BAR; G_WAIT_L(0); G_MMA(0, 1, At, B1); G_BAR;
      G_LDA(At, 1, 1); G_STAGE(G_SA(1, 0), a3, voffA);
      G_BAR; G_WAIT_L(0); G_MMA(1, 0, At, B0); G_BAR; G_SCHED;
      G_STAGE(G_SB(1, 1), b3 + hstep, vb);
      G_WAIT_V(6); G_BAR; G_MMA(1, 1, At, B1); G_BAR;
    }
    { const int t2 = opaque_tid() & 63; E(acc, cur, wr, wc, t2 & 15, t2 >> 4, lds, ui & 1); }
    if (!has_next) break;
    cur = nxt; cA = nA; cB = nB; ++ui;
    { const int t3 = opaque_tid() & 63; E.init(acc, cur, wr, wc, t3 & 15, t3 >> 4, lds, ui & 1); }
  }
  G_WAIT_V(0);
  if (wr == 0) G_BAR;
  G_BAR;
}

#define XB_TMO      128
#define XB_XCNT(j)  (256  + 64 * (j))
#define XB_XSUB(j)  (1280 + 64 * (j))
#define XB_XGEN(j)  (2304 + 64 * (j))
#define XB_TOP      3328
#define XB_TOPGEN   3392
#define XCD_BAR_WORDS 3456
#define XB_SPIN_CAP (1u << 18)
DI unsigned xb_ld(unsigned* p) { return __hip_atomic_load(p, __ATOMIC_RELAXED, __HIP_MEMORY_SCOPE_AGENT); }
DI unsigned xb_add(unsigned* p, unsigned v) { return __hip_atomic_fetch_add(p, v, __ATOMIC_RELAXED, __HIP_MEMORY_SCOPE_AGENT); }
DI unsigned xb_xcc_id() { return (unsigned)__builtin_amdgcn_s_getreg((3 << 11) | 20) & 0xFu; }
#define XB_SPIN(cond, bar) do { unsigned _sp = 0; while (cond) { __builtin_amdgcn_s_sleep(1); \
    if ((++_sp & 255u) == 0u) { if (xb_ld(&(bar)[XB_TMO])) break; if (_sp > XB_SPIN_CAP) { atomicAdd(&(bar)[XB_TMO], 1u); break; } } } } while (0)
struct XcdBarrier { unsigned* bar; unsigned x; volatile LAS unsigned* st; };
DI XcdBarrier xcd_barrier_post(unsigned* bar, volatile LAS unsigned* st) {
  XcdBarrier b; b.bar = bar; b.x = xb_xcc_id(); b.st = st;
  if (threadIdx.x == 0) (void)xb_add(&bar[XB_XCNT(b.x)], 1u);
  return b;
}
DI void xcd_barrier_complete(unsigned* bar, unsigned x, unsigned& nloc, unsigned& nx) {
  const unsigned G = gridDim.x * gridDim.y * gridDim.z;
  unsigned sum, cnt, mine, sp = 0u;
  for (;;) {
    sum = 0u; cnt = 0u; mine = 0u;
#pragma unroll
    for (unsigned j = 0; j < 16; ++j) { const unsigned c = xb_ld(&bar[XB_XCNT(j)]); sum += c; cnt += (c > 0u) ? 1u : 0u; mine = (j == x) ? c : mine; }
    if (sum == G) break;
    __builtin_amdgcn_s_sleep(1);
    if ((++sp & 255u) == 0u) { if (xb_ld(&bar[XB_TMO])) break; if (sp > XB_SPIN_CAP) { atomicAdd(&bar[XB_TMO], 1u); break; } }
  }
  nloc = mine > 0u ? mine : 1u; nx = cnt > 0u ? cnt : 1u;
}
DI void xcd_barrier(const XcdBarrier& b) {
  asm volatile("s_waitcnt vmcnt(0)" ::: "memory");
  __syncthreads();
  if (threadIdx.x == 0) {
    unsigned* bar = b.bar;
    __builtin_amdgcn_s_waitcnt(0);
    unsigned nloc = b.st[0], nx = b.st[1];
    if (nloc == 0u) { xcd_barrier_complete(bar, b.x, nloc, nx); b.st[0] = nloc; b.st[1] = nx; }
    const unsigned old = xb_add(&bar[XB_XSUB(b.x)], 1u);
    const unsigned gen = old / nloc;
    if (old + 1u == (gen + 1u) * nloc) {
      __builtin_amdgcn_fence(__ATOMIC_RELEASE, "agent");
      asm volatile("s_waitcnt vmcnt(0)" ::: "memory");
      const unsigned og = xb_add(&bar[XB_TOP], 1u);
      const unsigned tg = og / nx;
      if (og + 1u == (tg + 1u) * nx) xb_add(&bar[XB_TOPGEN], 1u);
      else XB_SPIN(xb_ld(&bar[XB_TOPGEN]) == tg, bar);
      __builtin_amdgcn_fence(__ATOMIC_ACQUIRE, "agent");
      xb_add(&bar[XB_XGEN(b.x)], 1u);
      asm volatile("s_waitcnt vmcnt(0)" ::: "memory");
    } else {
      XB_SPIN(xb_ld(&bar[XB_XGEN(b.x)]) == gen, bar);
      __builtin_amdgcn_fence(__ATOMIC_ACQUIRE, "agent");
      asm volatile("s_waitcnt vmcnt(0)" ::: "memory");
    }
  }
  __syncthreads();
}

DI void tile_map(int wgid, int nM, int nN, int& pm, int& pn) {
  const int nwg = nM * nN;
  { int q = nwg / 8, r = nwg % 8, xcd = wgid % 8, off = wgid / 8; wgid = (xcd < r ? xcd * (q + 1) : r * (q + 1) + (xcd - r) * q) + off; }
  const int nig = 8 * nN, gid = wgid / nig, fm = gid * 8, gsz = min(nM - fm, 8);
  pm = fm + ((wgid % nig) % gsz); pn = (wgid % nig) / gsz;
}

struct Sched1 {
  const bf16_t* hb; const bf16_t* W; int ubeg, uend;
  DI bool next(int i, Unit& u) const {
    const int U = ubeg + i * (int)gridDim.x + (int)blockIdx.x; if (U >= uend) return false;
    int pm, pn;
    if (U < 928) tile_map(U, 29, 32, pm, pn);
    else if (U < 1024) { const int q = U - 928, c = q % 24; pm = 29 + q / 24; pn = c < 12 ? c : c + 4; }
    else { const int q = U - 1024, g = q & 7; pm = 29 + (q >> 3); pn = g < 4 ? 12 + g : 24 + g; }
    u.mt = pm; u.nt = pn; u.k0 = 0; u.nkt = 32; const int g = pn >> 2; u.tr = (g == 1 || g == 2 || g == 6) ? 1 : 0; u.nb = u.tr; return true;
  }
  DI const char* pa(const Unit& u) const { return u.tr ? (const char*)W + (size_t)u.nt * TSTEP : (const char*)hb + (size_t)u.mt * TSTEP; }
  DI const char* pb(const Unit& u) const { return u.tr ? (const char*)hb + (size_t)u.mt * TSTEP : (const char*)W + (size_t)u.nt * TSTEP; }
};
struct Sched2 {
  const bf16_t* mix; const bf16_t* W;
  DI bool next(int i, Unit& u) const {
    const int U = i * (int)gridDim.x + (int)blockIdx.x; if (U >= 256 + 64) return false;
    if (U < 256) { int pm, pn; tile_map(U, 32, 8, pm, pn); u.mt = pm; u.nt = pn; u.tr = 0; u.k0 = 0; u.nkt = 32; u.nb = 0; }
    else { const int j = U - 256; u.mt = 32; u.nt = j >> 3; u.tr = 1 + (j & 7); u.k0 = (j & 7) * 256; u.nkt = 4; u.nb = 0; }
    return true;
  }
  DI const char* pa(const Unit& u) const { return (const char*)mix + (size_t)u.mt * TSTEP + (size_t)u.k0 * 2; }
  DI const char* pb(const Unit& u) const { return (const char*)W + (size_t)u.nt * TSTEP + (size_t)u.k0 * 2; }
};

DI void acc_zero(f32x4 (&acc)[2][2][4][2]) {
#pragma unroll
  for (int a = 0; a < 2; ++a)
#pragma unroll
    for (int b = 0; b < 2; ++b)
#pragma unroll
      for (int m = 0; m < 4; ++m)
#pragma unroll
        for (int n = 0; n < 2; ++n) acc[a][b][m][n] = (f32x4){0.f, 0.f, 0.f, 0.f};
}
struct Epi1 {
  bf16_t* proj; bf16_t* T; const float* ss;
  DI void init(f32x4 (&acc)[2][2][4][2], const Unit& u, int wr, int wc, int fr, int fq, LAS unsigned char* lds, int par) const {
    acc_zero(acc);
    if (wr == 0)
      __builtin_amdgcn_global_load_lds((const unsigned*)(ss + u.mt * 256 + wc * 64 + fq * 16 + fr), (LAS unsigned*)(lds + 131072 + par * 1024 + wc * 256), 4, 0, 0);
  }
  DI void operator()(const f32x4 (&acc)[2][2][4][2], const Unit& u, int wr, int wc, int fr, int fq, LAS unsigned char* lds, int par) const {
    const LAS float* ssl = (const LAS float*)(lds + 131072 + par * 1024);
    const int g = u.nt >> 2;
    if (!u.tr) {
      const float sc = (g == 4) ? 0.125f * LOG2E : 1.f;
      const int n0 = u.nt * 256 + wc * 32 + fq * 8;
#pragma unroll
      for (int ai = 0; ai < 2; ++ai)
#pragma unroll
        for (int mi = 0; mi < 4; ++mi) {
          const int m = u.mt * 256 + ai * 128 + wr * 64 + mi * 16 + fr;
          const float rs = rsqrtf(ssl[ai * 128 + wr * 64 + mi * 16 + fr] * (1.f / 2048.f) + 1e-6f) * sc;
          bf16_t* rowp = proj + (size_t)m * NIN + n0;
#pragma unroll
          for (int bj = 0; bj < 2; ++bj) {
            const f32x4 a = acc[ai][bj][mi][0], c = acc[ai][bj][mi][1];
            const u32x4 o = {pk2(a[0] * rs, a[1] * rs), pk2(a[2] * rs, a[3] * rs), pk2(c[0] * rs, c[1] * rs), pk2(c[2] * rs, c[3] * rs)};
            *(u32x4*)(rowp + bj * 128) = o;
          }
        }
    } else {
      const int tbase = (g == 1 ? 0 : (g == 2 ? 1024 : 2048)) - g * 1024;
#pragma unroll
      for (int bj = 0; bj < 2; ++bj) {
        const int mb = u.mt * 256 + bj * 128 + wc * 32;
        const int b = mb / LROW, posb = mb - b * LROW;
        const f32x4 q0 = *(const LAS f32x4*)(ssl + bj * 128 + wc * 32 + 4 * fq), q1 = *(const LAS f32x4*)(ssl + bj * 128 + wc * 32 + 16 + 4 * fq);
        float rs[8];
#pragma unroll
        for (int j = 0; j < 4; ++j) { rs[j] = rsqrtf(q0[j] * (1.f / 2048.f) + 1e-6f); rs[4 + j] = rsqrtf(q1[j] * (1.f / 2048.f) + 1e-6f); }
        const int p0 = posb + 4 * fq, p1 = p0 + 16;
        if (g == 1) {
#pragma unroll
          for (int j = 0; j < 4; ++j) { rs[j] = (p0 + j >= 48) ? rs[j] * 0.08838834764831845f : 0.f; rs[4 + j] = (p1 + j >= 48) ? rs[4 + j] * 0.08838834764831845f : 0.f; }
        }
#pragma unroll
        for (int ai = 0; ai < 2; ++ai)
#pragma unroll
          for (int mi = 0; mi < 4; ++mi) {
            const int col = u.nt * 256 + ai * 128 + wr * 64 + mi * 16 + fr;
            const f32x4 a = acc[ai][bj][mi][0], c = acc[ai][bj][mi][1];
            float v[8] = {a[0] * rs[0], a[1] * rs[1], a[2] * rs[2], a[3] * rs[3], c[0] * rs[4], c[1] * rs[5], c[2] * rs[6], c[3] * rs[7]};
            if (g == 1) {
              const int hh = (col - 1024) >> 7;
              const float l2g = log2f(1.f - exp2f(-5.f - (float)hh));
              const int z0 = 63 - (p0 & 63), z1 = 63 - (p1 & 63);
#pragma unroll
              for (int j = 0; j < 4; ++j) { v[j] *= exp2f(l2g * (float)(z0 - j)); v[4 + j] *= exp2f(l2g * (float)(z1 - j)); }
            }
            const u32x4 o = {pk2(v[0], v[1]), pk2(v[2], v[3]), pk2(v[4], v[5]), pk2(v[6], v[7])};
            const int trow = (g == 1) ? (col & ~31) + 16 * ((col >> 2) & 1) + 4 * ((col >> 3) & 3) + (col & 3) : col;
            *(u32x4*)(T + ((size_t)(b * 3072 + tbase + trow)) * LROW + posb + 8 * fq) = o;
          }
      }
    }
  }
};
struct Epi2 {
  float* h; float* P2; bf16_t* hb; float* ssn; const float* x; const float* meta;
  DI void init(f32x4 (&acc)[2][2][4][2], const Unit& u, int wr, int wc, int fr, int fq, LAS unsigned char*, int) const {
    if (u.tr) { acc_zero(acc); return; }
    const int n0 = u.nt * 256 + wc * 32 + fq * 8;
#pragma unroll
    for (int ai = 0; ai < 2; ++ai)
#pragma unroll
      for (int mi = 0; mi < 4; ++mi) {
        const int m = u.mt * 256 + ai * 128 + wr * 64 + mi * 16 + fr;
        const float* rowp = h + (size_t)m * DM + n0;
        if (x) { const int b = m / LROW, pos = m - b * LROW; rowp = pos < 48 ? nullptr : (pos < 64 ? meta + (size_t)(pos - 48) * DM : x + ((size_t)b * 2048 + (pos - 64)) * DM) + n0; }
#pragma unroll
        for (int bj = 0; bj < 2; ++bj)
#pragma unroll
          for (int ni = 0; ni < 2; ++ni) acc[ai][bj][mi][ni] = rowp ? __builtin_nontemporal_load((const f32x4*)(rowp + bj * 128 + ni * 4)) : (f32x4){0.f, 0.f, 0.f, 0.f};
      }
  }
  DI void operator()(const f32x4 (&acc)[2][2][4][2], const Unit& u, int wr, int wc, int fr, int fq, LAS unsigned char*, int) const {
    const int n0 = u.nt * 256 + wc * 32 + fq * 8;
#pragma unroll
    for (int ai = 0; ai < 2; ++ai)
#pragma unroll
      for (int mi = 0; mi < 4; ++mi) {
        const int m = u.mt * 256 + ai * 128 + wr * 64 + mi * 16 + fr;
        float* rowp = (u.tr ? P2 + ((size_t)(u.tr - 1) * 256 + (m - 8192)) * DM : h + (size_t)m * DM) + n0;
        float sq = 0.f;
#pragma unroll
        for (int bj = 0; bj < 2; ++bj) {
          const f32x4 a = acc[ai][bj][mi][0], c = acc[ai][bj][mi][1];
          *(f32x4*)(rowp + bj * 128) = a; *(f32x4*)(rowp + bj * 128 + 4) = c;
          if (ssn && !u.tr) {
            sq += a[0] * a[0] + a[1] * a[1] + a[2] * a[2] + a[3] * a[3] + c[0] * c[0] + c[1] * c[1] + c[2] * c[2] + c[3] * c[3];
            const u32x4 o = {pk2(a[0], a[1]), pk2(a[2], a[3]), pk2(c[0], c[1]), pk2(c[2], c[3])};
            *(u32x4*)(hb + (size_t)m * DM + n0 + bj * 128) = o;
          }
        }
        if (ssn && !u.tr) {
          sq += __shfl_xor(sq, 16); sq += __shfl_xor(sq, 32);
          if (fq == 0) unsafeAtomicAdd(ssn + m, sq);
        }
      }
  }
};

DI void gemm1_phase(const Params& p, int l, LAS unsigned char* lds, int ubeg, int uend) {
  Sched1 S{p.hb, p.WinT + (size_t)l * NIN * DM, ubeg, uend}; Epi1 E{p.proj, p.T, p.ss + (size_t)l * MROWS};
  gemm_phase(lds, S, E);
}
DI void gemm2_phase(const Params& p, int l, LAS unsigned char* lds) {
  Sched2 S{p.mix, p.WoutT + (size_t)l * DM * DM}; Epi2 E{p.h, p.P2, p.hb, l == 0 ? p.ss + MROWS : nullptr, l == 0 ? p.x : nullptr, p.meta};
  gemm_phase(lds, S, E);
}

DI void ret_scan_chain(const Params& p, int b, int h, LAS unsigned char* lds, unsigned* done_ctr) {
  constexpr int D = 6;
  const int tid = opaque_tid(), w = __builtin_amdgcn_readfirstlane(tid >> 6), lane = tid & 63, fr = lane & 15, fq = lane >> 4;
  const float l2g = log2f(1.f - exp2f(-5.f - (float)h));
  const float dec64 = exp2f(l2g * 64.f);
  const int sub16 = lds_byte(fr, fq * 8);
  const int frow = ((tid >> 4) & 31) * 2 + ((tid >> 2) & 1), fcol = ((tid >> 3) & 1) * 32 + (tid & 3) * 8;
  const int fillT = lds_byte(frow, fcol);
  const bf16_t* gk = p.T + (size_t)b * 3072 * LROW + (size_t)(h * 128 + frow) * LROW + fcol;
  u32x4* so = (u32x4*)p.ST + ((size_t)((b * 8 + h) * NCH) * 8 + w) * 256 + lane;
  f32x4 st[8];
#pragma unroll
  for (int i = 0; i < 8; ++i) st[i] = (f32x4){0.f, 0.f, 0.f, 0.f};
  u32x4 ring[D][4];
#define SCAN_LOAD(slot, n) do { const bf16_t* _t = gk + (n) * 64; ring[slot][0] = *(const u32x4*)_t; ring[slot][1] = *(const u32x4*)(_t + (size_t)64 * LROW); \
    ring[slot][2] = *(const u32x4*)(_t + (size_t)1024 * LROW); ring[slot][3] = *(const u32x4*)(_t + (size_t)1088 * LROW); } while (0)
#define SCAN_STORE(n) do { _Pragma("unroll") for (int kd = 0; kd < 4; ++kd) { const f32x4 sa = st[2 * kd], sc = st[2 * kd + 1]; \
    const u32x4 bsu = {pk2(sa[0], sa[1]), pk2(sa[2], sa[3]), pk2(sc[0], sc[1]), pk2(sc[2], sc[3])}; so[(size_t)(n) * 2048 + kd * 64] = bsu; } } while (0)
#pragma unroll
  for (int i = 0; i < D; ++i) SCAN_LOAD(i, i);
#pragma unroll
  for (int n = 0; n < NCH - 1; ++n) {
    const int slot = n % D, bo = (n & 1) * 32768;
    *(LAS u32x4*)(lds + bo + fillT) = ring[slot][0]; *(LAS u32x4*)(lds + bo + fillT + 8192) = ring[slot][1];
    *(LAS u32x4*)(lds + bo + 16384 + fillT) = ring[slot][2]; *(LAS u32x4*)(lds + bo + 16384 + fillT + 8192) = ring[slot][3];
    if (n + D < NCH - 1) SCAN_LOAD(slot, n + D);
    __syncthreads();
    SCAN_STORE(n);
    const bf16x8 vf0 = *(const LAS bf16x8*)(lds + bo + 16384 + w * 2048 + sub16), vf1 = *(const LAS bf16x8*)(lds + bo + 16384 + w * 2048 + 1024 + sub16);
#pragma unroll
    for (int db = 0; db < 8; ++db) {
      st[db] *= dec64;
      const bf16x8 a0 = *(const LAS bf16x8*)(lds + bo + sub16 + db * 2048);
      const bf16x8 a1 = *(const LAS bf16x8*)(lds + bo + sub16 + db * 2048 + 1024);
      st[db] = MFMA16(a0, vf0, st[db]); st[db] = MFMA16(a1, vf1, st[db]);
    }
  }
  SCAN_STORE(NCH - 1);
  asm volatile("s_waitcnt vmcnt(0)" ::: "memory");
  __syncthreads();
  if (threadIdx.x == 0) { __builtin_amdgcn_fence(__ATOMIC_RELEASE, "agent"); asm volatile("s_waitcnt vmcnt(0)" ::: "memory"); xb_add(done_ctr, 1u); }
#undef SCAN_LOAD
#undef SCAN_STORE
}

DI void retention_items(const Params& p, int l, LAS unsigned char* lds, int first, int stride, int count) {
  constexpr int QS = 0, KS = 16384, VTS = 49152, PS = 65536, OS = 73728;
  const int tid = opaque_tid(), w = __builtin_amdgcn_readfirstlane(tid >> 6), lane = tid & 63, fr = lane & 15, fq = lane >> 4;
  const int sub16 = lds_byte(fr, fq * 8), sub8a = lds_byte(fr, fq * 4), sub8b = lds_byte(fr, fq * 4 + 16);
  const int tq = ((tid >> 5) & 15) * 2 + ((tid >> 2) & 1), dq = ((tid >> 4) & 1) * 64 + ((tid >> 3) & 1) * 32 + (tid & 3) * 8;
  const int ve = ((tid >> 4) & 31) * 2 + ((tid >> 2) & 1), vs0 = ((tid >> 3) & 1) * 32 + (tid & 3) * 8;
  const int fillQ = (dq >> 6) * 8192 + lds_byte(tq, dq & 63);
  const int fillT = lds_byte(ve, vs0);
  const int sb = w & 3, tb0 = (w >> 2) * 2;
  const int kbase = KS + sb * 2048 + sub16, qbase = QS + tb0 * 2048 + sub16;
  const int pbase = PS + tb0 * 2048 + (sb >> 1) * 1024 + lds_byte(fr, fq * 8 + 4 * (sb & 1));
  const int vbase = VTS + w * 2048 + sub16;
  const int obase = OS + ((fq * 4) * 132 + w * 16 + fr) * 4;
  const int nbase = OS + ((tid >> 3) * 132 + (tid & 7) * 16) * 4;
  u32x4 pq0, pq1, pk0, pk1, pv0, pv1, ns0, ns1, ns2, ns3, ng0, ng1;
#define RET_GLOAD(it) do { const int _bh = (it) / NCH, _n = (it) - _bh * NCH, _b = _bh >> 3, _h = _bh & 7; \
    const bf16_t* _q = p.proj + ((size_t)_b * LROW + _n * 64 + tq) * NIN + _h * 128 + dq; \
    const bf16_t* _tk = p.T + ((size_t)_b * 3072 + _h * 128 + (tid >> 3)) * LROW + _n * 64 + (tid & 7) * 8; \
    const bf16_t* _tv = p.T + ((size_t)_b * 3072 + 1024 + _h * 128 + ve) * LROW + _n * 64 + vs0; \
    pq0 = *(const u32x4*)_q; pq1 = *(const u32x4*)(_q + (size_t)32 * NIN); pk0 = *(const u32x4*)_tk; pk1 = *(const u32x4*)(_tk + (size_t)64 * LROW); \
    pv0 = *(const u32x4*)_tv; pv1 = *(const u32x4*)(_tv + (size_t)64 * LROW); \
    const u32x4* _sp = (const u32x4*)p.ST + ((size_t)(it) * 8 + w) * 256 + lane; ns0 = _sp[0]; ns1 = _sp[64]; ns2 = _sp[128]; ns3 = _sp[192]; \
    const bf16_t* _gp = p.proj + ((size_t)_b * LROW + _n * 64 + (tid >> 3)) * NIN + 3072 + _h * 128 + (tid & 7) * 16; \
    ng0 = *(const u32x4*)_gp; ng1 = *(const u32x4*)(_gp + 8); } while (0)
  int it = first;
  const int iend = first + stride * count;
  if (it < iend) RET_GLOAD(it);
  for (; it < iend; it += stride) {
    const int bh = it / NCH, n = it - bh * NCH, b = bh >> 3, h = bh & 7;
    const float l2g = log2f(1.f - exp2f(-5.f - (float)h));
    *(LAS u32x4*)(lds + QS + fillQ) = pq0; *(LAS u32x4*)(lds + QS + fillQ + 4096) = pq1;
    {
      const int d0 = tid >> 3, s0 = (tid & 7) * 8;
#pragma unroll
      for (int i = 0; i < 2; ++i) {
        const u32x4 kv = i ? pk1 : pk0;
        const int r_ = d0 + 64 * i, d = (r_ & ~31) + 8 * ((r_ >> 2) & 3) + 4 * ((r_ >> 4) & 1) + (r_ & 3), ko = KS + (d >> 6) * 8192;
#pragma unroll
        for (int j = 0; j < 8; ++j) {
          const unsigned wv = kv[j >> 1];
          const int st = (s0 & 32) + 16 * (j >> 2) + 4 * ((s0 >> 3) & 3) + (j & 3);
          *(LAS bf16_t*)(lds + ko + lds_byte(st, d & 63)) = (bf16_t)((j & 1) ? (wv >> 16) : (wv & 0xffffu));
        }
      }
    }
    *(LAS u32x4*)(lds + VTS + fillT) = pv0; *(LAS u32x4*)(lds + VTS + fillT + 8192) = pv1;
    const u32x4 sf0 = ns0, sf1 = ns1, sf2 = ns2, sf3 = ns3, g0 = ng0, g1 = ng1;
    __syncthreads();
    if (it + stride < iend) RET_GLOAD(it + stride);
    const size_t row = (size_t)b * LROW + n * 64 + (tid >> 3);
    {
      f32x4 s0 = {0.f, 0.f, 0.f, 0.f}, s1 = {0.f, 0.f, 0.f, 0.f};
#pragma unroll
      for (int ks = 0; ks < 4; ++ks) {
        const int off = (ks >> 1) * 8192 + (ks & 1) * 1024;
        const bf16x8 a = *(const LAS bf16x8*)(lds + kbase + off);
        const bf16x8 b0 = *(const LAS bf16x8*)(lds + qbase + off);
        const bf16x8 b1 = *(const LAS bf16x8*)(lds + qbase + off + 2048);
        s0 = MFMA16(a, b0, s0); s1 = MFMA16(a, b1, s1);
      }
      const int srow = sb * 16 + fq * 4;
#pragma unroll
      for (int i = 0; i < 2; ++i) {
        const f32x4 sv = i ? s1 : s0;
        const int t = (tb0 + i) * 16 + fr;
        const float v0 = sv[0] * EXP2(l2g * (fabsf((float)(t - srow)) - (float)(63 - srow))), v1 = sv[1] * EXP2(l2g * (fabsf((float)(t - srow - 1)) - (float)(62 - srow)));
        const float v2 = sv[2] * EXP2(l2g * (fabsf((float)(t - srow - 2)) - (float)(61 - srow))), v3 = sv[3] * EXP2(l2g * (fabsf((float)(t - srow - 3)) - (float)(60 - srow)));
        const u32x2 o = {pk2(v0, v1), pk2(v2, v3)};
        *(LAS u32x2*)(lds + pbase + i * 2048) = o;
      }
    }
    __syncthreads();
    {
      const bf16x8 vf0 = *(const LAS bf16x8*)(lds + vbase), vf1 = *(const LAS bf16x8*)(lds + vbase + 1024);
      f32x4 o[4], cr[4];
#pragma unroll
      for (int tb = 0; tb < 4; ++tb) {
        o[tb] = (f32x4){0.f, 0.f, 0.f, 0.f}; cr[tb] = (f32x4){0.f, 0.f, 0.f, 0.f};
        const bf16x8 a0 = *(const LAS bf16x8*)(lds + PS + sub16 + tb * 2048);
        const bf16x8 a1 = *(const LAS bf16x8*)(lds + PS + sub16 + tb * 2048 + 1024);
        o[tb] = MFMA16(a0, vf0, o[tb]); o[tb] = MFMA16(a1, vf1, o[tb]);
      }
#pragma unroll
      for (int kd = 0; kd < 4; ++kd) {
        const bf16x8 bsv = __builtin_bit_cast(bf16x8, kd == 0 ? sf0 : (kd == 1 ? sf1 : (kd == 2 ? sf2 : sf3)));
#pragma unroll
        for (int tb = 0; tb < 4; ++tb) {
          const bf16x8 a = *(const LAS bf16x8*)(lds + QS + (kd >> 1) * 8192 + (tb * 2 + (kd & 1)) * 1024 + sub16);
          cr[tb] = MFMA16(a, bsv, cr[tb]);
        }
      }
#pragma unroll
      for (int tb = 0; tb < 4; ++tb)
#pragma unroll
        for (int j = 0; j < 4; ++j) o[tb][j] += EXP2(l2g * (float)(tb * 16 + fq * 4 + j + 1)) * cr[tb][j];
#pragma unroll
      for (int tb = 0; tb < 4; ++tb)
#pragma unroll
        for (int j = 0; j < 4; ++j) *(LAS float*)(lds + obase + (tb * 16 + j) * 528) = o[tb][j];
    }
    __syncthreads();
    {
      const int seg = tid & 7;
      const f32x4 x0 = *(const LAS f32x4*)(lds + nbase), x1 = *(const LAS f32x4*)(lds + nbase + 16), x2 = *(const LAS f32x4*)(lds + nbase + 32), x3 = *(const LAS f32x4*)(lds + nbase + 48);
      f32x4 xs = x0 + x1 + x2 + x3;
      float sum = xs[0] + xs[1] + xs[2] + xs[3];
      sum += __shfl_xor(sum, 1); sum += __shfl_xor(sum, 2); sum += __shfl_xor(sum, 4);
      const float mu = sum * (1.f / 128.f);
      const f32x4 d0 = x0 - mu, d1 = x1 - mu, d2 = x2 - mu, d3 = x3 - mu;
      const f32x4 q = d0 * d0 + d1 * d1 + d2 * d2 + d3 * d3;
      float vs = q[0] + q[1] + q[2] + q[3];
      vs += __shfl_xor(vs, 1); vs += __shfl_xor(vs, 2); vs += __shfl_xor(vs, 4);
      const float rn = rsqrtf(vs * (1.f / 128.f) + 1e-6f);
      const float* gr = p.ret_g + l * 1024 + h * 128 + seg * 16;
      const f32x4 w0 = *(const f32x4*)gr, w1 = *(const f32x4*)(gr + 4), w2 = *(const f32x4*)(gr + 8), w3 = *(const f32x4*)(gr + 12);
      uint4 oa, ob;
      oa.x = pk2(d0[0] * rn * w0[0] * silu(bflo(g0[0])), d0[1] * rn * w0[1] * silu(bfhi(g0[0])));
      oa.y = pk2(d0[2] * rn * w0[2] * silu(bflo(g0[1])), d0[3] * rn * w0[3] * silu(bfhi(g0[1])));
      oa.z = pk2(d1[0] * rn * w1[0] * silu(bflo(g0[2])), d1[1] * rn * w1[1] * silu(bfhi(g0[2])));
      oa.w = pk2(d1[2] * rn * w1[2] * silu(bflo(g0[3])), d1[3] * rn * w1[3] * silu(bfhi(g0[3])));
      ob.x = pk2(d2[0] * rn * w2[0] * silu(bflo(g1[0])), d2[1] * rn * w2[1] * silu(bfhi(g1[0])));
      ob.y = pk2(d2[2] * rn * w2[2] * silu(bflo(g1[1])), d2[3] * rn * w2[3] * silu(bfhi(g1[1])));
      ob.z = pk2(d3[0] * rn * w3[0] * silu(bflo(g1[2])), d3[1] * rn * w3[1] * silu(bfhi(g1[2])));
      ob.w = pk2(d3[2] * rn * w3[2] * silu(bflo(g1[3])), d3[3] * rn * w3[3] * silu(bfhi(g1[3])));
      bf16_t* mp = p.mix + row * DM + h * 128 + seg * 16;
      *(uint4*)mp = oa; *(uint4*)(mp + 8) = ob;
    }
  }
#undef RET_GLOAD
}

DI void diff_pv(LAS unsigned char* lds, int vgb, const bf16x8 (&pfr)[2][2], f32x4 (&o)[2][8], int sub16) {
  __builtin_amdgcn_s_setprio(1);
#pragma unroll
  for (int eb = 0; eb < 8; ++eb)
#pragma unroll
    for (int kp = 0; kp < 2; ++kp) {
      const bf16x8 a = *(const LAS bf16x8*)(lds + vgb + (eb * 2 + kp) * 1024 + sub16);
      o[0][eb] = MFMA16(a, pfr[0][kp], o[0][eb]);
      o[1][eb] = MFMA16(a, pfr[1][kp], o[1][eb]);
    }
  __builtin_amdgcn_s_setprio(0);
}
DI void diff_tile(bool general, LAS unsigned char* lds, int kfb, const bf16x8 (&qf)[2][2], f32x4 (&o)[2][8], bf16x8 (&pfr)[2][2], float& m0, float& m1, float& l0, float& l1,
                  const f32x4 (&cj)[4], float slope2, int kt, int qrow, int fq) {
  f32x4 s[2][4];
#pragma unroll
  for (int kb = 0; kb < 4; ++kb) {
    const f32x4 init = cj[kb];
    const bf16x8 a0 = *(const LAS bf16x8*)(lds + kfb + (kb * 2) * 1024);
    const bf16x8 a1 = *(const LAS bf16x8*)(lds + kfb + (kb * 2 + 1) * 1024);
    s[0][kb] = MFMA16(a0, qf[0][0], init); s[1][kb] = MFMA16(a0, qf[1][0], init);
    s[0][kb] = MFMA16(a1, qf[0][1], s[0][kb]); s[1][kb] = MFMA16(a1, qf[1][1], s[1][kb]);
  }
  const float tconst = slope2 * (float)(kt * 64);
#pragma unroll
  for (int rb = 0; rb < 2; ++rb) {
    if (general) {
      const int qrel = qrow + rb * 16 - kt * 64;
      const float ms2 = -2.f * slope2;
#pragma unroll
      for (int kb = 0; kb < 4; ++kb)
#pragma unroll
        for (int j = 0; j < 4; ++j) {
          const int kl = kb * 16 + fq * 4 + j;
          float v = s[rb][kb][j] + ms2 * (float)max(kl - qrel, 0);
          if (kt == 0 && kl < 48) v = -INFINITY;
          s[rb][kb][j] = v;
        }
    }
    float mx = fmaxf(fmaxf(s[rb][0][0], s[rb][0][1]), fmaxf(s[rb][0][2], s[rb][0][3]));
#pragma unroll
    for (int kb = 1; kb < 4; ++kb) mx = fmaxf(fmaxf(mx, fmaxf(s[rb][kb][0], s[rb][kb][1])), fmaxf(s[rb][kb][2], s[rb][kb][3]));
    mx = xmax32(xmax16(mx));
    const float mloc = (rb ? m1 : m0) - tconst;
    float mnew = mloc, alpha = 1.f;
    if (!__all(mx <= mloc + 8.f)) {
      mnew = fmaxf(mloc, mx); alpha = EXP2(mloc - mnew);
#pragma unroll
      for (int eb = 0; eb < 8; ++eb) o[rb][eb] *= alpha;
    }
    float rsum = 0.f;
#pragma unroll
    for (int kb = 0; kb < 4; ++kb)
#pragma unroll
      for (int j = 0; j < 4; ++j) { const float pv = EXP2(s[rb][kb][j] - mnew); s[rb][kb][j] = pv; rsum += pv; }
    if (rb) { l1 = l1 * alpha + rsum; m1 = mnew + tconst; } else { l0 = l0 * alpha + rsum; m0 = mnew + tconst; }
#pragma unroll
    for (int kp = 0; kp < 2; ++kp) {
      const f32x4 sa = s[rb][2 * kp], sc = s[rb][2 * kp + 1];
      const u32x4 pbu = {pk2(sa[0], sa[1]), pk2(sa[2], sa[3]), pk2(sc[0], sc[1]), pk2(sc[2], sc[3])};
      pfr[rb][kp] = __builtin_bit_cast(bf16x8, pbu);
    }
  }
}

DI void diff_item(const Params& p, int l, int b, int h, int pi, float lam, float lam_init, LAS unsigned char* lds, bool& gsync) {
  const int tid = opaque_tid(), w = __builtin_amdgcn_readfirstlane(tid >> 6), lane = tid & 63, fr = lane & 15, fq = lane >> 4;
  const int c = w & 1, rgq = w >> 1, qc = 2 * pi + (rgq >> 1);
  const bool active = qc <= 32;
  const int ktmax = min(2 * pi + 1, 32);
  const int sub16 = lds_byte(fr, fq * 8), sub8a = lds_byte(fr, fq * 4), sub8b = lds_byte(fr, fq * 4 + 16);
  const bf16_t* projb = p.proj + (size_t)b * LROW * NIN;
  const int qrow = qc * 64 + (rgq & 1) * 32 + fr;
  bf16x8 qf[2][2];
#pragma unroll
  for (int rb = 0; rb < 2; ++rb)
#pragma unroll
    for (int ks = 0; ks < 2; ++ks)
      qf[rb][ks] = active ? *(const bf16x8*)(projb + (size_t)(qrow + rb * 16) * NIN + 4096 + h * 128 + c * 64 + ks * 32 + fq * 8) : (bf16x8){0, 0, 0, 0, 0, 0, 0, 0};
  float m0 = -INFINITY, m1 = -INFINITY, l0 = 0.f, l1 = 0.f;
  f32x4 o[2][8];
#pragma unroll
  for (int rb = 0; rb < 2; ++rb)
#pragma unroll
    for (int eb = 0; eb < 8; ++eb) o[rb][eb] = (f32x4){0.f, 0.f, 0.f, 0.f};
  const float slope2 = exp2f(-(float)(h + 1)) * LOG2E;
  f32x4 cj[4];
#pragma unroll
  for (int kb = 0; kb < 4; ++kb)
#pragma unroll
    for (int j = 0; j < 4; ++j) cj[kb][j] = slope2 * (float)(kb * 16 + fq * 4 + j);
  const int dswz = (lane * 16) ^ ((((lane * 16) >> 9) & 1) << 5), drr = dswz >> 6, dcc = (dswz & 63) >> 1;
  const bf16_t* gk = projb + (size_t)((w & 3) * 16 + drr) * NIN + 5120 + h * 128 + (w >> 2) * 64 + dcc;
  const bf16_t* gv = p.T + (size_t)b * 3072 * LROW + (size_t)(2048 + h * 128 + w * 16 + drr) * LROW + dcc;
  const int kdst = (w >> 2) * 8192 + (w & 3) * 2048, vdst = 32768 + w * 2048;
#define DIFF_DMA(kt, kb_, vs_) do { const bf16_t* _k = gk + (size_t)(kt) * 64 * NIN; const bf16_t* _v = gv + (kt) * 64; \
    __builtin_amdgcn_global_load_lds((const unsigned*)_k, (LAS unsigned*)(lds + (kb_) + kdst), 16, 0, 0); \
    __builtin_amdgcn_global_load_lds((const unsigned*)(_k + 32), (LAS unsigned*)(lds + (kb_) + kdst + 1024), 16, 0, 0); \
    __builtin_amdgcn_global_load_lds((const unsigned*)_v, (LAS unsigned*)(lds + (vs_) + vdst), 16, 0, 0); \
    __builtin_amdgcn_global_load_lds((const unsigned*)(_v + 32), (LAS unsigned*)(lds + (vs_) + vdst + 1024), 16, 0, 0); } while (0)
  DIFF_DMA(0, 0, 0);
  asm volatile("s_waitcnt vmcnt(0)" ::: "memory");
  __syncthreads();
  const int kfb0 = c * 8192 + sub16;
  const bool stag = (w >> 2) != 0;
  bf16x8 pfr[2][2];
  int vs = 0;
  for (int kt = 0; kt <= ktmax; ++kt) {
    const int kb = (kt & 1) * 16384;
    const int vsn = vs == 32768 ? 0 : vs + 16384;
    if (kt + 1 <= ktmax) DIFF_DMA(kt + 1, 16384 - kb, vsn);
    if (active && kt <= qc) {
      if (stag && kt > 0) diff_pv(lds, 32768 + (vs == 0 ? 32768 : vs - 16384), pfr, o, sub16);
      diff_tile(kt == 0 || kt == qc, lds, kfb0 + kb, qf, o, pfr, m0, m1, l0, l1, cj, slope2, kt, qrow, fq);
      if (!stag) diff_pv(lds, 32768 + vs, pfr, o, sub16);
    }
    vs = vsn;
    asm volatile("s_waitcnt vmcnt(0)" ::: "memory");
    __syncthreads();
  }
  if (active && stag) { const int lastslot = (qc % 3) * 16384; diff_pv(lds, 32768 + lastslot, pfr, o, sub16); }
#undef DIFF_DMA
  l0 += __shfl_xor(l0, 16); l0 += __shfl_xor(l0, 32);
  l1 += __shfl_xor(l1, 16); l1 += __shfl_xor(l1, 32);
  const int xb = 81920 + rgq * 16384 + lane * 4;
  if (c == 1 && active) {
#pragma unroll
    for (int rb = 0; rb < 2; ++rb) {
      const float inv = lam / (rb ? l1 : l0);
#pragma unroll
      for (int eb = 0; eb < 8; ++eb)
#pragma unroll
        for (int j = 0; j < 4; ++j) *(LAS float*)(lds + xb + ((rb * 8 + eb) * 4 + j) * 256) = o[rb][eb][j] * inv;
    }
  }
  if (!gsync && tid == 0) { unsigned sp = 0; while (xb_ld(p.ctr + 32 + l) < 32u && ++sp < (1u << 22)) __builtin_amdgcn_s_sleep(2); }
  __syncthreads();
  if (!gsync) { __builtin_amdgcn_fence(__ATOMIC_ACQUIRE, "agent"); gsync = true; }
  if (c == 0 && active) {
#pragma unroll
    for (int rb = 0; rb < 2; ++rb) {
      const float inv = 1.f / (rb ? l1 : l0);
      float ss = 0.f;
#pragma unroll
      for (int eb = 0; eb < 8; ++eb)
#pragma unroll
        for (int j = 0; j < 4; ++j) { const float d = o[rb][eb][j] * inv - *(const LAS float*)(lds + xb + ((rb * 8 + eb) * 4 + j) * 256); o[rb][eb][j] = d; ss += d * d; }
      ss += __shfl_xor(ss, 16); ss += __shfl_xor(ss, 32);
      const float rn = rsqrtf(ss * (1.f / 128.f) + 1e-6f) * (1.f - lam_init);
      const size_t row = (size_t)b * LROW + qrow + rb * 16;
#pragma unroll
      for (int eb = 0; eb < 8; ++eb) {
        const int e0 = h * 128 + eb * 16 + fq * 4;
        const uint2 gu = *(const uint2*)(p.proj + row * NIN + 7168 + e0);
        const float4 gg = *(const float4*)(p.diff_g + l * 1024 + e0);
        const float y0 = o[rb][eb][0] * rn * gg.x * silu(bflo(gu.x)), y1 = o[rb][eb][1] * rn * gg.y * silu(bfhi(gu.x));
        const float y2 = o[rb][eb][2] * rn * gg.z * silu(bflo(gu.y)), y3 = o[rb][eb][3] * rn * gg.w * silu(bfhi(gu.y));
        uint2 ov; ov.x = pk2(y0, y1); ov.y = pk2(y2, y3);
        *(uint2*)(p.mix + row * DM + 1024 + e0) = ov;
      }
    }
  }
}

DI void mixer_phase(const Params& p, int l, LAS unsigned char* lds) {
  volatile LAS int* s_item = (volatile LAS int*)(lds + 147456);
  const float lam = p.lam[l];
  const float lam_init = 0.8f - 0.6f * expf(-0.3f * (float)l);
  for (int c = (int)blockIdx.x - 32; c >= 0 && c < 32; c += (int)gridDim.x) ret_scan_chain(p, c >> 3, c & 7, lds, p.ctr + 34 + l);
  const int xcd = blockIdx.x & 7;
  bool gsync = false, rsync = false;
  for (;;) {
    if (threadIdx.x == 0) *s_item = (int)atomicAdd(p.ctr + l * 8 + xcd, 1u);
    __syncthreads();
    const int it = *s_item;
    __syncthreads();
    if (it >= 68 + 22) break;
    if (it < 48 || it >= 70) {
      const int ai = it < 48 ? it : it - 22;
      const int bh = 4 * xcd + (ai & 3);
      diff_item(p, l, bh >> 3, bh & 7, 16 - (ai >> 2), lam, lam_init, lds, gsync);
    } else {
      if (!rsync) {
        if (threadIdx.x == 0) { unsigned sp = 0; while ((xb_ld(p.ctr + 34 + l) < 32u || xb_ld(p.ctr + 32 + l) < 32u) && ++sp < (1u << 22)) __builtin_amdgcn_s_sleep(2); }
        __syncthreads();
        __builtin_amdgcn_fence(__ATOMIC_ACQUIRE, "agent");
        rsync = true; gsync = true;
      }
      retention_items(p, l, lds, xcd + 48 * (it - 48), 8, 6);
      __syncthreads();
    }
  }
}

__global__ void __launch_bounds__(512) hymba_megakernel(Params p_unused) {
  cg::grid_group grid = cg::this_grid();
  extern __shared__ __attribute__((aligned(16))) char smem[];
  LAS unsigned char* lds = (LAS unsigned char*)smem;
  volatile LAS unsigned* xst = (volatile LAS unsigned*)(lds + 147456 + 16);
  if (threadIdx.x == 0) { xst[0] = 0u; xst[1] = 0u; }
  __syncthreads();
  XcdBarrier xb;
  { const Params p = load_params(); xb = xcd_barrier_post(p.bar, xst); }
  { const Params p = load_params(); prep_weights(p, lds, 0, 1792, blockIdx.x, gridDim.x, true); }
  { const Params p = load_params(); rownorm<0>(p); }
  grid.sync();
  for (int l = 0; l < 2; ++l) {
    { const Params p = load_params(); gemm1_phase(p, l, lds, 0, 1024); }
    xcd_barrier(xb);
    if (blockIdx.x < 32) {
      const Params p = load_params();
      gemm1_phase(p, l, lds, 1024, 1056);
      if (threadIdx.x == 0) {
        int nl = 0; for (int U = 1024 + (int)blockIdx.x; U < 1056; U += (int)gridDim.x) ++nl;
        __builtin_amdgcn_fence(__ATOMIC_RELEASE, "agent");
        asm volatile("s_waitcnt vmcnt(0)" ::: "memory");
        xb_add(p.ctr + 32 + l, (unsigned)nl);
      }
    }
    { const Params p = load_params(); mixer_phase(p, l, lds); }
    xcd_barrier(xb);
    { const Params p = load_params(); gemm2_phase(p, l, lds); }
    if (l == 0) { const Params p = load_params(); if (gridDim.x > 64) { if (blockIdx.x >= 64) prep_weights(p, lds, 1792, 2560, blockIdx.x - 64, gridDim.x - 64, false); } else prep_weights(p, lds, 1792, 2560, blockIdx.x, gridDim.x, false); }
    xcd_barrier(xb);
    if (l == 0) { { const Params p = load_params(); rownorm<1>(p); } xcd_barrier(xb); }
    else { const Params p = load_params(); rownorm<2>(p); }
  }
}

extern "C" void kernel_launch(void* const* d_in, const int* in_sizes, int n_in, void* d_out, int out_size, void* d_ws, size_t ws_size, hipStream_t stream) {
  static int grid_blocks = 0;
  if (!grid_blocks) {
    int dev = 0, cus = 0, per_cu = 0;
    hipGetDevice(&dev);
    hipDeviceGetAttribute(&cus, hipDeviceAttributeMultiprocessorCount, dev);
    hipFuncSetAttribute((const void*)hymba_megakernel, hipFuncAttributeMaxDynamicSharedMemorySize, SMEM_BYTES);
    hipOccupancyMaxActiveBlocksPerMultiprocessor(&per_cu, hymba_megakernel, 512, SMEM_BYTES);
    if (per_cu < 1) per_cu = 1;
    if (per_cu > 1) per_cu = 1;
    grid_blocks = cus * per_cu;
  }
  Params p{};
  p.x = (const float*)d_in[0]; p.meta = (const float*)d_in[1]; p.norm_g = (const float*)d_in[2]; p.w_in = (const float*)d_in[3];
  p.w_out = (const float*)d_in[4]; p.ret_g = (const float*)d_in[5]; p.diff_g = (const float*)d_in[6];
  p.lq1 = (const float*)d_in[7]; p.lk1 = (const float*)d_in[8]; p.lq2 = (const float*)d_in[9]; p.lk2 = (const float*)d_in[10];
  p.fin_g = (const float*)d_in[11];
  p.out = (float*)d_out;
  char* ws = (char*)d_ws; size_t off = 0;
  auto take = [&](size_t bytes) { char* r = ws + off; off += (bytes + 255) & ~(size_t)255; return r; };
  p.ctr = (unsigned*)take(256);
  p.bar = (unsigned*)take((size_t)XCD_BAR_WORDS * 4);
  p.ss = (float*)take((size_t)2 * MROWS * 4);
  p.lam = (float*)take(256);
  p.WinT = (bf16_t*)take((size_t)2 * NIN * DM * 2);
  p.WoutT = (bf16_t*)take((size_t)2 * DM * DM * 2);
  p.h = (float*)take((size_t)MROWS * DM * 4);
  p.hb = (bf16_t*)take((size_t)MROWS * DM * 2);
  p.proj = (bf16_t*)take((size_t)MROWS * NIN * 2);
  p.T = (bf16_t*)take((size_t)4 * 3072 * LROW * 2);
  p.mix = (bf16_t*)take((size_t)MROWS * DM * 2);
  p.ST = (bf16_t*)take((size_t)32 * NCH * 32768);
  p.P2 = (float*)take((size_t)8 * 256 * DM * 4);
  hipMemsetAsync(p.ctr, 0, 256 + (size_t)XCD_BAR_WORDS * 4 + (size_t)2 * MROWS * 4, stream);
  void* args[] = {&p};
  hipError_t e = hipLaunchCooperativeKernel((void*)hymba_megakernel, dim3(grid_blocks), dim3(512), args, SMEM_BYTES, stream);
  if (e != hipSuccess) fprintf(stderr, "cooperative launch failed: %s (grid %d)\n", hipGetErrorString(e), grid_blocks);
}
```

```cpp
#include <hip/hip_runtime.h>
#include <hip/hip_cooperative_groups.h>
#include <cstdio>
namespace cg = cooperative_groups;

typedef unsigned short bf16_t;
typedef short bf16x8 __attribute__((ext_vector_type(8)));
typedef short s16x4 __attribute__((ext_vector_type(4)));
typedef float f32x4 __attribute__((ext_vector_type(4)));
typedef float f32x2 __attribute__((ext_vector_type(2)));
typedef unsigned u32x4 __attribute__((ext_vector_type(4)));
typedef unsigned u32x2 __attribute__((ext_vector_type(2)));
typedef __bf16 bf16x2_t __attribute__((ext_vector_type(2)));
#define DI __device__ __forceinline__
#define LAS __attribute__((address_space(3)))
#define MFMA16(a, b, c) __builtin_amdgcn_mfma_f32_16x16x32_bf16((a), (b), (c), 0, 0, 0)

constexpr int LROW = 2112;
constexpr int MROWS = 4 * LROW;
constexpr int DM = 2048;
constexpr int NIN = 8192;
constexpr int NCH = 33;
constexpr float LOG2E = 1.4426950408889634f;
constexpr int SMEM_BYTES = 147456 + 64;

struct Params {
  const float *x, *meta, *norm_g, *w_in, *w_out, *ret_g, *diff_g, *lq1, *lk1, *lq2, *lk2, *fin_g;
  float* out;
  bf16_t *WinT, *WoutT, *hb, *proj, *T, *mix, *ST;
  float *h, *ss, *lam, *P2;
  unsigned* ctr;
  unsigned* bar;
};

DI Params load_params() {
  const Params __attribute__((address_space(4)))* q = (const Params __attribute__((address_space(4)))*)__builtin_amdgcn_kernarg_segment_ptr();
  asm volatile("" : "+s"(q));
  Params r; __builtin_memcpy(&r, (const void*)q, sizeof(Params)); return r;
}
DI unsigned pk2(float a, float b) { f32x2 v = {a, b}; bf16x2_t r = __builtin_convertvector(v, bf16x2_t); return __builtin_bit_cast(unsigned, r); }
DI float bf2f(unsigned v16) { return __uint_as_float(v16 << 16); }
DI float bflo(unsigned u) { return __uint_as_float(u << 16); }
DI float bfhi(unsigned u) { return __uint_as_float(u & 0xffff0000u); }
DI int opaque_tid() { int t = threadIdx.x; asm volatile("" : "+v"(t)); return t; }
#define EXP2(x) __builtin_amdgcn_exp2f(x)
DI float xmax16(float x) { const u32x2 r = __builtin_amdgcn_permlane16_swap(__float_as_uint(x), __float_as_uint(x), false, false); return fmaxf(__uint_as_float(r[0]), __uint_as_float(r[1])); }
DI float xmax32(float x) { const u32x2 r = __builtin_amdgcn_permlane32_swap(__float_as_uint(x), __float_as_uint(x), false, false); return fmaxf(__uint_as_float(r[0]), __uint_as_float(r[1])); }
DI float silu(float v) { return v * __builtin_amdgcn_rcpf(1.f + __expf(-v)); }

DI int lds_byte(int r, int c) { int st = (r >> 4) * 2 + (c >> 5), rr = r & 15, cc = c & 31, ob = rr * 64 + cc * 2; return st * 1024 + (ob ^ (((ob >> 9) & 1) << 5)); }
DI int perm32(int rho) { const int n = rho >> 4, i = rho & 15; return 8 * (i >> 2) + 4 * n + (i & 3); }
DI void stage_rc(int b, int& R, int& C) { int st = b / 1024, sb = b % 1024, swz = sb ^ (((sb >> 9) & 1) << 5); R = (st >> 1) * 16 + swz / 64; C = (st & 1) * 32 + (swz % 64) / 2; }

DI void prep_weights(const Params& p, LAS unsigned char* lds, int ubeg, int uend, int wgi, int wgn, bool do_lam) {
  const int tid = opaque_tid();
  const int NTOT = uend;
  const int lrow = tid >> 6, c4 = (tid & 63) * 4;
  f32x4 r[8];
#define PREP_DECODE(u) const float* src; bf16_t* dst; int N; const float* g; int kt, ntile; \
    { const int _l = (u) >= 1280 ? 1 : 0, _v = (u) - _l * 1280; \
      if (_v < 1024) { kt = _v >> 5; ntile = _v & 31; src = p.w_in + (size_t)_l * DM * NIN; dst = p.WinT + (size_t)_l * NIN * DM; N = NIN; g = p.norm_g + _l * DM; } \
      else { const int q = _v - 1024; kt = q >> 3; ntile = q & 7; src = p.w_out + (size_t)_l * DM * DM; dst = p.WoutT + (size_t)_l * DM * DM; N = DM; g = nullptr; } } \
    const int k0 = kt * 64, n0 = ntile * 256;
#define PREP_LOAD(u) do { PREP_DECODE(u) (void)dst; _Pragma("unroll") for (int i = 0; i < 8; ++i) { const int kk = lrow + 8 * i; \
    const f32x4 v = __builtin_nontemporal_load((const f32x4*)(src + (size_t)(k0 + kk) * N + n0 + c4));     const float gg = g ? g[k0 + kk] : 1.f; r[i] = v * gg; } } while (0)
  int u = ubeg + wgi;
  if (u < NTOT) PREP_LOAD(u);
  for (; u < NTOT; u += wgn) {
#pragma unroll
    for (int i = 0; i < 8; ++i) *(LAS f32x4*)(lds + ((lrow + 8 * i) * 260 + c4) * 4) = r[i];
    __syncthreads();
    const int un = u + wgn;
    if (un < NTOT) PREP_LOAD(un);
    {
      PREP_DECODE(u) (void)src; (void)N; (void)g;
      const int n = tid >> 1, kh = (tid & 1) * 32;
      bf16_t* op = dst + (size_t)(n0 + n) * DM + k0 + kh;
#pragma unroll
      for (int q = 0; q < 4; ++q) {
        float f[8];
#pragma unroll
        for (int j = 0; j < 8; ++j) f[j] = *(const LAS float*)(lds + ((kh + q * 8 + j) * 260 + n) * 4);
        const u32x4 o = {pk2(f[0], f[1]), pk2(f[2], f[3]), pk2(f[4], f[5]), pk2(f[6], f[7])};
        *(u32x4*)(op + q * 8) = o;
      }
    }
    __syncthreads();
  }
#undef PREP_DECODE
#undef PREP_LOAD
  if (do_lam && blockIdx.x == 0 && tid < 64) {
    for (int l = 0; l < 2; ++l) {
      float a = p.lq1[l * 64 + tid] * p.lk1[l * 64 + tid], b = p.lq2[l * 64 + tid] * p.lk2[l * 64 + tid];
#pragma unroll
      for (int off = 32; off >= 1; off >>= 1) { a += __shfl_xor(a, off); b += __shfl_xor(b, off); }
      float li = 0.8f - 0.6f * expf(-0.3f * (float)l);
      if (tid == 0) p.lam[l] = expf(a) - expf(b) + li;
    }
  }
}

template <int MODE> DI void rownorm(const Params& p) {
  const int tid = opaque_tid(); const int wave = tid >> 6, lane = tid & 63;
  const int nw = gridDim.x * 8;
  for (int row = (MODE == 1 ? 8192 : 0) + blockIdx.x * 8 + wave; row < MROWS; row += nw) {
    const int b = row / LROW, pos = row - b * LROW;
    if (MODE == 2 && pos < 64) continue;
    const float* src;
    if (MODE <= 1) src = pos < 48 ? nullptr : (pos < 64 ? p.meta + (size_t)(pos - 48) * DM : p.x + ((size_t)b * 2048 + (pos - 64)) * DM);
    else src = p.h + (size_t)row * DM;
    float4 v[8]; float ss = 0.f;
#pragma unroll
    for (int i = 0; i < 8; ++i) {
      if (src) { const f32x4 t = __builtin_nontemporal_load((const f32x4*)(src + i * 256 + lane * 4)); v[i] = make_float4(t[0], t[1], t[2], t[3]); }
      else v[i] = make_float4(0.f, 0.f, 0.f, 0.f);
      if (MODE != 0 && row >= 8192) {
#pragma unroll
        for (int s = 0; s < 8; ++s) { const float4 q = *(const float4*)(p.P2 + ((size_t)s * 256 + (row - 8192)) * DM + i * 256 + lane * 4); v[i].x += q.x; v[i].y += q.y; v[i].z += q.z; v[i].w += q.w; }
      }
      ss += v[i].x * v[i].x + v[i].y * v[i].y + v[i].z * v[i].z + v[i].w * v[i].w;
    }
#pragma unroll
    for (int off = 32; off >= 1; off >>= 1) ss += __shfl_xor(ss, off);
    const float rs = rsqrtf(ss * (1.f / 2048.f) + 1e-6f);
    if (MODE < 2) {
#pragma unroll
      for (int i = 0; i < 8; ++i) {
        if (MODE == 1) *(float4*)(p.h + (size_t)row * DM + i * 256 + lane * 4) = v[i];
        uint2 o; o.x = pk2(v[i].x, v[i].y); o.y = pk2(v[i].z, v[i].w);
        *(uint2*)(p.hb + (size_t)row * DM + i * 256 + lane * 4) = o;
      }
      if (lane == 0) p.ss[(MODE == 0 ? 0 : 1) * MROWS + row] = ss;
    } else {
      float* dst = p.out + ((size_t)b * 2048 + (pos - 64)) * DM;
#pragma unroll
      for (int i = 0; i < 8; ++i) {
        float4 g = *(const float4*)(p.fin_g + i * 256 + lane * 4);
        float4 o; o.x = v[i].x * rs * g.x; o.y = v[i].y * rs * g.y; o.z = v[i].z * rs * g.z; o.w = v[i].w * rs * g.w;
        *(float4*)(dst + i * 256 + lane * 4) = o;
      }
    }
  }
}

constexpr int GK = 2048, GBK = 64, GHALF = 128, GHTB = GHALF * GBK * 2;
constexpr size_t TSTEP = (size_t)256 * GK * 2;
struct Unit { int mt, nt, tr, k0, nkt, nb; };

template <class Epi, class Sched>
DI void gemm_phase(LAS unsigned char* lds, const Sched& S, const Epi& E) {
  const int tid = opaque_tid(), wid = __builtin_amdgcn_readfirstlane(tid >> 6), lane = tid & 63, wr = wid >> 2, wc = wid & 3, fr = lane & 15, fq = lane >> 4;
  constexpr int K = GK;
  unsigned voffA[2], dperm;
#pragma unroll
  for (int i = 0; i < 2; ++i) { int R, C; stage_rc(tid * 16 + i * 8192, R, C); voffA[i] = (unsigned)(R * K + C) * 2u;
    if (i == 0) dperm = (unsigned)((perm32(R & 31) - (R & 31)) * K * 2); }
  const size_t kstep = (size_t)(GBK * 2);
  const size_t hstep = (size_t)GHALF * K * 2;
  const unsigned ldsw = (unsigned)wid * 1024u;
  const int aoff = lds_byte(wr * 64 + fr, fq * 8), boff = lds_byte(wc * 32 + fr, fq * 8);
#define G_SA(b, h) (((b) * 2 + (h)) * GHTB)
#define G_SB(b, h) ((4 + (b) * 2 + (h)) * GHTB)
#define G_STAGE(bufoff, gbase, voff) do { _Pragma("unroll") for (int _i = 0; _i < 2; ++_i) \
    __builtin_amdgcn_global_load_lds((const unsigned*)((const char*)(gbase) + voff[_i]), (LAS unsigned*)(lds + (bufoff) + ldsw + _i * 8192), 16, 0, 0); } while (0)
#define G_LDA(dst, b, h) do { _Pragma("unroll") for (int m = 0; m < 4; ++m) _Pragma("unroll") for (int k = 0; k < 2; ++k) dst[m][k] = *(const LAS bf16x8*)(lds + G_SA(b, h) + aoff + m * 2048 + k * 1024); } while (0)
#define G_LDB(dst, b, h) do { _Pragma("unroll") for (int n = 0; n < 2; ++n) _Pragma("unroll") for (int k = 0; k < 2; ++k) dst[n][k] = *(const LAS bf16x8*)(lds + G_SB(b, h) + boff + n * 2048 + k * 1024); } while (0)
#define G_MMA(ai, bj, At, Bx) do { __builtin_amdgcn_s_setprio(1); _Pragma("unroll") for (int m = 0; m < 4; ++m) _Pragma("unroll") for (int n = 0; n < 2; ++n) _Pragma("unroll") for (int k = 0; k < 2; ++k) \
    acc[ai][bj][m][n] = MFMA16(Bx[n][k], At[m][k], acc[ai][bj][m][n]); __builtin_amdgcn_s_setprio(0); } while (0)
#define G_WAIT_V(n) asm volatile("s_waitcnt vmcnt(" #n ")" ::: "memory")
#define G_WAIT_L(n) asm volatile("s_waitcnt lgkmcnt(" #n ")" ::: "memory")
#define G_BAR __builtin_amdgcn_s_barrier()
#define G_SCHED __builtin_amdgcn_sched_barrier(0)
  Unit cur, nxt; int ui = 0;
  if (!S.next(0, cur)) return;
  f32x4 acc[2][2][4][2];
  E.init(acc, cur, wr, wc, fr, fq, lds, 0);
  bf16x8 At[4][2], B0[2][2], B1[2][2];
  const char* cA = S.pa(cur); const char* cB = S.pb(cur);
  { const unsigned ds0 = cur.nb ? 0u : dperm; const unsigned vb[2] = {voffA[0] + ds0, voffA[1] + ds0};
  G_STAGE(G_SB(0, 0), cB, vb); G_STAGE(G_SA(0, 0), cA, voffA); G_STAGE(G_SB(0, 1), cB + hstep, vb); G_STAGE(G_SA(0, 1), cA + hstep, voffA);
  if (wr == 1) G_BAR;
  G_WAIT_V(4); G_BAR;
  G_STAGE(G_SB(1, 0), cB + kstep, vb); G_STAGE(G_SA(1, 0), cA + kstep, voffA); G_STAGE(G_SB(1, 1), cB + hstep + kstep, vb); }
  G_WAIT_V(6); G_BAR;
  for (;;) {
    const bool has_next = S.next(ui + 1, nxt);
    if (!has_next) nxt = cur;
    const char* nA = has_next ? S.pa(nxt) : cA; const char* nB = has_next ? S.pb(nxt) : cB;
    const int nt = cur.nkt;
    for (int t = 0; t < nt; t += 2) {
      const bool last = (t == nt - 2);
      const char* a1 = cA + (size_t)(t + 1) * kstep;
      const char* a2 = last ? nA : cA + (size_t)(t + 2) * kstep; const char* b2 = last ? nB : cB + (size_t)(t + 2) * kstep;
      const char* a3 = a2 + kstep; const char* b3 = b2 + kstep;
      const bool nbs = last ? (nxt.nb != 0) : (cur.nb != 0);
      const unsigned ds = nbs ? 0u : dperm; const unsigned vb[2] = {voffA[0] + ds, voffA[1] + ds};
      G_LDB(B0, 0, 0); G_SCHED; G_LDA(At, 0, 0); G_STAGE(G_SA(1, 1), a1 + hstep, voffA);
      G_WAIT_L(8); G_BAR; G_WAIT_L(0); G_MMA(0, 0, At, B0); G_BAR; G_SCHED;
      G_LDB(B1, 0, 1); G_STAGE(G_SB(0, 0), b2, vb);
      G_BAR; G_WAIT_L(0); G_MMA(0, 1, At, B1); G_BAR;
      G_LDA(At, 0, 1); G_STAGE(G_SA(0, 0), a2, voffA);
      G_BAR; G_WAIT_L(0); G_MMA(1, 0, At, B0); G_BAR; G_SCHED;
      G_STAGE(G_SB(0, 1), b2 + hstep, vb);
      G_WAIT_V(6); G_BAR; G_MMA(1, 1, At, B1); G_BAR;
      G_LDB(B0, 1, 0); G_SCHED; G_LDA(At, 1, 0); G_STAGE(G_SA(0, 1), a2 + hstep, voffA);
      G_WAIT_L(8); G_BAR; G_WAIT_L(0); G_MMA(0, 0, At, B0); G_BAR; G_SCHED;
      G_LDB(B1, 1, 1); G_STAGE(G_SB(1, 0), b3, vb);
      G_BAR; G_WAIT_L(0); G_MMA(0, 1, At, B1); G_BAR;
      G_LDA(At, 1, 1); G_STAGE(G_SA(1, 0), a3, voffA);
      G_BAR; G_WAIT_L(0); G_MMA(1, 0, At, B0); G_BAR; G_SCHED;
      G_STAGE(G_SB(1, 1), b3 + hstep, vb);
      G_WAIT_V(6); G_BAR; G_MMA(1, 1, At, B1); G_BAR;
    }
    { const int t2 = opaque_tid() & 63; E(acc, cur, wr, wc, t2 & 15, t2 >> 4, lds, ui & 1); }
    if (!has_next) break;
    cur = nxt; cA = nA; cB = nB; ++ui;
    { const int t3 = opaque_tid() & 63; E.init(acc, cur, wr, wc, t3 & 15, t3 >> 4, lds, ui & 1); }
  }
  G_WAIT_V(0);
  if (wr == 0) G_BAR;
  G_BAR;
}

#define XB_TMO      128
#define XB_XCNT(j)  (256  + 64 * (j))
#define XB_XSUB(j)  (1280 + 64 * (j))
#define XB_XGEN(j)  (2304 + 64 * (j))
#define XB_TOP      3328
#define XB_TOPGEN   3392
#define XCD_BAR_WORDS 3456
#define XB_SPIN_CAP (1u << 18)
DI unsigned xb_ld(unsigned* p) { return __hip_atomic_load(p, __ATOMIC_RELAXED, __HIP_MEMORY_SCOPE_AGENT); }
DI unsigned xb_add(unsigned* p, unsigned v) { return __hip_atomic_fetch_add(p, v, __ATOMIC_RELAXED, __HIP_MEMORY_SCOPE_AGENT); }
DI unsigned xb_xcc_id() { return (unsigned)__builtin_amdgcn_s_getreg((3 << 11) | 20) & 0xFu; }
#define XB_SPIN(cond, bar) do { unsigned _sp = 0; while (cond) { __builtin_amdgcn_s_sleep(1); \
    if ((++_sp & 255u) == 0u) { if (xb_ld(&(bar)[XB_TMO])) break; if (_sp > XB_SPIN_CAP) { atomicAdd(&(bar)[XB_TMO], 1u); break; } } } } while (0)
struct XcdBarrier { unsigned* bar; unsigned x; volatile LAS unsigned* st; };
DI XcdBarrier xcd_barrier_post(unsigned* bar, volatile LAS unsigned* st) {
  XcdBarrier b; b.bar = bar; b.x = xb_xcc_id(); b.st = st;
  if (threadIdx.x == 0) (void)xb_add(&bar[XB_XCNT(b.x)], 1u);
  return b;
}
DI void xcd_barrier_complete(unsigned* bar, unsigned x, unsigned& nloc, unsigned& nx) {
  const unsigned G = gridDim.x * gridDim.y * gridDim.z;
  unsigned sum, cnt, mine, sp = 0u;
  for (;;) {
    sum = 0u; cnt = 0u; mine = 0u;
#pragma unroll
    for (unsigned j = 0; j < 16; ++j) { const unsigned c = xb_ld(&bar[XB_XCNT(j)]); sum += c; cnt += (c > 0u) ? 1u : 0u; mine = (j == x) ? c : mine; }
    if (sum == G) break;
    __builtin_amdgcn_s_sleep(1);
    if ((++sp & 255u) == 0u) { if (xb_ld(&bar[XB_TMO])) break; if (sp > XB_SPIN_CAP) { atomicAdd(&bar[XB_TMO], 1u); break; } }
  }
  nloc = mine > 0u ? mine : 1u; nx = cnt > 0u ? cnt : 1u;
}
DI void xcd_barrier(const XcdBarrier& b) {
  asm volatile("s_waitcnt vmcnt(0)" ::: "memory");
  __syncthreads();
  if (threadIdx.x == 0) {
    unsigned* bar = b.bar;
    __builtin_amdgcn_s_waitcnt(0);
    unsigned nloc = b.st[0], nx = b.st[1];
    if (nloc == 0u) { xcd_barrier_complete(bar, b.x, nloc, nx); b.st[0] = nloc; b.st[1] = nx; }
    const unsigned old = xb_add(&bar[XB_XSUB(b.x)], 1u);
    const unsigned gen = old / nloc;
    if (old + 1u == (gen + 1u) * nloc) {
      __builtin_amdgcn_fence(__ATOMIC_RELEASE, "agent");
      asm volatile("s_waitcnt vmcnt(0)" ::: "memory");
      const unsigned og = xb_add(&bar[XB_TOP], 1u);
      const unsigned tg = og / nx;
      if (og + 1u == (tg + 1u) * nx) xb_add(&bar[XB_TOPGEN], 1u);
      else XB_SPIN(xb_ld(&bar[XB_TOPGEN]) == tg, bar);
      __builtin_amdgcn_fence(__ATOMIC_ACQUIRE, "agent");
      xb_add(&bar[XB_XGEN(b.x)], 1u);
      asm volatile("s_waitcnt vmcnt(0)" ::: "memory");
    } else {
      XB_SPIN(xb_ld(&bar[XB_XGEN(b.x)]) == gen, bar);
      __builtin_amdgcn_fence(__ATOMIC_ACQUIRE, "agent");
      asm volatile("s_waitcnt vmcnt(0)" ::: "memory");
    }
  }
  __syncthreads();
}

DI void tile_map(int wgid, int nM, int nN, int& pm, int& pn) {
  const int nwg = nM * nN;
  { int q = nwg / 8, r = nwg % 8, xcd = wgid % 8, off = wgid / 8; wgid = (xcd < r ? xcd * (q + 1) : r * (q + 1) + (xcd - r) * q) + off; }
  const int nig = 8 * nN, gid = wgid / nig, fm = gid * 8, gsz = min(nM - fm, 8);
  pm = fm + ((wgid % nig) % gsz); pn = (wgid % nig) / gsz;
}

struct Sched1 {
  const bf16_t* hb; const bf16_t* W; int ubeg, uend;
  DI bool next(int i, Unit& u) const {
    const int U = ubeg + i * (int)gridDim.x + (int)blockIdx.x; if (U >= uend) return false;
    int pm, pn;
    if (U < 928) tile_map(U, 29, 32, pm, pn);
    else if (U < 1024) { const int q = U - 928, c = q % 24; pm = 29 + q / 24; pn = c < 12 ? c : c + 4; }
    else { const int q = U - 1024, g = q & 7; pm = 29 + (q >> 3); pn = g < 4 ? 12 + g : 24 + g; }
    u.mt = pm; u.nt = pn; u.k0 = 0; u.nkt = 32; const int g = pn >> 2; u.tr = (g == 1 || g == 2 || g == 6) ? 1 : 0; u.nb = u.tr; return true;
  }
  DI const char* pa(const Unit& u) const { return u.tr ? (const char*)W + (size_t)u.nt * TSTEP : (const char*)hb + (size_t)u.mt * TSTEP; }
  DI const char* pb(const Unit& u) const { return u.tr ? (const char*)hb + (size_t)u.mt * TSTEP : (const char*)W + (size_t)u.nt * TSTEP; }
};
struct Sched2 {
  const bf16_t* mix; const bf16_t* W;
  DI bool next(int i, Unit& u) const {
    const int U = i * (int)gridDim.x + (int)blockIdx.x; if (U >= 256 + 64) return false;
    if (U < 256) { int pm, pn; tile_map(U, 32, 8, pm, pn); u.mt = pm; u.nt = pn; u.tr = 0; u.k0 = 0; u.nkt = 32; u.nb = 0; }
    else { const int j = U - 256; u.mt = 32; u.nt = j >> 3; u.tr = 1 + (j & 7); u.k0 = (j & 7) * 256; u.nkt = 4; u.nb = 0; }
    return true;
  }
  DI const char* pa(const Unit& u) const { return (const char*)mix + (size_t)u.mt * TSTEP + (size_t)u.k0 * 2; }
  DI const char* pb(const Unit& u) const { return (const char*)W + (size_t)u.nt * TSTEP + (size_t)u.k0 * 2; }
};

DI void acc_zero(f32x4 (&acc)[2][2][4][2]) {
#pragma unroll
  for (int a = 0; a < 2; ++a)
#pragma unroll
    for (int b = 0; b < 2; ++b)
#pragma unroll
      for (int m = 0; m < 4; ++m)
#pragma unroll
        for (int n = 0; n < 2; ++n) acc[a][b][m][n] = (f32x4){0.f, 0.f, 0.f, 0.f};
}
struct Epi1 {
  bf16_t* proj; bf16_t* T; const float* ss;
  DI void init(f32x4 (&acc)[2][2][4][2], const Unit& u, int wr, int wc, int fr, int fq, LAS unsigned char* lds, int par) const {
    acc_zero(acc);
    if (wr == 0)
      __builtin_amdgcn_global_load_lds((const unsigned*)(ss + u.mt * 256 + wc * 64 + fq * 16 + fr), (LAS unsigned*)(lds + 131072 + par * 1024 + wc * 256), 4, 0, 0);
  }
  DI void operator()(const f32x4 (&acc)[2][2][4][2], const Unit& u, int wr, int wc, int fr, int fq, LAS unsigned char* lds, int par) const {
    const LAS float* ssl = (const LAS float*)(lds + 131072 + par * 1024);
    const int g = u.nt >> 2;
    if (!u.tr) {
      const float sc = (g == 4) ? 0.125f * LOG2E : 1.f;
      const int n0 = u.nt * 256 + wc * 32 + fq * 8;
#pragma unroll
      for (int ai = 0; ai < 2; ++ai)
#pragma unroll
        for (int mi = 0; mi < 4; ++mi) {
          const int m = u.mt * 256 + ai * 128 + wr * 64 + mi * 16 + fr;
          const float rs = rsqrtf(ssl[ai * 128 + wr * 64 + mi * 16 + fr] * (1.f / 2048.f) + 1e-6f) * sc;
          bf16_t* rowp = proj + (size_t)m * NIN + n0;
#pragma unroll
          for (int bj = 0; bj < 2; ++bj) {
            const f32x4 a = acc[ai][bj][mi][0], c = acc[ai][bj][mi][1];
            const u32x4 o = {pk2(a[0] * rs, a[1] * rs), pk2(a[2] * rs, a[3] * rs), pk2(c[0] * rs, c[1] * rs), pk2(c[2] * rs, c[3] * rs)};
            *(u32x4*)(rowp + bj * 128) = o;
          }
        }
    } else {
      const int tbase = (g == 1 ? 0 : (g == 2 ? 1024 : 2048)) - g * 1024;
#pragma unroll
      for (int bj = 0; bj < 2; ++bj) {
        const int mb = u.mt * 256 + bj * 128 + wc * 32;
        const int b = mb / LROW, posb = mb - b * LROW;
        const f32x4 q0 = *(const LAS f32x4*)(ssl + bj * 128 + wc * 32 + 4 * fq), q1 = *(const LAS f32x4*)(ssl + bj * 128 + wc * 32 + 16 + 4 * fq);
        float rs[8];
#pragma unroll
        for (int j = 0; j < 4; ++j) { rs[j] = rsqrtf(q0[j] * (1.f / 2048.f) + 1e-6f); rs[4 + j] = rsqrtf(q1[j] * (1.f / 2048.f) + 1e-6f); }
        const int p0 = posb + 4 * fq, p1 = p0 + 16;
        if (g == 1) {
#pragma unroll
          for (int j = 0; j < 4; ++j) { rs[j] = (p0 + j >= 48) ? rs[j] * 0.08838834764831845f : 0.f; rs[4 + j] = (p1 + j >= 48) ? rs[4 + j] * 0.08838834764831845f : 0.f; }
        }
#pragma unroll
        for (int ai = 0; ai < 2; ++ai)
#pragma unroll
          for (int mi = 0; mi < 4; ++mi) {
            const int col = u.nt * 256 + ai * 128 + wr * 64 + mi * 16 + fr;
            const f32x4 a = acc[ai][bj][mi][0], c = acc[ai][bj][mi][1];
            float v[8] = {a[0] * rs[0], a[1] * rs[1], a[2] * rs[2], a[3] * rs[3], c[0] * rs[4], c[1] * rs[5], c[2] * rs[6], c[3] * rs[7]};
            if (g == 1) {
              const int hh = (col - 1024) >> 7;
              const float l2g = log2f(1.f - exp2f(-5.f - (float)hh));
              const int z0 = 63 - (p0 & 63), z1 = 63 - (p1 & 63);
#pragma unroll
              for (int j = 0; j < 4; ++j) { v[j] *= exp2f(l2g * (float)(z0 - j)); v[4 + j] *= exp2f(l2g * (float)(z1 - j)); }
            }
            const u32x4 o = {pk2(v[0], v[1]), pk2(v[2], v[3]), pk2(v[4], v[5]), pk2(v[6], v[7])};
            const int trow = (g == 1) ? (col & ~31) + 16 * ((col >> 2) & 1) + 4 * ((col >> 3) & 3) + (col & 3) : col;
            *(u32x4*)(T + ((size_t)(b * 3072 + tbase + trow)) * LROW + posb + 8 * fq) = o;
          }
      }
    }
  }
};
struct Epi2 {
  float* h; float* P2; bf16_t* hb; float* ssn; const float* x; const float* meta;
  DI void init(f32x4 (&acc)[2][2][4][2], const Unit& u, int wr, int wc, int fr, int fq, LAS unsigned char*, int) const {
    if (u.tr) { acc_zero(acc); return; }
    const int n0 = u.nt * 256 + wc * 32 + fq * 8;
#pragma unroll
    for (int ai = 0; ai < 2; ++ai)
#pragma unroll
      for (int mi = 0; mi < 4; ++mi) {
        const int m = u.mt * 256 + ai * 128 + wr * 64 + mi * 16 + fr;
        const float* rowp = h + (size_t)m * DM + n0;
        if (x) { const int b = m / LROW, pos = m - b * LROW; rowp = pos < 48 ? nullptr : (pos < 64 ? meta + (size_t)(pos - 48) * DM : x + ((size_t)b * 2048 + (pos - 64)) * DM) + n0; }
#pragma unroll
        for (int bj = 0; bj < 2; ++bj)
#pragma unroll
          for (int ni = 0; ni < 2; ++ni) acc[ai][bj][mi][ni] = rowp ? __builtin_nontemporal_load((const f32x4*)(rowp + bj * 128 + ni * 4)) : (f32x4){0.f, 0.f, 0.f, 0.f};
      }
  }
  DI void operator()(const f32x4 (&acc)[2][2][4][2], const Unit& u, int wr, int wc, int fr, int fq, LAS unsigned char*, int) const {
    const int n0 = u.nt * 256 + wc * 32 + fq * 8;
#pragma unroll
    for (int ai = 0; ai < 2; ++ai)
#pragma unroll
      for (int mi = 0; mi < 4; ++mi) {
        const int m = u.mt * 256 + ai * 128 + wr * 64 + mi * 16 + fr;
        float* rowp = (u.tr ? P2 + ((size_t)(u.tr - 1) * 256 + (m - 8192)) * DM : h + (size_t)m * DM) + n0;
        float sq = 0.f;
#pragma unroll
        for (int bj = 0; bj < 2; ++bj) {
          const f32x4 a = acc[ai][bj][mi][0], c = acc[ai][bj][mi][1];
          *(f32x4*)(rowp + bj * 128) = a; *(f32x4*)(rowp + bj * 128 + 4) = c;
          if (ssn && !u.tr) {
            sq += a[0] * a[0] + a[1] * a[1] + a[2] * a[2] + a[3] * a[3] + c[0] * c[0] + c[1] * c[1] + c[2] * c[2] + c[3] * c[3];
            const u32x4 o = {pk2(a[0], a[1]), pk2(a[2], a[3]), pk2(c[0], c[1]), pk2(c[2], c[3])};
            *(u32x4*)(hb + (size_t)m * DM + n0 + bj * 128) = o;
          }
        }
        if (ssn && !u.tr) {
          sq += __shfl_xor(sq, 16); sq += __shfl_xor(sq, 32);
          if (fq == 0) unsafeAtomicAdd(ssn + m, sq);
        }
      }
  }
};

DI void gemm1_phase(const Params& p, int l, LAS unsigned char* lds, int ubeg, int uend) {
  Sched1 S{p.hb, p.WinT + (size_t)l * NIN * DM, ubeg, uend}; Epi1 E{p.proj, p.T, p.ss + (size_t)l * MROWS};
  gemm_phase(lds, S, E);
}
DI void gemm2_phase(const Params& p, int l, LAS unsigned char* lds) {
  Sched2 S{p.mix, p.WoutT + (size_t)l * DM * DM}; Epi2 E{p.h, p.P2, p.hb, l == 0 ? p.ss + MROWS : nullptr, l == 0 ? p.x : nullptr, p.meta};
  gemm_phase(lds, S, E);
}

DI void ret_scan_chain(const Params& p, int b, int h, LAS unsigned char* lds, unsigned* done_ctr) {
  constexpr int D = 6;
  const int tid = opaque_tid(), w = __builtin_amdgcn_readfirstlane(tid >> 6), lane = tid & 63, fr = lane & 15, fq = lane >> 4;
  const float l2g = log2f(1.f - exp2f(-5.f - (float)h));
  const float dec64 = exp2f(l2g * 64.f);
  const int sub16 = lds_byte(fr, fq * 8);
  const int frow = ((tid >> 4) & 31) * 2 + ((tid >> 2) & 1), fcol = ((tid >> 3) & 1) * 32 + (tid & 3) * 8;
  const int fillT = lds_byte(frow, fcol);
  const bf16_t* gk = p.T + (size_t)b * 3072 * LROW + (size_t)(h * 128 + frow) * LROW + fcol;
  u32x4* so = (u32x4*)p.ST + ((size_t)((b * 8 + h) * NCH) * 8 + w) * 256 + lane;
  f32x4 st[8];
#pragma unroll
  for (int i = 0; i < 8; ++i) st[i] = (f32x4){0.f, 0.f, 0.f, 0.f};
  u32x4 ring[D][4];
#define SCAN_LOAD(slot, n) do { const bf16_t* _t = gk + (n) * 64; ring[slot][0] = *(const u32x4*)_t; ring[slot][1] = *(const u32x4*)(_t + (size_t)64 * LROW); \
    ring[slot][2] = *(const u32x4*)(_t + (size_t)1024 * LROW); ring[slot][3] = *(const u32x4*)(_t + (size_t)1088 * LROW); } while (0)
#define SCAN_STORE(n) do { _Pragma("unroll") for (int kd = 0; kd < 4; ++kd) { const f32x4 sa = st[2 * kd], sc = st[2 * kd + 1]; \
    const u32x4 bsu = {pk2(sa[0], sa[1]), pk2(sa[2], sa[3]), pk2(sc[0], sc[1]), pk2(sc[2], sc[3])}; so[(size_t)(n) * 2048 + kd * 64] = bsu; } } while (0)
#pragma unroll
  for (int i = 0; i < D; ++i) SCAN_LOAD(i, i);
#pragma unroll
  for (int n = 0; n < NCH - 1; ++n) {
    const int slot = n % D, bo = (n & 1) * 32768;
    *(LAS u32x4*)(lds + bo + fillT) = ring[slot][0]; *(LAS u32x4*)(lds + bo + fillT + 8192) = ring[slot][1];
    *(LAS u32x4*)(lds + bo + 16384 + fillT) = ring[slot][2]; *(LAS u32x4*)(lds + bo + 16384 + fillT + 8192) = ring[slot][3];
    if (n + D < NCH - 1) SCAN_LOAD(slot, n + D);
    __syncthreads();
    SCAN_STORE(n);
    const bf16x8 vf0 = *(const LAS bf16x8*)(lds + bo + 16384 + w * 2048 + sub16), vf1 = *(const LAS bf16x8*)(lds + bo + 16384 + w * 2048 + 1024 + sub16);
#pragma unroll
    for (int db = 0; db < 8; ++db) {
      st[db] *= dec64;
      const bf16x8 a0 = *(const LAS bf16x8*)(lds + bo + sub16 + db * 2048);
      const bf16x8 a1 = *(const LAS bf16x8*)(lds + bo + sub16 + db * 2048 + 1024);
      st[db] = MFMA16(a0, vf0, st[db]); st[db] = MFMA16(a1, vf1, st[db]);
    }
  }
  SCAN_STORE(NCH - 1);
  asm volatile("s_waitcnt vmcnt(0)" ::: "memory");
  __syncthreads();
  if (threadIdx.x == 0) { __builtin_amdgcn_fence(__ATOMIC_RELEASE, "agent"); asm volatile("s_waitcnt vmcnt(0)" ::: "memory"); xb_add(done_ctr, 1u); }
#undef SCAN_LOAD
#undef SCAN_STORE
}

DI void retention_items(const Params& p, int l, LAS unsigned char* lds, int first, int stride, int count) {
  constexpr int QS = 0, KS = 16384, VTS = 49152, PS = 65536, OS = 73728;
  const int tid = opaque_tid(), w = __builtin_amdgcn_readfirstlane(tid >> 6), lane = tid & 63, fr = lane & 15, fq = lane >> 4;
  const int sub16 = lds_byte(fr, fq * 8), sub8a = lds_byte(fr, fq * 4), sub8b = lds_byte(fr, fq * 4 + 16);
  const int tq = ((tid >> 5) & 15) * 2 + ((tid >> 2) & 1), dq = ((tid >> 4) & 1) * 64 + ((tid >> 3) & 1) * 32 + (tid & 3) * 8;
  const int ve = ((tid >> 4) & 31) * 2 + ((tid >> 2) & 1), vs0 = ((tid >> 3) & 1) * 32 + (tid & 3) * 8;
  const int fillQ = (dq >> 6) * 8192 + lds_byte(tq, dq & 63);
  const int fillT = lds_byte(ve, vs0);
  const int sb = w & 3, tb0 = (w >> 2) * 2;
  const int kbase = KS + sb * 2048 + sub16, qbase = QS + tb0 * 2048 + sub16;
  const int pbase = PS + tb0 * 2048 + (sb >> 1) * 1024 + lds_byte(fr, fq * 8 + 4 * (sb & 1));
  const int vbase = VTS + w * 2048 + sub16;
  const int obase = OS + ((fq * 4) * 132 + w * 16 + fr) * 4;
  const int nbase = OS + ((tid >> 3) * 132 + (tid & 7) * 16) * 4;
  u32x4 pq0, pq1, pk0, pk1, pv0, pv1, ns0, ns1, ns2, ns3, ng0, ng1;
#define RET_GLOAD(it) do { const int _bh = (it) / NCH, _n = (it) - _bh * NCH, _b = _bh >> 3, _h = _bh & 7; \
    const bf16_t* _q = p.proj + ((size_t)_b * LROW + _n * 64 + tq) * NIN + _h * 128 + dq; \
    const bf16_t* _tk = p.T + ((size_t)_b * 3072 + _h * 128 + (tid >> 3)) * LROW + _n * 64 + (tid & 7) * 8; \
    const bf16_t* _tv = p.T + ((size_t)_b * 3072 + 1024 + _h * 128 + ve) * LROW + _n * 64 + vs0; \
    pq0 = *(const u32x4*)_q; pq1 = *(const u32x4*)(_q + (size_t)32 * NIN); pk0 = *(const u32x4*)_tk; pk1 = *(const u32x4*)(_tk + (size_t)64 * LROW); \
    pv0 = *(const u32x4*)_tv; pv1 = *(const u32x4*)(_tv + (size_t)64 * LROW); \
    const u32x4* _sp = (const u32x4*)p.ST + ((size_t)(it) * 8 + w) * 256 + lane; ns0 = _sp[0]; ns1 = _sp[64]; ns2 = _sp[128]; ns3 = _sp[192]; \
    const bf16_t* _gp = p.proj + ((size_t)_b * LROW + _n * 64 + (tid >> 3)) * NIN + 3072 + _h * 128 + (tid & 7) * 16; \
    ng0 = *(const u32x4*)_gp; ng1 = *(const u32x4*)(_gp + 8); } while (0)
  int it = first;
  const int iend = first + stride * count;
  if (it < iend) RET_GLOAD(it);
  for (; it < iend; it += stride) {
    const int bh = it / NCH, n = it - bh * NCH, b = bh >> 3, h = bh & 7;
    const float l2g = log2f(1.f - exp2f(-5.f - (float)h));
    *(LAS u32x4*)(lds + QS + fillQ) = pq0; *(LAS u32x4*)(lds + QS + fillQ + 4096) = pq1;
    {
      const int d0 = tid >> 3, s0 = (tid & 7) * 8;
#pragma unroll
      for (int i = 0; i < 2; ++i) {
        const u32x4 kv = i ? pk1 : pk0;
        const int r_ = d0 + 64 * i, d = (r_ & ~31) + 8 * ((r_ >> 2) & 3) + 4 * ((r_ >> 4) & 1) + (r_ & 3), ko = KS + (d >> 6) * 8192;
#pragma unroll
        for (int j = 0; j < 8; ++j) {
          const unsigned wv = kv[j >> 1];
          const int st = (s0 & 32) + 16 * (j >> 2) + 4 * ((s0 >> 3) & 3) + (j & 3);
          *(LAS bf16_t*)(lds + ko + lds_byte(st, d & 63)) = (bf16_t)((j & 1) ? (wv >> 16) : (wv & 0xffffu));
        }
      }
    }
    *(LAS u32x4*)(lds + VTS + fillT) = pv0; *(LAS u32x4*)(lds + VTS + fillT + 8192) = pv1;
    const u32x4 sf0 = ns0, sf1 = ns1, sf2 = ns2, sf3 = ns3, g0 = ng0, g1 = ng1;
    __syncthreads();
    if (it + stride < iend) RET_GLOAD(it + stride);
    const size_t row = (size_t)b * LROW + n * 64 + (tid >> 3);
    {
      f32x4 s0 = {0.f, 0.f, 0.f, 0.f}, s1 = {0.f, 0.f, 0.f, 0.f};
#pragma unroll
      for (int ks = 0; ks < 4; ++ks) {
        const int off = (ks >> 1) * 8192 + (ks & 1) * 1024;
        const bf16x8 a = *(const LAS bf16x8*)(lds + kbase + off);
        const bf16x8 b0 = *(const LAS bf16x8*)(lds + qbase + off);
        const bf16x8 b1 = *(const LAS bf16x8*)(lds + qbase + off + 2048);
        s0 = MFMA16(a, b0, s0); s1 = MFMA16(a, b1, s1);
      }
      const int srow = sb * 16 + fq * 4;
#pragma unroll
      for (int i = 0; i < 2; ++i) {
        const f32x4 sv = i ? s1 : s0;
        const int t = (tb0 + i) * 16 + fr;
        const float v0 = sv[0] * EXP2(l2g * (fabsf((float)(t - srow)) - (float)(63 - srow))), v1 = sv[1] * EXP2(l2g * (fabsf((float)(t - srow - 1)) - (float)(62 - srow)));
        const float v2 = sv[2] * EXP2(l2g * (fabsf((float)(t - srow - 2)) - (float)(61 - srow))), v3 = sv[3] * EXP2(l2g * (fabsf((float)(t - srow - 3)) - (float)(60 - srow)));
        const u32x2 o = {pk2(v0, v1), pk2(v2, v3)};
        *(LAS u32x2*)(lds + pbase + i * 2048) = o;
      }
    }
    __syncthreads();
    {
      const bf16x8 vf0 = *(const LAS bf16x8*)(lds + vbase), vf1 = *(const LAS bf16x8*)(lds + vbase + 1024);
      f32x4 o[4], cr[4];
#pragma unroll
      for (int tb = 0; tb < 4; ++tb) {
        o[tb] = (f32x4){0.f, 0.f, 0.f, 0.f}; cr[tb] = (f32x4){0.f, 0.f, 0.f, 0.f};
        const bf16x8 a0 = *(const LAS bf16x8*)(lds + PS + sub16 + tb * 2048);
        const bf16x8 a1 = *(const LAS bf16x8*)(lds + PS + sub16 + tb * 2048 + 1024);
        o[tb] = MFMA16(a0, vf0, o[tb]); o[tb] = MFMA16(a1, vf1, o[tb]);
      }
#pragma unroll
      for (int kd = 0; kd < 4; ++kd) {
        const bf16x8 bsv = __builtin_bit_cast(bf16x8, kd == 0 ? sf0 : (kd == 1 ? sf1 : (kd == 2 ? sf2 : sf3)));
#pragma unroll
        for (int tb = 0; tb < 4; ++tb) {
          const bf16x8 a = *(const LAS bf16x8*)(lds + QS + (kd >> 1) * 8192 + (tb * 2 + (kd & 1)) * 1024 + sub16);
          cr[tb] = MFMA16(a, bsv, cr[tb]);
        }
      }
#pragma unroll
      for (int tb = 0; tb < 4; ++tb)
#pragma unroll
        for (int j = 0; j < 4; ++j) o[tb][j] += EXP2(l2g * (float)(tb * 16 + fq * 4 + j + 1)) * cr[tb][j];
#pragma unroll
      for (int tb = 0; tb < 4; ++tb)
#pragma unroll
        for (int j = 0; j < 4; ++j) *(LAS float*)(lds + obase + (tb * 16 + j) * 528) = o[tb][j];
    }
    __syncthreads();
    {
      const int seg = tid & 7;
      const f32x4 x0 = *(const LAS f32x4*)(lds + nbase), x1 = *(const LAS f32x4*)(lds + nbase + 16), x2 = *(const LAS f32x4*)(lds + nbase + 32), x3 = *(const LAS f32x4*)(lds + nbase + 48);
      f32x4 xs = x0 + x1 + x2 + x3;
      float sum = xs[0] + xs[1] + xs[2] + xs[3];
      sum += __shfl_xor(sum, 1); sum += __shfl_xor(sum, 2); sum += __shfl_xor(sum, 4);
      const float mu = sum * (1.f / 128.f);
      const f32x4 d0 = x0 - mu, d1 = x1 - mu, d2 = x2 - mu, d3 = x3 - mu;
      const f32x4 q = d0 * d0 + d1 * d1 + d2 * d2 + d3 * d3;
      float vs = q[0] + q[1] + q[2] + q[3];
      vs += __shfl_xor(vs, 1); vs += __shfl_xor(vs, 2); vs += __shfl_xor(vs, 4);
      const float rn = rsqrtf(vs * (1.f / 128.f) + 1e-6f);
      const float* gr = p.ret_g + l * 1024 + h * 128 + seg * 16;
      const f32x4 w0 = *(const f32x4*)gr, w1 = *(const f32x4*)(gr + 4), w2 = *(const f32x4*)(gr + 8), w3 = *(const f32x4*)(gr + 12);
      uint4 oa, ob;
      oa.x = pk2(d0[0] * rn * w0[0] * silu(bflo(g0[0])), d0[1] * rn * w0[1] * silu(bfhi(g0[0])));
      oa.y = pk2(d0[2] * rn * w0[2] * silu(bflo(g0[1])), d0[3] * rn * w0[3] * silu(bfhi(g0[1])));
      oa.z = pk2(d1[0] * rn * w1[0] * silu(bflo(g0[2])), d1[1] * rn * w1[1] * silu(bfhi(g0[2])));
      oa.w = pk2(d1[2] * rn * w1[2] * silu(bflo(g0[3])), d1[3] * rn * w1[3] * silu(bfhi(g0[3])));
      ob.x = pk2(d2[0] * rn * w2[0] * silu(bflo(g1[0])), d2[1] * rn * w2[1] * silu(bfhi(g1[0])));
      ob.y = pk2(d2[2] * rn * w2[2] * silu(bflo(g1[1])), d2[3] * rn * w2[3] * silu(bfhi(g1[1])));
      ob.z = pk2(d3[0] * rn * w3[0] * silu(bflo(g1[2])), d3[1] * rn * w3[1] * silu(bfhi(g1[2])));
      ob.w = pk2(d3[2] * rn * w3[2] * silu(bflo(g1[3])), d3[3] * rn * w3[3] * silu(bfhi(g1[3])));
      bf16_t* mp = p.mix + row * DM + h * 128 + seg * 16;
      *(uint4*)mp = oa; *(uint4*)(mp + 8) = ob;
    }
  }
#undef RET_GLOAD
}

DI void diff_pv(LAS unsigned char* lds, int vgb, const bf16x8 (&pfr)[2][2], f32x4 (&o)[2][8], int sub16) {
  __builtin_amdgcn_s_setprio(1);
#pragma unroll
  for (int eb = 0; eb < 8; ++eb)
#pragma unroll
    for (int kp = 0; kp < 2; ++kp) {
      const bf16x8 a = *(const LAS bf16x8*)(lds + vgb + (eb * 2 + kp) * 1024 + sub16);
      o[0][eb] = MFMA16(a, pfr[0][kp], o[0][eb]);
      o[1][eb] = MFMA16(a, pfr[1][kp], o[1][eb]);
    }
  __builtin_amdgcn_s_setprio(0);
}
DI void diff_tile(bool general, LAS unsigned char* lds, int kfb, const bf16x8 (&qf)[2][2], f32x4 (&o)[2][8], bf16x8 (&pfr)[2][2], float& m0, float& m1, float& l0, float& l1,
                  const f32x4 (&cj)[4], float slope2, int kt, int qrow, int fq) {
  f32x4 s[2][4];
#pragma unroll
  for (int kb = 0; kb < 4; ++kb) {
    const f32x4 init = cj[kb];
    const bf16x8 a0 = *(const LAS bf16x8*)(lds + kfb + (kb * 2) * 1024);
    const bf16x8 a1 = *(const LAS bf16x8*)(lds + kfb + (kb * 2 + 1) * 1024);
    s[0][kb] = MFMA16(a0, qf[0][0], init); s[1][kb] = MFMA16(a0, qf[1][0], init);
    s[0][kb] = MFMA16(a1, qf[0][1], s[0][kb]); s[1][kb] = MFMA16(a1, qf[1][1], s[1][kb]);
  }
  const float tconst = slope2 * (float)(kt * 64);
#pragma unroll
  for (int rb = 0; rb < 2; ++rb) {
    if (general) {
      const int qrel = qrow + rb * 16 - kt * 64;
      const float ms2 = -2.f * slope2;
#pragma unroll
      for (int kb = 0; kb < 4; ++kb)
#pragma unroll
        for (int j = 0; j < 4; ++j) {
          const int kl = kb * 16 + fq * 4 + j;
          float v = s[rb][kb][j] + ms2 * (float)max(kl - qrel, 0);
          if (kt == 0 && kl < 48) v = -INFINITY;
          s[rb][kb][j] = v;
        }
    }
    float mx = fmaxf(fmaxf(s[rb][0][0], s[rb][0][1]), fmaxf(s[rb][0][2], s[rb][0][3]));
#pragma unroll
    for (int kb = 1; kb < 4; ++kb) mx = fmaxf(fmaxf(mx, fmaxf(s[rb][kb][0], s[rb][kb][1])), fmaxf(s[rb][kb][2], s[rb][kb][3]));
    mx = xmax32(xmax16(mx));
    const float mloc = (rb ? m1 : m0) - tconst;
    float mnew = mloc, alpha = 1.f;
    if (!__all(mx <= mloc + 8.f)) {
      mnew = fmaxf(mloc, mx); alpha = EXP2(mloc - mnew);
#pragma unroll
      for (int eb = 0; eb < 8; ++eb) o[rb][eb] *= alpha;
    }
    float rsum = 0.f;
#pragma unroll
    for (int kb = 0; kb < 4; ++kb)
#pragma unroll
      for (int j = 0; j < 4; ++j) { const float pv = EXP2(s[rb][kb][j] - mnew); s[rb][kb][j] = pv; rsum += pv; }
    if (rb) { l1 = l1 * alpha + rsum; m1 = mnew + tconst; } else { l0 = l0 * alpha + rsum; m0 = mnew + tconst; }
#pragma unroll
    for (int kp = 0; kp < 2; ++kp) {
      const f32x4 sa = s[rb][2 * kp], sc = s[rb][2 * kp + 1];
      const u32x4 pbu = {pk2(sa[0], sa[1]), pk2(sa[2], sa[3]), pk2(sc[0], sc[1]), pk2(sc[2], sc[3])};
      pfr[rb][kp] = __builtin_bit_cast(bf16x8, pbu);
    }
  }
}

DI void diff_item(const Params& p, int l, int b, int h, int pi, float lam, float lam_init, LAS unsigned char* lds, bool& gsync) {
  const int tid = opaque_tid(), w = __builtin_amdgcn_readfirstlane(tid >> 6), lane = tid & 63, fr = lane & 15, fq = lane >> 4;
  const int c = w & 1, rgq = w >> 1, qc = 2 * pi + (rgq >> 1);
  const bool active = qc <= 32;
  const int ktmax = min(2 * pi + 1, 32);
  const int sub16 = lds_byte(fr, fq * 8), sub8a = lds_byte(fr, fq * 4), sub8b = lds_byte(fr, fq * 4 + 16);
  const bf16_t* projb = p.proj + (size_t)b * LROW * NIN;
  const int qrow = qc * 64 + (rgq & 1) * 32 + fr;
  bf16x8 qf[2][2];
#pragma unroll
  for (int rb = 0; rb < 2; ++rb)
#pragma unroll
    for (int ks = 0; ks < 2; ++ks)
      qf[rb][ks] = active ? *(const bf16x8*)(projb + (size_t)(qrow + rb * 16) * NIN + 4096 + h * 128 + c * 64 + ks * 32 + fq * 8) : (bf16x8){0, 0, 0, 0, 0, 0, 0, 0};
  float m0 = -INFINITY, m1 = -INFINITY, l0 = 0.f, l1 = 0.f;
  f32x4 o[2][8];
#pragma unroll
  for (int rb = 0; rb < 2; ++rb)
#pragma unroll
    for (int eb = 0; eb < 8; ++eb) o[rb][eb] = (f32x4){0.f, 0.f, 0.f, 0.f};
  const float slope2 = exp2f(-(float)(h + 1)) * LOG2E;
  f32x4 cj[4];
#pragma unroll
  for (int kb = 0; kb < 4; ++kb)
#pragma unroll
    for (int j = 0; j < 4; ++j) cj[kb][j] = slope2 * (float)(kb * 16 + fq * 4 + j);
  const int dswz = (lane * 16) ^ ((((lane * 16) >> 9) & 1) << 5), drr = dswz >> 6, dcc = (dswz & 63) >> 1;
  const bf16_t* gk = projb + (size_t)((w & 3) * 16 + drr) * NIN + 5120 + h * 128 + (w >> 2) * 64 + dcc;
  const bf16_t* gv = p.T + (size_t)b * 3072 * LROW + (size_t)(2048 + h * 128 + w * 16 + drr) * LROW + dcc;
  const int kdst = (w >> 2) * 8192 + (w & 3) * 2048, vdst = 32768 + w * 2048;
#define DIFF_DMA(kt, kb_, vs_) do { const bf16_t* _k = gk + (size_t)(kt) * 64 * NIN; const bf16_t* _v = gv + (kt) * 64; \
    __builtin_amdgcn_global_load_lds((const unsigned*)_k, (LAS unsigned*)(lds + (kb_) + kdst), 16, 0, 0); \
    __builtin_amdgcn_global_load_lds((const unsigned*)(_k + 32), (LAS unsigned*)(lds + (kb_) + kdst + 1024), 16, 0, 0); \
    __builtin_amdgcn_global_load_lds((const unsigned*)_v, (LAS unsigned*)(lds + (vs_) + vdst), 16, 0, 0); \
    __builtin_amdgcn_global_load_lds((const unsigned*)(_v + 32), (LAS unsigned*)(lds + (vs_) + vdst + 1024), 16, 0, 0); } while (0)
  DIFF_DMA(0, 0, 0);
  asm volatile("s_waitcnt vmcnt(0)" ::: "memory");
  __syncthreads();
  const int kfb0 = c * 8192 + sub16;
  const bool stag = (w >> 2) != 0;
  bf16x8 pfr[2][2];
  int vs = 0;
  for (int kt = 0; kt <= ktmax; ++kt) {
    const int kb = (kt & 1) * 16384;
    const int vsn = vs == 32768 ? 0 : vs + 16384;
    if (kt + 1 <= ktmax) DIFF_DMA(kt + 1, 16384 - kb, vsn);
    if (active && kt <= qc) {
      if (stag && kt > 0) diff_pv(lds, 32768 + (vs == 0 ? 32768 : vs - 16384), pfr, o, sub16);
      diff_tile(kt == 0 || kt == qc, lds, kfb0 + kb, qf, o, pfr, m0, m1, l0, l1, cj, slope2, kt, qrow, fq);
      if (!stag) diff_pv(lds, 32768 + vs, pfr, o, sub16);
    }
    vs = vsn;
    asm volatile("s_waitcnt vmcnt(0)" ::: "memory");
    __syncthreads();
  }
  if (active && stag) { const int lastslot = (qc % 3) * 16384; diff_pv(lds, 32768 + lastslot, pfr, o, sub16); }
#undef DIFF_DMA
  l0 += __shfl_xor(l0, 16); l0 += __shfl_xor(l0, 32);
  l1 += __shfl_xor(l1, 16); l1 += __shfl_xor(l1, 32);
  const int xb = 81920 + rgq * 16384 + lane * 4;
  if (c == 1 && active) {
#pragma unroll
    for (int rb = 0; rb < 2; ++rb) {
      const float inv = lam / (rb ? l1 : l0);
#pragma unroll
      for (int eb = 0; eb < 8; ++eb)
#pragma unroll
        for (int j = 0; j < 4; ++j) *(LAS float*)(lds + xb + ((rb * 8 + eb) * 4 + j) * 256) = o[rb][eb][j] * inv;
    }
  }
  if (!gsync && tid == 0) { unsigned sp = 0; while (xb_ld(p.ctr + 32 + l) < 32u && ++sp < (1u << 22)) __builtin_amdgcn_s_sleep(2); }
  __syncthreads();
  if (!gsync) { __builtin_amdgcn_fence(__ATOMIC_ACQUIRE, "agent"); gsync = true; }
  if (c == 0 && active) {
#pragma unroll
    for (int rb = 0; rb < 2; ++rb) {
      const float inv = 1.f / (rb ? l1 : l0);
      float ss = 0.f;
#pragma unroll
      for (int eb = 0; eb < 8; ++eb)
#pragma unroll
        for (int j = 0; j < 4; ++j) { const float d = o[rb][eb][j] * inv - *(const LAS float*)(lds + xb + ((rb * 8 + eb) * 4 + j) * 256); o[rb][eb][j] = d; ss += d * d; }
      ss += __shfl_xor(ss, 16); ss += __shfl_xor(ss, 32);
      const float rn = rsqrtf(ss * (1.f / 128.f) + 1e-6f) * (1.f - lam_init);
      const size_t row = (size_t)b * LROW + qrow + rb * 16;
#pragma unroll
      for (int eb = 0; eb < 8; ++eb) {
        const int e0 = h * 128 + eb * 16 + fq * 4;
        const uint2 gu = *(const uint2*)(p.proj + row * NIN + 7168 + e0);
        const float4 gg = *(const float4*)(p.diff_g + l * 1024 + e0);
        const float y0 = o[rb][eb][0] * rn * gg.x * silu(bflo(gu.x)), y1 = o[rb][eb][1] * rn * gg.y * silu(bfhi(gu.x));
        const float y2 = o[rb][eb][2] * rn * gg.z * silu(bflo(gu.y)), y3 = o[rb][eb][3] * rn * gg.w * silu(bfhi(gu.y));
        uint2 ov; ov.x = pk2(y0, y1); ov.y = pk2(y2, y3);
        *(uint2*)(p.mix + row * DM + 1024 + e0) = ov;
      }
    }
  }
}

DI void mixer_phase(const Params& p, int l, LAS unsigned char* lds) {
  volatile LAS int* s_item = (volatile LAS int*)(lds + 147456);
  const float lam = p.lam[l];
  const float lam_init = 0.8f - 0.6f * expf(-0.3f * (float)l);
  for (int c = (int)blockIdx.x - 32; c >= 0 && c < 32; c += (int)gridDim.x) ret_scan_chain(p, c >> 3, c & 7, lds, p.ctr + 34 + l);
  const int xcd = (int)(xb_xcc_id() & 7u);
  bool gsync = false, rsync = false;
  for (;;) {
    if (threadIdx.x == 0) *s_item = (int)atomicAdd(p.ctr + l * 8 + xcd, 1u);
    __syncthreads();
    const int it = *s_item;
    __syncthreads();
    if (it >= 68 + 22) break;
    if (it < 48 || it >= 70) {
      const int ai = it < 48 ? it : it - 22;
      const int bh = 4 * xcd + (ai & 3);
      diff_item(p, l, bh >> 3, bh & 7, 16 - (ai >> 2), lam, lam_init, lds, gsync);
    } else {
      if (!rsync) {
        if (threadIdx.x == 0) { unsigned sp = 0; while ((xb_ld(p.ctr + 34 + l) < 32u || xb_ld(p.ctr + 32 + l) < 32u) && ++sp < (1u << 22)) __builtin_amdgcn_s_sleep(2); }
        __syncthreads();
        __builtin_amdgcn_fence(__ATOMIC_ACQUIRE, "agent");
        rsync = true; gsync = true;
      }
      retention_items(p, l, lds, xcd + 48 * (it - 48), 8, 6);
      __syncthreads();
    }
  }
}

__global__ void __launch_bounds__(512) hymba_megakernel(Params p_unused) {
  cg::grid_group grid = cg::this_grid();
  extern __shared__ __attribute__((aligned(16))) char smem[];
  LAS unsigned char* lds = (LAS unsigned char*)smem;
  volatile LAS unsigned* xst = (volatile LAS unsigned*)(lds + 147456 + 16);
  if (threadIdx.x == 0) { xst[0] = 0u; xst[1] = 0u; }
  __syncthreads();
  XcdBarrier xb;
  { const Params p = load_params(); xb = xcd_barrier_post(p.bar, xst); }
  { const Params p = load_params(); prep_weights(p, lds, 0, 1792, blockIdx.x, gridDim.x, true); }
  { const Params p = load_params(); rownorm<0>(p); }
  grid.sync();
  for (int l = 0; l < 2; ++l) {
    { const Params p = load_params(); gemm1_phase(p, l, lds, 0, 1024); }
    xcd_barrier(xb);
    if (blockIdx.x < 32) {
      const Params p = load_params();
      gemm1_phase(p, l, lds, 1024, 1056);
      if (threadIdx.x == 0) {
        int nl = 0; for (int U = 1024 + (int)blockIdx.x; U < 1056; U += (int)gridDim.x) ++nl;
        __builtin_amdgcn_fence(__ATOMIC_RELEASE, "agent");
        asm volatile("s_waitcnt vmcnt(0)" ::: "memory");
        xb_add(p.ctr + 32 + l, (unsigned)nl);
      }
    }
    { const Params p = load_params(); mixer_phase(p, l, lds); }
    xcd_barrier(xb);
    { const Params p = load_params(); gemm2_phase(p, l, lds); }
    if (l == 0) { const Params p = load_params(); if (gridDim.x > 64) { if (blockIdx.x >= 64) prep_weights(p, lds, 1792, 2560, blockIdx.x - 64, gridDim.x - 64, false); } else prep_weights(p, lds, 1792, 2560, blockIdx.x, gridDim.x, false); }
    xcd_barrier(xb);
    if (l == 0) { { const Params p = load_params(); rownorm<1>(p); } xcd_barrier(xb); }
    else { const Params p = load_params(); rownorm<2>(p); }
  }
}

extern "C" void kernel_launch(void* const* d_in, const int* in_sizes, int n_in, void* d_out, int out_size, void* d_ws, size_t ws_size, hipStream_t stream) {
  static int grid_blocks = 0;
  if (!grid_blocks) {
    int dev = 0, cus = 0, per_cu = 0;
    hipGetDevice(&dev);
    hipDeviceGetAttribute(&cus, hipDeviceAttributeMultiprocessorCount, dev);
    hipFuncSetAttribute((const void*)hymba_megakernel, hipFuncAttributeMaxDynamicSharedMemorySize, SMEM_BYTES);
    hipOccupancyMaxActiveBlocksPerMultiprocessor(&per_cu, hymba_megakernel, 512, SMEM_BYTES);
    if (per_cu < 1) per_cu = 1;
    if (per_cu > 1) per_cu = 1;
    grid_blocks = cus * per_cu;
  }
  Params p{};
  p.x = (const float*)d_in[0]; p.meta = (const float*)d_in[1]; p.norm_g = (const float*)d_in[2]; p.w_in = (const float*)d_in[3];
  p.w_out = (const float*)d_in[4]; p.ret_g = (const float*)d_in[5]; p.diff_g = (const float*)d_in[6];
  p.lq1 = (const float*)d_in[7]; p.lk1 = (const float*)d_in[8]; p.lq2 = (const float*)d_in[9]; p.lk2 = (const float*)d_in[10];
  p.fin_g = (const float*)d_in[11];
  p.out = (float*)d_out;
  char* ws = (char*)d_ws; size_t off = 0;
  auto take = [&](size_t bytes) { char* r = ws + off; off += (bytes + 255) & ~(size_t)255; return r; };
  p.ctr = (unsigned*)take(256);
  p.bar = (unsigned*)take((size_t)XCD_BAR_WORDS * 4);
  p.ss = (float*)take((size_t)2 * MROWS * 4);
  p.lam = (float*)take(256);
  p.WinT = (bf16_t*)take((size_t)2 * NIN * DM * 2);
  p.WoutT = (bf16_t*)take((size_t)2 * DM * DM * 2);
  p.h = (float*)take((size_t)MROWS * DM * 4);
  p.hb = (bf16_t*)take((size_t)MROWS * DM * 2);
  p.proj = (bf16_t*)take((size_t)MROWS * NIN * 2);
  p.T = (bf16_t*)take((size_t)4 * 3072 * LROW * 2);
  p.mix = (bf16_t*)take((size_t)MROWS * DM * 2);
  p.ST = (bf16_t*)take((size_t)32 * NCH * 32768);
  p.P2 = (float*)take((size_t)8 * 256 * DM * 4);
  hipMemsetAsync(p.ctr, 0, 256 + (size_t)XCD_BAR_WORDS * 4 + (size_t)2 * MROWS * 4, stream);
  void* args[] = {&p};
  hipError_t e = hipLaunchCooperativeKernel((void*)hymba_megakernel, dim3(grid_blocks), dim3(512), args, SMEM_BYTES, stream);
  if (e != hipSuccess) fprintf(stderr, "cooperative launch failed: %s (grid %d)\n", hipGetErrorString(e), grid_blocks);
}
```

```cpp
#include <hip/hip_runtime.h>
#include <hip/hip_cooperative_groups.h>
#include <cstdio>
namespace cg = cooperative_groups;

typedef unsigned short bf16_t;
typedef short bf16x8 __attribute__((ext_vector_type(8)));
typedef short s16x4 __attribute__((ext_vector_type(4)));
typedef float f32x4 __attribute__((ext_vector_type(4)));
typedef float f32x2 __attribute__((ext_vector_type(2)));
typedef unsigned u32x4 __attribute__((ext_vector_type(4)));
typedef unsigned u32x2 __attribute__((ext_vector_type(2)));
typedef __bf16 bf16x2_t __attribute__((ext_vector_type(2)));
#define DI __device__ __forceinline__
#define LAS __attribute__((address_space(3)))
#define MFMA16(a, b, c) __builtin_amdgcn_mfma_f32_16x16x32_bf16((a), (b), (c), 0, 0, 0)

constexpr int LROW = 2112;
constexpr int MROWS = 4 * LROW;
constexpr int DM = 2048;
constexpr int NIN = 8192;
constexpr int NCH = 33;
constexpr float LOG2E = 1.4426950408889634f;
constexpr int SMEM_BYTES = 147456 + 64;

struct Params {
  const float *x, *meta, *norm_g, *w_in, *w_out, *ret_g, *diff_g, *lq1, *lk1, *lq2, *lk2, *fin_g;
  float* out;
  bf16_t *WinT, *WoutT, *hb, *proj, *T, *mix, *ST;
  float *h, *ss, *lam, *P2;
  unsigned* ctr;
  unsigned* bar;
};

DI Params load_params() {
  const Params __attribute__((address_space(4)))* q = (const Params __attribute__((address_space(4)))*)__builtin_amdgcn_kernarg_segment_ptr();
  asm volatile("" : "+s"(q));
  Params r; __builtin_memcpy(&r, (const void*)q, sizeof(Params)); return r;
}
DI unsigned pk2(float a, float b) { f32x2 v = {a, b}; bf16x2_t r = __builtin_convertvector(v, bf16x2_t); return __builtin_bit_cast(unsigned, r); }
DI float bf2f(unsigned v16) { return __uint_as_float(v16 << 16); }
DI float bflo(unsigned u) { return __uint_as_float(u << 16); }
DI float bfhi(unsigned u) { return __uint_as_float(u & 0xffff0000u); }
DI int opaque_tid() { int t = threadIdx.x; asm volatile("" : "+v"(t)); return t; }
#define EXP2(x) __builtin_amdgcn_exp2f(x)
DI float xmax16(float x) { const u32x2 r = __builtin_amdgcn_permlane16_swap(__float_as_uint(x), __float_as_uint(x), false, false); return fmaxf(__uint_as_float(r[0]), __uint_as_float(r[1])); }
DI float xmax32(float x) { const u32x2 r = __builtin_amdgcn_permlane32_swap(__float_as_uint(x), __float_as_uint(x), false, false); return fmaxf(__uint_as_float(r[0]), __uint_as_float(r[1])); }
DI float silu(float v) { return v * __builtin_amdgcn_rcpf(1.f + __expf(-v)); }

DI int lds_byte(int r, int c) { int st = (r >> 4) * 2 + (c >> 5), rr = r & 15, cc = c & 31, ob = rr * 64 + cc * 2; return st * 1024 + (ob ^ (((ob >> 9) & 1) << 5)); }
DI int perm32(int rho) { const int n = rho >> 4, i = rho & 15; return 8 * (i >> 2) + 4 * n + (i & 3); }
DI void stage_rc(int b, int& R, int& C) { int st = b / 1024, sb = b % 1024, swz = sb ^ (((sb >> 9) & 1) << 5); R = (st >> 1) * 16 + swz / 64; C = (st & 1) * 32 + (swz % 64) / 2; }

DI void prep_weights(const Params& p, LAS unsigned char* lds, int ubeg, int uend, int wgi, int wgn, bool do_lam) {
  const int tid = opaque_tid();
  const int NTOT = uend;
  const int lrow = tid >> 6, c4 = (tid & 63) * 4;
  f32x4 r[8];
#define PREP_DECODE(u) const float* src; bf16_t* dst; int N; const float* g; int kt, ntile; \
    { const int _l = (u) >= 1280 ? 1 : 0, _v = (u) - _l * 1280; \
      if (_v < 1024) { kt = _v >> 5; ntile = _v & 31; src = p.w_in + (size_t)_l * DM * NIN; dst = p.WinT + (size_t)_l * NIN * DM; N = NIN; g = p.norm_g + _l * DM; } \
      else { const int q = _v - 1024; kt = q >> 3; ntile = q & 7; src = p.w_out + (size_t)_l * DM * DM; dst = p.WoutT + (size_t)_l * DM * DM; N = DM; g = nullptr; } } \
    const int k0 = kt * 64, n0 = ntile * 256;
#define PREP_LOAD(u) do { PREP_DECODE(u) (void)dst; _Pragma("unroll") for (int i = 0; i < 8; ++i) { const int kk = lrow + 8 * i; \
    const f32x4 v = __builtin_nontemporal_load((const f32x4*)(src + (size_t)(k0 + kk) * N + n0 + c4));     const float gg = g ? g[k0 + kk] : 1.f; r[i] = v * gg; } } while (0)
  int u = ubeg + wgi;
  if (u < NTOT) PREP_LOAD(u);
  for (; u < NTOT; u += wgn) {
#pragma unroll
    for (int i = 0; i < 8; ++i) *(LAS f32x4*)(lds + ((lrow + 8 * i) * 260 + c4) * 4) = r[i];
    __syncthreads();
    const int un = u + wgn;
    if (un < NTOT) PREP_LOAD(un);
    {
      PREP_DECODE(u) (void)src; (void)N; (void)g;
      const int n = tid >> 1, kh = (tid & 1) * 32;
      bf16_t* op = dst + (size_t)(n0 + n) * DM + k0 + kh;
#pragma unroll
      for (int q = 0; q < 4; ++q) {
        float f[8];
#pragma unroll
        for (int j = 0; j < 8; ++j) f[j] = *(const LAS float*)(lds + ((kh + q * 8 + j) * 260 + n) * 4);
        const u32x4 o = {pk2(f[0], f[1]), pk2(f[2], f[3]), pk2(f[4], f[5]), pk2(f[6], f[7])};
        *(u32x4*)(op + q * 8) = o;
      }
    }
    __syncthreads();
  }
#undef PREP_DECODE
#undef PREP_LOAD
  if (do_lam && blockIdx.x == 0 && tid < 64) {
    for (int l = 0; l < 2; ++l) {
      float a = p.lq1[l * 64 + tid] * p.lk1[l * 64 + tid], b = p.lq2[l * 64 + tid] * p.lk2[l * 64 + tid];
#pragma unroll
      for (int off = 32; off >= 1; off >>= 1) { a += __shfl_xor(a, off); b += __shfl_xor(b, off); }
      float li = 0.8f - 0.6f * expf(-0.3f * (float)l);
      if (tid == 0) p.lam[l] = expf(a) - expf(b) + li;
    }
  }
}

template <int MODE> DI void rownorm(const Params& p) {
  const int tid = opaque_tid(); const int wave = tid >> 6, lane = tid & 63;
  const int nw = gridDim.x * 8;
  for (int row = (MODE == 1 ? 8192 : 0) + blockIdx.x * 8 + wave; row < MROWS; row += nw) {
    const int b = row / LROW, pos = row - b * LROW;
    if (MODE == 2 && pos < 64) continue;
    const float* src;
    if (MODE <= 1) src = pos < 48 ? nullptr : (pos < 64 ? p.meta + (size_t)(pos - 48) * DM : p.x + ((size_t)b * 2048 + (pos - 64)) * DM);
    else src = p.h + (size_t)row * DM;
    float4 v[8]; float ss = 0.f;
#pragma unroll
    for (int i = 0; i < 8; ++i) {
      if (src) { const f32x4 t = __builtin_nontemporal_load((const f32x4*)(src + i * 256 + lane * 4)); v[i] = make_float4(t[0], t[1], t[2], t[3]); }
      else v[i] = make_float4(0.f, 0.f, 0.f, 0.f);
      if (MODE != 0 && row >= 8192) {
#pragma unroll
        for (int s = 0; s < 8; ++s) { const float4 q = *(const float4*)(p.P2 + ((size_t)s * 256 + (row - 8192)) * DM + i * 256 + lane * 4); v[i].x += q.x; v[i].y += q.y; v[i].z += q.z; v[i].w += q.w; }
      }
      ss += v[i].x * v[i].x + v[i].y * v[i].y + v[i].z * v[i].z + v[i].w * v[i].w;
    }
#pragma unroll
    for (int off = 32; off >= 1; off >>= 1) ss += __shfl_xor(ss, off);
    const float rs = rsqrtf(ss * (1.f / 2048.f) + 1e-6f);
    if (MODE < 2) {
#pragma unroll
      for (int i = 0; i < 8; ++i) {
        if (MODE == 1) *(float4*)(p.h + (size_t)row * DM + i * 256 + lane * 4) = v[i];
        uint2 o; o.x = pk2(v[i].x, v[i].y); o.y = pk2(v[i].z, v[i].w);
        *(uint2*)(p.hb + (size_t)row * DM + i * 256 + lane * 4) = o;
      }
      if (lane == 0) p.ss[(MODE == 0 ? 0 : 1) * MROWS + row] = ss;
    } else {
      float* dst = p.out + ((size_t)b * 2048 + (pos - 64)) * DM;
#pragma unroll
      for (int i = 0; i < 8; ++i) {
        float4 g = *(const float4*)(p.fin_g + i * 256 + lane * 4);
        float4 o; o.x = v[i].x * rs * g.x; o.y = v[i].y * rs * g.y; o.z = v[i].z * rs * g.z; o.w = v[i].w * rs * g.w;
        *(float4*)(dst + i * 256 + lane * 4) = o;
      }
    }
  }
}

constexpr int GK = 2048, GBK = 64, GHALF = 128, GHTB = GHALF * GBK * 2;
constexpr size_t TSTEP = (size_t)256 * GK * 2;
struct Unit { int mt, nt, tr, k0, nkt, nb; };

template <class Epi, class Sched>
DI void gemm_phase(LAS unsigned char* lds, const Sched& S, const Epi& E) {
  const int tid = opaque_tid(), wid = __builtin_amdgcn_readfirstlane(tid >> 6), lane = tid & 63, wr = wid >> 2, wc = wid & 3, fr = lane & 15, fq = lane >> 4;
  constexpr int K = GK;
  unsigned voffA[2], dperm;
#pragma unroll
  for (int i = 0; i < 2; ++i) { int R, C; stage_rc(tid * 16 + i * 8192, R, C); voffA[i] = (unsigned)(R * K + C) * 2u;
    if (i == 0) dperm = (unsigned)((perm32(R & 31) - (R & 31)) * K * 2); }
  const size_t kstep = (size_t)(GBK * 2);
  const size_t hstep = (size_t)GHALF * K * 2;
  const unsigned ldsw = (unsigned)wid * 1024u;
  const int aoff = lds_byte(wr * 64 + fr, fq * 8), boff = lds_byte(wc * 32 + fr, fq * 8);
#define G_SA(b, h) (((b) * 2 + (h)) * GHTB)
#define G_SB(b, h) ((4 + (b) * 2 + (h)) * GHTB)
#define G_STAGE(bufoff, gbase, voff) do { _Pragma("unroll") for (int _i = 0; _i < 2; ++_i) \
    __builtin_amdgcn_global_load_lds((const unsigned*)((const char*)(gbase) + voff[_i]), (LAS unsigned*)(lds + (bufoff) + ldsw + _i * 8192), 16, 0, 0); } while (0)
#define G_LDA(dst, b, h) do { _Pragma("unroll") for (int m = 0; m < 4; ++m) _Pragma("unroll") for (int k = 0; k < 2; ++k) dst[m][k] = *(const LAS bf16x8*)(lds + G_SA(b, h) + aoff + m * 2048 + k * 1024); } while (0)
#define G_LDB(dst, b, h) do { _Pragma("unroll") for (int n = 0; n < 2; ++n) _Pragma("unroll") for (int k = 0; k < 2; ++k) dst[n][k] = *(const LAS bf16x8*)(lds + G_SB(b, h) + boff + n * 2048 + k * 1024); } while (0)
#define G_MMA(ai, bj, At, Bx) do { __builtin_amdgcn_s_setprio(1); _Pragma("unroll") for (int m = 0; m < 4; ++m) _Pragma("unroll") for (int n = 0; n < 2; ++n) _Pragma("unroll") for (int k = 0; k < 2; ++k) \
    acc[ai][bj][m][n] = MFMA16(Bx[n][k], At[m][k], acc[ai][bj][m][n]); __builtin_amdgcn_s_setprio(0); } while (0)
#define G_WAIT_V(n) asm volatile("s_waitcnt vmcnt(" #n ")" ::: "memory")
#define G_WAIT_L(n) asm volatile("s_waitcnt lgkmcnt(" #n ")" ::: "memory")
#define G_BAR __builtin_amdgcn_s_barrier()
#define G_SCHED __builtin_amdgcn_sched_barrier(0)
  Unit cur, nxt; int ui = 0;
  if (!S.next(0, cur)) return;
  f32x4 acc[2][2][4][2];
  E.init(acc, cur, wr, wc, fr, fq, lds, 0);
  bf16x8 At[4][2], B0[2][2], B1[2][2];
  const char* cA = S.pa(cur); const char* cB = S.pb(cur);
  { const unsigned ds0 = cur.nb ? 0u : dperm; const unsigned vb[2] = {voffA[0] + ds0, voffA[1] + ds0};
  G_STAGE(G_SB(0, 0), cB, vb); G_STAGE(G_SA(0, 0), cA, voffA); G_STAGE(G_SB(0, 1), cB + hstep, vb); G_STAGE(G_SA(0, 1), cA + hstep, voffA);
  if (wr == 1) G_BAR;
  G_WAIT_V(4); G_BAR;
  G_STAGE(G_SB(1, 0), cB + kstep, vb); G_STAGE(G_SA(1, 0), cA + kstep, voffA); G_STAGE(G_SB(1, 1), cB + hstep + kstep, vb); }
  G_WAIT_V(6); G_BAR;
  for (;;) {
    const bool has_next = S.next(ui + 1, nxt);
    if (!has_next) nxt = cur;
    const char* nA = has_next ? S.pa(nxt) : cA; const char* nB = has_next ? S.pb(nxt) : cB;
    const int nt = cur.nkt;
    for (int t = 0; t < nt; t += 2) {
      const bool last = (t == nt - 2);
      const char* a1 = cA + (size_t)(t + 1) * kstep;
      const char* a2 = last ? nA : cA + (size_t)(t + 2) * kstep; const char* b2 = last ? nB : cB + (size_t)(t + 2) * kstep;
      const char* a3 = a2 + kstep; const char* b3 = b2 + kstep;
      const bool nbs = last ? (nxt.nb != 0) : (cur.nb != 0);
      const unsigned ds = nbs ? 0u : dperm; const unsigned vb[2] = {voffA[0] + ds, voffA[1] + ds};
      G_LDB(B0, 0, 0); G_SCHED; G_LDA(At, 0, 0); G_STAGE(G_SA(1, 1), a1 + hstep, voffA);
      G_WAIT_L(8); G_BAR; G_WAIT_L(0); G_MMA(0, 0, At, B0); G_BAR; G_SCHED;
      G_LDB(B1, 0, 1); G_STAGE(G_SB(0, 0), b2, vb);
      G_BAR; G_WAIT_L(0); G_MMA(0, 1, At, B1); G_BAR;
      G_LDA(At, 0, 1); G_STAGE(G_SA(0, 0), a2, voffA);
      G_BAR; G_WAIT_L(0); G_MMA(1, 0, At, B0); G_BAR; G_SCHED;
      G_STAGE(G_SB(0, 1), b2 + hstep, vb);
      G_WAIT_V(6); G_BAR; G_MMA(1, 1, At, B1); G_BAR;
      G_LDB(B0, 1, 0); G_SCHED; G_LDA(At, 1, 0); G_STAGE(G_SA(0, 1), a2 + hstep, voffA);
      G_WAIT_L(8); G_BAR; G_WAIT_L(0); G_MMA(0, 0, At, B0); G_BAR; G_SCHED;
      G_LDB(B1, 1, 1); G_STAGE(G_SB(1, 0), b3, vb);
      G_BAR; G_WAIT_L(0); G_MMA(0, 1, At, B1); G_BAR;
      G_LDA(At, 1, 1); G_STAGE(G_SA(1, 0), a3, voffA);
      G_BAR; G_WAIT_L(0); G_MMA(1, 0, At, B0); G_BAR; G_SCHED;
      G_STAGE(G_SB(1, 1), b3 + hstep, vb);
      G_WAIT_V(6); G_BAR; G_MMA(1, 1, At, B1); G_BAR;
    }
    { const int t2 = opaque_tid() & 63; E(acc, cur, wr, wc, t2 & 15, t2 >> 4, lds, ui & 1); }
    if (!has_next) break;
    cur = nxt; cA = nA; cB = nB; ++ui;
    { const int t3 = opaque_tid() & 63; E.init(acc, cur, wr, wc, t3 & 15, t3 >> 4, lds, ui & 1); }
  }
  G_WAIT_V(0);
  if (wr == 0) G_BAR;
  G_BAR;
}

#define XB_TMO      128
#define XB_XCNT(j)  (256  + 64 * (j))
#define XB_XSUB(j)  (1280 + 64 * (j))
#define XB_XGEN(j)  (2304 + 64 * (j))
#define XB_TOP      3328
#define XB_TOPGEN   3392
#define XCD_BAR_WORDS 3456
#define XB_SPIN_CAP (1u << 18)
DI unsigned xb_ld(unsigned* p) { return __hip_atomic_load(p, __ATOMIC_RELAXED, __HIP_MEMORY_SCOPE_AGENT); }
DI unsigned xb_add(unsigned* p, unsigned v) { return __hip_atomic_fetch_add(p, v, __ATOMIC_RELAXED, __HIP_MEMORY_SCOPE_AGENT); }
DI unsigned xb_xcc_id() { return (unsigned)__builtin_amdgcn_s_getreg((3 << 11) | 20) & 0xFu; }
#define XB_SPIN(cond, bar) do { unsigned _sp = 0; while (cond) { __builtin_amdgcn_s_sleep(1); \
    if ((++_sp & 255u) == 0u) { if (xb_ld(&(bar)[XB_TMO])) break; if (_sp > XB_SPIN_CAP) { atomicAdd(&(bar)[XB_TMO], 1u); break; } } } } while (0)
struct XcdBarrier { unsigned* bar; unsigned x; volatile LAS unsigned* st; };
DI XcdBarrier xcd_barrier_post(unsigned* bar, volatile LAS unsigned* st) {
  XcdBarrier b; b.bar = bar; b.x = xb_xcc_id(); b.st = st;
  if (threadIdx.x == 0) (void)xb_add(&bar[XB_XCNT(b.x)], 1u);
  return b;
}
DI void xcd_barrier_complete(unsigned* bar, unsigned x, unsigned& nloc, unsigned& nx) {
  const unsigned G = gridDim.x * gridDim.y * gridDim.z;
  unsigned sum, cnt, mine, sp = 0u;
  for (;;) {
    sum = 0u; cnt = 0u; mine = 0u;
#pragma unroll
    for (unsigned j = 0; j < 16; ++j) { const unsigned c = xb_ld(&bar[XB_XCNT(j)]); sum += c; cnt += (c > 0u) ? 1u : 0u; mine = (j == x) ? c : mine; }
    if (sum == G) break;
    __builtin_amdgcn_s_sleep(1);
    if ((++sp & 255u) == 0u) { if (xb_ld(&bar[XB_TMO])) break; if (sp > XB_SPIN_CAP) { atomicAdd(&bar[XB_TMO], 1u); break; } }
  }
  nloc = mine > 0u ? mine : 1u; nx = cnt > 0u ? cnt : 1u;
}
DI void xcd_barrier(const XcdBarrier& b) {
  asm volatile("s_waitcnt vmcnt(0)" ::: "memory");
  __syncthreads();
  if (threadIdx.x == 0) {
    unsigned* bar = b.bar;
    __builtin_amdgcn_s_waitcnt(0);
    unsigned nloc = b.st[0], nx = b.st[1];
    if (nloc == 0u) { xcd_barrier_complete(bar, b.x, nloc, nx); b.st[0] = nloc; b.st[1] = nx; }
    const unsigned old = xb_add(&bar[XB_XSUB(b.x)], 1u);
    const unsigned gen = old / nloc;
    if (old + 1u == (gen + 1u) * nloc) {
      __builtin_amdgcn_fence(__ATOMIC_RELEASE, "agent");
      asm volatile("s_waitcnt vmcnt(0)" ::: "memory");
      const unsigned og = xb_add(&bar[XB_TOP], 1u);
      const unsigned tg = og / nx;
      if (og + 1u == (tg + 1u) * nx) xb_add(&bar[XB_TOPGEN], 1u);
      else XB_SPIN(xb_ld(&bar[XB_TOPGEN]) == tg, bar);
      __builtin_amdgcn_fence(__ATOMIC_ACQUIRE, "agent");
      xb_add(&bar[XB_XGEN(b.x)], 1u);
      asm volatile("s_waitcnt vmcnt(0)" ::: "memory");
    } else {
      XB_SPIN(xb_ld(&bar[XB_XGEN(b.x)]) == gen, bar);
      __builtin_amdgcn_fence(__ATOMIC_ACQUIRE, "agent");
      asm volatile("s_waitcnt vmcnt(0)" ::: "memory");
    }
  }
  __syncthreads();
}

DI void tile_map(int wgid, int nM, int nN, int& pm, int& pn) {
  const int nwg = nM * nN;
  { int q = nwg / 8, r = nwg % 8, xcd = wgid % 8, off = wgid / 8; wgid = (xcd < r ? xcd * (q + 1) : r * (q + 1) + (xcd - r) * q) + off; }
  const int nig = 8 * nN, gid = wgid / nig, fm = gid * 8, gsz = min(nM - fm, 8);
  pm = fm + ((wgid % nig) % gsz); pn = (wgid % nig) / gsz;
}

struct Sched1 {
  const bf16_t* hb; const bf16_t* W; int ubeg, uend;
  DI bool next(int i, Unit& u) const {
    const int U = ubeg + i * (int)gridDim.x + (int)blockIdx.x; if (U >= uend) return false;
    int pm, pn;
    if (U < 928) tile_map(U, 29, 32, pm, pn);
    else if (U < 1024) { const int q = U - 928, c = q % 24; pm = 29 + q / 24; pn = c < 12 ? c : c + 4; }
    else { const int q = U - 1024, g = q & 7; pm = 29 + (q >> 3); pn = g < 4 ? 12 + g : 24 + g; }
    u.mt = pm; u.nt = pn; u.k0 = 0; u.nkt = 32; const int g = pn >> 2; u.tr = (g == 1 || g == 2 || g == 6) ? 1 : 0; u.nb = u.tr; return true;
  }
  DI const char* pa(const Unit& u) const { return u.tr ? (const char*)W + (size_t)u.nt * TSTEP : (const char*)hb + (size_t)u.mt * TSTEP; }
  DI const char* pb(const Unit& u) const { return u.tr ? (const char*)hb + (size_t)u.mt * TSTEP : (const char*)W + (size_t)u.nt * TSTEP; }
};
struct Sched2 {
  const bf16_t* mix; const bf16_t* W;
  DI bool next(int i, Unit& u) const {
    const int U = i * (int)gridDim.x + (int)blockIdx.x; if (U >= 256 + 64) return false;
    if (U < 256) { int pm, pn; tile_map(U, 32, 8, pm, pn); u.mt = pm; u.nt = pn; u.tr = 0; u.k0 = 0; u.nkt = 32; u.nb = 0; }
    else { const int j = U - 256; u.mt = 32; u.nt = j >> 3; u.tr = 1 + (j & 7); u.k0 = (j & 7) * 256; u.nkt = 4; u.nb = 0; }
    return true;
  }
  DI const char* pa(const Unit& u) const { return (const char*)mix + (size_t)u.mt * TSTEP + (size_t)u.k0 * 2; }
  DI const char* pb(const Unit& u) const { return (const char*)W + (size_t)u.nt * TSTEP + (size_t)u.k0 * 2; }
};

DI void acc_zero(f32x4 (&acc)[2][2][4][2]) {
#pragma unroll
  for (int a = 0; a < 2; ++a)
#pragma unroll
    for (int b = 0; b < 2; ++b)
#pragma unroll
      for (int m = 0; m < 4; ++m)
#pragma unroll
        for (int n = 0; n < 2; ++n) acc[a][b][m][n] = (f32x4){0.f, 0.f, 0.f, 0.f};
}
struct Epi1 {
  bf16_t* proj; bf16_t* T; const float* ss;
  DI void init(f32x4 (&acc)[2][2][4][2], const Unit& u, int wr, int wc, int fr, int fq, LAS unsigned char* lds, int par) const {
    acc_zero(acc);
    if (wr == 0)
      __builtin_amdgcn_global_load_lds((const unsigned*)(ss + u.mt * 256 + wc * 64 + fq * 16 + fr), (LAS unsigned*)(lds + 131072 + par * 1024 + wc * 256), 4, 0, 0);
  }
  DI void operator()(const f32x4 (&acc)[2][2][4][2], const Unit& u, int wr, int wc, int fr, int fq, LAS unsigned char* lds, int par) const {
    const LAS float* ssl = (const LAS float*)(lds + 131072 + par * 1024);
    const int g = u.nt >> 2;
    if (!u.tr) {
      const float sc = (g == 4) ? 0.125f * LOG2E : 1.f;
      const int n0 = u.nt * 256 + wc * 32 + fq * 8;
#pragma unroll
      for (int ai = 0; ai < 2; ++ai)
#pragma unroll
        for (int mi = 0; mi < 4; ++mi) {
          const int m = u.mt * 256 + ai * 128 + wr * 64 + mi * 16 + fr;
          const float rs = rsqrtf(ssl[ai * 128 + wr * 64 + mi * 16 + fr] * (1.f / 2048.f) + 1e-6f) * sc;
          bf16_t* rowp = proj + (size_t)m * NIN + n0;
#pragma unroll
          for (int bj = 0; bj < 2; ++bj) {
            const f32x4 a = acc[ai][bj][mi][0], c = acc[ai][bj][mi][1];
            const u32x4 o = {pk2(a[0] * rs, a[1] * rs), pk2(a[2] * rs, a[3] * rs), pk2(c[0] * rs, c[1] * rs), pk2(c[2] * rs, c[3] * rs)};
            *(u32x4*)(rowp + bj * 128) = o;
          }
        }
    } else {
      const int tbase = (g == 1 ? 0 : (g == 2 ? 1024 : 2048)) - g * 1024;
#pragma unroll
      for (int bj = 0; bj < 2; ++bj) {
        const int mb = u.mt * 256 + bj * 128 + wc * 32;
        const int b = mb / LROW, posb = mb - b * LROW;
        const f32x4 q0 = *(const LAS f32x4*)(ssl + bj * 128 + wc * 32 + 4 * fq), q1 = *(const LAS f32x4*)(ssl + bj * 128 + wc * 32 + 16 + 4 * fq);
        float rs[8];
#pragma unroll
        for (int j = 0; j < 4; ++j) { rs[j] = rsqrtf(q0[j] * (1.f / 2048.f) + 1e-6f); rs[4 + j] = rsqrtf(q1[j] * (1.f / 2048.f) + 1e-6f); }
        const int p0 = posb + 4 * fq, p1 = p0 + 16;
        if (g == 1) {
#pragma unroll
          for (int j = 0; j < 4; ++j) { rs[j] = (p0 + j >= 48) ? rs[j] * 0.08838834764831845f : 0.f; rs[4 + j] = (p1 + j >= 48) ? rs[4 + j] * 0.08838834764831845f : 0.f; }
        }
#pragma unroll
        for (int ai = 0; ai < 2; ++ai)
#pragma unroll
          for (int mi = 0; mi < 4; ++mi) {
            const int col = u.nt * 256 + ai * 128 + wr * 64 + mi * 16 + fr;
            const f32x4 a = acc[ai][bj][mi][0], c = acc[ai][bj][mi][1];
            float v[8] = {a[0] * rs[0], a[1] * rs[1], a[2] * rs[2], a[3] * rs[3], c[0] * rs[4], c[1] * rs[5], c[2] * rs[6], c[3] * rs[7]};
            if (g == 1) {
              const int hh = (col - 1024) >> 7;
              const float l2g = log2f(1.f - exp2f(-5.f - (float)hh));
              const int z0 = 63 - (p0 & 63), z1 = 63 - (p1 & 63);
#pragma unroll
              for (int j = 0; j < 4; ++j) { v[j] *= exp2f(l2g * (float)(z0 - j)); v[4 + j] *= exp2f(l2g * (float)(z1 - j)); }
            }
            const u32x4 o = {pk2(v[0], v[1]), pk2(v[2], v[3]), pk2(v[4], v[5]), pk2(v[6], v[7])};
            const int trow = (g == 1) ? (col & ~31) + 16 * ((col >> 2) & 1) + 4 * ((col >> 3) & 3) + (col & 3) : col;
            *(u32x4*)(T + ((size_t)(b * 3072 + tbase + trow)) * LROW + posb + 8 * fq) = o;
          }
      }
    }
  }
};
struct Epi2 {
  float* h; float* P2; bf16_t* hb; float* ssn; const float* x; const float* meta;
  DI void init(f32x4 (&acc)[2][2][4][2], const Unit& u, int wr, int wc, int fr, int fq, LAS unsigned char*, int) const {
    if (u.tr) { acc_zero(acc); return; }
    const int n0 = u.nt * 256 + wc * 32 + fq * 8;
#pragma unroll
    for (int ai = 0; ai < 2; ++ai)
#pragma unroll
      for (int mi = 0; mi < 4; ++mi) {
        const int m = u.mt * 256 + ai * 128 + wr * 64 + mi * 16 + fr;
        const float* rowp = h + (size_t)m * DM + n0;
        if (x) { const int b = m / LROW, pos = m - b * LROW; rowp = pos < 48 ? nullptr : (pos < 64 ? meta + (size_t)(pos - 48) * DM : x + ((size_t)b * 2048 + (pos - 64)) * DM) + n0; }
#pragma unroll
        for (int bj = 0; bj < 2; ++bj)
#pragma unroll
          for (int ni = 0; ni < 2; ++ni) acc[ai][bj][mi][ni] = rowp ? __builtin_nontemporal_load((const f32x4*)(rowp + bj * 128 + ni * 4)) : (f32x4){0.f, 0.f, 0.f, 0.f};
      }
  }
  DI void operator()(const f32x4 (&acc)[2][2][4][2], const Unit& u, int wr, int wc, int fr, int fq, LAS unsigned char*, int) const {
    const int n0 = u.nt * 256 + wc * 32 + fq * 8;
#pragma unroll
    for (int ai = 0; ai < 2; ++ai)
#pragma unroll
      for (int mi = 0; mi < 4; ++mi) {
        const int m = u.mt * 256 + ai * 128 + wr * 64 + mi * 16 + fr;
        float* rowp = (u.tr ? P2 + ((size_t)(u.tr - 1) * 256 + (m - 8192)) * DM : h + (size_t)m * DM) + n0;
        float sq = 0.f;
#pragma unroll
        for (int bj = 0; bj < 2; ++bj) {
          const f32x4 a = acc[ai][bj][mi][0], c = acc[ai][bj][mi][1];
          *(f32x4*)(rowp + bj * 128) = a; *(f32x4*)(rowp + bj * 128 + 4) = c;
          if (ssn && !u.tr) {
            sq += a[0] * a[0] + a[1] * a[1] + a[2] * a[2] + a[3] * a[3] + c[0] * c[0] + c[1] * c[1] + c[2] * c[2] + c[3] * c[3];
            const u32x4 o = {pk2(a[0], a[1]), pk2(a[2], a[3]), pk2(c[0], c[1]), pk2(c[2], c[3])};
            *(u32x4*)(hb + (size_t)m * DM + n0 + bj * 128) = o;
          }
        }
        if (ssn && !u.tr) {
          sq += __shfl_xor(sq, 16); sq += __shfl_xor(sq, 32);
          if (fq == 0) unsafeAtomicAdd(ssn + m, sq);
        }
      }
  }
};

DI void gemm1_phase(const Params& p, int l, LAS unsigned char* lds, int ubeg, int uend) {
  Sched1 S{p.hb, p.WinT + (size_t)l * NIN * DM, ubeg, uend}; Epi1 E{p.proj, p.T, p.ss + (size_t)l * MROWS};
  gemm_phase(lds, S, E);
}
DI void gemm2_phase(const Params& p, int l, LAS unsigned char* lds) {
  Sched2 S{p.mix, p.WoutT + (size_t)l * DM * DM}; Epi2 E{p.h, p.P2, p.hb, l == 0 ? p.ss + MROWS : nullptr, l == 0 ? p.x : nullptr, p.meta};
  gemm_phase(lds, S, E);
}

DI void ret_scan_chain(const Params& p, int b, int h, LAS unsigned char* lds, unsigned* done_ctr) {
  constexpr int D = 6;
  const int tid = opaque_tid(), w = __builtin_amdgcn_readfirstlane(tid >> 6), lane = tid & 63, fr = lane & 15, fq = lane >> 4;
  const float l2g = log2f(1.f - exp2f(-5.f - (float)h));
  const float dec64 = exp2f(l2g * 64.f);
  const int sub16 = lds_byte(fr, fq * 8);
  const int frow = ((tid >> 4) & 31) * 2 + ((tid >> 2) & 1), fcol = ((tid >> 3) & 1) * 32 + (tid & 3) * 8;
  const int fillT = lds_byte(frow, fcol);
  const bf16_t* gk = p.T + (size_t)b * 3072 * LROW + (size_t)(h * 128 + frow) * LROW + fcol;
  u32x4* so = (u32x4*)p.ST + ((size_t)((b * 8 + h) * NCH) * 8 + w) * 256 + lane;
  f32x4 st[8];
#pragma unroll
  for (int i = 0; i < 8; ++i) st[i] = (f32x4){0.f, 0.f, 0.f, 0.f};
  u32x4 ring[D][4];
#define SCAN_LOAD(slot, n) do { const bf16_t* _t = gk + (n) * 64; ring[slot][0] = *(const u32x4*)_t; ring[slot][1] = *(const u32x4*)(_t + (size_t)64 * LROW); \
    ring[slot][2] = *(const u32x4*)(_t + (size_t)1024 * LROW); ring[slot][3] = *(const u32x4*)(_t + (size_t)1088 * LROW); } while (0)
#define SCAN_STORE(n) do { _Pragma("unroll") for (int kd = 0; kd < 4; ++kd) { const f32x4 sa = st[2 * kd], sc = st[2 * kd + 1]; \
    const u32x4 bsu = {pk2(sa[0], sa[1]), pk2(sa[2], sa[3]), pk2(sc[0], sc[1]), pk2(sc[2], sc[3])}; so[(size_t)(n) * 2048 + kd * 64] = bsu; } } while (0)
#pragma unroll
  for (int i = 0; i < D; ++i) SCAN_LOAD(i, i);
#pragma unroll
  for (int n = 0; n < NCH - 1; ++n) {
    const int slot = n % D, bo = (n & 1) * 32768;
    *(LAS u32x4*)(lds + bo + fillT) = ring[slot][0]; *(LAS u32x4*)(lds + bo + fillT + 8192) = ring[slot][1];
    *(LAS u32x4*)(lds + bo + 16384 + fillT) = ring[slot][2]; *(LAS u32x4*)(lds + bo + 16384 + fillT + 8192) = ring[slot][3];
    if (n + D < NCH - 1) SCAN_LOAD(slot, n + D);
    __syncthreads();
    SCAN_STORE(n);
    const bf16x8 vf0 = *(const LAS bf16x8*)(lds + bo + 16384 + w * 2048 + sub16), vf1 = *(const LAS bf16x8*)(lds + bo + 16384 + w * 2048 + 1024 + sub16);
#pragma unroll
    for (int db = 0; db < 8; ++db) {
      st[db] *= dec64;
      const bf16x8 a0 = *(const LAS bf16x8*)(lds + bo + sub16 + db * 2048);
      const bf16x8 a1 = *(const LAS bf16x8*)(lds + bo + sub16 + db * 2048 + 1024);
      st[db] = MFMA16(a0, vf0, st[db]); st[db] = MFMA16(a1, vf1, st[db]);
    }
  }
  SCAN_STORE(NCH - 1);
  asm volatile("s_waitcnt vmcnt(0)" ::: "memory");
  __syncthreads();
  if (threadIdx.x == 0) { __builtin_amdgcn_fence(__ATOMIC_RELEASE, "agent"); asm volatile("s_waitcnt vmcnt(0)" ::: "memory"); xb_add(done_ctr, 1u); }
#undef SCAN_LOAD
#undef SCAN_STORE
}

DI void retention_items(const Params& p, int l, LAS unsigned char* lds, int first, int stride, int count) {
  constexpr int QS = 0, KS = 16384, VTS = 49152, PS = 65536, OS = 73728;
  const int tid = opaque_tid(), w = __builtin_amdgcn_readfirstlane(tid >> 6), lane = tid & 63, fr = lane & 15, fq = lane >> 4;
  const int sub16 = lds_byte(fr, fq * 8), sub8a = lds_byte(fr, fq * 4), sub8b = lds_byte(fr, fq * 4 + 16);
  const int tq = ((tid >> 5) & 15) * 2 + ((tid >> 2) & 1), dq = ((tid >> 4) & 1) * 64 + ((tid >> 3) & 1) * 32 + (tid & 3) * 8;
  const int ve = ((tid >> 4) & 31) * 2 + ((tid >> 2) & 1), vs0 = ((tid >> 3) & 1) * 32 + (tid & 3) * 8;
  const int fillQ = (dq >> 6) * 8192 + lds_byte(tq, dq & 63);
  const int fillT = lds_byte(ve, vs0);
  const int sb = w & 3, tb0 = (w >> 2) * 2;
  const int kbase = KS + sb * 2048 + sub16, qbase = QS + tb0 * 2048 + sub16;
  const int pbase = PS + tb0 * 2048 + (sb >> 1) * 1024 + lds_byte(fr, fq * 8 + 4 * (sb & 1));
  const int vbase = VTS + w * 2048 + sub16;
  const int obase = OS + ((fq * 4) * 132 + w * 16 + fr) * 4;
  const int nbase = OS + ((tid >> 3) * 132 + (tid & 7) * 16) * 4;
  u32x4 pq0, pq1, pk0, pk1, pv0, pv1, ns0, ns1, ns2, ns3, ng0, ng1;
#define RET_GLOAD(it) do { const int _bh = (it) / NCH, _n = (it) - _bh * NCH, _b = _bh >> 3, _h = _bh & 7; \
    const bf16_t* _q = p.proj + ((size_t)_b * LROW + _n * 64 + tq) * NIN + _h * 128 + dq; \
    const bf16_t* _tk = p.T + ((size_t)_b * 3072 + _h * 128 + (tid >> 3)) * LROW + _n * 64 + (tid & 7) * 8; \
    const bf16_t* _tv = p.T + ((size_t)_b * 3072 + 1024 + _h * 128 + ve) * LROW + _n * 64 + vs0; \
    pq0 = *(const u32x4*)_q; pq1 = *(const u32x4*)(_q + (size_t)32 * NIN); pk0 = *(const u32x4*)_tk; pk1 = *(const u32x4*)(_tk + (size_t)64 * LROW); \
    pv0 = *(const u32x4*)_tv; pv1 = *(const u32x4*)(_tv + (size_t)64 * LROW); \
    const u32x4* _sp = (const u32x4*)p.ST + ((size_t)(it) * 8 + w) * 256 + lane; ns0 = _sp[0]; ns1 = _sp[64]; ns2 = _sp[128]; ns3 = _sp[192]; \
    const bf16_t* _gp = p.proj + ((size_t)_b * LROW + _n * 64 + (tid >> 3)) * NIN + 3072 + _h * 128 + (tid & 7) * 16; \
    ng0 = *(const u32x4*)_gp; ng1 = *(const u32x4*)(_gp + 8); } while (0)
  int it = first;
  const int iend = first + stride * count;
  if (it < iend) RET_GLOAD(it);
  for (; it < iend; it += stride) {
    const int bh = it / NCH, n = it - bh * NCH, b = bh >> 3, h = bh & 7;
    const float l2g = log2f(1.f - exp2f(-5.f - (float)h));
    *(LAS u32x4*)(lds + QS + fillQ) = pq0; *(LAS u32x4*)(lds + QS + fillQ + 4096) = pq1;
    {
      const int d0 = tid >> 3, s0 = (tid & 7) * 8;
#pragma unroll
      for (int i = 0; i < 2; ++i) {
        const u32x4 kv = i ? pk1 : pk0;
        const int r_ = d0 + 64 * i, d = (r_ & ~31) + 8 * ((r_ >> 2) & 3) + 4 * ((r_ >> 4) & 1) + (r_ & 3), ko = KS + (d >> 6) * 8192;
#pragma unroll
        for (int j = 0; j < 8; ++j) {
          const unsigned wv = kv[j >> 1];
          const int st = (s0 & 32) + 16 * (j >> 2) + 4 * ((s0 >> 3) & 3) + (j & 3);
          *(LAS bf16_t*)(lds + ko + lds_byte(st, d & 63)) = (bf16_t)((j & 1) ? (wv >> 16) : (wv & 0xffffu));
        }
      }
    }
    *(LAS u32x4*)(lds + VTS + fillT) = pv0; *(LAS u32x4*)(lds + VTS + fillT + 8192) = pv1;
    const u32x4 sf0 = ns0, sf1 = ns1, sf2 = ns2, sf3 = ns3, g0 = ng0, g1 = ng1;
    __syncthreads();
    if (it + stride < iend) RET_GLOAD(it + stride);
    const size_t row = (size_t)b * LROW + n * 64 + (tid >> 3);
    {
      f32x4 s0 = {0.f, 0.f, 0.f, 0.f}, s1 = {0.f, 0.f, 0.f, 0.f};
#pragma unroll
      for (int ks = 0; ks < 4; ++ks) {
        const int off = (ks >> 1) * 8192 + (ks & 1) * 1024;
        const bf16x8 a = *(const LAS bf16x8*)(lds + kbase + off);
        const bf16x8 b0 = *(const LAS bf16x8*)(lds + qbase + off);
        const bf16x8 b1 = *(const LAS bf16x8*)(lds + qbase + off + 2048);
        s0 = MFMA16(a, b0, s0); s1 = MFMA16(a, b1, s1);
      }
      const int srow = sb * 16 + fq * 4;
#pragma unroll
      for (int i = 0; i < 2; ++i) {
        const f32x4 sv = i ? s1 : s0;
        const int t = (tb0 + i) * 16 + fr;
        const float v0 = sv[0] * EXP2(l2g * (fabsf((float)(t - srow)) - (float)(63 - srow))), v1 = sv[1] * EXP2(l2g * (fabsf((float)(t - srow - 1)) - (float)(62 - srow)));
        const float v2 = sv[2] * EXP2(l2g * (fabsf((float)(t - srow - 2)) - (float)(61 - srow))), v3 = sv[3] * EXP2(l2g * (fabsf((float)(t - srow - 3)) - (float)(60 - srow)));
        const u32x2 o = {pk2(v0, v1), pk2(v2, v3)};
        *(LAS u32x2*)(lds + pbase + i * 2048) = o;
      }
    }
    __syncthreads();
    {
      const bf16x8 vf0 = *(const LAS bf16x8*)(lds + vbase), vf1 = *(const LAS bf16x8*)(lds + vbase + 1024);
      f32x4 o[4], cr[4];
#pragma unroll
      for (int tb = 0; tb < 4; ++tb) {
        o[tb] = (f32x4){0.f, 0.f, 0.f, 0.f}; cr[tb] = (f32x4){0.f, 0.f, 0.f, 0.f};
        const bf16x8 a0 = *(const LAS bf16x8*)(lds + PS + sub16 + tb * 2048);
        const bf16x8 a1 = *(const LAS bf16x8*)(lds + PS + sub16 + tb * 2048 + 1024);
        o[tb] = MFMA16(a0, vf0, o[tb]); o[tb] = MFMA16(a1, vf1, o[tb]);
      }
#pragma unroll
      for (int kd = 0; kd < 4; ++kd) {
        const bf16x8 bsv = __builtin_bit_cast(bf16x8, kd == 0 ? sf0 : (kd == 1 ? sf1 : (kd == 2 ? sf2 : sf3)));
#pragma unroll
        for (int tb = 0; tb < 4; ++tb) {
          const bf16x8 a = *(const LAS bf16x8*)(lds + QS + (kd >> 1) * 8192 + (tb * 2 + (kd & 1)) * 1024 + sub16);
          cr[tb] = MFMA16(a, bsv, cr[tb]);
        }
      }
#pragma unroll
      for (int tb = 0; tb < 4; ++tb)
#pragma unroll
        for (int j = 0; j < 4; ++j) o[tb][j] += EXP2(l2g * (float)(tb * 16 + fq * 4 + j + 1)) * cr[tb][j];
#pragma unroll
      for (int tb = 0; tb < 4; ++tb)
#pragma unroll
        for (int j = 0; j < 4; ++j) *(LAS float*)(lds + obase + (tb * 16 + j) * 528) = o[tb][j];
    }
    __syncthreads();
    {
      const int seg = tid & 7;
      const f32x4 x0 = *(const LAS f32x4*)(lds + nbase), x1 = *(const LAS f32x4*)(lds + nbase + 16), x2 = *(const LAS f32x4*)(lds + nbase + 32), x3 = *(const LAS f32x4*)(lds + nbase + 48);
      f32x4 xs = x0 + x1 + x2 + x3;
      float sum = xs[0] + xs[1] + xs[2] + xs[3];
      sum += __shfl_xor(sum, 1); sum += __shfl_xor(sum, 2); sum += __shfl_xor(sum, 4);
      const float mu = sum * (1.f / 128.f);
      const f32x4 d0 = x0 - mu, d1 = x1 - mu, d2 = x2 - mu, d3 = x3 - mu;
      const f32x4 q = d0 * d0 + d1 * d1 + d2 * d2 + d3 * d3;
      float vs = q[0] + q[1] + q[2] + q[3];
      vs += __shfl_xor(vs, 1); vs += __shfl_xor(vs, 2); vs += __shfl_xor(vs, 4);
      const float rn = rsqrtf(vs * (1.f / 128.f) + 1e-6f);
      const float* gr = p.ret_g + l * 1024 + h * 128 + seg * 16;
      const f32x4 w0 = *(const f32x4*)gr, w1 = *(const f32x4*)(gr + 4), w2 = *(const f32x4*)(gr + 8), w3 = *(const f32x4*)(gr + 12);
      uint4 oa, ob;
      oa.x = pk2(d0[0] * rn * w0[0] * silu(bflo(g0[0])), d0[1] * rn * w0[1] * silu(bfhi(g0[0])));
      oa.y = pk2(d0[2] * rn * w0[2] * silu(bflo(g0[1])), d0[3] * rn * w0[3] * silu(bfhi(g0[1])));
      oa.z = pk2(d1[0] * rn * w1[0] * silu(bflo(g0[2])), d1[1] * rn * w1[1] * silu(bfhi(g0[2])));
      oa.w = pk2(d1[2] * rn * w1[2] * silu(bflo(g0[3])), d1[3] * rn * w1[3] * silu(bfhi(g0[3])));
      ob.x = pk2(d2[0] * rn * w2[0] * silu(bflo(g1[0])), d2[1] * rn * w2[1] * silu(bfhi(g1[0])));
      ob.y = pk2(d2[2] * rn * w2[2] * silu(bflo(g1[1])), d2[3] * rn * w2[3] * silu(bfhi(g1[1])));
      ob.z = pk2(d3[0] * rn * w3[0] * silu(bflo(g1[2])), d3[1] * rn * w3[1] * silu(bfhi(g1[2])));
      ob.w = pk2(d3[2] * rn * w3[2] * silu(bflo(g1[3])), d3[3] * rn * w3[3] * silu(bfhi(g1[3])));
      bf16_t* mp = p.mix + row * DM + h * 128 + seg * 16;
      *(uint4*)mp = oa; *(uint4*)(mp + 8) = ob;
    }
  }
#undef RET_GLOAD
}

DI void diff_pv(LAS unsigned char* lds, int vgb, const bf16x8 (&pfr)[2][2], f32x4 (&o)[2][8], int sub16) {
  __builtin_amdgcn_s_setprio(1);
#pragma unroll
  for (int eb = 0; eb < 8; ++eb)
#pragma unroll
    for (int kp = 0; kp < 2; ++kp) {
      const bf16x8 a = *(const LAS bf16x8*)(lds + vgb + (eb * 2 + kp) * 1024 + sub16);
      o[0][eb] = MFMA16(a, pfr[0][kp], o[0][eb]);
      o[1][eb] = MFMA16(a, pfr[1][kp], o[1][eb]);
    }
  __builtin_amdgcn_s_setprio(0);
}
DI void diff_tile(bool general, LAS unsigned char* lds, int kfb, const bf16x8 (&qf)[2][2], f32x4 (&o)[2][8], bf16x8 (&pfr)[2][2], float& m0, float& m1, float& l0, float& l1,
                  const f32x4 (&cj)[4], float slope2, int kt, int qrow, int fq) {
  f32x4 s[2][4];
#pragma unroll
  for (int kb = 0; kb < 4; ++kb) {
    const f32x4 init = cj[kb];
    const bf16x8 a0 = *(const LAS bf16x8*)(lds + kfb + (kb * 2) * 1024);
    const bf16x8 a1 = *(const LAS bf16x8*)(lds + kfb + (kb * 2 + 1) * 1024);
    s[0][kb] = MFMA16(a0, qf[0][0], init); s[1][kb] = MFMA16(a0, qf[1][0], init);
    s[0][kb] = MFMA16(a1, qf[0][1], s[0][kb]); s[1][kb] = MFMA16(a1, qf[1][1], s[1][kb]);
  }
  const float tconst = slope2 * (float)(kt * 64);
#pragma unroll
  for (int rb = 0; rb < 2; ++rb) {
    if (general) {
      const int qrel = qrow + rb * 16 - kt * 64;
      const float ms2 = -2.f * slope2;
#pragma unroll
      for (int kb = 0; kb < 4; ++kb)
#pragma unroll
        for (int j = 0; j < 4; ++j) {
          const int kl = kb * 16 + fq * 4 + j;
          float v = s[rb][kb][j] + ms2 * (float)max(kl - qrel, 0);
          if (kt == 0 && kl < 48) v = -INFINITY;
          s[rb][kb][j] = v;
        }
    }
    float mx = fmaxf(fmaxf(s[rb][0][0], s[rb][0][1]), fmaxf(s[rb][0][2], s[rb][0][3]));
#pragma unroll
    for (int kb = 1; kb < 4; ++kb) mx = fmaxf(fmaxf(mx, fmaxf(s[rb][kb][0], s[rb][kb][1])), fmaxf(s[rb][kb][2], s[rb][kb][3]));
    mx = xmax32(xmax16(mx));
    const float mloc = (rb ? m1 : m0) - tconst;
    float mnew = mloc, alpha = 1.f;
    if (!__all(mx <= mloc + 8.f)) {
      mnew = fmaxf(mloc, mx); alpha = EXP2(mloc - mnew);
#pragma unroll
      for (int eb = 0; eb < 8; ++eb) o[rb][eb] *= alpha;
    }
    float rsum = 0.f;
#pragma unroll
    for (int kb = 0; kb < 4; ++kb)
#pragma unroll
      for (int j = 0; j < 4; ++j) { const float pv = EXP2(s[rb][kb][j] - mnew); s[rb][kb][j] = pv; rsum += pv; }
    if (rb) { l1 = l1 * alpha + rsum; m1 = mnew + tconst; } else { l0 = l0 * alpha + rsum; m0 = mnew + tconst; }
#pragma unroll
    for (int kp = 0; kp < 2; ++kp) {
      const f32x4 sa = s[rb][2 * kp], sc = s[rb][2 * kp + 1];
      const u32x4 pbu = {pk2(sa[0], sa[1]), pk2(sa[2], sa[3]), pk2(sc[0], sc[1]), pk2(sc[2], sc[3])};
      pfr[rb][kp] = __builtin_bit_cast(bf16x8, pbu);
    }
  }
}

DI void diff_item(const Params& p, int l, int b, int h, int pi, float lam, float lam_init, LAS unsigned char* lds, bool& gsync) {
  const int tid = opaque_tid(), w = __builtin_amdgcn_readfirstlane(tid >> 6), lane = tid & 63, fr = lane & 15, fq = lane >> 4;
  const int c = w & 1, rgq = w >> 1, qc = 2 * pi + (rgq >> 1);
  const bool active = qc <= 32;
  const int ktmax = min(2 * pi + 1, 32);
  const int sub16 = lds_byte(fr, fq * 8), sub8a = lds_byte(fr, fq * 4), sub8b = lds_byte(fr, fq * 4 + 16);
  const bf16_t* projb = p.proj + (size_t)b * LROW * NIN;
  const int qrow = qc * 64 + (rgq & 1) * 32 + fr;
  bf16x8 qf[2][2];
#pragma unroll
  for (int rb = 0; rb < 2; ++rb)
#pragma unroll
    for (int ks = 0; ks < 2; ++ks)
      qf[rb][ks] = active ? *(const bf16x8*)(projb + (size_t)(qrow + rb * 16) * NIN + 4096 + h * 128 + c * 64 + ks * 32 + fq * 8) : (bf16x8){0, 0, 0, 0, 0, 0, 0, 0};
  float m0 = -INFINITY, m1 = -INFINITY, l0 = 0.f, l1 = 0.f;
  f32x4 o[2][8];
#pragma unroll
  for (int rb = 0; rb < 2; ++rb)
#pragma unroll
    for (int eb = 0; eb < 8; ++eb) o[rb][eb] = (f32x4){0.f, 0.f, 0.f, 0.f};
  const float slope2 = exp2f(-(float)(h + 1)) * LOG2E;
  f32x4 cj[4];
#pragma unroll
  for (int kb = 0; kb < 4; ++kb)
#pragma unroll
    for (int j = 0; j < 4; ++j) cj[kb][j] = slope2 * (float)(kb * 16 + fq * 4 + j);
  const int dswz = (lane * 16) ^ ((((lane * 16) >> 9) & 1) << 5), drr = dswz >> 6, dcc = (dswz & 63) >> 1;
  const bf16_t* gk = projb + (size_t)((w & 3) * 16 + drr) * NIN + 5120 + h * 128 + (w >> 2) * 64 + dcc;
  const bf16_t* gv = p.T + (size_t)b * 3072 * LROW + (size_t)(2048 + h * 128 + w * 16 + drr) * LROW + dcc;
  const int kdst = (w >> 2) * 8192 + (w & 3) * 2048, vdst = 32768 + w * 2048;
#define DIFF_DMA(kt, kb_, vs_) do { const bf16_t* _k = gk + (size_t)(kt) * 64 * NIN; const bf16_t* _v = gv + (kt) * 64; \
    __builtin_amdgcn_global_load_lds((const unsigned*)_k, (LAS unsigned*)(lds + (kb_) + kdst), 16, 0, 0); \
    __builtin_amdgcn_global_load_lds((const unsigned*)(_k + 32), (LAS unsigned*)(lds + (kb_) + kdst + 1024), 16, 0, 0); \
    __builtin_amdgcn_global_load_lds((const unsigned*)_v, (LAS unsigned*)(lds + (vs_) + vdst), 16, 0, 0); \
    __builtin_amdgcn_global_load_lds((const unsigned*)(_v + 32), (LAS unsigned*)(lds + (vs_) + vdst + 1024), 16, 0, 0); } while (0)
  DIFF_DMA(0, 0, 0);
  asm volatile("s_waitcnt vmcnt(0)" ::: "memory");
  __syncthreads();
  const int kfb0 = c * 8192 + sub16;
  const bool stag = (w >> 2) != 0;
  bf16x8 pfr[2][2];
  int vs = 0;
  for (int kt = 0; kt <= ktmax; ++kt) {
    const int kb = (kt & 1) * 16384;
    const int vsn = vs == 32768 ? 0 : vs + 16384;
    if (kt + 1 <= ktmax) DIFF_DMA(kt + 1, 16384 - kb, vsn);
    if (active && kt <= qc) {
      if (stag && kt > 0) diff_pv(lds, 32768 + (vs == 0 ? 32768 : vs - 16384), pfr, o, sub16);
      diff_tile(kt == 0 || kt == qc, lds, kfb0 + kb, qf, o, pfr, m0, m1, l0, l1, cj, slope2, kt, qrow, fq);
      if (!stag) diff_pv(lds, 32768 + vs, pfr, o, sub16);
    }
    vs = vsn;
    asm volatile("s_waitcnt vmcnt(0)" ::: "memory");
    __syncthreads();
  }
  if (active && stag) { const int lastslot = (qc % 3) * 16384; diff_pv(lds, 32768 + lastslot, pfr, o, sub16); }
#undef DIFF_DMA
  l0 += __shfl_xor(l0, 16); l0 += __shfl_xor(l0, 32);
  l1 += __shfl_xor(l1, 16); l1 += __shfl_xor(l1, 32);
  const int xb = 81920 + rgq * 16384 + lane * 4;
  if (!gsync) {
    if (tid == 0) { unsigned sp = 0; while (xb_ld(p.ctr + 32 + l) < 32u && ++sp < (1u << 22)) __builtin_amdgcn_s_sleep(2); }
    __syncthreads();
    __builtin_amdgcn_fence(__ATOMIC_ACQUIRE, "agent"); gsync = true;
  }
  u32x2 gpre[2][8];
  if (c == 0 && active) {
#pragma unroll
    for (int rb = 0; rb < 2; ++rb)
#pragma unroll
      for (int eb = 0; eb < 8; ++eb)
        gpre[rb][eb] = *(const u32x2*)(p.proj + ((size_t)b * LROW + qrow + rb * 16) * NIN + 7168 + h * 128 + eb * 16 + fq * 4);
  }
  if (c == 1 && active) {
#pragma unroll
    for (int rb = 0; rb < 2; ++rb) {
      const float inv = lam / (rb ? l1 : l0);
#pragma unroll
      for (int eb = 0; eb < 8; ++eb)
#pragma unroll
        for (int j = 0; j < 4; ++j) *(LAS float*)(lds + xb + ((rb * 8 + eb) * 4 + j) * 256) = o[rb][eb][j] * inv;
    }
  }
  __syncthreads();
  if (c == 0 && active) {
#pragma unroll
    for (int rb = 0; rb < 2; ++rb) {
      const float inv = 1.f / (rb ? l1 : l0);
      float ss = 0.f;
#pragma unroll
      for (int eb = 0; eb < 8; ++eb)
#pragma unroll
        for (int j = 0; j < 4; ++j) { const float d = o[rb][eb][j] * inv - *(const LAS float*)(lds + xb + ((rb * 8 + eb) * 4 + j) * 256); o[rb][eb][j] = d; ss += d * d; }
      ss += __shfl_xor(ss, 16); ss += __shfl_xor(ss, 32);
      const float rn = rsqrtf(ss * (1.f / 128.f) + 1e-6f) * (1.f - lam_init);
      const size_t row = (size_t)b * LROW + qrow + rb * 16;
#pragma unroll
      for (int eb = 0; eb < 8; ++eb) {
        const int e0 = h * 128 + eb * 16 + fq * 4;
        uint2 gu; gu.x = gpre[rb][eb][0]; gu.y = gpre[rb][eb][1];
        const float4 gg = *(const float4*)(p.diff_g + l * 1024 + e0);
        const float y0 = o[rb][eb][0] * rn * gg.x * silu(bflo(gu.x)), y1 = o[rb][eb][1] * rn * gg.y * silu(bfhi(gu.x));
        const float y2 = o[rb][eb][2] * rn * gg.z * silu(bflo(gu.y)), y3 = o[rb][eb][3] * rn * gg.w * silu(bfhi(gu.y));
        uint2 ov; ov.x = pk2(y0, y1); ov.y = pk2(y2, y3);
        *(uint2*)(p.mix + row * DM + 1024 + e0) = ov;
      }
    }
  }
}

DI void mixer_phase(const Params& p, int l, LAS unsigned char* lds) {
  volatile LAS int* s_item = (volatile LAS int*)(lds + 147456);
  const float lam = p.lam[l];
  const float lam_init = 0.8f - 0.6f * expf(-0.3f * (float)l);
  for (int c = (int)blockIdx.x - 32; c >= 0 && c < 32; c += (int)gridDim.x) ret_scan_chain(p, c >> 3, c & 7, lds, p.ctr + 34 + l);
  const int xcd = (int)(xb_xcc_id() & 7u);
  bool gsync = false, rsync = false;
  for (;;) {
    if (threadIdx.x == 0) *s_item = (int)atomicAdd(p.ctr + l * 8 + xcd, 1u);
    __syncthreads();
    const int it = *s_item;
    __syncthreads();
    if (it >= 68 + 22) break;
    if (it < 48 || it >= 70) {
      const int ai = it < 48 ? it : it - 22;
      const int bh = 4 * xcd + (ai & 3);
      diff_item(p, l, bh >> 3, bh & 7, 16 - (ai >> 2), lam, lam_init, lds, gsync);
    } else {
      if (!rsync) {
        if (threadIdx.x == 0) { unsigned sp = 0; while ((xb_ld(p.ctr + 34 + l) < 32u || xb_ld(p.ctr + 32 + l) < 32u) && ++sp < (1u << 22)) __builtin_amdgcn_s_sleep(2); }
        __syncthreads();
        __builtin_amdgcn_fence(__ATOMIC_ACQUIRE, "agent");
        rsync = true; gsync = true;
      }
      retention_items(p, l, lds, xcd + 48 * (it - 48), 8, 6);
      __syncthreads();
    }
  }
}

__global__ void __launch_bounds__(512) hymba_megakernel(Params p_unused) {
  cg::grid_group grid = cg::this_grid();
  extern __shared__ __attribute__((aligned(16))) char smem[];
  LAS unsigned char* lds = (LAS unsigned char*)smem;
  volatile LAS unsigned* xst = (volatile LAS unsigned*)(lds + 147456 + 16);
  if (threadIdx.x == 0) { xst[0] = 0u; xst[1] = 0u; }
  __syncthreads();
  XcdBarrier xb;
  { const Params p = load_params(); xb = xcd_barrier_post(p.bar, xst); }
  { const Params p = load_params(); prep_weights(p, lds, 0, 1792, blockIdx.x, gridDim.x, true); }
  { const Params p = load_params(); rownorm<0>(p); }
  grid.sync();
  for (int l = 0; l < 2; ++l) {
    { const Params p = load_params(); gemm1_phase(p, l, lds, 0, 1024); }
    xcd_barrier(xb);
    if (blockIdx.x < 32) {
      const Params p = load_params();
      gemm1_phase(p, l, lds, 1024, 1056);
      if (threadIdx.x == 0) {
        int nl = 0; for (int U = 1024 + (int)blockIdx.x; U < 1056; U += (int)gridDim.x) ++nl;
        __builtin_amdgcn_fence(__ATOMIC_RELEASE, "agent");
        asm volatile("s_waitcnt vmcnt(0)" ::: "memory");
        xb_add(p.ctr + 32 + l, (unsigned)nl);
      }
    }
    { const Params p = load_params(); mixer_phase(p, l, lds); }
    xcd_barrier(xb);
    { const Params p = load_params(); gemm2_phase(p, l, lds); }
    if (l == 0) { const Params p = load_params(); if (gridDim.x > 64) { if (blockIdx.x >= 64) prep_weights(p, lds, 1792, 2560, blockIdx.x - 64, gridDim.x - 64, false); } else prep_weights(p, lds, 1792, 2560, blockIdx.x, gridDim.x, false); }
    xcd_barrier(xb);
    if (l == 0) { { const Params p = load_params(); rownorm<1>(p); } xcd_barrier(xb); }
    else { const Params p = load_params(); rownorm<2>(p); }
  }
}

extern "C" void kernel_launch(void* const* d_in, const int* in_sizes, int n_in, void* d_out, int out_size, void* d_ws, size_t ws_size, hipStream_t stream) {
  static int grid_blocks = 0;
  if (!grid_blocks) {
    int dev = 0, cus = 0, per_cu = 0;
    hipGetDevice(&dev);
    hipDeviceGetAttribute(&cus, hipDeviceAttributeMultiprocessorCount, dev);
    hipFuncSetAttribute((const void*)hymba_megakernel, hipFuncAttributeMaxDynamicSharedMemorySize, SMEM_BYTES);
    hipOccupancyMaxActiveBlocksPerMultiprocessor(&per_cu, hymba_megakernel, 512, SMEM_BYTES);
    if (per_cu < 1) per_cu = 1;
    if (per_cu > 1) per_cu = 1;
    grid_blocks = cus * per_cu;
  }
  Params p{};
  p.x = (const float*)d_in[0]; p.meta = (const float*)d_in[1]; p.norm_g = (const float*)d_in[2]; p.w_in = (const float*)d_in[3];
  p.w_out = (const float*)d_in[4]; p.ret_g = (const float*)d_in[5]; p.diff_g = (const float*)d_in[6];
  p.lq1 = (const float*)d_in[7]; p.lk1 = (const float*)d_in[8]; p.lq2 = (const float*)d_in[9]; p.lk2 = (const float*)d_in[10];
  p.fin_g = (const float*)d_in[11];
  p.out = (float*)d_out;
  char* ws = (char*)d_ws; size_t off = 0;
  auto take = [&](size_t bytes) { char* r = ws + off; off += (bytes + 255) & ~(size_t)255; return r; };
  p.ctr = (unsigned*)take(256);
  p.bar = (unsigned*)take((size_t)XCD_BAR_WORDS * 4);
  p.ss = (float*)take((size_t)2 * MROWS * 4);
  p.lam = (float*)take(256);
  p.WinT = (bf16_t*)take((size_t)2 * NIN * DM * 2);
  p.WoutT = (bf16_t*)take((size_t)2 * DM * DM * 2);
  p.h = (float*)take((size_t)MROWS * DM * 4);
  p.hb = (bf16_t*)take((size_t)MROWS * DM * 2);
  p.proj = (bf16_t*)take((size_t)MROWS * NIN * 2);
  p.T = (bf16_t*)take((size_t)4 * 3072 * LROW * 2);
  p.mix = (bf16_t*)take((size_t)MROWS * DM * 2);
  p.ST = (bf16_t*)take((size_t)32 * NCH * 32768);
  p.P2 = (float*)take((size_t)8 * 256 * DM * 4);
  hipMemsetAsync(p.ctr, 0, 256 + (size_t)XCD_BAR_WORDS * 4 + (size_t)2 * MROWS * 4, stream);
  void* args[] = {&p};
  hipError_t e = hipLaunchCooperativeKernel((void*)hymba_megakernel, dim3(grid_blocks), dim3(512), args, SMEM_BYTES, stream);
  if (e != hipSuccess) fprintf(stderr, "cooperative launch failed: %s (grid %d)\n", hipGetErrorString(e), grid_blocks);
}
```

```cpp
#include <hip/hip_runtime.h>
#include <hip/hip_cooperative_groups.h>
#include <cstdio>
namespace cg = cooperative_groups;

typedef unsigned short bf16_t;
typedef short bf16x8 __attribute__((ext_vector_type(8)));
typedef short s16x4 __attribute__((ext_vector_type(4)));
typedef float f32x4 __attribute__((ext_vector_type(4)));
typedef float f32x2 __attribute__((ext_vector_type(2)));
typedef unsigned u32x4 __attribute__((ext_vector_type(4)));
typedef unsigned u32x2 __attribute__((ext_vector_type(2)));
typedef __bf16 bf16x2_t __attribute__((ext_vector_type(2)));
#define DI __device__ __forceinline__
#define LAS __attribute__((address_space(3)))
#define MFMA16(a, b, c) __builtin_amdgcn_mfma_f32_16x16x32_bf16((a), (b), (c), 0, 0, 0)

constexpr int LROW = 2112;
constexpr int MROWS = 4 * LROW;
constexpr int DM = 2048;
constexpr int NIN = 8192;
constexpr int NCH = 33;
constexpr float LOG2E = 1.4426950408889634f;
constexpr int SMEM_BYTES = 147456 + 64;

struct Params {
  const float *x, *meta, *norm_g, *w_in, *w_out, *ret_g, *diff_g, *lq1, *lk1, *lq2, *lk2, *fin_g;
  float* out;
  bf16_t *WinT, *WoutT, *hb, *proj, *T, *mix, *ST;
  float *h, *ss, *lam, *P2;
  unsigned* ctr;
  unsigned* bar;
};

DI Params load_params() {
  const Params __attribute__((address_space(4)))* q = (const Params __attribute__((address_space(4)))*)__builtin_amdgcn_kernarg_segment_ptr();
  asm volatile("" : "+s"(q));
  Params r; __builtin_memcpy(&r, (const void*)q, sizeof(Params)); return r;
}
DI unsigned pk2(float a, float b) { f32x2 v = {a, b}; bf16x2_t r = __builtin_convertvector(v, bf16x2_t); return __builtin_bit_cast(unsigned, r); }
DI float bf2f(unsigned v16) { return __uint_as_float(v16 << 16); }
DI float bflo(unsigned u) { return __uint_as_float(u << 16); }
DI float bfhi(unsigned u) { return __uint_as_float(u & 0xffff0000u); }
DI int opaque_tid() { int t = threadIdx.x; asm volatile("" : "+v"(t)); return t; }
#define EXP2(x) __builtin_amdgcn_exp2f(x)
DI float xmax16(float x) { const u32x2 r = __builtin_amdgcn_permlane16_swap(__float_as_uint(x), __float_as_uint(x), false, false); return fmaxf(__uint_as_float(r[0]), __uint_as_float(r[1])); }
DI float xmax32(float x) { const u32x2 r = __builtin_amdgcn_permlane32_swap(__float_as_uint(x), __float_as_uint(x), false, false); return fmaxf(__uint_as_float(r[0]), __uint_as_float(r[1])); }
DI float silu(float v) { return v * __builtin_amdgcn_rcpf(1.f + __expf(-v)); }

DI int lds_byte(int r, int c) { int st = (r >> 4) * 2 + (c >> 5), rr = r & 15, cc = c & 31, ob = rr * 64 + cc * 2; return st * 1024 + (ob ^ (((ob >> 9) & 1) << 5)); }
DI int perm32(int rho) { const int n = rho >> 4, i = rho & 15; return 8 * (i >> 2) + 4 * n + (i & 3); }
DI void stage_rc(int b, int& R, int& C) { int st = b / 1024, sb = b % 1024, swz = sb ^ (((sb >> 9) & 1) << 5); R = (st >> 1) * 16 + swz / 64; C = (st & 1) * 32 + (swz % 64) / 2; }

DI void prep_weights(const Params& p, LAS unsigned char* lds, int ubeg, int uend, int wgi, int wgn, bool do_lam) {
  const int tid = opaque_tid();
  const int NTOT = uend;
  const int lrow = tid >> 6, c4 = (tid & 63) * 4;
  f32x4 r[8];
#define PREP_DECODE(u) const float* src; bf16_t* dst; int N; const float* g; int kt, ntile; \
    { const int _l = (u) >= 1280 ? 1 : 0, _v = (u) - _l * 1280; \
      if (_v < 1024) { kt = _v >> 5; ntile = _v & 31; src = p.w_in + (size_t)_l * DM * NIN; dst = p.WinT + (size_t)_l * NIN * DM; N = NIN; g = p.norm_g + _l * DM; } \
      else { const int q = _v - 1024; kt = q >> 3; ntile = q & 7; src = p.w_out + (size_t)_l * DM * DM; dst = p.WoutT + (size_t)_l * DM * DM; N = DM; g = nullptr; } } \
    const int k0 = kt * 64, n0 = ntile * 256;
#define PREP_LOAD(u) do { PREP_DECODE(u) (void)dst; _Pragma("unroll") for (int i = 0; i < 8; ++i) { const int kk = lrow + 8 * i; \
    const f32x4 v = __builtin_nontemporal_load((const f32x4*)(src + (size_t)(k0 + kk) * N + n0 + c4));     const float gg = g ? g[k0 + kk] : 1.f; r[i] = v * gg; } } while (0)
  int u = ubeg + wgi;
  if (u < NTOT) PREP_LOAD(u);
  for (; u < NTOT; u += wgn) {
#pragma unroll
    for (int i = 0; i < 8; ++i) *(LAS f32x4*)(lds + ((lrow + 8 * i) * 260 + c4) * 4) = r[i];
    __syncthreads();
    const int un = u + wgn;
    if (un < NTOT) PREP_LOAD(un);
    {
      PREP_DECODE(u) (void)src; (void)N; (void)g;
      const int n = tid >> 1, kh = (tid & 1) * 32;
      bf16_t* op = dst + (size_t)(n0 + n) * DM + k0 + kh;
#pragma unroll
      for (int q = 0; q < 4; ++q) {
        float f[8];
#pragma unroll
        for (int j = 0; j < 8; ++j) f[j] = *(const LAS float*)(lds + ((kh + q * 8 + j) * 260 + n) * 4);
        const u32x4 o = {pk2(f[0], f[1]), pk2(f[2], f[3]), pk2(f[4], f[5]), pk2(f[6], f[7])};
        *(u32x4*)(op + q * 8) = o;
      }
    }
    __syncthreads();
  }
#undef PREP_DECODE
#undef PREP_LOAD
  if (do_lam && blockIdx.x == 0 && tid < 64) {
    for (int l = 0; l < 2; ++l) {
      float a = p.lq1[l * 64 + tid] * p.lk1[l * 64 + tid], b = p.lq2[l * 64 + tid] * p.lk2[l * 64 + tid];
#pragma unroll
      for (int off = 32; off >= 1; off >>= 1) { a += __shfl_xor(a, off); b += __shfl_xor(b, off); }
      float li = 0.8f - 0.6f * expf(-0.3f * (float)l);
      if (tid == 0) p.lam[l] = expf(a) - expf(b) + li;
    }
  }
}

template <int MODE> DI void rownorm(const Params& p) {
  const int tid = opaque_tid(); const int wave = tid >> 6, lane = tid & 63;
  const int nw = gridDim.x * 8;
  for (int row = (MODE == 1 ? 8192 : 0) + blockIdx.x * 8 + wave; row < MROWS; row += nw) {
    const int b = row / LROW, pos = row - b * LROW;
    if (MODE == 2 && pos < 64) continue;
    const float* src;
    if (MODE <= 1) src = pos < 48 ? nullptr : (pos < 64 ? p.meta + (size_t)(pos - 48) * DM : p.x + ((size_t)b * 2048 + (pos - 64)) * DM);
    else src = p.h + (size_t)row * DM;
    float4 v[8]; float ss = 0.f;
#pragma unroll
    for (int i = 0; i < 8; ++i) {
      if (src) { const f32x4 t = __builtin_nontemporal_load((const f32x4*)(src + i * 256 + lane * 4)); v[i] = make_float4(t[0], t[1], t[2], t[3]); }
      else v[i] = make_float4(0.f, 0.f, 0.f, 0.f);
      if (MODE != 0 && row >= 8192) {
#pragma unroll
        for (int s = 0; s < 8; ++s) { const float4 q = *(const float4*)(p.P2 + ((size_t)s * 256 + (row - 8192)) * DM + i * 256 + lane * 4); v[i].x += q.x; v[i].y += q.y; v[i].z += q.z; v[i].w += q.w; }
      }
      ss += v[i].x * v[i].x + v[i].y * v[i].y + v[i].z * v[i].z + v[i].w * v[i].w;
    }
#pragma unroll
    for (int off = 32; off >= 1; off >>= 1) ss += __shfl_xor(ss, off);
    const float rs = rsqrtf(ss * (1.f / 2048.f) + 1e-6f);
    if (MODE < 2) {
#pragma unroll
      for (int i = 0; i < 8; ++i) {
        if (MODE == 1) *(float4*)(p.h + (size_t)row * DM + i * 256 + lane * 4) = v[i];
        uint2 o; o.x = pk2(v[i].x, v[i].y); o.y = pk2(v[i].z, v[i].w);
        *(uint2*)(p.hb + (size_t)row * DM + i * 256 + lane * 4) = o;
      }
      if (lane == 0) p.ss[(MODE == 0 ? 0 : 1) * MROWS + row] = ss;
    } else {
      float* dst = p.out + ((size_t)b * 2048 + (pos - 64)) * DM;
#pragma unroll
      for (int i = 0; i < 8; ++i) {
        float4 g = *(const float4*)(p.fin_g + i * 256 + lane * 4);
        float4 o; o.x = v[i].x * rs * g.x; o.y = v[i].y * rs * g.y; o.z = v[i].z * rs * g.z; o.w = v[i].w * rs * g.w;
        *(float4*)(dst + i * 256 + lane * 4) = o;
      }
    }
  }
}

constexpr int GK = 2048, GBK = 64, GHALF = 128, GHTB = GHALF * GBK * 2;
constexpr size_t TSTEP = (size_t)256 * GK * 2;
struct Unit { int mt, nt, tr, k0, nkt, nb; };

template <class Epi, class Sched>
DI void gemm_phase(LAS unsigned char* lds, const Sched& S, const Epi& E) {
  const int tid = opaque_tid(), wid = __builtin_amdgcn_readfirstlane(tid >> 6), lane = tid & 63, wr = wid >> 2, wc = wid & 3, fr = lane & 15, fq = lane >> 4;
  constexpr int K = GK;
  unsigned voffA[2], dperm;
#pragma unroll
  for (int i = 0; i < 2; ++i) { int R, C; stage_rc(tid * 16 + i * 8192, R, C); voffA[i] = (unsigned)(R * K + C) * 2u;
    if (i == 0) dperm = (unsigned)((perm32(R & 31) - (R & 31)) * K * 2); }
  const size_t kstep = (size_t)(GBK * 2);
  const size_t hstep = (size_t)GHALF * K * 2;
  const unsigned ldsw = (unsigned)wid * 1024u;
  const int aoff = lds_byte(wr * 64 + fr, fq * 8), boff = lds_byte(wc * 32 + fr, fq * 8);
#define G_SA(b, h) (((b) * 2 + (h)) * GHTB)
#define G_SB(b, h) ((4 + (b) * 2 + (h)) * GHTB)
#define G_STAGE(bufoff, gbase, voff) do { _Pragma("unroll") for (int _i = 0; _i < 2; ++_i) \
    __builtin_amdgcn_global_load_lds((const unsigned*)((const char*)(gbase) + voff[_i]), (LAS unsigned*)(lds + (bufoff) + ldsw + _i * 8192), 16, 0, 0); } while (0)
#define G_LDA(dst, b, h) do { _Pragma("unroll") for (int m = 0; m < 4; ++m) _Pragma("unroll") for (int k = 0; k < 2; ++k) dst[m][k] = *(const LAS bf16x8*)(lds + G_SA(b, h) + aoff + m * 2048 + k * 1024); } while (0)
#define G_LDB(dst, b, h) do { _Pragma("unroll") for (int n = 0; n < 2; ++n) _Pragma("unroll") for (int k = 0; k < 2; ++k) dst[n][k] = *(const LAS bf16x8*)(lds + G_SB(b, h) + boff + n * 2048 + k * 1024); } while (0)
#define G_MMA(ai, bj, At, Bx) do { __builtin_amdgcn_s_setprio(1); _Pragma("unroll") for (int m = 0; m < 4; ++m) _Pragma("unroll") for (int n = 0; n < 2; ++n) _Pragma("unroll") for (int k = 0; k < 2; ++k) \
    acc[ai][bj][m][n] = MFMA16(Bx[n][k], At[m][k], acc[ai][bj][m][n]); __builtin_amdgcn_s_setprio(0); } while (0)
#define G_WAIT_V(n) asm volatile("s_waitcnt vmcnt(" #n ")" ::: "memory")
#define G_WAIT_L(n) asm volatile("s_waitcnt lgkmcnt(" #n ")" ::: "memory")
#define G_BAR __builtin_amdgcn_s_barrier()
#define G_SCHED __builtin_amdgcn_sched_barrier(0)
  Unit cur, nxt; int ui = 0;
  if (!S.next(0, cur)) return;
  f32x4 acc[2][2][4][2];
  E.init(acc, cur, wr, wc, fr, fq, lds, 0);
  bf16x8 At[4][2], B0[2][2], B1[2][2];
  const char* cA = S.pa(cur); const char* cB = S.pb(cur);
  { const unsigned ds0 = cur.nb ? 0u : dperm; const unsigned vb[2] = {voffA[0] + ds0, voffA[1] + ds0};
  G_STAGE(G_SB(0, 0), cB, vb); G_STAGE(G_SA(0, 0), cA, voffA); G_STAGE(G_SB(0, 1), cB + hstep, vb); G_STAGE(G_SA(0, 1), cA + hstep, voffA);
  if (wr == 1) G_BAR;
  G_WAIT_V(4); G_BAR;
  G_STAGE(G_SB(1, 0), cB + kstep, vb); G_STAGE(G_SA(1, 0), cA + kstep, voffA); G_STAGE(G_SB(1, 1), cB + hstep + kstep, vb); }
  G_WAIT_V(6); G_BAR;
  for (;;) {
    const bool has_next = S.next(ui + 1, nxt);
    if (!has_next) nxt = cur;
    const char* nA = has_next ? S.pa(nxt) : cA; const char* nB = has_next ? S.pb(nxt) : cB;
    const int nt = cur.nkt;
    for (int t = 0; t < nt; t += 2) {
      const bool last = (t == nt - 2);
      const char* a1 = cA + (size_t)(t + 1) * kstep;
      const char* a2 = last ? nA : cA + (size_t)(t + 2) * kstep; const char* b2 = last ? nB : cB + (size_t)(t + 2) * kstep;
      const char* a3 = a2 + kstep; const char* b3 = b2 + kstep;
      const bool nbs = last ? (nxt.nb != 0) : (cur.nb != 0);
      const unsigned ds = nbs ? 0u : dperm; const unsigned vb[2] = {voffA[0] + ds, voffA[1] + ds};
      G_LDB(B0, 0, 0); G_SCHED; G_LDA(At, 0, 0); G_STAGE(G_SA(1, 1), a1 + hstep, voffA);
      G_WAIT_L(8); G_BAR; G_WAIT_L(0); G_MMA(0, 0, At, B0); G_BAR; G_SCHED;
      G_LDB(B1, 0, 1); G_STAGE(G_SB(0, 0), b2, vb);
      G_BAR; G_WAIT_L(0); G_MMA(0, 1, At, B1); G_BAR;
      G_LDA(At, 0, 1); G_STAGE(G_SA(0, 0), a2, voffA);
      G_BAR; G_WAIT_L(0); G_MMA(1, 0, At, B0); G_BAR; G_SCHED;
      G_STAGE(G_SB(0, 1), b2 + hstep, vb);
      G_WAIT_V(6); G_BAR; G_MMA(1, 1, At, B1); G_BAR;
      G_LDB(B0, 1, 0); G_SCHED; G_LDA(At, 1, 0); G_STAGE(G_SA(0, 1), a2 + hstep, voffA);
      G_WAIT_L(8); G_BAR; G_WAIT_L(0); G_MMA(0, 0, At, B0); G_BAR; G_SCHED;
      G_LDB(B1, 1, 1); G_STAGE(G_SB(1, 0), b3, vb);
      G_BAR; G_WAIT_L(0); G_MMA(0, 1, At, B1); G_BAR;
      G_LDA(At, 1, 1); G_STAGE(G_SA(1, 0), a3, voffA);
      G_BAR; G_WAIT_L(0); G_MMA(1, 0, At, B0); G_BAR; G_SCHED;
      G_STAGE(G_SB(1, 1), b3 + hstep, vb);
      G_WAIT_V(6); G_BAR; G_MMA(1, 1, At, B1); G_BAR;
    }
    { const int t2 = opaque_tid() & 63; E(acc, cur, wr, wc, t2 & 15, t2 >> 4, lds, ui & 1); }
    if (!has_next) break;
    cur = nxt; cA = nA; cB = nB; ++ui;
    { const int t3 = opaque_tid() & 63; E.init(acc, cur, wr, wc, t3 & 15, t3 >> 4, lds, ui & 1); }
  }
  G_WAIT_V(0);
  if (wr == 0) G_BAR;
  G_BAR;
}

#define XB_TMO      128
#define XB_XCNT(j)  (256  + 64 * (j))
#define XB_XSUB(j)  (1280 + 64 * (j))
#define XB_XGEN(j)  (2304 + 64 * (j))
#define XB_TOP      3328
#define XB_TOPGEN   3392
#define XCD_BAR_WORDS 3456
#define XB_SPIN_CAP (1u << 18)
DI unsigned xb_ld(unsigned* p) { return __hip_atomic_load(p, __ATOMIC_RELAXED, __HIP_MEMORY_SCOPE_AGENT); }
DI unsigned xb_add(unsigned* p, unsigned v) { return __hip_atomic_fetch_add(p, v, __ATOMIC_RELAXED, __HIP_MEMORY_SCOPE_AGENT); }
DI unsigned xb_xcc_id() { return (unsigned)__builtin_amdgcn_s_getreg((3 << 11) | 20) & 0xFu; }
#define XB_SPIN(cond, bar) do { unsigned _sp = 0; while (cond) { __builtin_amdgcn_s_sleep(1); \
    if ((++_sp & 255u) == 0u) { if (xb_ld(&(bar)[XB_TMO])) break; if (_sp > XB_SPIN_CAP) { atomicAdd(&(bar)[XB_TMO], 1u); break; } } } } while (0)
struct XcdBarrier { unsigned* bar; unsigned x; volatile LAS unsigned* st; };
DI XcdBarrier xcd_barrier_post(unsigned* bar, volatile LAS unsigned* st) {
  XcdBarrier b; b.bar = bar; b.x = xb_xcc_id(); b.st = st;
  if (threadIdx.x == 0) (void)xb_add(&bar[XB_XCNT(b.x)], 1u);
  return b;
}
DI void xcd_barrier_complete(unsigned* bar, unsigned x, unsigned& nloc, unsigned& nx) {
  const unsigned G = gridDim.x * gridDim.y * gridDim.z;
  unsigned sum, cnt, mine, sp = 0u;
  for (;;) {
    sum = 0u; cnt = 0u; mine = 0u;
#pragma unroll
    for (unsigned j = 0; j < 16; ++j) { const unsigned c = xb_ld(&bar[XB_XCNT(j)]); sum += c; cnt += (c > 0u) ? 1u : 0u; mine = (j == x) ? c : mine; }
    if (sum == G) break;
    __builtin_amdgcn_s_sleep(1);
    if ((++sp & 255u) == 0u) { if (xb_ld(&bar[XB_TMO])) break; if (sp > XB_SPIN_CAP) { atomicAdd(&bar[XB_TMO], 1u); break; } }
  }
  nloc = mine > 0u ? mine : 1u; nx = cnt > 0u ? cnt : 1u;
}
DI void xcd_barrier(const XcdBarrier& b) {
  asm volatile("s_waitcnt vmcnt(0)" ::: "memory");
  __syncthreads();
  if (threadIdx.x == 0) {
    unsigned* bar = b.bar;
    __builtin_amdgcn_s_waitcnt(0);
    unsigned nloc = b.st[0], nx = b.st[1];
    if (nloc == 0u) { xcd_barrier_complete(bar, b.x, nloc, nx); b.st[0] = nloc; b.st[1] = nx; }
    const unsigned old = xb_add(&bar[XB_XSUB(b.x)], 1u);
    const unsigned gen = old / nloc;
    if (old + 1u == (gen + 1u) * nloc) {
      __builtin_amdgcn_fence(__ATOMIC_RELEASE, "agent");
      asm volatile("s_waitcnt vmcnt(0)" ::: "memory");
      const unsigned og = xb_add(&bar[XB_TOP], 1u);
      const unsigned tg = og / nx;
      if (og + 1u == (tg + 1u) * nx) xb_add(&bar[XB_TOPGEN], 1u);
      else XB_SPIN(xb_ld(&bar[XB_TOPGEN]) == tg, bar);
      __builtin_amdgcn_fence(__ATOMIC_ACQUIRE, "agent");
      xb_add(&bar[XB_XGEN(b.x)], 1u);
      asm volatile("s_waitcnt vmcnt(0)" ::: "memory");
    } else {
      XB_SPIN(xb_ld(&bar[XB_XGEN(b.x)]) == gen, bar);
      __builtin_amdgcn_fence(__ATOMIC_ACQUIRE, "agent");
      asm volatile("s_waitcnt vmcnt(0)" ::: "memory");
    }
  }
  __syncthreads();
}

DI void tile_map(int wgid, int nM, int nN, int& pm, int& pn) {
  const int nwg = nM * nN;
  { int q = nwg / 8, r = nwg % 8, xcd = wgid % 8, off = wgid / 8; wgid = (xcd < r ? xcd * (q + 1) : r * (q + 1) + (xcd - r) * q) + off; }
  const int nig = 8 * nN, gid = wgid / nig, fm = gid * 8, gsz = min(nM - fm, 8);
  pm = fm + ((wgid % nig) % gsz); pn = (wgid % nig) / gsz;
}

struct Sched1 {
  const bf16_t* hb; const bf16_t* W; int ubeg, uend;
  DI bool next(int i, Unit& u) const {
    const int U = ubeg + i * (int)gridDim.x + (int)blockIdx.x; if (U >= uend) return false;
    int pm, pn;
    if (U < 928) tile_map(U, 29, 32, pm, pn);
    else if (U < 1024) { const int q = U - 928, c = q % 24; pm = 29 + q / 24; pn = c < 12 ? c : c + 4; }
    else { const int q = U - 1024, g = q & 7; pm = 29 + (q >> 3); pn = g < 4 ? 12 + g : 24 + g; }
    u.mt = pm; u.nt = pn; u.k0 = 0; u.nkt = 32; const int g = pn >> 2; u.tr = (g == 1 || g == 2 || g == 6) ? 1 : 0; u.nb = u.tr; return true;
  }
  DI const char* pa(const Unit& u) const { return u.tr ? (const char*)W + (size_t)u.nt * TSTEP : (const char*)hb + (size_t)u.mt * TSTEP; }
  DI const char* pb(const Unit& u) const { return u.tr ? (const char*)hb + (size_t)u.mt * TSTEP : (const char*)W + (size_t)u.nt * TSTEP; }
};
struct Sched2 {
  const bf16_t* mix; const bf16_t* W;
  DI bool next(int i, Unit& u) const {
    const int U = i * (int)gridDim.x + (int)blockIdx.x; if (U >= 256 + 64) return false;
    if (U < 256) { int pm, pn; tile_map(U, 32, 8, pm, pn); u.mt = pm; u.nt = pn; u.tr = 0; u.k0 = 0; u.nkt = 32; u.nb = 0; }
    else { const int j = U - 256; u.mt = 32; u.nt = j >> 3; u.tr = 1 + (j & 7); u.k0 = (j & 7) * 256; u.nkt = 4; u.nb = 0; }
    return true;
  }
  DI const char* pa(const Unit& u) const { return (const char*)mix + (size_t)u.mt * TSTEP + (size_t)u.k0 * 2; }
  DI const char* pb(const Unit& u) const { return (const char*)W + (size_t)u.nt * TSTEP + (size_t)u.k0 * 2; }
};

DI void acc_zero(f32x4 (&acc)[2][2][4][2]) {
#pragma unroll
  for (int a = 0; a < 2; ++a)
#pragma unroll
    for (int b = 0; b < 2; ++b)
#pragma unroll
      for (int m = 0; m < 4; ++m)
#pragma unroll
        for (int n = 0; n < 2; ++n) acc[a][b][m][n] = (f32x4){0.f, 0.f, 0.f, 0.f};
}
struct Epi1 {
  bf16_t* proj; bf16_t* T; const float* ss;
  DI void init(f32x4 (&acc)[2][2][4][2], const Unit& u, int wr, int wc, int fr, int fq, LAS unsigned char* lds, int par) const {
    acc_zero(acc);
    if (wr == 0)
      __builtin_amdgcn_global_load_lds((const unsigned*)(ss + u.mt * 256 + wc * 64 + fq * 16 + fr), (LAS unsigned*)(lds + 131072 + par * 1024 + wc * 256), 4, 0, 0);
  }
  DI void operator()(const f32x4 (&acc)[2][2][4][2], const Unit& u, int wr, int wc, int fr, int fq, LAS unsigned char* lds, int par) const {
    const LAS float* ssl = (const LAS float*)(lds + 131072 + par * 1024);
    const int g = u.nt >> 2;
    if (!u.tr) {
      const float sc = (g == 4) ? 0.125f * LOG2E : 1.f;
      const int n0 = u.nt * 256 + wc * 32 + fq * 8;
#pragma unroll
      for (int ai = 0; ai < 2; ++ai)
#pragma unroll
        for (int mi = 0; mi < 4; ++mi) {
          const int m = u.mt * 256 + ai * 128 + wr * 64 + mi * 16 + fr;
          const float rs = rsqrtf(ssl[ai * 128 + wr * 64 + mi * 16 + fr] * (1.f / 2048.f) + 1e-6f) * sc;
          bf16_t* rowp = proj + (size_t)m * NIN + n0;
#pragma unroll
          for (int bj = 0; bj < 2; ++bj) {
            const f32x4 a = acc[ai][bj][mi][0], c = acc[ai][bj][mi][1];
            const u32x4 o = {pk2(a[0] * rs, a[1] * rs), pk2(a[2] * rs, a[3] * rs), pk2(c[0] * rs, c[1] * rs), pk2(c[2] * rs, c[3] * rs)};
            *(u32x4*)(rowp + bj * 128) = o;
          }
        }
    } else {
      const int tbase = (g == 1 ? 0 : (g == 2 ? 1024 : 2048)) - g * 1024;
#pragma unroll
      for (int bj = 0; bj < 2; ++bj) {
        const int mb = u.mt * 256 + bj * 128 + wc * 32;
        const int b = mb / LROW, posb = mb - b * LROW;
        const f32x4 q0 = *(const LAS f32x4*)(ssl + bj * 128 + wc * 32 + 4 * fq), q1 = *(const LAS f32x4*)(ssl + bj * 128 + wc * 32 + 16 + 4 * fq);
        float rs[8];
#pragma unroll
        for (int j = 0; j < 4; ++j) { rs[j] = rsqrtf(q0[j] * (1.f / 2048.f) + 1e-6f); rs[4 + j] = rsqrtf(q1[j] * (1.f / 2048.f) + 1e-6f); }
        const int p0 = posb + 4 * fq, p1 = p0 + 16;
        if (g == 1) {
#pragma unroll
          for (int j = 0; j < 4; ++j) { rs[j] = (p0 + j >= 48) ? rs[j] * 0.08838834764831845f : 0.f; rs[4 + j] = (p1 + j >= 48) ? rs[4 + j] * 0.08838834764831845f : 0.f; }
        }
#pragma unroll
        for (int ai = 0; ai < 2; ++ai)
#pragma unroll
          for (int mi = 0; mi < 4; ++mi) {
            const int col = u.nt * 256 + ai * 128 + wr * 64 + mi * 16 + fr;
            const f32x4 a = acc[ai][bj][mi][0], c = acc[ai][bj][mi][1];
            float v[8] = {a[0] * rs[0], a[1] * rs[1], a[2] * rs[2], a[3] * rs[3], c[0] * rs[4], c[1] * rs[5], c[2] * rs[6], c[3] * rs[7]};
            if (g == 1) {
              const int hh = (col - 1024) >> 7;
              const float l2g = log2f(1.f - exp2f(-5.f - (float)hh));
              const int z0 = 63 - (p0 & 63), z1 = 63 - (p1 & 63);
#pragma unroll
              for (int j = 0; j < 4; ++j) { v[j] *= exp2f(l2g * (float)(z0 - j)); v[4 + j] *= exp2f(l2g * (float)(z1 - j)); }
            }
            const u32x4 o = {pk2(v[0], v[1]), pk2(v[2], v[3]), pk2(v[4], v[5]), pk2(v[6], v[7])};
            const int trow = (g == 1) ? (col & ~31) + 16 * ((col >> 2) & 1) + 4 * ((col >> 3) & 3) + (col & 3) : col;
            *(u32x4*)(T + ((size_t)(b * 3072 + tbase + trow)) * LROW + posb + 8 * fq) = o;
          }
      }
    }
  }
};
struct Epi2 {
  float* h; float* P2; bf16_t* hb; float* ssn; const float* x; const float* meta;
  DI void init(f32x4 (&acc)[2][2][4][2], const Unit& u, int wr, int wc, int fr, int fq, LAS unsigned char*, int) const {
    if (u.tr) { acc_zero(acc); return; }
    const int n0 = u.nt * 256 + wc * 32 + fq * 8;
#pragma unroll
    for (int ai = 0; ai < 2; ++ai)
#pragma unroll
      for (int mi = 0; mi < 4; ++mi) {
        const int m = u.mt * 256 + ai * 128 + wr * 64 + mi * 16 + fr;
        const float* rowp = h + (size_t)m * DM + n0;
        if (x) { const int b = m / LROW, pos = m - b * LROW; rowp = pos < 48 ? nullptr : (pos < 64 ? meta + (size_t)(pos - 48) * DM : x + ((size_t)b * 2048 + (pos - 64)) * DM) + n0; }
#pragma unroll
        for (int bj = 0; bj < 2; ++bj)
#pragma unroll
          for (int ni = 0; ni < 2; ++ni) acc[ai][bj][mi][ni] = rowp ? __builtin_nontemporal_load((const f32x4*)(rowp + bj * 128 + ni * 4)) : (f32x4){0.f, 0.f, 0.f, 0.f};
      }
  }
  DI void operator()(const f32x4 (&acc)[2][2][4][2], const Unit& u, int wr, int wc, int fr, int fq, LAS unsigned char*, int) const {
    const int n0 = u.nt * 256 + wc * 32 + fq * 8;
#pragma unroll
    for (int ai = 0; ai < 2; ++ai)
#pragma unroll
      for (int mi = 0; mi < 4; ++mi) {
        const int m = u.mt * 256 + ai * 128 + wr * 64 + mi * 16 + fr;
        float* rowp = (u.tr ? P2 + ((size_t)(u.tr - 1) * 256 + (m - 8192)) * DM : h + (size_t)m * DM) + n0;
        float sq = 0.f;
#pragma unroll
        for (int bj = 0; bj < 2; ++bj) {
          const f32x4 a = acc[ai][bj][mi][0], c = acc[ai][bj][mi][1];
          *(f32x4*)(rowp + bj * 128) = a; *(f32x4*)(rowp + bj * 128 + 4) = c;
          if (ssn && !u.tr) {
            sq += a[0] * a[0] + a[1] * a[1] + a[2] * a[2] + a[3] * a[3] + c[0] * c[0] + c[1] * c[1] + c[2] * c[2] + c[3] * c[3];
            const u32x4 o = {pk2(a[0], a[1]), pk2(a[2], a[3]), pk2(c[0], c[1]), pk2(c[2], c[3])};
            *(u32x4*)(hb + (size_t)m * DM + n0 + bj * 128) = o;
          }
        }
        if (ssn && !u.tr) {
          sq += __shfl_xor(sq, 16); sq += __shfl_xor(sq, 32);
          if (fq == 0) unsafeAtomicAdd(ssn + m, sq);
        }
      }
  }
};

DI void gemm1_phase(const Params& p, int l, LAS unsigned char* lds, int ubeg, int uend) {
  Sched1 S{p.hb, p.WinT + (size_t)l * NIN * DM, ubeg, uend}; Epi1 E{p.proj, p.T, p.ss + (size_t)l * MROWS};
  gemm_phase(lds, S, E);
}
DI void gemm2_phase(const Params& p, int l, LAS unsigned char* lds) {
  Sched2 S{p.mix, p.WoutT + (size_t)l * DM * DM}; Epi2 E{p.h, p.P2, p.hb, l == 0 ? p.ss + MROWS : nullptr, l == 0 ? p.x : nullptr, p.meta};
  gemm_phase(lds, S, E);
}

DI void ret_scan_chain(const Params& p, int b, int h, LAS unsigned char* lds, unsigned* done_ctr) {
  constexpr int D = 6;
  const int tid = opaque_tid(), w = __builtin_amdgcn_readfirstlane(tid >> 6), lane = tid & 63, fr = lane & 15, fq = lane >> 4;
  const float l2g = log2f(1.f - exp2f(-5.f - (float)h));
  const float dec64 = exp2f(l2g * 64.f);
  const int sub16 = lds_byte(fr, fq * 8);
  const int frow = ((tid >> 4) & 31) * 2 + ((tid >> 2) & 1), fcol = ((tid >> 3) & 1) * 32 + (tid & 3) * 8;
  const int fillT = lds_byte(frow, fcol);
  const bf16_t* gk = p.T + (size_t)b * 3072 * LROW + (size_t)(h * 128 + frow) * LROW + fcol;
  u32x4* so = (u32x4*)p.ST + ((size_t)((b * 8 + h) * NCH) * 8 + w) * 256 + lane;
  f32x4 st[8];
#pragma unroll
  for (int i = 0; i < 8; ++i) st[i] = (f32x4){0.f, 0.f, 0.f, 0.f};
  u32x4 ring[D][4];
#define SCAN_LOAD(slot, n) do { const bf16_t* _t = gk + (n) * 64; ring[slot][0] = *(const u32x4*)_t; ring[slot][1] = *(const u32x4*)(_t + (size_t)64 * LROW); \
    ring[slot][2] = *(const u32x4*)(_t + (size_t)1024 * LROW); ring[slot][3] = *(const u32x4*)(_t + (size_t)1088 * LROW); } while (0)
#define SCAN_STORE(n) do { _Pragma("unroll") for (int kd = 0; kd < 4; ++kd) { const f32x4 sa = st[2 * kd], sc = st[2 * kd + 1]; \
    const u32x4 bsu = {pk2(sa[0], sa[1]), pk2(sa[2], sa[3]), pk2(sc[0], sc[1]), pk2(sc[2], sc[3])}; so[(size_t)(n) * 2048 + kd * 64] = bsu; } } while (0)
#pragma unroll
  for (int i = 0; i < D; ++i) SCAN_LOAD(i, i);
#pragma unroll
  for (int n = 0; n < NCH - 1; ++n) {
    const int slot = n % D, bo = (n & 1) * 32768;
    *(LAS u32x4*)(lds + bo + fillT) = ring[slot][0]; *(LAS u32x4*)(lds + bo + fillT + 8192) = ring[slot][1];
    *(LAS u32x4*)(lds + bo + 16384 + fillT) = ring[slot][2]; *(LAS u32x4*)(lds + bo + 16384 + fillT + 8192) = ring[slot][3];
    if (n + D < NCH - 1) SCAN_LOAD(slot, n + D);
    __syncthreads();
    SCAN_STORE(n);
    const bf16x8 vf0 = *(const LAS bf16x8*)(lds + bo + 16384 + w * 2048 + sub16), vf1 = *(const LAS bf16x8*)(lds + bo + 16384 + w * 2048 + 1024 + sub16);
#pragma unroll
    for (int db = 0; db < 8; ++db) {
      st[db] *= dec64;
      const bf16x8 a0 = *(const LAS bf16x8*)(lds + bo + sub16 + db * 2048);
      const bf16x8 a1 = *(const LAS bf16x8*)(lds + bo + sub16 + db * 2048 + 1024);
      st[db] = MFMA16(a0, vf0, st[db]); st[db] = MFMA16(a1, vf1, st[db]);
    }
  }
  SCAN_STORE(NCH - 1);
  asm volatile("s_waitcnt vmcnt(0)" ::: "memory");
  __syncthreads();
  if (threadIdx.x == 0) { __builtin_amdgcn_fence(__ATOMIC_RELEASE, "agent"); asm volatile("s_waitcnt vmcnt(0)" ::: "memory"); xb_add(done_ctr, 1u); }
#undef SCAN_LOAD
#undef SCAN_STORE
}

DI void retention_items(const Params& p, int l, LAS unsigned char* lds, int first, int stride, int count) {
  constexpr int QS = 0, KS = 16384, VTS = 49152, PS = 65536, OS = 73728;
  const int tid = opaque_tid(), w = __builtin_amdgcn_readfirstlane(tid >> 6), lane = tid & 63, fr = lane & 15, fq = lane >> 4;
  const int sub16 = lds_byte(fr, fq * 8), sub8a = lds_byte(fr, fq * 4), sub8b = lds_byte(fr, fq * 4 + 16);
  const int tq = ((tid >> 5) & 15) * 2 + ((tid >> 2) & 1), dq = ((tid >> 4) & 1) * 64 + ((tid >> 3) & 1) * 32 + (tid & 3) * 8;
  const int ve = ((tid >> 4) & 31) * 2 + ((tid >> 2) & 1), vs0 = ((tid >> 3) & 1) * 32 + (tid & 3) * 8;
  const int fillQ = (dq >> 6) * 8192 + lds_byte(tq, dq & 63);
  const int fillT = lds_byte(ve, vs0);
  const int sb = w & 3, tb0 = (w >> 2) * 2;
  const int kbase = KS + sb * 2048 + sub16, qbase = QS + tb0 * 2048 + sub16;
  const int pbase = PS + tb0 * 2048 + (sb >> 1) * 1024 + lds_byte(fr, fq * 8 + 4 * (sb & 1));
  const int vbase = VTS + w * 2048 + sub16;
  const int obase = OS + ((fq * 4) * 132 + w * 16 + fr) * 4;
  const int nbase = OS + ((tid >> 3) * 132 + (tid & 7) * 16) * 4;
  u32x4 pq0, pq1, pk0, pk1, pv0, pv1, ns0, ns1, ns2, ns3, ng0, ng1;
#define RET_GLOAD(it) do { const int _bh = (it) / NCH, _n = (it) - _bh * NCH, _b = _bh >> 3, _h = _bh & 7; \
    const bf16_t* _q = p.proj + ((size_t)_b * LROW + _n * 64 + tq) * NIN + _h * 128 + dq; \
    const bf16_t* _tk = p.T + ((size_t)_b * 3072 + _h * 128 + (tid >> 3)) * LROW + _n * 64 + (tid & 7) * 8; \
    const bf16_t* _tv = p.T + ((size_t)_b * 3072 + 1024 + _h * 128 + ve) * LROW + _n * 64 + vs0; \
    pq0 = *(const u32x4*)_q; pq1 = *(const u32x4*)(_q + (size_t)32 * NIN); pk0 = *(const u32x4*)_tk; pk1 = *(const u32x4*)(_tk + (size_t)64 * LROW); \
    pv0 = *(const u32x4*)_tv; pv1 = *(const u32x4*)(_tv + (size_t)64 * LROW); \
    const u32x4* _sp = (const u32x4*)p.ST + ((size_t)(it) * 8 + w) * 256 + lane; ns0 = _sp[0]; ns1 = _sp[64]; ns2 = _sp[128]; ns3 = _sp[192]; \
    const bf16_t* _gp = p.proj + ((size_t)_b * LROW + _n * 64 + (tid >> 3)) * NIN + 3072 + _h * 128 + (tid & 7) * 16; \
    ng0 = *(const u32x4*)_gp; ng1 = *(const u32x4*)(_gp + 8); } while (0)
  int it = first;
  const int iend = first + stride * count;
  if (it < iend) RET_GLOAD(it);
  for (; it < iend; it += stride) {
    const int bh = it / NCH, n = it - bh * NCH, b = bh >> 3, h = bh & 7;
    const float l2g = log2f(1.f - exp2f(-5.f - (float)h));
    *(LAS u32x4*)(lds + QS + fillQ) = pq0; *(LAS u32x4*)(lds + QS + fillQ + 4096) = pq1;
    {
      const int d0 = tid >> 3, s0 = (tid & 7) * 8;
#pragma unroll
      for (int i = 0; i < 2; ++i) {
        const u32x4 kv = i ? pk1 : pk0;
        const int r_ = d0 + 64 * i, d = (r_ & ~31) + 8 * ((r_ >> 2) & 3) + 4 * ((r_ >> 4) & 1) + (r_ & 3), ko = KS + (d >> 6) * 8192;
#pragma unroll
        for (int j = 0; j < 8; ++j) {
          const unsigned wv = kv[j >> 1];
          const int st = (s0 & 32) + 16 * (j >> 2) + 4 * ((s0 >> 3) & 3) + (j & 3);
          *(LAS bf16_t*)(lds + ko + lds_byte(st, d & 63)) = (bf16_t)((j & 1) ? (wv >> 16) : (wv & 0xffffu));
        }
      }
    }
    *(LAS u32x4*)(lds + VTS + fillT) = pv0; *(LAS u32x4*)(lds + VTS + fillT + 8192) = pv1;
    const u32x4 sf0 = ns0, sf1 = ns1, sf2 = ns2, sf3 = ns3, g0 = ng0, g1 = ng1;
    __syncthreads();
    if (it + stride < iend) RET_GLOAD(it + stride);
    const size_t row = (size_t)b * LROW + n * 64 + (tid >> 3);
    {
      f32x4 s0 = {0.f, 0.f, 0.f, 0.f}, s1 = {0.f, 0.f, 0.f, 0.f};
#pragma unroll
      for (int ks = 0; ks < 4; ++ks) {
        const int off = (ks >> 1) * 8192 + (ks & 1) * 1024;
        const bf16x8 a = *(const LAS bf16x8*)(lds + kbase + off);
        const bf16x8 b0 = *(const LAS bf16x8*)(lds + qbase + off);
        const bf16x8 b1 = *(const LAS bf16x8*)(lds + qbase + off + 2048);
        s0 = MFMA16(a, b0, s0); s1 = MFMA16(a, b1, s1);
      }
      const int srow = sb * 16 + fq * 4;
#pragma unroll
      for (int i = 0; i < 2; ++i) {
        const f32x4 sv = i ? s1 : s0;
        const int t = (tb0 + i) * 16 + fr;
        const float v0 = sv[0] * EXP2(l2g * (fabsf((float)(t - srow)) - (float)(63 - srow))), v1 = sv[1] * EXP2(l2g * (fabsf((float)(t - srow - 1)) - (float)(62 - srow)));
        const float v2 = sv[2] * EXP2(l2g * (fabsf((float)(t - srow - 2)) - (float)(61 - srow))), v3 = sv[3] * EXP2(l2g * (fabsf((float)(t - srow - 3)) - (float)(60 - srow)));
        const u32x2 o = {pk2(v0, v1), pk2(v2, v3)};
        *(LAS u32x2*)(lds + pbase + i * 2048) = o;
      }
    }
    __syncthreads();
    {
      const bf16x8 vf0 = *(const LAS bf16x8*)(lds + vbase), vf1 = *(const LAS bf16x8*)(lds + vbase + 1024);
      f32x4 o[4], cr[4];
#pragma unroll
      for (int tb = 0; tb < 4; ++tb) {
        o[tb] = (f32x4){0.f, 0.f, 0.f, 0.f}; cr[tb] = (f32x4){0.f, 0.f, 0.f, 0.f};
        const bf16x8 a0 = *(const LAS bf16x8*)(lds + PS + sub16 + tb * 2048);
        const bf16x8 a1 = *(const LAS bf16x8*)(lds + PS + sub16 + tb * 2048 + 1024);
        o[tb] = MFMA16(a0, vf0, o[tb]); o[tb] = MFMA16(a1, vf1, o[tb]);
      }
#pragma unroll
      for (int kd = 0; kd < 4; ++kd) {
        const bf16x8 bsv = __builtin_bit_cast(bf16x8, kd == 0 ? sf0 : (kd == 1 ? sf1 : (kd == 2 ? sf2 : sf3)));
#pragma unroll
        for (int tb = 0; tb < 4; ++tb) {
          const bf16x8 a = *(const LAS bf16x8*)(lds + QS + (kd >> 1) * 8192 + (tb * 2 + (kd & 1)) * 1024 + sub16);
          cr[tb] = MFMA16(a, bsv, cr[tb]);
        }
      }
#pragma unroll
      for (int tb = 0; tb < 4; ++tb)
#pragma unroll
        for (int j = 0; j < 4; ++j) o[tb][j] += EXP2(l2g * (float)(tb * 16 + fq * 4 + j + 1)) * cr[tb][j];
#pragma unroll
      for (int tb = 0; tb < 4; ++tb)
#pragma unroll
        for (int j = 0; j < 4; ++j) *(LAS float*)(lds + obase + (tb * 16 + j) * 528) = o[tb][j];
    }
    __syncthreads();
    {
      const int seg = tid & 7;
      const f32x4 x0 = *(const LAS f32x4*)(lds + nbase), x1 = *(const LAS f32x4*)(lds + nbase + 16), x2 = *(const LAS f32x4*)(lds + nbase + 32), x3 = *(const LAS f32x4*)(lds + nbase + 48);
      f32x4 xs = x0 + x1 + x2 + x3;
      float sum = xs[0] + xs[1] + xs[2] + xs[3];
      sum += __shfl_xor(sum, 1); sum += __shfl_xor(sum, 2); sum += __shfl_xor(sum, 4);
      const float mu = sum * (1.f / 128.f);
      const f32x4 d0 = x0 - mu, d1 = x1 - mu, d2 = x2 - mu, d3 = x3 - mu;
      const f32x4 q = d0 * d0 + d1 * d1 + d2 * d2 + d3 * d3;
      float vs = q[0] + q[1] + q[2] + q[3];
      vs += __shfl_xor(vs, 1); vs += __shfl_xor(vs, 2); vs += __shfl_xor(vs, 4);
      const float rn = rsqrtf(vs * (1.f / 128.f) + 1e-6f);
      const float* gr = p.ret_g + l * 1024 + h * 128 + seg * 16;
      const f32x4 w0 = *(const f32x4*)gr, w1 = *(const f32x4*)(gr + 4), w2 = *(const f32x4*)(gr + 8), w3 = *(const f32x4*)(gr + 12);
      uint4 oa, ob;
      oa.x = pk2(d0[0] * rn * w0[0] * silu(bflo(g0[0])), d0[1] * rn * w0[1] * silu(bfhi(g0[0])));
      oa.y = pk2(d0[2] * rn * w0[2] * silu(bflo(g0[1])), d0[3] * rn * w0[3] * silu(bfhi(g0[1])));
      oa.z = pk2(d1[0] * rn * w1[0] * silu(bflo(g0[2])), d1[1] * rn * w1[1] * silu(bfhi(g0[2])));
      oa.w = pk2(d1[2] * rn * w1[2] * silu(bflo(g0[3])), d1[3] * rn * w1[3] * silu(bfhi(g0[3])));
      ob.x = pk2(d2[0] * rn * w2[0] * silu(bflo(g1[0])), d2[1] * rn * w2[1] * silu(bfhi(g1[0])));
      ob.y = pk2(d2[2] * rn * w2[2] * silu(bflo(g1[1])), d2[3] * rn * w2[3] * silu(bfhi(g1[1])));
      ob.z = pk2(d3[0] * rn * w3[0] * silu(bflo(g1[2])), d3[1] * rn * w3[1] * silu(bfhi(g1[2])));
      ob.w = pk2(d3[2] * rn * w3[2] * silu(bflo(g1[3])), d3[3] * rn * w3[3] * silu(bfhi(g1[3])));
      bf16_t* mp = p.mix + row * DM + h * 128 + seg * 16;
      *(uint4*)mp = oa; *(uint4*)(mp + 8) = ob;
    }
  }
#undef RET_GLOAD
}

DI void diff_pv(LAS unsigned char* lds, int vgb, const bf16x8 (&pfr)[2][2], f32x4 (&o)[2][8], int sub16) {
  __builtin_amdgcn_s_setprio(1);
#pragma unroll
  for (int eb = 0; eb < 8; ++eb)
#pragma unroll
    for (int kp = 0; kp < 2; ++kp) {
      const bf16x8 a = *(const LAS bf16x8*)(lds + vgb + (eb * 2 + kp) * 1024 + sub16);
      o[0][eb] = MFMA16(a, pfr[0][kp], o[0][eb]);
      o[1][eb] = MFMA16(a, pfr[1][kp], o[1][eb]);
    }
  __builtin_amdgcn_s_setprio(0);
}
DI void diff_tile(bool general, LAS unsigned char* lds, int kfb, const bf16x8 (&qf)[2][2], f32x4 (&o)[2][8], bf16x8 (&pfr)[2][2], float& m0, float& m1, float& l0, float& l1,
                  const f32x4 (&cj)[4], float slope2, int kt, int qrow, int fq) {
  f32x4 s[2][4];
#pragma unroll
  for (int kb = 0; kb < 4; ++kb) {
    const f32x4 init = cj[kb];
    const bf16x8 a0 = *(const LAS bf16x8*)(lds + kfb + (kb * 2) * 1024);
    const bf16x8 a1 = *(const LAS bf16x8*)(lds + kfb + (kb * 2 + 1) * 1024);
    s[0][kb] = MFMA16(a0, qf[0][0], init); s[1][kb] = MFMA16(a0, qf[1][0], init);
    s[0][kb] = MFMA16(a1, qf[0][1], s[0][kb]); s[1][kb] = MFMA16(a1, qf[1][1], s[1][kb]);
  }
  const float tconst = slope2 * (float)(kt * 64);
#pragma unroll
  for (int rb = 0; rb < 2; ++rb) {
    if (general) {
      const int qrel = qrow + rb * 16 - kt * 64;
      const float ms2 = -2.f * slope2;
#pragma unroll
      for (int kb = 0; kb < 4; ++kb)
#pragma unroll
        for (int j = 0; j < 4; ++j) {
          const int kl = kb * 16 + fq * 4 + j;
          float v = s[rb][kb][j] + ms2 * (float)max(kl - qrel, 0);
          if (kt == 0 && kl < 48) v = -INFINITY;
          s[rb][kb][j] = v;
        }
    }
    float mx = fmaxf(fmaxf(s[rb][0][0], s[rb][0][1]), fmaxf(s[rb][0][2], s[rb][0][3]));
#pragma unroll
    for (int kb = 1; kb < 4; ++kb) mx = fmaxf(fmaxf(mx, fmaxf(s[rb][kb][0], s[rb][kb][1])), fmaxf(s[rb][kb][2], s[rb][kb][3]));
    mx = xmax32(xmax16(mx));
    const float mloc = (rb ? m1 : m0) - tconst;
    float mnew = mloc, alpha = 1.f;
    if (!__all(mx <= mloc + 8.f)) {
      mnew = fmaxf(mloc, mx); alpha = EXP2(mloc - mnew);
#pragma unroll
      for (int eb = 0; eb < 8; ++eb) o[rb][eb] *= alpha;
    }
    float rsum = 0.f;
#pragma unroll
    for (int kb = 0; kb < 4; ++kb)
#pragma unroll
      for (int j = 0; j < 4; ++j) { const float pv = EXP2(s[rb][kb][j] - mnew); s[rb][kb][j] = pv; rsum += pv; }
    if (rb) { l1 = l1 * alpha + rsum; m1 = mnew + tconst; } else { l0 = l0 * alpha + rsum; m0 = mnew + tconst; }
#pragma unroll
    for (int kp = 0; kp < 2; ++kp) {
      const f32x4 sa = s[rb][2 * kp], sc = s[rb][2 * kp + 1];
      const u32x4 pbu = {pk2(sa[0], sa[1]), pk2(sa[2], sa[3]), pk2(sc[0], sc[1]), pk2(sc[2], sc[3])};
      pfr[rb][kp] = __builtin_bit_cast(bf16x8, pbu);
    }
  }
}

DI void diff_item(const Params& p, int l, int b, int h, int pi, float lam, float lam_init, LAS unsigned char* lds, bool& gsync) {
  const int tid = opaque_tid(), w = __builtin_amdgcn_readfirstlane(tid >> 6), lane = tid & 63, fr = lane & 15, fq = lane >> 4;
  const int c = w & 1, rgq = w >> 1, qc = 2 * pi + (rgq >> 1);
  const bool active = qc <= 32;
  const int ktmax = min(2 * pi + 1, 32);
  const int sub16 = lds_byte(fr, fq * 8), sub8a = lds_byte(fr, fq * 4), sub8b = lds_byte(fr, fq * 4 + 16);
  const bf16_t* projb = p.proj + (size_t)b * LROW * NIN;
  const int qrow = qc * 64 + (rgq & 1) * 32 + fr;
  bf16x8 qf[2][2];
#pragma unroll
  for (int rb = 0; rb < 2; ++rb)
#pragma unroll
    for (int ks = 0; ks < 2; ++ks)
      qf[rb][ks] = active ? *(const bf16x8*)(projb + (size_t)(qrow + rb * 16) * NIN + 4096 + h * 128 + c * 64 + ks * 32 + fq * 8) : (bf16x8){0, 0, 0, 0, 0, 0, 0, 0};
  float m0 = -INFINITY, m1 = -INFINITY, l0 = 0.f, l1 = 0.f;
  f32x4 o[2][8];
#pragma unroll
  for (int rb = 0; rb < 2; ++rb)
#pragma unroll
    for (int eb = 0; eb < 8; ++eb) o[rb][eb] = (f32x4){0.f, 0.f, 0.f, 0.f};
  const float slope2 = exp2f(-(float)(h + 1)) * LOG2E;
  f32x4 cj[4];
#pragma unroll
  for (int kb = 0; kb < 4; ++kb)
#pragma unroll
    for (int j = 0; j < 4; ++j) cj[kb][j] = slope2 * (float)(kb * 16 + fq * 4 + j);
  const int dswz = (lane * 16) ^ ((((lane * 16) >> 9) & 1) << 5), drr = dswz >> 6, dcc = (dswz & 63) >> 1;
  const bf16_t* gk = projb + (size_t)((w & 3) * 16 + drr) * NIN + 5120 + h * 128 + (w >> 2) * 64 + dcc;
  const bf16_t* gv = p.T + (size_t)b * 3072 * LROW + (size_t)(2048 + h * 128 + w * 16 + drr) * LROW + dcc;
  const int kdst = (w >> 2) * 8192 + (w & 3) * 2048, vdst = 32768 + w * 2048;
#define DIFF_DMA(kt, kb_, vs_) do { const bf16_t* _k = gk + (size_t)(kt) * 64 * NIN; const bf16_t* _v = gv + (kt) * 64; \
    __builtin_amdgcn_global_load_lds((const unsigned*)_k, (LAS unsigned*)(lds + (kb_) + kdst), 16, 0, 0); \
    __builtin_amdgcn_global_load_lds((const unsigned*)(_k + 32), (LAS unsigned*)(lds + (kb_) + kdst + 1024), 16, 0, 0); \
    __builtin_amdgcn_global_load_lds((const unsigned*)_v, (LAS unsigned*)(lds + (vs_) + vdst), 16, 0, 0); \
    __builtin_amdgcn_global_load_lds((const unsigned*)(_v + 32), (LAS unsigned*)(lds + (vs_) + vdst + 1024), 16, 0, 0); } while (0)
  DIFF_DMA(0, 0, 0);
  asm volatile("s_waitcnt vmcnt(0)" ::: "memory");
  __syncthreads();
  const int kfb0 = c * 8192 + sub16;
  const bool stag = (w >> 2) != 0;
  bf16x8 pfr[2][2];
  int vs = 0;
  for (int kt = 0; kt <= ktmax; ++kt) {
    const int kb = (kt & 1) * 16384;
    const int vsn = vs == 32768 ? 0 : vs + 16384;
    if (kt + 1 <= ktmax) DIFF_DMA(kt + 1, 16384 - kb, vsn);
    if (active && kt <= qc) {
      if (stag && kt > 0) diff_pv(lds, 32768 + (vs == 0 ? 32768 : vs - 16384), pfr, o, sub16);
      diff_tile(kt == 0 || kt == qc, lds, kfb0 + kb, qf, o, pfr, m0, m1, l0, l1, cj, slope2, kt, qrow, fq);
      if (!stag) diff_pv(lds, 32768 + vs, pfr, o, sub16);
    }
    vs = vsn;
    asm volatile("s_waitcnt vmcnt(0)" ::: "memory");
    __syncthreads();
  }
  if (active && stag) { const int lastslot = (qc % 3) * 16384; diff_pv(lds, 32768 + lastslot, pfr, o, sub16); }
#undef DIFF_DMA
  l0 += __shfl_xor(l0, 16); l0 += __shfl_xor(l0, 32);
  l1 += __shfl_xor(l1, 16); l1 += __shfl_xor(l1, 32);
  const int xb = 81920 + rgq * 16384 + lane * 4;
  if (!gsync) {
    if (tid == 0) { unsigned sp = 0; while (xb_ld(p.ctr + 32 + l) < 32u && ++sp < (1u << 22)) __builtin_amdgcn_s_sleep(2); }
    __syncthreads();
    __builtin_amdgcn_fence(__ATOMIC_ACQUIRE, "agent"); gsync = true;
  }
  u32x2 gpre[2][8];
  if (c == 0 && active) {
#pragma unroll
    for (int rb = 0; rb < 2; ++rb)
#pragma unroll
      for (int eb = 0; eb < 8; ++eb)
        gpre[rb][eb] = *(const u32x2*)(p.proj + ((size_t)b * LROW + qrow + rb * 16) * NIN + 7168 + h * 128 + eb * 16 + fq * 4);
  }
  if (c == 1 && active) {
#pragma unroll
    for (int rb = 0; rb < 2; ++rb) {
      const float inv = lam / (rb ? l1 : l0);
#pragma unroll
      for (int eb = 0; eb < 8; ++eb)
#pragma unroll
        for (int j = 0; j < 4; ++j) *(LAS float*)(lds + xb + ((rb * 8 + eb) * 4 + j) * 256) = o[rb][eb][j] * inv;
    }
  }
  __syncthreads();
  if (c == 0 && active) {
    float rn[2];
#pragma unroll
    for (int rb = 0; rb < 2; ++rb) {
      const float inv = 1.f / (rb ? l1 : l0);
      float ss = 0.f;
#pragma unroll
      for (int eb = 0; eb < 8; ++eb)
#pragma unroll
        for (int j = 0; j < 4; ++j) { const float d = o[rb][eb][j] * inv - *(const LAS float*)(lds + xb + ((rb * 8 + eb) * 4 + j) * 256); o[rb][eb][j] = d; ss += d * d; }
      ss += __shfl_xor(ss, 16); ss += __shfl_xor(ss, 32);
      rn[rb] = rsqrtf(ss * (1.f / 128.f) + 1e-6f) * (1.f - lam_init);
    }
    const size_t row0 = (size_t)b * LROW + qrow;
#pragma unroll
    for (int eb = 0; eb < 8; ++eb) {
      const int e0 = h * 128 + eb * 16 + fq * 4;
      const float4 gg = *(const float4*)(p.diff_g + l * 1024 + e0);
#pragma unroll
      for (int rb = 0; rb < 2; ++rb) {
        uint2 gu; gu.x = gpre[rb][eb][0]; gu.y = gpre[rb][eb][1];
        const float y0 = o[rb][eb][0] * rn[rb] * gg.x * silu(bflo(gu.x)), y1 = o[rb][eb][1] * rn[rb] * gg.y * silu(bfhi(gu.x));
        const float y2 = o[rb][eb][2] * rn[rb] * gg.z * silu(bflo(gu.y)), y3 = o[rb][eb][3] * rn[rb] * gg.w * silu(bfhi(gu.y));
        uint2 ov; ov.x = pk2(y0, y1); ov.y = pk2(y2, y3);
        *(uint2*)(p.mix + (row0 + rb * 16) * DM + 1024 + e0) = ov;
      }
    }
  }
}

DI void mixer_phase(const Params& p, int l, LAS unsigned char* lds) {
  volatile LAS int* s_item = (volatile LAS int*)(lds + 147456);
  const float lam = p.lam[l];
  const float lam_init = 0.8f - 0.6f * expf(-0.3f * (float)l);
  for (int c = (int)blockIdx.x - 32; c >= 0 && c < 32; c += (int)gridDim.x) ret_scan_chain(p, c >> 3, c & 7, lds, p.ctr + 34 + l);
  const int xcd = (int)(xb_xcc_id() & 7u);
  bool gsync = false, rsync = false;
  for (;;) {
    if (threadIdx.x == 0) *s_item = (int)atomicAdd(p.ctr + l * 8 + xcd, 1u);
    __syncthreads();
    const int it = *s_item;
    __syncthreads();
    if (it >= 68 + 22) break;
    if (it < 48 || it >= 70) {
      const int ai = it < 48 ? it : it - 22;
      const int bh = 4 * xcd + (ai & 3);
      diff_item(p, l, bh >> 3, bh & 7, 16 - (ai >> 2), lam, lam_init, lds, gsync);
    } else {
      if (!rsync) {
        if (threadIdx.x == 0) { unsigned sp = 0; while ((xb_ld(p.ctr + 34 + l) < 32u || xb_ld(p.ctr + 32 + l) < 32u) && ++sp < (1u << 22)) __builtin_amdgcn_s_sleep(2); }
        __syncthreads();
        __builtin_amdgcn_fence(__ATOMIC_ACQUIRE, "agent");
        rsync = true; gsync = true;
      }
      retention_items(p, l, lds, xcd + 48 * (it - 48), 8, 6);
      __syncthreads();
    }
  }
}

__global__ void __launch_bounds__(512) hymba_megakernel(Params p_unused) {
  cg::grid_group grid = cg::this_grid();
  extern __shared__ __attribute__((aligned(16))) char smem[];
  LAS unsigned char* lds = (LAS unsigned char*)smem;
  volatile LAS unsigned* xst = (volatile LAS unsigned*)(lds + 147456 + 16);
  if (threadIdx.x == 0) { xst[0] = 0u; xst[1] = 0u; }
  __syncthreads();
  XcdBarrier xb;
  { const Params p = load_params(); xb = xcd_barrier_post(p.bar, xst); }
  { const Params p = load_params(); prep_weights(p, lds, 0, 1792, blockIdx.x, gridDim.x, true); }
  { const Params p = load_params(); rownorm<0>(p); }
  grid.sync();
  for (int l = 0; l < 2; ++l) {
    { const Params p = load_params(); gemm1_phase(p, l, lds, 0, 1024); }
    xcd_barrier(xb);
    if (blockIdx.x < 32) {
      const Params p = load_params();
      gemm1_phase(p, l, lds, 1024, 1056);
      if (threadIdx.x == 0) {
        int nl = 0; for (int U = 1024 + (int)blockIdx.x; U < 1056; U += (int)gridDim.x) ++nl;
        __builtin_amdgcn_fence(__ATOMIC_RELEASE, "agent");
        asm volatile("s_waitcnt vmcnt(0)" ::: "memory");
        xb_add(p.ctr + 32 + l, (unsigned)nl);
      }
    }
    { const Params p = load_params(); mixer_phase(p, l, lds); }
    xcd_barrier(xb);
    { const Params p = load_params(); gemm2_phase(p, l, lds); }
    if (l == 0) { const Params p = load_params(); if (gridDim.x > 64) { if (blockIdx.x >= 64) prep_weights(p, lds, 1792, 2560, blockIdx.x - 64, gridDim.x - 64, false); } else prep_weights(p, lds, 1792, 2560, blockIdx.x, gridDim.x, false); }
    xcd_barrier(xb);
    if (l == 0) { { const Params p = load_params(); rownorm<1>(p); } xcd_barrier(xb); }
    else { const Params p = load_params(); rownorm<2>(p); }
  }
}

extern "C" void kernel_launch(void* const* d_in, const int* in_sizes, int n_in, void* d_out, int out_size, void* d_ws, size_t ws_size, hipStream_t stream) {
  static int grid_blocks = 0;
  if (!grid_blocks) {
    int dev = 0, cus = 0, per_cu = 0;
    hipGetDevice(&dev);
    hipDeviceGetAttribute(&cus, hipDeviceAttributeMultiprocessorCount, dev);
    hipFuncSetAttribute((const void*)hymba_megakernel, hipFuncAttributeMaxDynamicSharedMemorySize, SMEM_BYTES);
    hipOccupancyMaxActiveBlocksPerMultiprocessor(&per_cu, hymba_megakernel, 512, SMEM_BYTES);
    if (per_cu < 1) per_cu = 1;
    if (per_cu > 1) per_cu = 1;
    grid_blocks = cus * per_cu;
  }
  Params p{};
  p.x = (const float*)d_in[0]; p.meta = (const float*)d_in[1]; p.norm_g = (const float*)d_in[2]; p.w_in = (const float*)d_in[3];
  p.w_out = (const float*)d_in[4]; p.ret_g = (const float*)d_in[5]; p.diff_g = (const float*)d_in[6];
  p.lq1 = (const float*)d_in[7]; p.lk1 = (const float*)d_in[8]; p.lq2 = (const float*)d_in[9]; p.lk2 = (const float*)d_in[10];
  p.fin_g = (const float*)d_in[11];
  p.out = (float*)d_out;
  char* ws = (char*)d_ws; size_t off = 0;
  auto take = [&](size_t bytes) { char* r = ws + off; off += (bytes + 255) & ~(size_t)255; return r; };
  p.ctr = (unsigned*)take(256);
  p.bar = (unsigned*)take((size_t)XCD_BAR_WORDS * 4);
  p.ss = (float*)take((size_t)2 * MROWS * 4);
  p.lam = (float*)take(256);
  p.WinT = (bf16_t*)take((size_t)2 * NIN * DM * 2);
  p.WoutT = (bf16_t*)take((size_t)2 * DM * DM * 2);
  p.h = (float*)take((size_t)MROWS * DM * 4);
  p.hb = (bf16_t*)take((size_t)MROWS * DM * 2);
  p.proj = (bf16_t*)take((size_t)MROWS * NIN * 2);
  p.T = (bf16_t*)take((size_t)4 * 3072 * LROW * 2);
  p.mix = (bf16_t*)take((size_t)MROWS * DM * 2);
  p.ST = (bf16_t*)take((size_t)32 * NCH * 32768);
  p.P2 = (float*)take((size_t)8 * 256 * DM * 4);
  hipMemsetAsync(p.ctr, 0, 256 + (size_t)XCD_BAR_WORDS * 4 + (size_t)2 * MROWS * 4, stream);
  void* args[] = {&p};
  hipError_t e = hipLaunchCooperativeKernel((void*)hymba_megakernel, dim3(grid_blocks), dim3(512), args, SMEM_BYTES, stream);
  if (e != hipSuccess) fprintf(stderr, "cooperative launch failed: %s (grid %d)\n", hipGetErrorString(e), grid_blocks);
}
```
